# Optimizing an MI355X kernel written in HIP

```python
import math
import jax, jax.numpy as jnp
from jax import lax
import numpy as np

D_MODEL = 1024
BATCH = 1
SEQ = 16384
DEPTH = 1
DEC_BATCH = 32
DEC_SEQ = 64
PAST_LEN = 1024

CHUNK = 64
Q_BLOCK = 128
D_A = 64
H_A = D_MODEL // 128
H_I = 8
D_I = 32
TOPK_MAX = 256
H_B = D_MODEL // 256
D_BQK = 32
D_BV = 64
H_C = D_MODEL // 256
D_C = 64
N_MEM = 256
N_BUCKETS = 32
MAX_DIST = 128
EPS = 1e-6
NEG = -1e30
W_A = H_A * D_A
W_B = H_B * D_BV
W_C = H_C * D_C
D_MIX = W_A + W_B + W_C
SPLIT_SIZES = (W_A, W_A, W_A, W_A, H_I * D_I, D_I, H_I,
               H_B * 2 * D_BQK, H_B * 2 * D_BQK, W_B, W_B, W_C, W_C)
SPLIT_POINTS = tuple(int(v) for v in np.cumsum(SPLIT_SIZES)[:-1])
D_IN = int(sum(SPLIT_SIZES))

kernel_name = "hybrid_dsa_diff_mem_streaming_step"


def rmsnorm(x, g):
    xf = x.astype(jnp.float32)
    y = xf * lax.rsqrt(jnp.mean(xf * xf, axis=-1, keepdims=True) + EPS)
    return (y * g.astype(jnp.float32)).astype(x.dtype)


def rel_bucket(rel):
    nb = N_BUCKETS // 2
    ret = jnp.where(rel > 0, nb, 0)
    n = jnp.abs(rel)
    max_exact = nb // 2
    nf = jnp.maximum(n, 1).astype(jnp.float32)
    large = max_exact + (jnp.log(nf / max_exact) / math.log(MAX_DIST / max_exact)
                         * (nb - max_exact)).astype(jnp.int32)
    large = jnp.minimum(large, nb - 1)
    return ret + jnp.where(n < max_exact, n, large)


def qkv_proj(x, ln_g, w_in, a_qn, a_kn, b_qn, b_kn, c_qn):
    bn, t, _ = x.shape
    h = rmsnorm(x, ln_g)
    aq, ak, av, ag, iq, ik, iw, bq, bk, bv, bg, cq, cg = jnp.split(h @ w_in, SPLIT_POINTS, axis=-1)
    aq = rmsnorm(aq.reshape(bn, t, H_A, D_A), a_qn)
    ak = rmsnorm(ak.reshape(bn, t, H_A, D_A), a_kn)
    av = av.reshape(bn, t, H_A, D_A)
    iq = iq.reshape(bn, t, H_I, D_I)
    bq = rmsnorm(bq.reshape(bn, t, H_B, 2, D_BQK), b_qn)
    bk = rmsnorm(bk.reshape(bn, t, H_B, 2, D_BQK), b_kn)
    bv = bv.reshape(bn, t, H_B, D_BV)
    cq = rmsnorm(cq.reshape(bn, t, H_C, D_C), c_qn)
    return aq, ak, av, ag, iq, ik, iw, bq, bk, bv, bg, cq, cg


def mem_kv(mem, mem_ln, w_mem_kv, c_kn):
    bn, m, _ = mem.shape
    mk, mv = jnp.split(rmsnorm(mem, mem_ln) @ w_mem_kv, 2, axis=-1)
    return rmsnorm(mk.reshape(bn, m, H_C, D_C), c_kn), mv.reshape(bn, m, H_C, D_C)


def dsa_attend(aq, iq, iw, ak, av, ik, q_pos, k_pos, tab, topk):
    tq = q_pos.shape[0]
    adm = (k_pos[None, :] // CHUNK) <= (q_pos[:, None] // CHUNK)
    dots = jnp.einsum('bthd,bsd->bths', iq, ik)
    score = jnp.einsum('bth,bths->bts', iw, jax.nn.relu(dots)).astype(jnp.float32)
    score = jnp.where(adm[None], score, NEG)
    _, idx = lax.top_k(score, topk)
    valid = adm[jnp.arange(tq)[None, :, None], idx]
    k_sel = jax.vmap(lambda kb, ib: kb[ib])(ak, idx)
    v_sel = jax.vmap(lambda vb, ib: vb[ib])(av, idx)
    logits = jnp.einsum('bthd,btkhd->bthk', aq, k_sel).astype(jnp.float32) * (D_A ** -0.5)
    rel = k_pos[idx] - q_pos[None, :, None]
    logits = logits + jnp.swapaxes(tab[rel_bucket(rel)], -1, -2).astype(jnp.float32)
    logits = jnp.where(valid[:, :, None, :], logits, NEG)
    p = jax.nn.softmax(logits, axis=-1).astype(av.dtype)
    return jnp.einsum('bthk,btkhd->bthd', p, v_sel)


def diff_attend(bq, bk, bv, q_pos, k_pos, tab, lam, lam_init, subln_g):
    s = jnp.einsum('bthcd,bshcd->bchts', bq, bk).astype(jnp.float32) * (D_BQK ** -0.5)
    rel = k_pos[None, :] - q_pos[:, None]
    bias = jnp.transpose(tab[rel_bucket(rel)], (2, 0, 1)).astype(jnp.float32)
    adm = (k_pos[None, :] // CHUNK) <= (q_pos[:, None] // CHUNK)
    p = jax.nn.softmax(jnp.where(adm, s + bias, NEG), axis=-1)
    attn = p[:, 0] - lam * p[:, 1]
    o = jnp.einsum('bhts,bshd->bthd', attn.astype(bv.dtype), bv)
    return rmsnorm(o, subln_g) * (1.0 - lam_init)


def mem_attend(cq, mk, mv):
    s = jnp.einsum('bthd,bmhd->bhtm', cq, mk).astype(jnp.float32) * (D_C ** -0.5)
    p = jax.nn.softmax(s, axis=-1).astype(mv.dtype)
    return jnp.einsum('bhtm,bmhd->bthd', p, mv)


def diff_lambda(lq1, lk1, lq2, lk2, lam_init):
    f32 = jnp.float32
    return (jnp.exp(jnp.sum(lq1.astype(f32) * lk1.astype(f32)))
            - jnp.exp(jnp.sum(lq2.astype(f32) * lk2.astype(f32))) + lam_init)


def merge(x, oa, ob, oc, ag, bg, cg, w_out):
    bn, t, _ = x.shape
    o = jnp.concatenate([oa.reshape(bn, t, W_A) * jax.nn.silu(ag),
                         ob.reshape(bn, t, W_B) * jax.nn.silu(bg),
                         oc.reshape(bn, t, W_C) * jax.nn.silu(cg)], axis=-1)
    return x + o @ w_out


def setup_inputs(seed: int = 0) -> dict:
    key = jax.random.key(seed)
    ks = jax.random.split(key, 32)
    f32 = jnp.float32

    def nrm(k, shape, s=1.0):
        return jax.random.normal(k, shape, f32) * s

    def gain(k, shape):
        return 1.0 + 0.02 * jax.random.normal(k, shape, f32)

    return {
        "x_prompt": nrm(ks[0], (BATCH, SEQ, D_MODEL)),
        "x_sample": nrm(ks[1], (DEC_BATCH, DEC_SEQ, D_MODEL)),
        "mem_prompt": nrm(ks[2], (BATCH, N_MEM, D_MODEL)),
        "cache_a_k": nrm(ks[3], (DEPTH, DEC_BATCH, PAST_LEN, H_A, D_A)),
        "cache_a_v": nrm(ks[4], (DEPTH, DEC_BATCH, PAST_LEN, H_A, D_A)),
        "cache_a_kidx": nrm(ks[5], (DEPTH, DEC_BATCH, PAST_LEN, D_I)),
        "cache_b_k": nrm(ks[6], (DEPTH, DEC_BATCH, PAST_LEN, H_B, 2, D_BQK)),
        "cache_b_v": nrm(ks[7], (DEPTH, DEC_BATCH, PAST_LEN, H_B, D_BV)),
        "cache_mem_k": nrm(ks[8], (DEPTH, DEC_BATCH, N_MEM, H_C, D_C)),
        "cache_mem_v": nrm(ks[9], (DEPTH, DEC_BATCH, N_MEM, H_C, D_C)),
        "rel_table": nrm(ks[10], (N_BUCKETS, H_A + H_B), 0.5),
        "ln_g": gain(ks[11], (DEPTH, D_MODEL)),
        "w_in": nrm(ks[12], (DEPTH, D_MODEL, D_IN), D_MODEL ** -0.5),
        "w_out": nrm(ks[13], (DEPTH, D_MIX, D_MODEL), D_MIX ** -0.5),
        "a_qn": gain(ks[14], (DEPTH, D_A)),
        "a_kn": gain(ks[15], (DEPTH, D_A)),
        "b_qn": gain(ks[16], (DEPTH, D_BQK)),
        "b_kn": gain(ks[17], (DEPTH, D_BQK)),
        "b_subln": gain(ks[18], (DEPTH, D_BV)),
        "lam_q1": nrm(ks[19], (DEPTH, D_BQK), 0.1),
        "lam_k1": nrm(ks[20], (DEPTH, D_BQK), 0.1),
        "lam_q2": nrm(ks[21], (DEPTH, D_BQK), 0.1),
        "lam_k2": nrm(ks[22], (DEPTH, D_BQK), 0.1),
        "c_qn": gain(ks[23], (DEPTH, D_C)),
        "c_kn": gain(ks[24], (DEPTH, D_C)),
        "mem_ln": gain(ks[25], (DEPTH, D_MODEL)),
        "w_mem_kv": nrm(ks[26], (DEPTH, D_MODEL, 2 * W_C), D_MODEL ** -0.5),
    }


def reference(x_prompt, x_sample, mem_prompt, cache_a_k, cache_a_v, cache_a_kidx, cache_b_k,
              cache_b_v, cache_mem_k, cache_mem_v, rel_table, ln_g, w_in, w_out, a_qn, a_kn,
              b_qn, b_kn, b_subln, lam_q1, lam_k1, lam_q2, lam_k2, c_qn, c_kn, mem_ln, w_mem_kv):
    tab_a = rel_table[:, :H_A]
    tab_b = rel_table[:, H_A:]

    t_p = x_prompt.shape[1]
    pos_p = jnp.arange(t_p, dtype=jnp.int32)
    topk_p = min(TOPK_MAX, t_p // 4)
    n_blk = t_p // Q_BLOCK

    def to_blocks(t):
        return jnp.moveaxis(t.reshape((t.shape[0], n_blk, Q_BLOCK) + t.shape[2:]), 1, 0)

    def from_blocks(t):
        t = jnp.moveaxis(t, 0, 1)
        return t.reshape((t.shape[0], t_p) + t.shape[3:])

    p_ak, p_av, p_aki, p_bk, p_bv, p_mk, p_mv = [], [], [], [], [], [], []
    h = x_prompt
    for l in range(DEPTH):
        lam_init = 0.8 - 0.6 * math.exp(-0.3 * l)
        lam = diff_lambda(lam_q1[l], lam_k1[l], lam_q2[l], lam_k2[l], lam_init)
        aq, ak, av, ag, iq, ik, iw, bq, bk, bv, bg, cq, cg = qkv_proj(
            h, ln_g[l], w_in[l], a_qn[l], a_kn[l], b_qn[l], b_kn[l], c_qn[l])
        mk, mv = mem_kv(mem_prompt, mem_ln[l], w_mem_kv[l], c_kn[l])
        sub_g = b_subln[l]

        def block_step(args):
            aq_b, iq_b, iw_b, bq_b, qp = args
            oa_b = dsa_attend(aq_b, iq_b, iw_b, ak, av, ik, qp, pos_p, tab_a, topk_p)
            ob_b = diff_attend(bq_b, bk, bv, qp, pos_p, tab_b, lam, lam_init, sub_g)
            return oa_b, ob_b

        oa, ob = lax.map(block_step, (to_blocks(aq), to_blocks(iq), to_blocks(iw), to_blocks(bq),
                                      pos_p.reshape(n_blk, Q_BLOCK)))
        oc = mem_attend(cq, mk, mv)
        h = merge(h, from_blocks(oa), from_blocks(ob), oc, ag, bg, cg, w_out[l])
        p_ak.append(ak); p_av.append(av); p_aki.append(ik)
        p_bk.append(bk); p_bv.append(bv); p_mk.append(mk); p_mv.append(mv)
    y_prompt = h

    t_s = x_sample.shape[1]
    past = cache_a_k.shape[2]
    l_tot = past + t_s
    q_pos_s = past + jnp.arange(t_s, dtype=jnp.int32)
    k_pos_s = jnp.arange(l_tot, dtype=jnp.int32)
    topk_s = min(TOPK_MAX, l_tot // 4)

    s_ak, s_av, s_aki, s_bk, s_bv = [], [], [], [], []
    g = x_sample
    for l in range(DEPTH):
        lam_init = 0.8 - 0.6 * math.exp(-0.3 * l)
        lam = diff_lambda(lam_q1[l], lam_k1[l], lam_q2[l], lam_k2[l], lam_init)
        aq, ak, av, ag, iq, ik, iw, bq, bk, bv, bg, cq, cg = qkv_proj(
            g, ln_g[l], w_in[l], a_qn[l], a_kn[l], b_qn[l], b_kn[l], c_qn[l])
        akf = jnp.concatenate([cache_a_k[l], ak], axis=1)
        avf = jnp.concatenate([cache_a_v[l], av], axis=1)
        ikf = jnp.concatenate([cache_a_kidx[l], ik], axis=1)
        bkf = jnp.concatenate([cache_b_k[l], bk], axis=1)
        bvf = jnp.concatenate([cache_b_v[l], bv], axis=1)

        def dsa_one(args):
            q1, i1, w1, k1, v1, ik1 = args
            return dsa_attend(q1[None], i1[None], w1[None], k1[None], v1[None], ik1[None],
                              q_pos_s, k_pos_s, tab_a, topk_s)[0]

        oa = lax.map(dsa_one, (aq, iq, iw, akf, avf, ikf))
        ob = diff_attend(bq, bkf, bvf, q_pos_s, k_pos_s, tab_b, lam, lam_init, b_subln[l])
        oc = mem_attend(cq, cache_mem_k[l], cache_mem_v[l])
        g = merge(g, oa, ob, oc, ag, bg, cg, w_out[l])
        s_ak.append(ak); s_av.append(av); s_aki.append(ik); s_bk.append(bk); s_bv.append(bv)
    y_sample = g

    p_a_k = jnp.stack(p_ak); p_a_v = jnp.stack(p_av); p_a_kidx = jnp.stack(p_aki)
    p_b_k = jnp.stack(p_bk); p_b_v = jnp.stack(p_bv)
    p_mem_k = jnp.stack(p_mk); p_mem_v = jnp.stack(p_mv)
    s_a_k = jnp.stack(s_ak); s_a_v = jnp.stack(s_av); s_a_kidx = jnp.stack(s_aki)
    s_b_k = jnp.stack(s_bk); s_b_v = jnp.stack(s_bv)
    return (y_prompt, y_sample, p_a_k, p_a_v, p_a_kidx, p_b_k, p_b_v, p_mem_k, p_mem_v,
            s_a_k, s_a_v, s_a_kidx, s_b_k, s_b_v)
```

```cpp
#include <hip/hip_runtime.h>
#include <hip/hip_cooperative_groups.h>
#include <cstdio>
#include <cstdint>
namespace cg = cooperative_groups;

#define NT 256
#define ONE_LAUNCH 1

constexpr int D = 1024, SEQ = 16384, DECB = 32, DECS = 64, PAST = 1024, NMEM = 256;
constexpr int MROWS = SEQ + DECB * DECS;
constexpr int DIN = 3880;
constexpr int LDP = 2312;
constexpr int PC_AQ = 0, PC_AG = 512, PC_IQ = 1024, PC_IW = 1280, PC_BQ = 1288, PC_BG = 1544, PC_CQ = 1800, PC_CG = 2056;
constexpr float EPS = 1e-6f;

constexpr size_t O_YP = 0, O_YS = 16777216, O_PAK = 18874368, O_PAV = 27262976, O_PAKI = 35651584, O_PBK = 36175872,
                 O_PBV = 40370176, O_PMK = 44564480, O_PMV = 44630016, O_SAK = 44695552, O_SAV = 45744128,
                 O_SAKI = 46792704, O_SBK = 46858240, O_SBV = 47382528;

constexpr size_t WS_H = 0;
constexpr size_t WS_HM = WS_H + (size_t)MROWS * D * 4;
constexpr size_t WS_P = WS_HM + (size_t)NMEM * D * 4;
constexpr size_t WS_END = WS_P + (size_t)MROWS * LDP * 4;

struct Params {
    const float* in[27];
    float* out;
    unsigned char* ws;
    int ph_lo, ph_hi;
};

__device__ __forceinline__ float wave_sum(float v) {
#pragma unroll
    for (int o = 1; o < 64; o <<= 1) v += __shfl_xor(v, o);
    return v;
}
__device__ __forceinline__ float wave_max(float v) {
#pragma unroll
    for (int o = 1; o < 64; o <<= 1) v = fmaxf(v, __shfl_xor(v, o));
    return v;
}
__device__ __forceinline__ float silu(float x) { return x / (1.0f + expf(-x)); }

__device__ __forceinline__ int rel_bucket(int rel) {
    const int ret = rel > 0 ? 16 : 0;
    const int n = rel < 0 ? -rel : rel;
    int b;
    if (n < 8) b = n;
    else if (n < 12) b = 8;
    else if (n < 16) b = 9;
    else if (n < 23) b = 10;
    else if (n < 32) b = 11;
    else if (n < 46) b = 12;
    else if (n < 64) b = 13;
    else if (n < 91) b = 14;
    else b = 15;
    return ret + b;
}

__device__ __forceinline__ void rms_row(const float* x, const float* g, float* o, int lane) {
    const float4* xr = (const float4*)x;
    const float4* gr = (const float4*)g;
    float4 v[4];
    float s = 0.f;
#pragma unroll
    for (int j = 0; j < 4; ++j) { v[j] = xr[lane + 64 * j]; s += v[j].x * v[j].x + v[j].y * v[j].y + v[j].z * v[j].z + v[j].w * v[j].w; }
    s = wave_sum(s);
    const float r = 1.0f / sqrtf(s * (1.0f / 1024.0f) + EPS);
#pragma unroll
    for (int j = 0; j < 4; ++j) {
        const float4 gg = gr[lane + 64 * j];
        float4 o4; o4.x = v[j].x * r * gg.x; o4.y = v[j].y * r * gg.y; o4.z = v[j].z * r * gg.z; o4.w = v[j].w * r * gg.w;
        ((float4*)o)[lane + 64 * j] = o4;
    }
}

__device__ void phase0(const Params& p) {
    const int lane = threadIdx.x & 63, w = threadIdx.x >> 6;
    const int gw = blockIdx.x * 4 + w, ngw = gridDim.x * 4;
    float* H = (float*)(p.ws + WS_H);
    float* HM = (float*)(p.ws + WS_HM);
    for (int r = gw; r < MROWS + NMEM; r += ngw) {
        if (r < SEQ) rms_row(p.in[0] + (size_t)r * D, p.in[11], H + (size_t)r * D, lane);
        else if (r < MROWS) rms_row(p.in[1] + (size_t)(r - SEQ) * D, p.in[11], H + (size_t)r * D, lane);
        else rms_row(p.in[2] + (size_t)(r - MROWS) * D, p.in[25], HM + (size_t)(r - MROWS) * D, lane);
    }
}

struct SmemGemm { float As[16][68]; float Bs[16][68]; float Cs[64][65]; };

template <class BCol>
__device__ __forceinline__ void sgemm64(const float* __restrict__ A, int lda, const float* __restrict__ B, int ldb, int K, int m0, int n0, int nvalid, BCol bcol, SmemGemm& S) {
    const int tid = threadIdx.x, tx = tid & 15, ty = tid >> 4;
    float acc[4][4];
#pragma unroll
    for (int i = 0; i < 4; ++i)
#pragma unroll
        for (int j = 0; j < 4; ++j) acc[i][j] = 0.f;
    const int arow = tid >> 2, akq = tid & 3;
    const int bk = tid >> 4, bnq = tid & 15;
    const bool bvalid = (4 * bnq) < nvalid;
    const int bc = bvalid ? bcol(n0 + 4 * bnq) : 0;
    const float* Ap = A + (size_t)(m0 + arow) * lda + 4 * akq;
    const float* Bp = B + (size_t)bk * ldb + bc;
    for (int k0 = 0; k0 < K; k0 += 16) {
        const float4 a4 = *(const float4*)(Ap + k0);
        float4 b4 = make_float4(0.f, 0.f, 0.f, 0.f);
        if (bvalid) b4 = *(const float4*)(Bp + (size_t)k0 * ldb);
        __syncthreads();
        S.As[4 * akq + 0][arow] = a4.x; S.As[4 * akq + 1][arow] = a4.y; S.As[4 * akq + 2][arow] = a4.z; S.As[4 * akq + 3][arow] = a4.w;
        *(float4*)&S.Bs[bk][4 * bnq] = b4;
        __syncthreads();
#pragma unroll
        for (int kk = 0; kk < 16; ++kk) {
            const float4 a = *(const float4*)&S.As[kk][ty * 4];
            const float4 b = *(const float4*)&S.Bs[kk][tx * 4];
            const float av[4] = {a.x, a.y, a.z, a.w}, bv[4] = {b.x, b.y, b.z, b.w};
#pragma unroll
            for (int i = 0; i < 4; ++i)
#pragma unroll
                for (int j = 0; j < 4; ++j) acc[i][j] = fmaf(av[i], bv[j], acc[i][j]);
        }
    }
    __syncthreads();
#pragma unroll
    for (int i = 0; i < 4; ++i)
#pragma unroll
        for (int j = 0; j < 4; ++j) S.Cs[ty * 4 + i][tx * 4 + j] = acc[i][j];
    __syncthreads();
}

__device__ __forceinline__ int inproj_col(int np) { return np < 2304 ? np : (np < 3840 ? np + 40 : np - 3840 + 2304); }

struct Seg { float* bp; float* bs; int ld; int col; int norm; const float* gain; };

__device__ __forceinline__ Seg seg_of(const Params& p, int n0) {
    float* P = (float*)(p.ws + WS_P);
    float* out = p.out;
    Seg s; s.norm = 0; s.gain = nullptr;
    auto setP = [&](int pc, int c) { s.bp = P; s.bs = P; s.ld = LDP; s.col = pc + c; };
    auto setO = [&](size_t op, size_t os, int ld, int c) { s.bp = out + op; s.bs = out + os - (size_t)SEQ * ld; s.ld = ld; s.col = c; };
    if (n0 < 512) { setP(PC_AQ, n0); s.norm = 64; s.gain = p.in[14]; }
    else if (n0 < 1024) { setO(O_PAK, O_SAK, 512, n0 - 512); s.norm = 64; s.gain = p.in[15]; }
    else if (n0 < 1536) { setO(O_PAV, O_SAV, 512, n0 - 1024); }
    else if (n0 < 2048) { setP(PC_AG, n0 - 1536); }
    else if (n0 < 2304) { setP(PC_IQ, n0 - 2048); }
    else if (n0 < 2560) { setP(PC_BQ, n0 - 2304); s.norm = 32; s.gain = p.in[16]; }
    else if (n0 < 2816) { setO(O_PBK, O_SBK, 256, n0 - 2560); s.norm = 32; s.gain = p.in[17]; }
    else if (n0 < 3072) { setO(O_PBV, O_SBV, 256, n0 - 2816); }
    else if (n0 < 3328) { setP(PC_BG, n0 - 3072); }
    else if (n0 < 3584) { setP(PC_CQ, n0 - 3328); s.norm = 64; s.gain = p.in[23]; }
    else { setP(PC_CG, n0 - 3584); }
    return s;
}

__device__ void phase1(const Params& p, unsigned char* smem) {
    SmemGemm& S = *(SmemGemm*)smem;
    const int tid = threadIdx.x;
    const float* H = (const float*)(p.ws + WS_H);
    const float* HM = (const float*)(p.ws + WS_HM);
    float* P = (float*)(p.ws + WS_P);
    constexpr int NCT = 61, NRT = MROWS / 64;
    constexpr int N_IN = NCT * NRT, N_MEM = 4 * 8;
    for (int it = blockIdx.x; it < N_IN + N_MEM; it += gridDim.x) {
        if (it < N_IN) {
            const int rt = it / NCT, ct = it % NCT;
            const int m0 = rt * 64, n0 = ct * 64;
            const int nvalid = (ct == NCT - 1) ? 40 : 64;
            sgemm64(H, D, p.in[12], DIN, D, m0, n0, nvalid, [](int np) { return inproj_col(np); }, S);
            const int r = tid >> 2, qd = tid & 3, row = m0 + r;
            if (ct < NCT - 1) {
                const Seg s = seg_of(p, n0);
                float scale = 1.f;
                if (s.norm == 64) { float ss = 0.f; for (int c = 0; c < 64; ++c) ss += S.Cs[r][c] * S.Cs[r][c]; scale = 1.0f / sqrtf(ss * (1.0f / 64.0f) + EPS); }
                else if (s.norm == 32) { float ss = 0.f; const int c0 = (qd >> 1) * 32; for (int c = 0; c < 32; ++c) ss += S.Cs[r][c0 + c] * S.Cs[r][c0 + c]; scale = 1.0f / sqrtf(ss * (1.0f / 32.0f) + EPS); }
                float* dst = (row < SEQ ? s.bp : s.bs) + (size_t)row * s.ld + s.col + 16 * qd;
#pragma unroll
                for (int i = 0; i < 16; ++i) {
                    const int c = 16 * qd + i;
                    float v = S.Cs[r][c];
                    if (s.norm == 64) v = v * scale * s.gain[c];
                    else if (s.norm == 32) v = v * scale * s.gain[c & 31];
                    dst[i] = v;
                }
            } else {
                if (qd < 2) {
                    float* dst = (row < SEQ ? p.out + O_PAKI + (size_t)row * 32 : p.out + O_SAKI + (size_t)(row - SEQ) * 32) + 16 * qd;
#pragma unroll
                    for (int i = 0; i < 16; ++i) dst[i] = S.Cs[r][16 * qd + i];
                } else if (qd == 2) {
                    float* dst = P + (size_t)row * LDP + PC_IW;
#pragma unroll
                    for (int i = 0; i < 8; ++i) dst[i] = S.Cs[r][32 + i];
                }
            }
        } else {
            const int im = it - N_IN, rt = im / 8, ct = im % 8;
            const int m0 = rt * 64, n0 = ct * 64;
            sgemm64(HM, D, p.in[26], 512, D, m0, n0, 64, [](int np) { return np; }, S);
            const int r = tid >> 2, qd = tid & 3, row = m0 + r;
            const bool isk = n0 < 256;
            float scale = 1.f;
            if (isk) { float ss = 0.f; for (int c = 0; c < 64; ++c) ss += S.Cs[r][c] * S.Cs[r][c]; scale = 1.0f / sqrtf(ss * (1.0f / 64.0f) + EPS); }
            float* dst = p.out + (isk ? O_PMK : O_PMV) + (size_t)row * 256 + (isk ? n0 : n0 - 256) + 16 * qd;
#pragma unroll
            for (int i = 0; i < 16; ++i) {
                const int c = 16 * qd + i;
                float v = S.Cs[r][c];
                if (isk) v = v * scale * p.in[24][c];
                dst[i] = v;
            }
        }
    }
}

struct KeySrc {
    const float* cache; const float* fresh; int past; int ld;
    __device__ __forceinline__ const float* row(int k) const { return k < past ? cache + (size_t)k * ld : fresh + (size_t)(k - past) * ld; }
};

__device__ __forceinline__ unsigned fkey(float f) { const unsigned u = __float_as_uint(f); return (u & 0x80000000u) ? ~u : (u | 0x80000000u); }

struct SmemDsa {
    float sc[16384];
    float iq[256]; float iw[8]; float qv[512];
    unsigned hist[256]; int sel[256]; float lg[8][256];
    int wcnt[4]; int wcnt2[4]; int misc[4];
};

__device__ void dsa_item(const Params& p, unsigned char* smem, int item) {
    SmemDsa& S = *(SmemDsa*)smem;
    const int tid = threadIdx.x, lane = tid & 63, w = tid >> 6;
    const float* P = (const float*)(p.ws + WS_P);
    float* O = (float*)(p.ws + WS_H);
    int row, N, qpos; KeySrc ki, kk, kv;
    if (item < SEQ) {
        row = item; N = 64 * (item / 64 + 1); qpos = item;
        ki = KeySrc{nullptr, p.out + O_PAKI, 0, 32}; kk = KeySrc{nullptr, p.out + O_PAK, 0, 512}; kv = KeySrc{nullptr, p.out + O_PAV, 0, 512};
    } else {
        const int bt = item - SEQ, b = bt / DECS, t = bt % DECS;
        row = item; N = PAST + DECS; qpos = PAST + t;
        ki = KeySrc{p.in[5] + (size_t)b * PAST * 32, p.out + O_SAKI + (size_t)b * DECS * 32, PAST, 32};
        kk = KeySrc{p.in[3] + (size_t)b * PAST * 512, p.out + O_SAK + (size_t)b * DECS * 512, PAST, 512};
        kv = KeySrc{p.in[4] + (size_t)b * PAST * 512, p.out + O_SAV + (size_t)b * DECS * 512, PAST, 512};
    }
    __syncthreads();
    S.iq[tid] = P[(size_t)row * LDP + PC_IQ + tid];
    if (tid < 8) S.iw[tid] = P[(size_t)row * LDP + PC_IW + tid];
    S.qv[tid] = P[(size_t)row * LDP + PC_AQ + tid];
    S.qv[tid + 256] = P[(size_t)row * LDP + PC_AQ + 256 + tid];
    __syncthreads();
    int cnt;
    if (N <= 256) {
        cnt = N;
        S.sel[tid] = tid;
        __syncthreads();
    } else {
        cnt = 256;
        for (int k = tid; k < N; k += NT) {
            const float4* kr = (const float4*)ki.row(k);
            float kd[32];
#pragma unroll
            for (int i = 0; i < 8; ++i) { const float4 t4 = kr[i]; kd[4 * i] = t4.x; kd[4 * i + 1] = t4.y; kd[4 * i + 2] = t4.z; kd[4 * i + 3] = t4.w; }
            float score = 0.f;
#pragma unroll
            for (int h = 0; h < 8; ++h) {
                float d = 0.f;
#pragma unroll
                for (int i = 0; i < 32; ++i) d = fmaf(S.iq[h * 32 + i], kd[i], d);
                score = fmaf(S.iw[h], fmaxf(d, 0.f), score);
            }
            S.sc[k] = score;
        }
        __syncthreads();
        unsigned prefix = 0; int remaining = 256; int eqcount = 0;
        for (int pass = 0; pass < 4; ++pass) {
            const int shift = 24 - 8 * pass;
            S.hist[tid] = 0;
            __syncthreads();
            for (int k = tid; k < N; k += NT) {
                const unsigned key = fkey(S.sc[k]);
                if (pass == 0 || (key >> (shift + 8)) == prefix) atomicAdd(&S.hist[(key >> shift) & 255u], 1u);
            }
            __syncthreads();
            const int hv = (int)S.hist[tid];
            int x = hv;
#pragma unroll
            for (int o = 1; o < 64; o <<= 1) { const int y = __shfl_down(x, o); if (lane + o < 64) x += y; }
            if (lane == 0) S.wcnt[w] = x;
            __syncthreads();
            int above = x - hv;
            for (int w2 = w + 1; w2 < 4; ++w2) above += S.wcnt[w2];
            if (above < remaining && remaining <= above + hv) { S.misc[0] = (int)((prefix << 8) | (unsigned)tid); S.misc[1] = remaining - above; S.misc[2] = hv; }
            __syncthreads();
            prefix = (unsigned)S.misc[0]; remaining = S.misc[1]; eqcount = S.misc[2];
            __syncthreads();
        }
        const unsigned T = prefix; const int r = remaining;
        (void)eqcount;
        int base_sel = 0, base_eq = 0;
        const unsigned long long lt = (lane == 0) ? 0ull : (~0ull >> (64 - lane));
        for (int k0 = 0; k0 < N; k0 += NT) {
            const int k = k0 + tid;
            const unsigned key = (k < N) ? fkey(S.sc[k]) : 0u;
            const bool gt = (k < N) && key > T, eq = (k < N) && key == T;
            const unsigned long long beq = __ballot(eq);
            const int eqpre = __popcll(beq & lt);
            if (lane == 0) S.wcnt[w] = __popcll(beq);
            __syncthreads();
            int eqbase = base_eq, eqtot = 0;
            for (int w2 = 0; w2 < 4; ++w2) { const int c = S.wcnt[w2]; if (w2 < w) eqbase += c; eqtot += c; }
            const bool s = gt || (eq && (eqbase + eqpre) < r);
            const unsigned long long bs = __ballot(s);
            const int spre = __popcll(bs & lt);
            if (lane == 0) S.wcnt2[w] = __popcll(bs);
            __syncthreads();
            int sbase = base_sel, stot = 0;
            for (int w2 = 0; w2 < 4; ++w2) { const int c = S.wcnt2[w2]; if (w2 < w) sbase += c; stot += c; }
            if (s && (sbase + spre) < 256) S.sel[sbase + spre] = k;
            base_eq += eqtot; base_sel += stot;
        }
        __syncthreads();
    }
    {
        const int j = tid;
        if (j < cnt) {
            const int k = S.sel[j];
            const float4* kr = (const float4*)kk.row(k);
            const int bkt = rel_bucket(k - qpos);
#pragma unroll 1
            for (int h = 0; h < 8; ++h) {
                float d = 0.f;
#pragma unroll
                for (int i = 0; i < 16; ++i) {
                    const float4 t4 = kr[h * 16 + i];
                    const float4 q4 = *(const float4*)&S.qv[h * 64 + 4 * i];
                    d = fmaf(q4.x, t4.x, d); d = fmaf(q4.y, t4.y, d); d = fmaf(q4.z, t4.z, d); d = fmaf(q4.w, t4.w, d);
                }
                S.lg[h][j] = d * 0.125f + p.in[10][bkt * 12 + h];
            }
        } else {
#pragma unroll
            for (int h = 0; h < 8; ++h) S.lg[h][j] = -INFINITY;
        }
    }
    __syncthreads();
#pragma unroll
    for (int hh = 0; hh < 2; ++hh) {
        const int h = 2 * w + hh;
        float v[4]; float m = -INFINITY;
#pragma unroll
        for (int i = 0; i < 4; ++i) { v[i] = S.lg[h][lane + 64 * i]; m = fmaxf(m, v[i]); }
        m = wave_max(m);
        float s = 0.f;
#pragma unroll
        for (int i = 0; i < 4; ++i) { v[i] = expf(v[i] - m); s += v[i]; }
        s = wave_sum(s);
        const float inv = 1.0f / s;
#pragma unroll
        for (int i = 0; i < 4; ++i) S.lg[h][lane + 64 * i] = v[i] * inv;
    }
    __syncthreads();
    {
        float acc0 = 0.f, acc1 = 0.f;
        const int h0 = tid >> 6, h1 = 4 + (tid >> 6);
        for (int j = 0; j < cnt; ++j) {
            const float* vr = kv.row(S.sel[j]);
            acc0 = fmaf(S.lg[h0][j], vr[tid], acc0);
            acc1 = fmaf(S.lg[h1][j], vr[256 + tid], acc1);
        }
        const float g0 = P[(size_t)row * LDP + PC_AG + tid], g1 = P[(size_t)row * LDP + PC_AG + 256 + tid];
        O[(size_t)row * D + tid] = acc0 * silu(g0);
        O[(size_t)row * D + 256 + tid] = acc1 * silu(g1);
    }
}

struct SmemDiff { float qv[8][256]; float pb[8][256][8]; };

__device__ void diff_item(const Params& p, unsigned char* smem, int item, float lam) {
    SmemDiff& S = *(SmemDiff*)smem;
    const int tid = threadIdx.x;
    const float* P = (const float*)(p.ws + WS_P);
    float* O = (float*)(p.ws + WS_H);
    int row0, N, qpos0; KeySrc kk, kv;
    if (item < SEQ / 8) {
        row0 = item * 8; N = 64 * (row0 / 64 + 1); qpos0 = row0;
        kk = KeySrc{nullptr, p.out + O_PBK, 0, 256}; kv = KeySrc{nullptr, p.out + O_PBV, 0, 256};
    } else {
        const int bt = (item - SEQ / 8) * 8, b = bt / DECS, t = bt % DECS;
        row0 = SEQ + bt; N = PAST + DECS; qpos0 = PAST + t;
        kk = KeySrc{p.in[6] + (size_t)b * PAST * 256, p.out + O_SBK + (size_t)b * DECS * 256, PAST, 256};
        kv = KeySrc{p.in[7] + (size_t)b * PAST * 256, p.out + O_SBV + (size_t)b * DECS * 256, PAST, 256};
    }
    __syncthreads();
#pragma unroll
    for (int qi = 0; qi < 8; ++qi) S.qv[qi][tid] = P[(size_t)(row0 + qi) * LDP + PC_BQ + tid];
    __syncthreads();
    const int h = tid >> 6, d = tid & 63;
    float acc0[8], acc1[8], l0[8], l1[8];
#pragma unroll
    for (int qi = 0; qi < 8; ++qi) { acc0[qi] = 0.f; acc1[qi] = 0.f; l0[qi] = 0.f; l1[qi] = 0.f; }
    const float* tabb = p.in[10] + 8;
    for (int k0 = 0; k0 < N; k0 += NT) {
        {
            const int k = k0 + tid;
            const bool valid = k < N;
            const float4* kr = (const float4*)kk.row(valid ? k : 0);
            int bkt[8];
#pragma unroll
            for (int qi = 0; qi < 8; ++qi) bkt[qi] = rel_bucket(k - (qpos0 + qi)) * 12;
#pragma unroll 1
            for (int hc = 0; hc < 8; ++hc) {
                float kd[32];
#pragma unroll
                for (int i = 0; i < 8; ++i) { const float4 t4 = kr[hc * 8 + i]; kd[4 * i] = t4.x; kd[4 * i + 1] = t4.y; kd[4 * i + 2] = t4.z; kd[4 * i + 3] = t4.w; }
                float pv[8];
#pragma unroll
                for (int qi = 0; qi < 8; ++qi) {
                    float s = 0.f;
#pragma unroll
                    for (int i = 0; i < 32; ++i) s = fmaf(S.qv[qi][hc * 32 + i], kd[i], s);
                    const float logit = s * 0.17677669529663687f + tabb[bkt[qi] + (hc >> 1)];
                    pv[qi] = valid ? expf(logit) : 0.f;
                }
                *(float4*)&S.pb[hc][tid][0] = make_float4(pv[0], pv[1], pv[2], pv[3]);
                *(float4*)&S.pb[hc][tid][4] = make_float4(pv[4], pv[5], pv[6], pv[7]);
            }
        }
        __syncthreads();
        {
            const int jn = (N - k0) < NT ? (N - k0) : NT;
            for (int j = 0; j < jn; ++j) {
                const float v = kv.row(k0 + j)[h * 64 + d];
                const float4 a0 = *(const float4*)&S.pb[2 * h][j][0], a1 = *(const float4*)&S.pb[2 * h][j][4];
                const float4 b0 = *(const float4*)&S.pb[2 * h + 1][j][0], b1 = *(const float4*)&S.pb[2 * h + 1][j][4];
                const float pa[8] = {a0.x, a0.y, a0.z, a0.w, a1.x, a1.y, a1.z, a1.w};
                const float pbv[8] = {b0.x, b0.y, b0.z, b0.w, b1.x, b1.y, b1.z, b1.w};
#pragma unroll
                for (int qi = 0; qi < 8; ++qi) { acc0[qi] = fmaf(pa[qi], v, acc0[qi]); acc1[qi] = fmaf(pbv[qi], v, acc1[qi]); l0[qi] += pa[qi]; l1[qi] += pbv[qi]; }
            }
        }
        __syncthreads();
    }
    const float gsub = p.in[18][d];
#pragma unroll
    for (int qi = 0; qi < 8; ++qi) {
        const float o = acc0[qi] / l0[qi] - lam * (acc1[qi] / l1[qi]);
        const float ss = wave_sum(o * o);
        const float on = o * (1.0f / sqrtf(ss * (1.0f / 64.0f) + EPS)) * gsub * 0.8f;
        const int row = row0 + qi;
        const float g = P[(size_t)row * LDP + PC_BG + tid];
        O[(size_t)row * D + 512 + tid] = on * silu(g);
    }
}

struct SmemMem { float qv[256]; float lg[4][256]; };

__device__ void mem_item(const Params& p, unsigned char* smem, int item) {
    SmemMem& S = *(SmemMem*)smem;
    const int tid = threadIdx.x, lane = tid & 63, w = tid >> 6;
    const float* P = (const float*)(p.ws + WS_P);
    float* O = (float*)(p.ws + WS_H);
    const int row = item;
    const float *mk, *mv;
    if (row < SEQ) { mk = p.out + O_PMK; mv = p.out + O_PMV; }
    else { const int b = (row - SEQ) / DECS; mk = p.in[8] + (size_t)b * NMEM * 256; mv = p.in[9] + (size_t)b * NMEM * 256; }
    __syncthreads();
    S.qv[tid] = P[(size_t)row * LDP + PC_CQ + tid];
    __syncthreads();
    {
        const float4* kr = (const float4*)(mk + (size_t)tid * 256);
#pragma unroll 1
        for (int h = 0; h < 4; ++h) {
            float dsum = 0.f;
#pragma unroll
            for (int i = 0; i < 16; ++i) {
                const float4 t4 = kr[h * 16 + i];
                const float4 q4 = *(const float4*)&S.qv[h * 64 + 4 * i];
                dsum = fmaf(q4.x, t4.x, dsum); dsum = fmaf(q4.y, t4.y, dsum); dsum = fmaf(q4.z, t4.z, dsum); dsum = fmaf(q4.w, t4.w, dsum);
            }
            S.lg[h][tid] = dsum * 0.125f;
        }
    }
    __syncthreads();
    {
        const int h = w;
        float v[4]; float m = -INFINITY;
#pragma unroll
        for (int i = 0; i < 4; ++i) { v[i] = S.lg[h][lane + 64 * i]; m = fmaxf(m, v[i]); }
        m = wave_max(m);
        float s = 0.f;
#pragma unroll
        for (int i = 0; i < 4; ++i) { v[i] = expf(v[i] - m); s += v[i]; }
        s = wave_sum(s);
        const float inv = 1.0f / s;
#pragma unroll
        for (int i = 0; i < 4; ++i) S.lg[h][lane + 64 * i] = v[i] * inv;
    }
    __syncthreads();
    {
        const int h = tid >> 6;
        float acc = 0.f;
        for (int j = 0; j < NMEM; ++j) acc = fmaf(S.lg[h][j], mv[(size_t)j * 256 + tid], acc);
        const float g = P[(size_t)row * LDP + PC_CG + tid];
        O[(size_t)row * D + 768 + tid] = acc * silu(g);
    }
}

__device__ void phase2(const Params& p, unsigned char* smem) {
    float s1 = 0.f, s2 = 0.f;
    for (int i = 0; i < 32; ++i) { s1 = fmaf(p.in[19][i], p.in[20][i], s1); s2 = fmaf(p.in[21][i], p.in[22][i], s2); }
    const float lam = expf(s1) - expf(s2) + 0.2f;
    constexpr int N_DIFF = MROWS / 8, N_DSA = MROWS, N_MEMA = MROWS;
    for (int it = blockIdx.x; it < N_DIFF + N_DSA + N_MEMA; it += gridDim.x) {
        if (it < N_DIFF) {
            int item = it;
            if (item < SEQ / 8) item = SEQ / 8 - 1 - item;
            diff_item(p, smem, item, lam);
        } else if (it < N_DIFF + N_DSA) {
            int item = it - N_DIFF;
            if (item < SEQ) item = SEQ - 1 - item;
            dsa_item(p, smem, item);
        } else {
            mem_item(p, smem, it - N_DIFF - N_DSA);
        }
    }
}

__device__ void phase3(const Params& p, unsigned char* smem) {
    SmemGemm& S = *(SmemGemm*)smem;
    const int tid = threadIdx.x;
    const float* O = (const float*)(p.ws + WS_H);
    constexpr int NCT = 16, NRT = MROWS / 64;
    for (int it = blockIdx.x; it < NCT * NRT; it += gridDim.x) {
        const int rt = it / NCT, ct = it % NCT;
        const int m0 = rt * 64, n0 = ct * 64;
        sgemm64(O, D, p.in[13], D, D, m0, n0, 64, [](int np) { return np; }, S);
        const int r = tid >> 2, qd = tid & 3, row = m0 + r;
        const float* x = (row < SEQ ? p.in[0] + (size_t)row * D : p.in[1] + (size_t)(row - SEQ) * D) + n0 + 16 * qd;
        float* y = (row < SEQ ? p.out + O_YP + (size_t)row * D : p.out + O_YS + (size_t)(row - SEQ) * D) + n0 + 16 * qd;
#pragma unroll
        for (int i = 0; i < 16; ++i) y[i] = x[i] + S.Cs[r][16 * qd + i];
    }
}

constexpr int SMEM_BYTES = 80 * 1024;

__global__ void __launch_bounds__(NT) fwd_kernel(Params p) {
    __shared__ __attribute__((aligned(16))) unsigned char smem[SMEM_BYTES];
    static_assert(sizeof(SmemDsa) <= SMEM_BYTES && sizeof(SmemDiff) <= SMEM_BYTES && sizeof(SmemGemm) <= SMEM_BYTES && sizeof(SmemMem) <= SMEM_BYTES, "smem");
    cg::grid_group grid = cg::this_grid();
    for (int ph = p.ph_lo; ph < p.ph_hi; ++ph) {
        if (ph == 0) phase0(p);
        else if (ph == 1) phase1(p, smem);
        else if (ph == 2) phase2(p, smem);
        else phase3(p, smem);
        if (ph + 1 < p.ph_hi) grid.sync();
    }
}

extern "C" void kernel_launch(void* const* d_in, const int* in_sizes, int n_in, void* d_out, int out_size, void* d_ws, size_t ws_size, hipStream_t stream) {
    static int grid_blocks = 0;
    if (!grid_blocks) {
        int dev = 0, cus = 0, per_cu = 0;
        (void)hipGetDevice(&dev);
        (void)hipDeviceGetAttribute(&cus, hipDeviceAttributeMultiprocessorCount, dev);
        (void)hipOccupancyMaxActiveBlocksPerMultiprocessor(&per_cu, fwd_kernel, NT, 0);
        if (per_cu < 1) per_cu = 1;
        grid_blocks = cus * per_cu;
        if (ws_size < WS_END) fprintf(stderr, "kernel_launch: workspace too small: %zu < %zu\n", ws_size, (size_t)WS_END);
    }
    Params p{};
    for (int i = 0; i < 27; ++i) p.in[i] = (const float*)d_in[i];
    p.out = (float*)d_out; p.ws = (unsigned char*)d_ws;
#if ONE_LAUNCH
    p.ph_lo = 0; p.ph_hi = 4;
    void* args[] = {&p};
    hipError_t e = hipLaunchCooperativeKernel((void*)fwd_kernel, dim3(grid_blocks), dim3(NT), args, 0, stream);
    if (e != hipSuccess) fprintf(stderr, "cooperative launch failed: %s (grid %d)\n", hipGetErrorString(e), grid_blocks);
#else
    for (int ph = 0; ph < 4; ++ph) {
        p.ph_lo = ph; p.ph_hi = ph + 1;
        hipLaunchKernelGGL(fwd_kernel, dim3(grid_blocks), dim3(NT), 0, stream, p);
    }
#endif
}
```

```cpp
#include <hip/hip_runtime.h>
#include <hip/hip_cooperative_groups.h>
#include <cstdio>
#include <cstdint>
namespace cg = cooperative_groups;

#define NT 256
#define ONE_LAUNCH 1

constexpr int D = 1024, SEQ = 16384, DECB = 32, DECS = 64, PAST = 1024, NMEM = 256;
constexpr int MROWS = SEQ + DECB * DECS;
constexpr int DIN = 3880;
constexpr int LDP = 264;
constexpr int PC_IQ = 0, PC_IW = 256;
constexpr float EPS = 1e-6f;

constexpr size_t O_YP = 0, O_YS = 16777216, O_PAK = 18874368, O_PAV = 27262976, O_PAKI = 35651584, O_PBK = 36175872,
                 O_PBV = 40370176, O_PMK = 44564480, O_PMV = 44630016, O_SAK = 44695552, O_SAV = 45744128,
                 O_SAKI = 46792704, O_SBK = 46858240, O_SBV = 47382528;

typedef _Float16 h16;
typedef h16 h16x2 __attribute__((ext_vector_type(2)));
typedef h16 h16x4 __attribute__((ext_vector_type(4)));
typedef h16 h16x8 __attribute__((ext_vector_type(8)));
typedef float f32x4 __attribute__((ext_vector_type(4)));
typedef unsigned u32x4 __attribute__((ext_vector_type(4)));
typedef float f32x16 __attribute__((ext_vector_type(16)));

constexpr int NPAD_IN = 3968;
constexpr float LOG2E = 1.4426950408889634f;
constexpr float P_SHIFT = 6.0f;
constexpr size_t WS_XH = 0;
constexpr size_t WS_O16 = WS_XH;
constexpr size_t WS_HMH = WS_XH + (size_t)MROWS * D * 2;
constexpr size_t WS_WTIN = WS_HMH + (size_t)NMEM * D * 2;
constexpr size_t WS_WTOUT = WS_WTIN + (size_t)NPAD_IN * D * 2;
constexpr size_t WS_WTMEM = WS_WTOUT + (size_t)D * D * 2;
constexpr size_t WS_QA = WS_WTMEM + (size_t)512 * D * 2;
constexpr size_t WS_QB = WS_QA + (size_t)MROWS * 512 * 2;
constexpr size_t WS_QC = WS_QB + (size_t)MROWS * 256 * 2;
constexpr size_t WS_G = WS_QC + (size_t)MROWS * 256 * 2;
constexpr size_t WS_KB_P = WS_G + (size_t)MROWS * 1024 * 2;
constexpr size_t WS_VTB_P = WS_KB_P + (size_t)SEQ * 256 * 2;
constexpr size_t WS_MK_P = WS_VTB_P + (size_t)SEQ * 256 * 2;
constexpr size_t WS_MVT_P = WS_MK_P + (size_t)NMEM * 256 * 2;
constexpr size_t WS_KA_P = WS_MVT_P + (size_t)NMEM * 256 * 2;
constexpr size_t WS_VTA_P = WS_KA_P + (size_t)SEQ * 512 * 2;
constexpr size_t WS_MASK_P = WS_VTA_P + (size_t)SEQ * 512 * 2;
constexpr size_t WS_MASK_S = WS_MASK_P + (size_t)SEQ * 512 * 4;
constexpr size_t WS_P = WS_MASK_S + (size_t)DECB * DECS * 34 * 4;
constexpr size_t WS_END = WS_P + (size_t)MROWS * LDP * 4;

struct Params {
    const float* in[27];
    float* out;
    unsigned char* ws;
    int ph_lo, ph_hi;
};

__device__ __forceinline__ float wave_sum(float v) {
#pragma unroll
    for (int o = 1; o < 64; o <<= 1) v += __shfl_xor(v, o);
    return v;
}
__device__ __forceinline__ float wave_max(float v) {
#pragma unroll
    for (int o = 1; o < 64; o <<= 1) v = fmaxf(v, __shfl_xor(v, o));
    return v;
}
__device__ __forceinline__ float silu(float x) { return x / (1.0f + expf(-x)); }

__device__ __forceinline__ int rel_bucket(int rel) {
    const int ret = rel > 0 ? 16 : 0;
    const int n = rel < 0 ? -rel : rel;
    int b;
    if (n < 8) b = n;
    else if (n < 12) b = 8;
    else if (n < 16) b = 9;
    else if (n < 23) b = 10;
    else if (n < 32) b = 11;
    else if (n < 46) b = 12;
    else if (n < 64) b = 13;
    else if (n < 91) b = 14;
    else b = 15;
    return ret + b;
}

__device__ __forceinline__ void rms_row_h(const float* x, const float* g, h16* o, int lane) {
    const float4* xr = (const float4*)x;
    const float4* gr = (const float4*)g;
    float4 v[4];
    float s = 0.f;
#pragma unroll
    for (int j = 0; j < 4; ++j) { v[j] = xr[lane + 64 * j]; s += v[j].x * v[j].x + v[j].y * v[j].y + v[j].z * v[j].z + v[j].w * v[j].w; }
    s = wave_sum(s);
    const float r = 1.0f / sqrtf(s * (1.0f / 1024.0f) + EPS);
#pragma unroll
    for (int j = 0; j < 4; ++j) {
        const float4 gg = gr[lane + 64 * j];
        h16x4 o4; o4.x = (h16)(v[j].x * r * gg.x); o4.y = (h16)(v[j].y * r * gg.y); o4.z = (h16)(v[j].z * r * gg.z); o4.w = (h16)(v[j].w * r * gg.w);
        ((h16x4*)o)[lane + 64 * j] = o4;
    }
}

__device__ __forceinline__ void transpose_item(const float* __restrict__ W, int ldw, int c0, int nvalid, int k0, h16* __restrict__ WT, int r0, float* scr, int lane) {
#pragma unroll 8
    for (int i = 0; i < 32; ++i) {
        const int kk = 2 * i + (lane >> 5), n = lane & 31;
        scr[kk * 33 + n] = (n < nvalid) ? W[(size_t)(k0 + kk) * ldw + c0 + n] : 0.f;
    }
    asm volatile("s_waitcnt lgkmcnt(0)" ::: "memory");
    const int c = lane & 7;
#pragma unroll
    for (int j = 0; j < 4; ++j) {
        const int n = (lane >> 3) + 8 * j;
        const float* s = scr + (8 * c) * 33 + n;
        h16x8 o;
#pragma unroll
        for (int e = 0; e < 8; ++e) o[e] = (h16)s[e * 33];
        *(h16x8*)(WT + (size_t)(r0 + n) * 1024 + k0 + 8 * c) = o;
    }
    asm volatile("s_waitcnt lgkmcnt(0)" ::: "memory");
}

__device__ __forceinline__ int inproj_col(int np) { return np < 2304 ? np : (np < 3840 ? np + 40 : np - 3840 + 2304); }

__device__ void phase0(const Params& p, unsigned char* smem) {
    const int lane = threadIdx.x & 63, w = threadIdx.x >> 6;
    const int gw = blockIdx.x * 4 + w, ngw = gridDim.x * 4;
    h16* XH = (h16*)(p.ws + WS_XH);
    h16* HMH = (h16*)(p.ws + WS_HMH);
    h16* WTIN = (h16*)(p.ws + WS_WTIN);
    h16* WTOUT = (h16*)(p.ws + WS_WTOUT);
    h16* WTMEM = (h16*)(p.ws + WS_WTMEM);
    float* scr = (float*)smem + w * (64 * 33);
    constexpr int N_ROWS = MROWS + NMEM;
    constexpr int I_IN = 16 * (NPAD_IN / 32), I_OUT = 16 * 32, I_MEM = 16 * 16;
    for (int it = gw; it < N_ROWS + I_IN + I_OUT + I_MEM; it += ngw) {
        if (it < N_ROWS) {
            const int r = it;
            if (r < SEQ) rms_row_h(p.in[0] + (size_t)r * D, p.in[11], XH + (size_t)r * D, lane);
            else if (r < MROWS) rms_row_h(p.in[1] + (size_t)(r - SEQ) * D, p.in[11], XH + (size_t)r * D, lane);
            else rms_row_h(p.in[2] + (size_t)(r - MROWS) * D, p.in[25], HMH + (size_t)(r - MROWS) * D, lane);
        } else if (it < N_ROWS + I_IN) {
            const int r = it - N_ROWS, nb = r % (NPAD_IN / 32), kb = r / (NPAD_IN / 32);
            const int np0 = nb * 32;
            int nvalid = DIN - np0; nvalid = nvalid < 0 ? 0 : (nvalid > 32 ? 32 : nvalid);
            const int c0 = nvalid > 0 ? inproj_col(np0) : 0;
            transpose_item(p.in[12], DIN, c0, nvalid, kb * 64, WTIN, np0, scr, lane);
        } else if (it < N_ROWS + I_IN + I_OUT) {
            const int r = it - N_ROWS - I_IN, nb = r % 32, kb = r / 32;
            transpose_item(p.in[13], D, nb * 32, 32, kb * 64, WTOUT, nb * 32, scr, lane);
        } else {
            const int r = it - N_ROWS - I_IN - I_OUT, nb = r % 16, kb = r / 16;
            transpose_item(p.in[26], 512, nb * 32, 32, kb * 64, WTMEM, nb * 32, scr, lane);
        }
    }
}

constexpr int CS_LD = 132;
template <class Epi>
__device__ __forceinline__ void gemm_tile(const Params& p, const h16* __restrict__ A, const h16* __restrict__ Bt, int m0, int n0, unsigned char* smem, const Epi& epi) {
    const int tid = threadIdx.x, lane = tid & 63, wid = tid >> 6, wm = wid >> 1, wn = wid & 1;
    const int l31 = lane & 31, hh = lane >> 5;
    f32x16 acc[2][2];
#pragma unroll
    for (int a = 0; a < 2; ++a)
#pragma unroll
        for (int b = 0; b < 2; ++b)
#pragma unroll
            for (int r = 0; r < 16; ++r) acc[a][b][r] = 0.f;
    const h16* ag[4]; const h16* bg[4]; int so[4];
#pragma unroll
    for (int i = 0; i < 4; ++i) {
        const int c = tid + 256 * i, row = c >> 3, ch = c & 7;
        ag[i] = A + (size_t)(m0 + row) * 1024 + ch * 8;
        bg[i] = Bt + (size_t)(n0 + row) * 1024 + ch * 8;
        so[i] = row * 128 + ((ch ^ ((row >> 1) & 7)) << 4);
    }
    unsigned char* As = smem; unsigned char* Bs = smem + 16384;
    u32x4 ra[4], rb[4];
#pragma unroll
    for (int i = 0; i < 4; ++i) { ra[i] = *(const u32x4*)(ag[i]); rb[i] = *(const u32x4*)(bg[i]); }
    __syncthreads();
#pragma unroll
    for (int i = 0; i < 4; ++i) { *(u32x4*)(As + so[i]) = ra[i]; *(u32x4*)(Bs + so[i]) = rb[i]; }
    __syncthreads();
    const int sw = (l31 >> 1) & 7;
    const int arow = (wm * 64 + l31) * 128, brow = (wn * 64 + l31) * 128;
    for (int kt = 0; kt < 16; ++kt) {
        if (kt < 15) {
#pragma unroll
            for (int i = 0; i < 4; ++i) { ra[i] = *(const u32x4*)(ag[i] + (kt + 1) * 64); rb[i] = *(const u32x4*)(bg[i] + (kt + 1) * 64); }
        }
#pragma unroll
        for (int s = 0; s < 4; ++s) {
            const int co = (((2 * s + hh) ^ sw) << 4);
            h16x8 a[2], b[2];
#pragma unroll
            for (int mt = 0; mt < 2; ++mt) a[mt] = *(const h16x8*)(As + arow + mt * 32 * 128 + co);
#pragma unroll
            for (int nt = 0; nt < 2; ++nt) b[nt] = *(const h16x8*)(Bs + brow + nt * 32 * 128 + co);
#pragma unroll
            for (int mt = 0; mt < 2; ++mt)
#pragma unroll
                for (int nt = 0; nt < 2; ++nt) acc[mt][nt] = __builtin_amdgcn_mfma_f32_32x32x16_f16(a[mt], b[nt], acc[mt][nt], 0, 0, 0);
        }
        __syncthreads();
        if (kt < 15) {
#pragma unroll
            for (int i = 0; i < 4; ++i) { *(u32x4*)(As + so[i]) = ra[i]; *(u32x4*)(Bs + so[i]) = rb[i]; }
            __syncthreads();
        }
    }
    float* Cs = (float*)smem;
#pragma unroll
    for (int mt = 0; mt < 2; ++mt)
#pragma unroll
        for (int nt = 0; nt < 2; ++nt)
#pragma unroll
            for (int r = 0; r < 16; ++r) {
                const int row = wm * 64 + mt * 32 + (r & 3) + 8 * (r >> 2) + 4 * hh, col = wn * 64 + nt * 32 + l31;
                Cs[row * CS_LD + col] = acc[mt][nt][r];
            }
    __syncthreads();
    epi(p, Cs, m0, n0, tid);
}

__device__ __forceinline__ float group_sum16(float v) { v += __shfl_xor(v, 1); v += __shfl_xor(v, 2); v += __shfl_xor(v, 4); v += __shfl_xor(v, 8); return v; }
__device__ __forceinline__ float group_sum8(float v) { v += __shfl_xor(v, 1); v += __shfl_xor(v, 2); v += __shfl_xor(v, 4); return v; }

struct Seg {
    float* bp; float* bs; int ld; int col; int norm; const float* gain;
    h16* hp; h16* hs; int hld; int hcol; float hscale;
    int vt; int head;
};

__device__ __forceinline__ Seg seg_of(const Params& p, int n0) {
    float* P = (float*)(p.ws + WS_P);
    float* out = p.out;
    h16* QA = (h16*)(p.ws + WS_QA); h16* QB = (h16*)(p.ws + WS_QB); h16* QC = (h16*)(p.ws + WS_QC); h16* G = (h16*)(p.ws + WS_G);
    Seg s; s.norm = 0; s.gain = nullptr; s.hp = nullptr; s.hs = nullptr; s.hld = 0; s.hcol = 0; s.hscale = 1.f; s.vt = 0; s.head = 0;
    s.bp = nullptr; s.bs = nullptr; s.ld = 0; s.col = 0;
#define SEG_O(op, os, ldv, c) do { s.bp = out + (op); s.bs = out + (os) - (size_t)SEQ * (ldv); s.ld = (ldv); s.col = (c); } while (0)
#define SEG_H(ptr, ldv, c, sc) do { s.hp = (ptr); s.hs = (ptr); s.hld = (ldv); s.hcol = (c); s.hscale = (sc); } while (0)
    if (n0 < 512) { s.norm = 64; s.gain = p.in[14]; SEG_H(QA, 512, n0, 0.125f * LOG2E); }
    else if (n0 < 1024) { SEG_O(O_PAK, O_SAK, 512, n0 - 512); s.norm = 64; s.gain = p.in[15]; s.hp = (h16*)(p.ws + WS_KA_P); s.hs = nullptr; s.hld = 512; s.hcol = n0 - 512; }
    else if (n0 < 1536) { SEG_O(O_PAV, O_SAV, 512, n0 - 1024); s.vt = 1; s.head = (n0 - 1024) >> 6; }
    else if (n0 < 2048) { SEG_H(G, 1024, n0 - 1536, 1.f); }
    else if (n0 < 2304) { s.bp = P; s.bs = P; s.ld = LDP; s.col = PC_IQ + n0 - 2048; }
    else if (n0 < 2560) { s.norm = 32; s.gain = p.in[16]; SEG_H(QB, 256, n0 - 2304, 0.17677669529663687f * LOG2E); }
    else if (n0 < 2816) { SEG_O(O_PBK, O_SBK, 256, n0 - 2560); s.norm = 32; s.gain = p.in[17]; s.hp = (h16*)(p.ws + WS_KB_P); s.hs = nullptr; s.hld = 256; s.hcol = n0 - 2560; }
    else if (n0 < 3072) { SEG_O(O_PBV, O_SBV, 256, n0 - 2816); s.vt = 2; s.head = (n0 - 2816) >> 6; }
    else if (n0 < 3328) { SEG_H(G, 1024, 512 + n0 - 3072, 1.f); }
    else if (n0 < 3584) { s.norm = 64; s.gain = p.in[23]; SEG_H(QC, 256, n0 - 3328, 0.125f * LOG2E); }
    else { SEG_H(G, 1024, 768 + n0 - 3584, 1.f); }
#undef SEG_O
#undef SEG_H
    return s;
}

__device__ __forceinline__ void vt_store(const float* Cs, int j, h16* dst_base, size_t ldv, int tid) {
    const int dv = tid & 63, rq = tid >> 6;
    h16* dst = dst_base + (size_t)dv * ldv + 32 * rq;
#pragma unroll
    for (int e8 = 0; e8 < 4; ++e8) {
        h16x8 o;
#pragma unroll
        for (int e = 0; e < 8; ++e) o[e] = (h16)Cs[(32 * rq + 8 * e8 + e) * CS_LD + 64 * j + dv];
        *(h16x8*)(dst + 8 * e8) = o;
    }
}

struct EpiIn {
    __device__ __forceinline__ void operator()(const Params& p, const float* Cs, int m0, int n0, int tid) const {
        const int cg = tid & 15, r0 = tid >> 4;
#pragma unroll 1
        for (int j = 0; j < 2; ++j) {
            const int n0j = n0 + 64 * j;
            if (n0j >= DIN) continue;
            if (n0j == 3840) {
                float* P = (float*)(p.ws + WS_P);
#pragma unroll 1
                for (int i = 0; i < 8; ++i) {
                    const int rl = r0 + 16 * i, row = m0 + rl;
                    const float4 v = *(const float4*)&Cs[rl * CS_LD + 4 * cg];
                    if (cg < 8) { float* dst = (row < SEQ ? p.out + O_PAKI + (size_t)row * 32 : p.out + O_SAKI + (size_t)(row - SEQ) * 32) + 4 * cg; *(float4*)dst = v; }
                    else if (cg < 10) { *(float4*)(P + (size_t)row * LDP + PC_IW + 4 * (cg - 8)) = v; }
                }
                continue;
            }
            const Seg s = seg_of(p, n0j);
            float4 g4 = make_float4(1.f, 1.f, 1.f, 1.f);
            if (s.norm == 64) g4 = *(const float4*)(s.gain + 4 * cg);
            else if (s.norm == 32) g4 = *(const float4*)(s.gain + ((4 * cg) & 31));
#pragma unroll 1
            for (int i = 0; i < 8; ++i) {
                const int rl = r0 + 16 * i, row = m0 + rl;
                float4 v = *(const float4*)&Cs[rl * CS_LD + 64 * j + 4 * cg];
                if (s.norm) {
                    float ss = v.x * v.x + v.y * v.y + v.z * v.z + v.w * v.w;
                    float sc;
                    if (s.norm == 64) { ss = group_sum16(ss); sc = 1.0f / sqrtf(ss * (1.0f / 64.0f) + EPS); }
                    else { ss = group_sum8(ss); sc = 1.0f / sqrtf(ss * (1.0f / 32.0f) + EPS); }
                    v.x *= sc * g4.x; v.y *= sc * g4.y; v.z *= sc * g4.z; v.w *= sc * g4.w;
                }
                if (s.bp) *(float4*)((row < SEQ ? s.bp : s.bs) + (size_t)row * s.ld + s.col + 4 * cg) = v;
                h16* hb = row < SEQ ? s.hp : s.hs;
                if (hb) {
                    h16x4 hv; hv.x = (h16)(v.x * s.hscale); hv.y = (h16)(v.y * s.hscale); hv.z = (h16)(v.z * s.hscale); hv.w = (h16)(v.w * s.hscale);
                    *(h16x4*)(hb + (size_t)row * s.hld + s.hcol + 4 * cg) = hv;
                }
            }
            if (s.vt == 2 && m0 < SEQ) vt_store(Cs, j, (h16*)(p.ws + WS_VTB_P) + (size_t)(s.head * 64) * SEQ + m0, SEQ, tid);
            if (s.vt == 1 && m0 < SEQ) vt_store(Cs, j, (h16*)(p.ws + WS_VTA_P) + (size_t)(s.head * 64) * SEQ + m0, SEQ, tid);
        }
    }
};

struct EpiMem {
    __device__ __forceinline__ void operator()(const Params& p, const float* Cs, int m0, int n0, int tid) const {
        const int cg = tid & 15, r0 = tid >> 4;
#pragma unroll 1
        for (int j = 0; j < 2; ++j) {
            const int n0j = n0 + 64 * j;
            const bool isk = n0j < 256;
            const float4 g4 = isk ? *(const float4*)(p.in[24] + 4 * cg) : make_float4(1.f, 1.f, 1.f, 1.f);
#pragma unroll 1
            for (int i = 0; i < 8; ++i) {
                const int rl = r0 + 16 * i, row = m0 + rl;
                float4 v = *(const float4*)&Cs[rl * CS_LD + 64 * j + 4 * cg];
                if (isk) {
                    float ss = group_sum16(v.x * v.x + v.y * v.y + v.z * v.z + v.w * v.w);
                    const float sc = 1.0f / sqrtf(ss * (1.0f / 64.0f) + EPS);
                    v.x *= sc * g4.x; v.y *= sc * g4.y; v.z *= sc * g4.z; v.w *= sc * g4.w;
                    h16x4 hv; hv.x = (h16)v.x; hv.y = (h16)v.y; hv.z = (h16)v.z; hv.w = (h16)v.w;
                    *(h16x4*)((h16*)(p.ws + WS_MK_P) + (size_t)row * 256 + n0j + 4 * cg) = hv;
                }
                float* dst = p.out + (isk ? O_PMK : O_PMV) + (size_t)row * 256 + (isk ? n0j : n0j - 256) + 4 * cg;
                *(float4*)dst = v;
            }
            if (!isk) vt_store(Cs, j, (h16*)(p.ws + WS_MVT_P) + (size_t)(((n0j - 256) >> 6) * 64) * NMEM + m0, NMEM, tid);
        }
    }
};

struct EpiOut {
    __device__ __forceinline__ void operator()(const Params& p, const float* Cs, int m0, int n0, int tid) const {
        const int cg = tid & 15, r0 = tid >> 4;
#pragma unroll 1
        for (int i = 0; i < 8; ++i) {
            const int rl = r0 + 16 * i, row = m0 + rl;
            const float* x = (row < SEQ ? p.in[0] + (size_t)row * D : p.in[1] + (size_t)(row - SEQ) * D) + n0 + 4 * cg;
            float* y = (row < SEQ ? p.out + O_YP + (size_t)row * D : p.out + O_YS + (size_t)(row - SEQ) * D) + n0 + 4 * cg;
#pragma unroll
            for (int j = 0; j < 2; ++j) {
                const float4 v = *(const float4*)&Cs[rl * CS_LD + 64 * j + 4 * cg];
                const float4 xv = *(const float4*)(x + 64 * j);
                *(float4*)(y + 64 * j) = make_float4(xv.x + v.x, xv.y + v.y, xv.z + v.z, xv.w + v.w);
            }
        }
    }
};

__device__ void phase1(const Params& p, unsigned char* smem) {
    const h16* XH = (const h16*)(p.ws + WS_XH);
    const h16* HMH = (const h16*)(p.ws + WS_HMH);
    const h16* WTIN = (const h16*)(p.ws + WS_WTIN);
    const h16* WTMEM = (const h16*)(p.ws + WS_WTMEM);
    constexpr int NCT = NPAD_IN / 128, NRT = MROWS / 128;
    constexpr int N_IN = NCT * NRT, N_MEM = 2 * 4;
    const EpiIn ein{}; const EpiMem emem{};
    for (int it = blockIdx.x; it < N_IN + N_MEM; it += gridDim.x) {
        if (it < N_IN) { const int rt = it / NCT, ct = it % NCT; gemm_tile(p, XH, WTIN, rt * 128, ct * 128, smem, ein); }
        else { const int im = it - N_IN, rt = im / 4, ct = im % 4; gemm_tile(p, HMH, WTMEM, rt * 128, ct * 128, smem, emem); }
    }
}

struct KeySrc {
    const float* cache; const float* fresh; int past; int ld;
    __device__ __forceinline__ const float* row(int k) const { return k < past ? cache + (size_t)k * ld : fresh + (size_t)(k - past) * ld; }
};

__device__ __forceinline__ unsigned fkey(float f) { const unsigned u = __float_as_uint(f); return (u & 0x80000000u) ? ~u : (u | 0x80000000u); }

struct SmemDsa {
    float sc[16384];
    float iq[256]; float iw[8];
    unsigned hist[256]; unsigned mw[512];
    int wcnt[4]; int wcnt2[4]; int misc[4];
};

__device__ void select_item(const Params& p, unsigned char* smem, int item) {
    SmemDsa& S = *(SmemDsa*)smem;
    const int tid = threadIdx.x, lane = tid & 63, w = tid >> 6;
    const float* P = (const float*)(p.ws + WS_P);
    int row, N; KeySrc ki; unsigned* mout;
    if (item < SEQ) {
        row = item; N = 64 * (item / 64 + 1);
        ki = KeySrc{nullptr, p.out + O_PAKI, 0, 32};
        mout = (unsigned*)(p.ws + WS_MASK_P) + (size_t)item * 512;
    } else {
        const int bt = item - SEQ, b = bt / DECS;
        row = item; N = PAST + DECS;
        ki = KeySrc{p.in[5] + (size_t)b * PAST * 32, p.out + O_SAKI + (size_t)b * DECS * 32, PAST, 32};
        mout = (unsigned*)(p.ws + WS_MASK_S) + (size_t)bt * 34;
    }
    const int nw = N / 32;
    __syncthreads();
    if (N <= 256) {
        if (tid < nw) mout[tid] = 0xffffffffu;
        return;
    }
    S.iq[tid] = P[(size_t)row * LDP + PC_IQ + tid];
    if (tid < 8) S.iw[tid] = P[(size_t)row * LDP + PC_IW + tid];
    S.mw[tid] = 0u; S.mw[tid + 256] = 0u;
    __syncthreads();
    for (int k = tid; k < N; k += NT) {
        const float4* kr = (const float4*)ki.row(k);
        float kd[32];
#pragma unroll
        for (int i = 0; i < 8; ++i) { const float4 t4 = kr[i]; kd[4 * i] = t4.x; kd[4 * i + 1] = t4.y; kd[4 * i + 2] = t4.z; kd[4 * i + 3] = t4.w; }
        float score = 0.f;
#pragma unroll
        for (int h = 0; h < 8; ++h) {
            float d = 0.f;
#pragma unroll
            for (int i = 0; i < 32; ++i) d = fmaf(S.iq[h * 32 + i], kd[i], d);
            score = fmaf(S.iw[h], fmaxf(d, 0.f), score);
        }
        S.sc[k] = score;
    }
    __syncthreads();
    unsigned prefix = 0; int remaining = 256;
    for (int pass = 0; pass < 4; ++pass) {
        const int shift = 24 - 8 * pass;
        S.hist[tid] = 0;
        __syncthreads();
        for (int k = tid; k < N; k += NT) {
            const unsigned key = fkey(S.sc[k]);
            if (pass == 0 || (key >> (shift + 8)) == prefix) atomicAdd(&S.hist[(key >> shift) & 255u], 1u);
        }
        __syncthreads();
        const int hv = (int)S.hist[tid];
        int x = hv;
#pragma unroll
        for (int o = 1; o < 64; o <<= 1) { const int y = __shfl_down(x, o); if (lane + o < 64) x += y; }
        if (lane == 0) S.wcnt[w] = x;
        __syncthreads();
        int above = x - hv;
        for (int w2 = w + 1; w2 < 4; ++w2) above += S.wcnt[w2];
        if (above < remaining && remaining <= above + hv) { S.misc[0] = (int)((prefix << 8) | (unsigned)tid); S.misc[1] = remaining - above; }
        __syncthreads();
        prefix = (unsigned)S.misc[0]; remaining = S.misc[1];
        __syncthreads();
    }
    const unsigned T = prefix; const int r = remaining;
    int base_eq = 0;
    const unsigned long long lt = (lane == 0) ? 0ull : (~0ull >> (64 - lane));
    for (int k0 = 0; k0 < N; k0 += NT) {
        const int k = k0 + tid;
        const unsigned key = (k < N) ? fkey(S.sc[k]) : 0u;
        const bool gt = (k < N) && key > T, eq = (k < N) && key == T;
        const unsigned long long beq = __ballot(eq);
        const int eqpre = __popcll(beq & lt);
        if (lane == 0) S.wcnt[w] = __popcll(beq);
        __syncthreads();
        int eqbase = base_eq, eqtot = 0;
        for (int w2 = 0; w2 < 4; ++w2) { const int c = S.wcnt[w2]; if (w2 < w) eqbase += c; eqtot += c; }
        const bool sel = gt || (eq && (eqbase + eqpre) < r);
        const unsigned long long bs = __ballot(sel);
        if (lane == 0) S.mw[(k0 >> 5) + 2 * w] = (unsigned)bs;
        if (lane == 32) S.mw[(k0 >> 5) + 2 * w + 1] = (unsigned)(bs >> 32);
        base_eq += eqtot;
        __syncthreads();
    }
    for (int i = tid; i < nw; i += NT) mout[i] = S.mw[i];
}

constexpr int ATT_TB_OFF = 32768;
constexpr int ATT_LDS = ATT_TB_OFF + 1024;

__device__ __forceinline__ int pi32(int r) { return (r & 0x13) | ((r & 4) << 1) | ((r & 8) >> 1); }
__device__ __forceinline__ unsigned pkrtz(float a, float b) { return __builtin_bit_cast(unsigned, __builtin_amdgcn_cvt_pkrtz(a, b)); }

struct AttnUnit {
    int row0, nwaves, ntiles, chunk0, chunk_step, qpos0, head;
    const h16* Kh; const h16* VTh; int ldk; int ldv;
    const float* Kc; const float* Vc; const float* Kn; const float* Vn; int ldf; int ntc;
    const unsigned* mask; int ldm;
};

template <int MODE, bool F32SRC>
__device__ __forceinline__ void attn_unit(const Params& p, unsigned char* smem, const AttnUnit& U, float lam) {
    const int tid = threadIdx.x, lane = tid & 63, w = tid >> 6, l31 = lane & 31, hh = lane >> 5;
    const bool active = w < U.nwaves;
    const int chunk_w = U.chunk0 + U.chunk_step * (w >> 1);
    const int rowq = U.row0 + 32 * w + l31;
    const int qpos = U.qpos0 + 32 * w + l31;
    constexpr int NMAP = (MODE == 1) ? 2 : 1;
    float* tb = (float*)(smem + ATT_TB_OFF);
    __syncthreads();
    if (MODE != 2) {
        if (tid < 255) { const int hc = (MODE == 0 ? U.head : 8 + U.head); tb[tid] = (p.in[10][rel_bucket(tid - 191) * 12 + hc] - p.in[10][15 * 12 + hc]) * LOG2E; }
    }
    h16x8 qf[4];
    if (active) {
        const h16* Qb = (MODE == 0) ? (const h16*)(p.ws + WS_QA) + (size_t)rowq * 512 + U.head * 64
                      : (MODE == 1) ? (const h16*)(p.ws + WS_QB) + (size_t)rowq * 256 + U.head * 64
                                    : (const h16*)(p.ws + WS_QC) + (size_t)rowq * 256 + U.head * 64;
#pragma unroll
        for (int s = 0; s < 4; ++s) qf[s] = *(const h16x8*)(Qb + 16 * s + 8 * hh);
    } else {
#pragma unroll
        for (int s = 0; s < 4; ++s)
#pragma unroll
            for (int e = 0; e < 8; ++e) qf[s][e] = (h16)0.f;
    }
    f32x16 O[NMAP][2];
    float lsum[NMAP];
#pragma unroll
    for (int c = 0; c < NMAP; ++c) {
        lsum[c] = 0.f;
#pragma unroll
        for (int m = 0; m < 2; ++m)
#pragma unroll
            for (int r = 0; r < 16; ++r) O[c][m][r] = 0.f;
    }
    int crow[2], cch[2], so[2];
#pragma unroll
    for (int i = 0; i < 2; ++i) { const int c = tid + 256 * i; crow[i] = c >> 3; cch[i] = c & 7; so[i] = crow[i] * 128 + ((cch[i] ^ ((crow[i] >> 1) & 7)) << 4); }
    u32x4 rk[2], rv[2];
    f32x4 fk[2][2], fv[2][2];
#define ATT_LOAD(j) do { \
        if constexpr (!F32SRC) { \
            _Pragma("unroll") for (int i = 0; i < 2; ++i) { \
                rk[i] = *(const u32x4*)(U.Kh + (size_t)(64 * (j) + crow[i]) * U.ldk + cch[i] * 8); \
                rv[i] = *(const u32x4*)(U.VTh + (size_t)crow[i] * U.ldv + 64 * (j) + cch[i] * 8); } \
        } else { \
            const float* kb_ = ((j) < U.ntc) ? U.Kc + (size_t)(64 * (j)) * U.ldf : U.Kn + (size_t)(64 * ((j) - U.ntc)) * U.ldf; \
            const float* vb_ = ((j) < U.ntc) ? U.Vc + (size_t)(64 * (j)) * U.ldf : U.Vn + (size_t)(64 * ((j) - U.ntc)) * U.ldf; \
            _Pragma("unroll") for (int i = 0; i < 2; ++i) { \
                const float* ks_ = kb_ + (size_t)crow[i] * U.ldf + cch[i] * 8; const float* vs_ = vb_ + (size_t)crow[i] * U.ldf + cch[i] * 8; \
                fk[i][0] = *(const f32x4*)ks_; fk[i][1] = *(const f32x4*)(ks_ + 4); fv[i][0] = *(const f32x4*)vs_; fv[i][1] = *(const f32x4*)(vs_ + 4); } \
        } } while (0)
#define ATT_WRITE(b) do { \
        unsigned char* kt_ = smem + (b) * 16384; unsigned char* vt_ = kt_ + 8192; \
        if constexpr (!F32SRC) { \
            _Pragma("unroll") for (int i = 0; i < 2; ++i) { *(u32x4*)(kt_ + so[i]) = rk[i]; *(u32x4*)(vt_ + so[i]) = rv[i]; } \
        } else { \
            _Pragma("unroll") for (int i = 0; i < 2; ++i) { \
                h16x8 hk_; _Pragma("unroll") for (int e = 0; e < 4; ++e) { hk_[e] = (h16)fk[i][0][e]; hk_[4 + e] = (h16)fk[i][1][e]; } \
                *(h16x8*)(kt_ + so[i]) = hk_; \
                const int key_ = crow[i]; \
                _Pragma("unroll") for (int e = 0; e < 8; ++e) { const int dv_ = 8 * cch[i] + e; \
                    *(h16*)(vt_ + dv_ * 128 + (((key_ >> 3) ^ ((dv_ >> 1) & 7)) << 4) + (key_ & 7) * 2) = (h16)(e < 4 ? fv[i][0][e] : fv[i][1][e - 4]); } } \
        } } while (0)

    ATT_LOAD(0);
    ATT_WRITE(0);
    __syncthreads();
    const int pil = pi32(l31), ksw = (pil >> 1) & 7, vsw = (l31 >> 1) & 7;
    for (int j = 0; j < U.ntiles; ++j) {
        const int buf = j & 1;
        if (j + 1 < U.ntiles) ATT_LOAD(j + 1);
        if (active && (MODE == 2 || j <= chunk_w)) {
            const unsigned char* Kt = smem + buf * 16384;
            const unsigned char* Vt = Kt + 8192;
            unsigned mw[2] = {0xffffffffu, 0xffffffffu};
            if (MODE == 0) { mw[0] = U.mask[(size_t)(32 * w + l31) * U.ldm + 2 * j] >> (8 * hh); mw[1] = U.mask[(size_t)(32 * w + l31) * U.ldm + 2 * j + 1] >> (8 * hh); }
            h16x8 vf[2][4];
#pragma unroll
            for (int m = 0; m < 2; ++m)
#pragma unroll
                for (int sp = 0; sp < 4; ++sp) vf[m][sp] = *(const h16x8*)(Vt + (32 * m + l31) * 128 + (((2 * sp + hh) ^ vsw) << 4));
            const bool near = (MODE != 2) && (j >= chunk_w - 2);
#pragma unroll
            for (int c = 0; c < NMAP; ++c) {
                f32x16 S[2];
#pragma unroll
                for (int u = 0; u < 2; ++u) {
#pragma unroll
                    for (int r = 0; r < 16; ++r) S[u][r] = -P_SHIFT;
                    const unsigned char* kp = Kt + (32 * u + pil) * 128;
                    if (MODE == 1) {
#pragma unroll
                        for (int s = 0; s < 2; ++s) { const int idx = 2 * c + s; const h16x8 a = *(const h16x8*)(kp + (((2 * idx + hh) ^ ksw) << 4)); S[u] = __builtin_amdgcn_mfma_f32_32x32x16_f16(a, qf[idx], S[u], 0, 0, 0); }
                    } else {
#pragma unroll
                        for (int s = 0; s < 4; ++s) { const h16x8 a = *(const h16x8*)(kp + (((2 * s + hh) ^ ksw) << 4)); S[u] = __builtin_amdgcn_mfma_f32_32x32x16_f16(a, qf[s], S[u], 0, 0, 0); }
                    }
                }
                if (near) {
#pragma unroll
                    for (int u = 0; u < 2; ++u) {
                        const int base = 64 * j + 32 * u + 8 * hh - qpos + 191;
#pragma unroll
                        for (int i = 0; i < 16; ++i) S[u][i] += tb[base + (i & 7) + 16 * (i >> 3)];
                    }
                }
                float ls = 0.f;
#pragma unroll
                for (int u = 0; u < 2; ++u)
#pragma unroll
                    for (int i = 0; i < 16; ++i) {
                        float pv = __builtin_amdgcn_exp2f(S[u][i]);
                        if (MODE == 0) { const int mbit = __builtin_amdgcn_sbfe((int)mw[u], (i & 7) + 16 * (i >> 3), 1); pv = __uint_as_float(__float_as_uint(pv) & (unsigned)mbit); }
                        ls += pv; S[u][i] = pv;
                    }
                lsum[c] += ls;
                h16x8 pf[4];
#pragma unroll
                for (int sp = 0; sp < 4; ++sp) {
                    const int u = sp >> 1, b8 = 8 * (sp & 1);
                    u32x4 pk;
                    pk[0] = pkrtz(S[u][b8 + 0], S[u][b8 + 1]); pk[1] = pkrtz(S[u][b8 + 2], S[u][b8 + 3]);
                    pk[2] = pkrtz(S[u][b8 + 4], S[u][b8 + 5]); pk[3] = pkrtz(S[u][b8 + 6], S[u][b8 + 7]);
                    pf[sp] = __builtin_bit_cast(h16x8, pk);
                }
#pragma unroll
                for (int m = 0; m < 2; ++m)
#pragma unroll
                    for (int sp = 0; sp < 4; ++sp) O[c][m] = __builtin_amdgcn_mfma_f32_32x32x16_f16(vf[m][sp], pf[sp], O[c][m], 0, 0, 0);
            }
        }
        if (j + 1 < U.ntiles) ATT_WRITE(buf ^ 1);
        __syncthreads();
    }
#undef ATT_LOAD
#undef ATT_WRITE
    if (!active) return;
    const int colbase = (MODE == 0 ? 0 : (MODE == 1 ? 512 : 768)) + U.head * 64;
    const h16* G = (const h16*)(p.ws + WS_G) + (size_t)rowq * 1024 + colbase;
    h16* Oo = (h16*)(p.ws + WS_O16) + (size_t)rowq * 1024 + colbase;
    float inv[NMAP];
#pragma unroll
    for (int c = 0; c < NMAP; ++c) { const float l = lsum[c] + __shfl_xor(lsum[c], 32); inv[c] = 1.0f / l; }
    float ov[2][16];
    float ss = 0.f;
#pragma unroll
    for (int m = 0; m < 2; ++m)
#pragma unroll
        for (int i = 0; i < 16; ++i) {
            float o = O[0][m][i] * inv[0];
            if (MODE == 1) { o -= lam * (O[NMAP - 1][m][i] * inv[NMAP - 1]); ss += o * o; }
            ov[m][i] = o;
        }
    float sc = 1.f;
    if (MODE == 1) { ss += __shfl_xor(ss, 32); sc = (1.0f / sqrtf(ss * (1.0f / 64.0f) + EPS)) * 0.8f; }
#pragma unroll
    for (int m = 0; m < 2; ++m)
#pragma unroll
        for (int g4 = 0; g4 < 4; ++g4) {
            const int dv = 32 * m + 8 * g4 + 4 * hh;
            const h16x4 gv = *(const h16x4*)(G + dv);
            h16x4 o4;
#pragma unroll
            for (int e = 0; e < 4; ++e) {
                float o = ov[m][4 * g4 + e];
                if (MODE == 1) o = o * sc * p.in[18][dv + e];
                o4[e] = (h16)(o * silu((float)gv[e]));
            }
            *(h16x4*)(Oo + dv) = o4;
        }
}

__device__ __forceinline__ AttnUnit unit_zero() {
    AttnUnit U; U.row0 = 0; U.nwaves = 0; U.ntiles = 0; U.chunk0 = 0; U.chunk_step = 0; U.qpos0 = 0; U.head = 0; U.Kh = nullptr; U.VTh = nullptr; U.ldk = 0; U.ldv = 0;
    U.Kc = nullptr; U.Vc = nullptr; U.Kn = nullptr; U.Vn = nullptr; U.ldf = 0; U.ntc = 0; U.mask = nullptr; U.ldm = 0; return U;
}

__device__ void phase2(const Params& p, unsigned char* smem) {
    float s1 = 0.f, s2 = 0.f;
    for (int i = 0; i < 32; ++i) { s1 = fmaf(p.in[19][i], p.in[20][i], s1); s2 = fmaf(p.in[21][i], p.in[22][i], s2); }
    const float lam = expf(s1) - expf(s2) + 0.2f;
    constexpr int N_BP = 512, N_BS = 128, N_CP = 512, N_CS = 128, N_SEL = MROWS;
    constexpr int N_ALL = N_BP + N_BS + N_CP + N_CS + N_SEL;
    for (int it0 = blockIdx.x; it0 < N_ALL; it0 += gridDim.x) {
        int it = it0;
        if (it < N_BP) {
            const int g = 127 - (it >> 2), head = it & 3;
            AttnUnit U = unit_zero();
            U.row0 = 128 * g; U.nwaves = 4; U.ntiles = 2 * g + 2; U.chunk0 = 2 * g; U.chunk_step = 1; U.qpos0 = 128 * g; U.head = head;
            U.Kh = (const h16*)(p.ws + WS_KB_P) + head * 64; U.ldk = 256;
            U.VTh = (const h16*)(p.ws + WS_VTB_P) + (size_t)(head * 64) * SEQ; U.ldv = SEQ;
            attn_unit<1, false>(p, smem, U, lam);
            continue;
        }
        it -= N_BP;
        if (it < N_BS) {
            const int b = it >> 2, head = it & 3;
            AttnUnit U = unit_zero();
            U.row0 = SEQ + 64 * b; U.nwaves = 2; U.ntiles = 17; U.chunk0 = 16; U.chunk_step = 0; U.qpos0 = PAST; U.head = head;
            U.Kc = p.in[6] + (size_t)b * PAST * 256 + head * 64; U.Vc = p.in[7] + (size_t)b * PAST * 256 + head * 64;
            U.Kn = p.out + O_SBK + (size_t)b * DECS * 256 + head * 64; U.Vn = p.out + O_SBV + (size_t)b * DECS * 256 + head * 64;
            U.ldf = 256; U.ntc = 16;
            attn_unit<1, true>(p, smem, U, lam);
            continue;
        }
        it -= N_BS;
        if (it < N_CP) {
            const int g = it >> 2, head = it & 3;
            AttnUnit U = unit_zero();
            U.row0 = 128 * g; U.nwaves = 4; U.ntiles = 4; U.head = head;
            U.Kh = (const h16*)(p.ws + WS_MK_P) + head * 64; U.ldk = 256;
            U.VTh = (const h16*)(p.ws + WS_MVT_P) + (size_t)(head * 64) * NMEM; U.ldv = NMEM;
            attn_unit<2, false>(p, smem, U, lam);
            continue;
        }
        it -= N_CP;
        if (it < N_CS) {
            const int b = it >> 2, head = it & 3;
            AttnUnit U = unit_zero();
            U.row0 = SEQ + 64 * b; U.nwaves = 2; U.ntiles = 4; U.head = head;
            U.Kc = p.in[8] + (size_t)b * NMEM * 256 + head * 64; U.Vc = p.in[9] + (size_t)b * NMEM * 256 + head * 64;
            U.Kn = U.Kc; U.Vn = U.Vc; U.ldf = 256; U.ntc = 4;
            attn_unit<2, true>(p, smem, U, lam);
            continue;
        }
        it -= N_CS;
        {
            int item = it;
            if (item < SEQ) item = SEQ - 1 - item;
            select_item(p, smem, item);
        }
    }
}

__device__ void phase3(const Params& p, unsigned char* smem) {
    constexpr int N_AP = 1024, N_AS = 256;
    for (int it0 = blockIdx.x; it0 < N_AP + N_AS; it0 += gridDim.x) {
        int it = it0;
        if (it < N_AP) {
            const int g = 127 - (it >> 3), head = it & 7;
            AttnUnit U = unit_zero();
            U.row0 = 128 * g; U.nwaves = 4; U.ntiles = 2 * g + 2; U.chunk0 = 2 * g; U.chunk_step = 1; U.qpos0 = 128 * g; U.head = head;
            U.Kh = (const h16*)(p.ws + WS_KA_P) + head * 64; U.ldk = 512;
            U.VTh = (const h16*)(p.ws + WS_VTA_P) + (size_t)(head * 64) * SEQ; U.ldv = SEQ;
            U.mask = (const unsigned*)(p.ws + WS_MASK_P) + (size_t)(128 * g) * 512; U.ldm = 512;
            attn_unit<0, false>(p, smem, U, 0.f);
            continue;
        }
        it -= N_AP;
        {
            const int b = it >> 3, head = it & 7;
            AttnUnit U = unit_zero();
            U.row0 = SEQ + 64 * b; U.nwaves = 2; U.ntiles = 17; U.chunk0 = 16; U.chunk_step = 0; U.qpos0 = PAST; U.head = head;
            U.Kc = p.in[3] + (size_t)b * PAST * 512 + head * 64; U.Vc = p.in[4] + (size_t)b * PAST * 512 + head * 64;
            U.Kn = p.out + O_SAK + (size_t)b * DECS * 512 + head * 64; U.Vn = p.out + O_SAV + (size_t)b * DECS * 512 + head * 64;
            U.ldf = 512; U.ntc = 16;
            U.mask = (const unsigned*)(p.ws + WS_MASK_S) + (size_t)(64 * b) * 34; U.ldm = 34;
            attn_unit<0, true>(p, smem, U, 0.f);
        }
    }
}

__device__ void phase4(const Params& p, unsigned char* smem) {
    const h16* O16 = (const h16*)(p.ws + WS_O16);
    const h16* WTOUT = (const h16*)(p.ws + WS_WTOUT);
    constexpr int NCT = D / 128, NRT = MROWS / 128;
    const EpiOut eo{};
    for (int it = blockIdx.x; it < NCT * NRT; it += gridDim.x) {
        const int rt = it / NCT, ct = it % NCT;
        gemm_tile(p, O16, WTOUT, rt * 128, ct * 128, smem, eo);
    }
}

constexpr int SMEM_BYTES = 80 * 1024;

__global__ void __launch_bounds__(NT) fwd_kernel(Params p) {
    __shared__ __attribute__((aligned(16))) unsigned char smem[SMEM_BYTES];
    static_assert(ATT_LDS <= SMEM_BYTES && sizeof(SmemDsa) <= SMEM_BYTES && CS_LD * 128 * 4 <= SMEM_BYTES, "smem");
    cg::grid_group grid = cg::this_grid();
    for (int ph = p.ph_lo; ph < p.ph_hi; ++ph) {
        if (ph == 0) phase0(p, smem);
        else if (ph == 1) phase1(p, smem);
        else if (ph == 2) phase2(p, smem);
        else if (ph == 3) phase3(p, smem);
        else phase4(p, smem);
        if (ph + 1 < p.ph_hi) grid.sync();
    }
}

extern "C" void kernel_launch(void* const* d_in, const int* in_sizes, int n_in, void* d_out, int out_size, void* d_ws, size_t ws_size, hipStream_t stream) {
    static int grid_blocks = 0;
    if (!grid_blocks) {
        int dev = 0, cus = 0, per_cu = 0;
        (void)hipGetDevice(&dev);
        (void)hipDeviceGetAttribute(&cus, hipDeviceAttributeMultiprocessorCount, dev);
        (void)hipOccupancyMaxActiveBlocksPerMultiprocessor(&per_cu, fwd_kernel, NT, 0);
        if (per_cu < 1) per_cu = 1;
        grid_blocks = cus * per_cu;
        if (ws_size < WS_END) fprintf(stderr, "kernel_launch: workspace too small: %zu < %zu\n", ws_size, (size_t)WS_END);
    }
    if (ws_size < WS_END) return;
    Params p{};
    for (int i = 0; i < 27; ++i) p.in[i] = (const float*)d_in[i];
    p.out = (float*)d_out; p.ws = (unsigned char*)d_ws;
#if ONE_LAUNCH
    p.ph_lo = 0; p.ph_hi = 5;
    void* args[] = {&p};
    hipError_t e = hipLaunchCooperativeKernel((void*)fwd_kernel, dim3(grid_blocks), dim3(NT), args, 0, stream);
    if (e != hipSuccess) fprintf(stderr, "cooperative launch failed: %s (grid %d)\n", hipGetErrorString(e), grid_blocks);
#else
    for (int ph = 0; ph < 5; ++ph) {
        p.ph_lo = ph; p.ph_hi = ph + 1;
        hipLaunchKernelGGL(fwd_kernel, dim3(grid_blocks), dim3(NT), 0, stream, p);
    }
#endif
}
```

```cpp
#include <hip/hip_runtime.h>
#include <hip/hip_cooperative_groups.h>
#include <cstdio>
#include <cstdint>
namespace cg = cooperative_groups;

#define NT 256
#define ONE_LAUNCH 1

constexpr int D = 1024, SEQ = 16384, DECB = 32, DECS = 64, PAST = 1024, NMEM = 256;
constexpr int MROWS = SEQ + DECB * DECS;
constexpr int DIN = 3880;
constexpr int LDP = 264;
constexpr int PC_IQ = 0, PC_IW = 256;
constexpr float EPS = 1e-6f;

constexpr size_t O_YP = 0, O_YS = 16777216, O_PAK = 18874368, O_PAV = 27262976, O_PAKI = 35651584, O_PBK = 36175872,
                 O_PBV = 40370176, O_PMK = 44564480, O_PMV = 44630016, O_SAK = 44695552, O_SAV = 45744128,
                 O_SAKI = 46792704, O_SBK = 46858240, O_SBV = 47382528;

typedef _Float16 h16;
typedef h16 h16x2 __attribute__((ext_vector_type(2)));
typedef h16 h16x4 __attribute__((ext_vector_type(4)));
typedef h16 h16x8 __attribute__((ext_vector_type(8)));
typedef float f32x4 __attribute__((ext_vector_type(4)));
typedef unsigned u32x4 __attribute__((ext_vector_type(4)));
typedef float f32x16 __attribute__((ext_vector_type(16)));

constexpr int NPAD_IN = 3968;
constexpr float LOG2E = 1.4426950408889634f;
constexpr float P_SHIFT = 6.0f;
constexpr size_t WS_XH = 0;
constexpr size_t WS_O16 = WS_XH;
constexpr size_t WS_HMH = WS_XH + (size_t)MROWS * D * 2;
constexpr size_t WS_WTIN = WS_HMH + (size_t)NMEM * D * 2;
constexpr size_t WS_WTOUT = WS_WTIN + (size_t)NPAD_IN * D * 2;
constexpr size_t WS_WTMEM = WS_WTOUT + (size_t)D * D * 2;
constexpr size_t WS_QA = WS_WTMEM + (size_t)512 * D * 2;
constexpr size_t WS_QB = WS_QA + (size_t)MROWS * 512 * 2;
constexpr size_t WS_QC = WS_QB + (size_t)MROWS * 256 * 2;
constexpr size_t WS_G = WS_QC + (size_t)MROWS * 256 * 2;
constexpr size_t WS_KB_P = WS_G + (size_t)MROWS * 1024 * 2;
constexpr size_t WS_VTB_P = WS_KB_P + (size_t)SEQ * 256 * 2;
constexpr size_t WS_MK_P = WS_VTB_P + (size_t)SEQ * 256 * 2;
constexpr size_t WS_MVT_P = WS_MK_P + (size_t)NMEM * 256 * 2;
constexpr size_t WS_KA_P = WS_MVT_P + (size_t)NMEM * 256 * 2;
constexpr size_t WS_VTA_P = WS_KA_P + (size_t)SEQ * 512 * 2;
constexpr size_t WS_MASK_P = WS_VTA_P + (size_t)SEQ * 512 * 2;
constexpr size_t WS_MASK_S = WS_MASK_P + (size_t)SEQ * 512 * 4;
constexpr size_t WS_IQ16 = WS_MASK_S + (size_t)DECB * DECS * 34 * 4;
constexpr size_t WS_IK_P = WS_IQ16 + (size_t)MROWS * 256 * 2;
constexpr size_t WS_IK_S = WS_IK_P + (size_t)SEQ * 32 * 2;
constexpr size_t WS_CTL = WS_IK_S + (size_t)DECB * (PAST + DECS) * 32 * 2;
constexpr size_t WS_P = WS_CTL + 256;
constexpr size_t WS_END = WS_P + (size_t)MROWS * LDP * 4;

struct Params {
    const float* in[27];
    float* out;
    unsigned char* ws;
    int ph_lo, ph_hi;
};

__device__ __forceinline__ float wave_sum(float v) {
#pragma unroll
    for (int o = 1; o < 64; o <<= 1) v += __shfl_xor(v, o);
    return v;
}
__device__ __forceinline__ float wave_max(float v) {
#pragma unroll
    for (int o = 1; o < 64; o <<= 1) v = fmaxf(v, __shfl_xor(v, o));
    return v;
}
__device__ __forceinline__ float silu(float x) { return x / (1.0f + expf(-x)); }

__device__ __forceinline__ int rel_bucket(int rel) {
    const int ret = rel > 0 ? 16 : 0;
    const int n = rel < 0 ? -rel : rel;
    int b;
    if (n < 8) b = n;
    else if (n < 12) b = 8;
    else if (n < 16) b = 9;
    else if (n < 23) b = 10;
    else if (n < 32) b = 11;
    else if (n < 46) b = 12;
    else if (n < 64) b = 13;
    else if (n < 91) b = 14;
    else b = 15;
    return ret + b;
}

__device__ __forceinline__ void rms_row_h(const float* x, const float* g, h16* o, int lane) {
    const float4* xr = (const float4*)x;
    const float4* gr = (const float4*)g;
    float4 v[4];
    float s = 0.f;
#pragma unroll
    for (int j = 0; j < 4; ++j) { v[j] = xr[lane + 64 * j]; s += v[j].x * v[j].x + v[j].y * v[j].y + v[j].z * v[j].z + v[j].w * v[j].w; }
    s = wave_sum(s);
    const float r = 1.0f / sqrtf(s * (1.0f / 1024.0f) + EPS);
#pragma unroll
    for (int j = 0; j < 4; ++j) {
        const float4 gg = gr[lane + 64 * j];
        h16x4 o4; o4.x = (h16)(v[j].x * r * gg.x); o4.y = (h16)(v[j].y * r * gg.y); o4.z = (h16)(v[j].z * r * gg.z); o4.w = (h16)(v[j].w * r * gg.w);
        ((h16x4*)o)[lane + 64 * j] = o4;
    }
}

__device__ __forceinline__ void transpose_item(const float* __restrict__ W, int ldw, int c0, int nvalid, int k0, h16* __restrict__ WT, int r0, float* scr, int lane) {
#pragma unroll 8
    for (int i = 0; i < 32; ++i) {
        const int kk = 2 * i + (lane >> 5), n = lane & 31;
        scr[kk * 33 + n] = (n < nvalid) ? W[(size_t)(k0 + kk) * ldw + c0 + n] : 0.f;
    }
    asm volatile("s_waitcnt lgkmcnt(0)" ::: "memory");
    const int c = lane & 7;
#pragma unroll
    for (int j = 0; j < 4; ++j) {
        const int n = (lane >> 3) + 8 * j;
        const float* s = scr + (8 * c) * 33 + n;
        h16x8 o;
#pragma unroll
        for (int e = 0; e < 8; ++e) o[e] = (h16)s[e * 33];
        *(h16x8*)(WT + (size_t)(r0 + n) * 1024 + k0 + 8 * c) = o;
    }
    asm volatile("s_waitcnt lgkmcnt(0)" ::: "memory");
}

__device__ __forceinline__ int inproj_col(int np) { return np < 2304 ? np : (np < 3840 ? np + 40 : np - 3840 + 2304); }

__device__ void phase0(const Params& p, unsigned char* smem) {
    const int lane = threadIdx.x & 63, w = threadIdx.x >> 6;
    const int gw = blockIdx.x * 4 + w, ngw = gridDim.x * 4;
    h16* XH = (h16*)(p.ws + WS_XH);
    h16* HMH = (h16*)(p.ws + WS_HMH);
    h16* WTIN = (h16*)(p.ws + WS_WTIN);
    h16* WTOUT = (h16*)(p.ws + WS_WTOUT);
    h16* WTMEM = (h16*)(p.ws + WS_WTMEM);
    float* scr = (float*)smem + w * (64 * 33);
    constexpr int N_ROWS = MROWS + NMEM;
    constexpr int I_IN = 16 * (NPAD_IN / 32), I_OUT = 16 * 32, I_MEM = 16 * 16, I_KIDX = DECB * (PAST / 64);
    for (int it = gw; it < N_ROWS + I_IN + I_OUT + I_MEM + I_KIDX; it += ngw) {
        if (it < N_ROWS) {
            const int r = it;
            if (r < SEQ) rms_row_h(p.in[0] + (size_t)r * D, p.in[11], XH + (size_t)r * D, lane);
            else if (r < MROWS) rms_row_h(p.in[1] + (size_t)(r - SEQ) * D, p.in[11], XH + (size_t)r * D, lane);
            else rms_row_h(p.in[2] + (size_t)(r - MROWS) * D, p.in[25], HMH + (size_t)(r - MROWS) * D, lane);
        } else if (it < N_ROWS + I_IN) {
            const int r = it - N_ROWS, nb = r % (NPAD_IN / 32), kb = r / (NPAD_IN / 32);
            const int np0 = nb * 32;
            int nvalid = DIN - np0; nvalid = nvalid < 0 ? 0 : (nvalid > 32 ? 32 : nvalid);
            const int c0 = nvalid > 0 ? inproj_col(np0) : 0;
            transpose_item(p.in[12], DIN, c0, nvalid, kb * 64, WTIN, np0, scr, lane);
        } else if (it < N_ROWS + I_IN + I_OUT) {
            const int r = it - N_ROWS - I_IN, nb = r % 32, kb = r / 32;
            transpose_item(p.in[13], D, nb * 32, 32, kb * 64, WTOUT, nb * 32, scr, lane);
        } else if (it < N_ROWS + I_IN + I_OUT + I_MEM) {
            const int r = it - N_ROWS - I_IN - I_OUT, nb = r % 16, kb = r / 16;
            transpose_item(p.in[26], 512, nb * 32, 32, kb * 64, WTMEM, nb * 32, scr, lane);
        } else {
            const int r = it - N_ROWS - I_IN - I_OUT - I_MEM, b = r / (PAST / 64), key = (r % (PAST / 64)) * 64 + lane;
            const f32x4* src = (const f32x4*)(p.in[5] + ((size_t)b * PAST + key) * 32);
            h16* dst = (h16*)(p.ws + WS_IK_S) + ((size_t)b * (PAST + DECS) + key) * 32;
            float ss = 0.f;
#pragma unroll
            for (int c = 0; c < 4; ++c) {
                const f32x4 x0 = src[2 * c], x1 = src[2 * c + 1];
                h16x8 o;
#pragma unroll
                for (int e = 0; e < 4; ++e) { o[e] = (h16)x0[e]; o[4 + e] = (h16)x1[e]; ss = fmaf(x0[e], x0[e], ss); ss = fmaf(x1[e], x1[e], ss); }
                *(h16x8*)(dst + 8 * c) = o;
            }
            ss = wave_max(ss);
            if (lane == 0) atomicMax((unsigned*)(p.ws + WS_CTL) + 1 + b, __float_as_uint(ss));
        }
    }
}

constexpr int CS_LD = 132;
template <class Epi>
__device__ __forceinline__ void gemm_tile(const Params& p, const h16* __restrict__ A, const h16* __restrict__ Bt, int m0, int n0, unsigned char* smem, const Epi& epi) {
    int tid = threadIdx.x; asm volatile("" : "+v"(tid));
    const int lane = tid & 63, wid = tid >> 6, wm = wid >> 1, wn = wid & 1;
    const int l31 = lane & 31, hh = lane >> 5;
    f32x16 acc[2][2];
#pragma unroll
    for (int a = 0; a < 2; ++a)
#pragma unroll
        for (int b = 0; b < 2; ++b)
#pragma unroll
            for (int r = 0; r < 16; ++r) acc[a][b][r] = 0.f;
    const h16* ag[4]; const h16* bg[4]; int so[4];
#pragma unroll
    for (int i = 0; i < 4; ++i) {
        const int c = tid + 256 * i, row = c >> 3, ch = c & 7;
        ag[i] = A + (size_t)(m0 + row) * 1024 + ch * 8;
        bg[i] = Bt + (size_t)(n0 + row) * 1024 + ch * 8;
        so[i] = row * 128 + ((ch ^ ((row >> 1) & 7)) << 4);
    }
    unsigned char* As = smem; unsigned char* Bs = smem + 16384;
    u32x4 ra[4], rb[4];
#pragma unroll
    for (int i = 0; i < 4; ++i) { ra[i] = *(const u32x4*)(ag[i]); rb[i] = *(const u32x4*)(bg[i]); }
    __syncthreads();
#pragma unroll
    for (int i = 0; i < 4; ++i) { *(u32x4*)(As + so[i]) = ra[i]; *(u32x4*)(Bs + so[i]) = rb[i]; }
    __syncthreads();
    const int sw = (l31 >> 1) & 7;
    const int arow = (wm * 64 + l31) * 128, brow = (wn * 64 + l31) * 128;
    for (int kt = 0; kt < 16; ++kt) {
        if (kt < 15) {
#pragma unroll
            for (int i = 0; i < 4; ++i) { ra[i] = *(const u32x4*)(ag[i] + (kt + 1) * 64); rb[i] = *(const u32x4*)(bg[i] + (kt + 1) * 64); }
        }
#pragma unroll
        for (int s = 0; s < 4; ++s) {
            const int co = (((2 * s + hh) ^ sw) << 4);
            h16x8 a[2], b[2];
#pragma unroll
            for (int mt = 0; mt < 2; ++mt) a[mt] = *(const h16x8*)(As + arow + mt * 32 * 128 + co);
#pragma unroll
            for (int nt = 0; nt < 2; ++nt) b[nt] = *(const h16x8*)(Bs + brow + nt * 32 * 128 + co);
#pragma unroll
            for (int mt = 0; mt < 2; ++mt)
#pragma unroll
                for (int nt = 0; nt < 2; ++nt) acc[mt][nt] = __builtin_amdgcn_mfma_f32_32x32x16_f16(a[mt], b[nt], acc[mt][nt], 0, 0, 0);
        }
        __syncthreads();
        if (kt < 15) {
#pragma unroll
            for (int i = 0; i < 4; ++i) { *(u32x4*)(As + so[i]) = ra[i]; *(u32x4*)(Bs + so[i]) = rb[i]; }
            __syncthreads();
        }
    }
    float* Cs = (float*)smem;
#pragma unroll
    for (int mt = 0; mt < 2; ++mt)
#pragma unroll
        for (int nt = 0; nt < 2; ++nt)
#pragma unroll
            for (int r = 0; r < 16; ++r) {
                const int row = wm * 64 + mt * 32 + (r & 3) + 8 * (r >> 2) + 4 * hh, col = wn * 64 + nt * 32 + l31;
                Cs[row * CS_LD + col] = acc[mt][nt][r];
            }
    __syncthreads();
    epi(p, Cs, m0, n0, tid);
}

__device__ __forceinline__ float group_sum16(float v) { v += __shfl_xor(v, 1); v += __shfl_xor(v, 2); v += __shfl_xor(v, 4); v += __shfl_xor(v, 8); return v; }
__device__ __forceinline__ float group_sum8(float v) { v += __shfl_xor(v, 1); v += __shfl_xor(v, 2); v += __shfl_xor(v, 4); return v; }

struct Seg {
    float* bp; float* bs; int ld; int col; int norm; const float* gain;
    h16* hp; h16* hs; int hld; int hcol; float hscale;
    int vt; int head;
};

__device__ __forceinline__ Seg seg_of(const Params& p, int n0) {
    float* P = (float*)(p.ws + WS_P);
    float* out = p.out;
    h16* QA = (h16*)(p.ws + WS_QA); h16* QB = (h16*)(p.ws + WS_QB); h16* QC = (h16*)(p.ws + WS_QC); h16* G = (h16*)(p.ws + WS_G);
    Seg s; s.norm = 0; s.gain = nullptr; s.hp = nullptr; s.hs = nullptr; s.hld = 0; s.hcol = 0; s.hscale = 1.f; s.vt = 0; s.head = 0;
    s.bp = nullptr; s.bs = nullptr; s.ld = 0; s.col = 0;
#define SEG_O(op, os, ldv, c) do { s.bp = out + (op); s.bs = out + (os) - (size_t)SEQ * (ldv); s.ld = (ldv); s.col = (c); } while (0)
#define SEG_H(ptr, ldv, c, sc) do { s.hp = (ptr); s.hs = (ptr); s.hld = (ldv); s.hcol = (c); s.hscale = (sc); } while (0)
    if (n0 < 512) { s.norm = 64; s.gain = p.in[14]; SEG_H(QA, 512, n0, 0.125f * LOG2E); }
    else if (n0 < 1024) { SEG_O(O_PAK, O_SAK, 512, n0 - 512); s.norm = 64; s.gain = p.in[15]; s.hp = (h16*)(p.ws + WS_KA_P); s.hs = nullptr; s.hld = 512; s.hcol = n0 - 512; }
    else if (n0 < 1536) { SEG_O(O_PAV, O_SAV, 512, n0 - 1024); s.vt = 1; s.head = (n0 - 1024) >> 6; }
    else if (n0 < 2048) { SEG_H(G, 1024, n0 - 1536, 1.f); }
    else if (n0 < 2304) { s.bp = P; s.bs = P; s.ld = LDP; s.col = PC_IQ + n0 - 2048; SEG_H((h16*)(p.ws + WS_IQ16), 256, n0 - 2048, 1.f); }
    else if (n0 < 2560) { s.norm = 32; s.gain = p.in[16]; SEG_H(QB, 256, n0 - 2304, 0.17677669529663687f * LOG2E); }
    else if (n0 < 2816) { SEG_O(O_PBK, O_SBK, 256, n0 - 2560); s.norm = 32; s.gain = p.in[17]; s.hp = (h16*)(p.ws + WS_KB_P); s.hs = nullptr; s.hld = 256; s.hcol = n0 - 2560; }
    else if (n0 < 3072) { SEG_O(O_PBV, O_SBV, 256, n0 - 2816); s.vt = 2; s.head = (n0 - 2816) >> 6; }
    else if (n0 < 3328) { SEG_H(G, 1024, 512 + n0 - 3072, 1.f); }
    else if (n0 < 3584) { s.norm = 64; s.gain = p.in[23]; SEG_H(QC, 256, n0 - 3328, 0.125f * LOG2E); }
    else { SEG_H(G, 1024, 768 + n0 - 3584, 1.f); }
#undef SEG_O
#undef SEG_H
    return s;
}

__device__ __forceinline__ void vt_store(const float* Cs, int j, h16* dst_base, size_t ldv, int tid) {
    const int dv = tid & 63, rq = tid >> 6;
    h16* dst = dst_base + (size_t)dv * ldv + 32 * rq;
#pragma unroll
    for (int e8 = 0; e8 < 4; ++e8) {
        h16x8 o;
#pragma unroll
        for (int e = 0; e < 8; ++e) o[e] = (h16)Cs[(32 * rq + 8 * e8 + e) * CS_LD + 64 * j + dv];
        *(h16x8*)(dst + 8 * e8) = o;
    }
}

struct EpiIn {
    __device__ __forceinline__ void operator()(const Params& p, const float* Cs, int m0, int n0, int tid) const {
        const int cg = tid & 15, r0 = tid >> 4;
#pragma unroll 1
        for (int j = 0; j < 2; ++j) {
            const int n0j = n0 + 64 * j;
            if (n0j >= DIN) continue;
            if (n0j == 3840) {
                float* P = (float*)(p.ws + WS_P);
                float mx0 = 0.f, mx1 = 0.f;
#pragma unroll 1
                for (int i = 0; i < 8; ++i) {
                    const int rl = r0 + 16 * i, row = m0 + rl;
                    const float4 v = *(const float4*)&Cs[rl * CS_LD + 4 * cg];
                    float ss = (cg < 8) ? (v.x * v.x + v.y * v.y + v.z * v.z + v.w * v.w) : 0.f;
                    ss = group_sum8(ss);
                    if (i < 4) mx0 = fmaxf(mx0, ss); else mx1 = fmaxf(mx1, ss);
                    if (cg < 8) {
                        float* dst = (row < SEQ ? p.out + O_PAKI + (size_t)row * 32 : p.out + O_SAKI + (size_t)(row - SEQ) * 32) + 4 * cg; *(float4*)dst = v;
                        h16x4 hv; hv.x = (h16)v.x; hv.y = (h16)v.y; hv.z = (h16)v.z; hv.w = (h16)v.w;
                        h16* hd = row < SEQ ? (h16*)(p.ws + WS_IK_P) + (size_t)row * 32 : (h16*)(p.ws + WS_IK_S) + ((size_t)((row - SEQ) >> 6) * (PAST + DECS) + PAST + ((row - SEQ) & 63)) * 32;
                        *(h16x4*)(hd + 4 * cg) = hv;
                    }
                    else if (cg < 10) { *(float4*)(P + (size_t)row * LDP + PC_IW + 4 * (cg - 8)) = v; }
                }
                if (cg == 0) {
                    unsigned* ctl = (unsigned*)(p.ws + WS_CTL);
                    if (m0 < SEQ) atomicMax(ctl, __float_as_uint(fmaxf(mx0, mx1)));
                    else { const int b0 = (m0 - SEQ) >> 6; atomicMax(ctl + 1 + b0, __float_as_uint(mx0)); atomicMax(ctl + 2 + b0, __float_as_uint(mx1)); }
                }
                continue;
            }
            const Seg s = seg_of(p, n0j);
            float4 g4 = make_float4(1.f, 1.f, 1.f, 1.f);
            if (s.norm == 64) g4 = *(const float4*)(s.gain + 4 * cg);
            else if (s.norm == 32) g4 = *(const float4*)(s.gain + ((4 * cg) & 31));
#pragma unroll 1
            for (int i = 0; i < 8; ++i) {
                const int rl = r0 + 16 * i, row = m0 + rl;
                float4 v = *(const float4*)&Cs[rl * CS_LD + 64 * j + 4 * cg];
                if (s.norm) {
                    float ss = v.x * v.x + v.y * v.y + v.z * v.z + v.w * v.w;
                    float sc;
                    if (s.norm == 64) { ss = group_sum16(ss); sc = 1.0f / sqrtf(ss * (1.0f / 64.0f) + EPS); }
                    else { ss = group_sum8(ss); sc = 1.0f / sqrtf(ss * (1.0f / 32.0f) + EPS); }
                    v.x *= sc * g4.x; v.y *= sc * g4.y; v.z *= sc * g4.z; v.w *= sc * g4.w;
                }
                if (s.bp) *(float4*)((row < SEQ ? s.bp : s.bs) + (size_t)row * s.ld + s.col + 4 * cg) = v;
                h16* hb = row < SEQ ? s.hp : s.hs;
                if (hb) {
                    h16x4 hv; hv.x = (h16)(v.x * s.hscale); hv.y = (h16)(v.y * s.hscale); hv.z = (h16)(v.z * s.hscale); hv.w = (h16)(v.w * s.hscale);
                    *(h16x4*)(hb + (size_t)row * s.hld + s.hcol + 4 * cg) = hv;
                }
            }
            if (s.vt == 2 && m0 < SEQ) vt_store(Cs, j, (h16*)(p.ws + WS_VTB_P) + (size_t)(s.head * 64) * SEQ + m0, SEQ, tid);
            if (s.vt == 1 && m0 < SEQ) vt_store(Cs, j, (h16*)(p.ws + WS_VTA_P) + (size_t)(s.head * 64) * SEQ + m0, SEQ, tid);
        }
    }
};

struct EpiMem {
    __device__ __forceinline__ void operator()(const Params& p, const float* Cs, int m0, int n0, int tid) const {
        const int cg = tid & 15, r0 = tid >> 4;
#pragma unroll 1
        for (int j = 0; j < 2; ++j) {
            const int n0j = n0 + 64 * j;
            const bool isk = n0j < 256;
            const float4 g4 = isk ? *(const float4*)(p.in[24] + 4 * cg) : make_float4(1.f, 1.f, 1.f, 1.f);
#pragma unroll 1
            for (int i = 0; i < 8; ++i) {
                const int rl = r0 + 16 * i, row = m0 + rl;
                float4 v = *(const float4*)&Cs[rl * CS_LD + 64 * j + 4 * cg];
                if (isk) {
                    float ss = group_sum16(v.x * v.x + v.y * v.y + v.z * v.z + v.w * v.w);
                    const float sc = 1.0f / sqrtf(ss * (1.0f / 64.0f) + EPS);
                    v.x *= sc * g4.x; v.y *= sc * g4.y; v.z *= sc * g4.z; v.w *= sc * g4.w;
                    h16x4 hv; hv.x = (h16)v.x; hv.y = (h16)v.y; hv.z = (h16)v.z; hv.w = (h16)v.w;
                    *(h16x4*)((h16*)(p.ws + WS_MK_P) + (size_t)row * 256 + n0j + 4 * cg) = hv;
                }
                float* dst = p.out + (isk ? O_PMK : O_PMV) + (size_t)row * 256 + (isk ? n0j : n0j - 256) + 4 * cg;
                *(float4*)dst = v;
            }
            if (!isk) vt_store(Cs, j, (h16*)(p.ws + WS_MVT_P) + (size_t)(((n0j - 256) >> 6) * 64) * NMEM + m0, NMEM, tid);
        }
    }
};

struct EpiOut {
    __device__ __forceinline__ void operator()(const Params& p, const float* Cs, int m0, int n0, int tid) const {
        const int cg = tid & 15, r0 = tid >> 4;
#pragma unroll 1
        for (int i = 0; i < 8; ++i) {
            const int rl = r0 + 16 * i, row = m0 + rl;
            const float* x = (row < SEQ ? p.in[0] + (size_t)row * D : p.in[1] + (size_t)(row - SEQ) * D) + n0 + 4 * cg;
            float* y = (row < SEQ ? p.out + O_YP + (size_t)row * D : p.out + O_YS + (size_t)(row - SEQ) * D) + n0 + 4 * cg;
#pragma unroll
            for (int j = 0; j < 2; ++j) {
                const float4 v = *(const float4*)&Cs[rl * CS_LD + 64 * j + 4 * cg];
                const float4 xv = *(const float4*)(x + 64 * j);
                *(float4*)(y + 64 * j) = make_float4(xv.x + v.x, xv.y + v.y, xv.z + v.z, xv.w + v.w);
            }
        }
    }
};

__device__ void phase1(const Params& p, unsigned char* smem) {
    const h16* XH = (const h16*)(p.ws + WS_XH);
    const h16* HMH = (const h16*)(p.ws + WS_HMH);
    const h16* WTIN = (const h16*)(p.ws + WS_WTIN);
    const h16* WTMEM = (const h16*)(p.ws + WS_WTMEM);
    constexpr int NCT = NPAD_IN / 128, NRT = MROWS / 128;
    constexpr int N_IN = NCT * NRT, N_MEM = 2 * 4;
    const EpiIn ein{}; const EpiMem emem{};
    for (int it = blockIdx.x; it < N_IN + N_MEM; it += gridDim.x) {
        if (it < N_IN) { const int rt = it / NCT, ct = it % NCT; gemm_tile(p, XH, WTIN, rt * 128, ct * 128, smem, ein); }
        else { const int im = it - N_IN, rt = im / 4, ct = im % 4; gemm_tile(p, HMH, WTMEM, rt * 128, ct * 128, smem, emem); }
    }
}

struct KeySrc {
    const float* cache; const float* fresh; int past; int ld;
    __device__ __forceinline__ const float* row(int k) const { return k < past ? cache + (size_t)k * ld : fresh + (size_t)(k - past) * ld; }
};

__device__ __forceinline__ unsigned fkey(float f) { const unsigned u = __float_as_uint(f); return (u & 0x80000000u) ? ~u : (u | 0x80000000u); }

struct SmemDsa {
    float sc[16384];
    float iq[256]; float iw[8];
    unsigned hist[256]; unsigned mw[512];
    int wcnt[4]; int wcnt2[4]; int misc[4];
};

__device__ void select_item(const Params& p, unsigned char* smem, int item) {
    SmemDsa& S = *(SmemDsa*)smem;
    int tid = threadIdx.x; asm volatile("" : "+v"(tid));
    const int lane = tid & 63, w = tid >> 6;
    const float* P = (const float*)(p.ws + WS_P);
    int row, N; KeySrc ki; unsigned* mout;
    if (item < SEQ) {
        row = item; N = 64 * (item / 64 + 1);
        ki = KeySrc{nullptr, p.out + O_PAKI, 0, 32};
        mout = (unsigned*)(p.ws + WS_MASK_P) + (size_t)item * 512;
    } else {
        const int bt = item - SEQ, b = bt / DECS;
        row = item; N = PAST + DECS;
        ki = KeySrc{p.in[5] + (size_t)b * PAST * 32, p.out + O_SAKI + (size_t)b * DECS * 32, PAST, 32};
        mout = (unsigned*)(p.ws + WS_MASK_S) + (size_t)bt * 34;
    }
    const int nw = N / 32;
    __syncthreads();
    if (N <= 256) {
        if (tid < nw) mout[tid] = 0xffffffffu;
        return;
    }
    S.iq[tid] = P[(size_t)row * LDP + PC_IQ + tid];
    if (tid < 8) S.iw[tid] = P[(size_t)row * LDP + PC_IW + tid];
    S.mw[tid] = 0u; S.mw[tid + 256] = 0u;
    __syncthreads();
    for (int k = tid; k < N; k += NT) {
        const float4* kr = (const float4*)ki.row(k);
        float kd[32];
#pragma unroll
        for (int i = 0; i < 8; ++i) { const float4 t4 = kr[i]; kd[4 * i] = t4.x; kd[4 * i + 1] = t4.y; kd[4 * i + 2] = t4.z; kd[4 * i + 3] = t4.w; }
        float score = 0.f;
#pragma unroll
        for (int h = 0; h < 8; ++h) {
            float d = 0.f;
#pragma unroll
            for (int i = 0; i < 32; ++i) d = fmaf(S.iq[h * 32 + i], kd[i], d);
            score = fmaf(S.iw[h], fmaxf(d, 0.f), score);
        }
        S.sc[k] = score;
    }
    __syncthreads();
    unsigned prefix = 0; int remaining = 256;
    for (int pass = 0; pass < 4; ++pass) {
        const int shift = 24 - 8 * pass;
        S.hist[tid] = 0;
        __syncthreads();
        for (int k = tid; k < N; k += NT) {
            const unsigned key = fkey(S.sc[k]);
            if (pass == 0 || (key >> (shift + 8)) == prefix) atomicAdd(&S.hist[(key >> shift) & 255u], 1u);
        }
        __syncthreads();
        const int hv = (int)S.hist[tid];
        int x = hv;
#pragma unroll
        for (int o = 1; o < 64; o <<= 1) { const int y = __shfl_down(x, o); if (lane + o < 64) x += y; }
        if (lane == 0) S.wcnt[w] = x;
        __syncthreads();
        int above = x - hv;
        for (int w2 = w + 1; w2 < 4; ++w2) above += S.wcnt[w2];
        if (above < remaining && remaining <= above + hv) { S.misc[0] = (int)((prefix << 8) | (unsigned)tid); S.misc[1] = remaining - above; }
        __syncthreads();
        prefix = (unsigned)S.misc[0]; remaining = S.misc[1];
        __syncthreads();
    }
    const unsigned T = prefix; const int r = remaining;
    int base_eq = 0;
    const unsigned long long lt = (lane == 0) ? 0ull : (~0ull >> (64 - lane));
    for (int k0 = 0; k0 < N; k0 += NT) {
        const int k = k0 + tid;
        const unsigned key = (k < N) ? fkey(S.sc[k]) : 0u;
        const bool gt = (k < N) && key > T, eq = (k < N) && key == T;
        const unsigned long long beq = __ballot(eq);
        const int eqpre = __popcll(beq & lt);
        if (lane == 0) S.wcnt[w] = __popcll(beq);
        __syncthreads();
        int eqbase = base_eq, eqtot = 0;
        for (int w2 = 0; w2 < 4; ++w2) { const int c = S.wcnt[w2]; if (w2 < w) eqbase += c; eqtot += c; }
        const bool sel = gt || (eq && (eqbase + eqpre) < r);
        const unsigned long long bs = __ballot(sel);
        if (lane == 0) S.mw[(k0 >> 5) + 2 * w] = (unsigned)bs;
        if (lane == 32) S.mw[(k0 >> 5) + 2 * w + 1] = (unsigned)(bs >> 32);
        base_eq += eqtot;
        __syncthreads();
    }
    for (int i = tid; i < nw; i += NT) mout[i] = S.mw[i];
}

typedef float f32x4m __attribute__((ext_vector_type(4)));
struct SelSm {
    unsigned hist[16][1024];
    float cand_s[16][64]; int cand_k[16][64];
    int cnt[16]; int bstar[16]; int nabove[16]; int ovf[16];
};

__device__ __forceinline__ void score_tile(const h16x8& a, const h16x8 (&bq)[8], const float (&wq)[8], float (&sc)[4]) {
    sc[0] = 0.f; sc[1] = 0.f; sc[2] = 0.f; sc[3] = 0.f;
#pragma unroll
    for (int h = 0; h < 8; ++h) {
        f32x4m z = {0.f, 0.f, 0.f, 0.f};
        const f32x4m d = __builtin_amdgcn_mfma_f32_16x16x32_f16(a, bq[h], z, 0, 0, 0);
#pragma unroll
        for (int i = 0; i < 4; ++i) sc[i] = fmaf(wq[h], fmaxf(d[i], 0.f), sc[i]);
    }
}

__device__ void select_unit(const Params& p, unsigned char* smem, int u) {
    SelSm& S = *(SelSm*)smem;
    int tid = threadIdx.x; asm volatile("" : "+v"(tid));
    const int lane = tid & 63, w = tid >> 6, q = lane & 15, g = lane >> 4;
    int row0, N, ldm, kslot; const h16* IK; unsigned* mask;
    if (u < 1024) {
        const int q0 = 16 * (1023 - u);
        row0 = q0; N = 64 * (q0 / 64 + 1); IK = (const h16*)(p.ws + WS_IK_P); mask = (unsigned*)(p.ws + WS_MASK_P) + (size_t)q0 * 512; ldm = 512; kslot = 0;
    } else {
        const int bu = u - 1024, b = bu >> 2, t0 = 16 * (bu & 3);
        row0 = SEQ + 64 * b + t0; N = PAST + DECS; IK = (const h16*)(p.ws + WS_IK_S) + (size_t)b * (PAST + DECS) * 32;
        mask = (unsigned*)(p.ws + WS_MASK_S) + (size_t)(64 * b + t0) * 34; ldm = 34; kslot = 1 + b;
    }
    const int nw = N / 32;
    __syncthreads();
    if (N <= 256) {
        for (int i = tid; i < 16 * nw; i += NT) mask[(size_t)(i / nw) * ldm + (i % nw)] = 0xffffffffu;
        return;
    }
    for (int i = tid; i < 16 * 1024; i += NT) ((unsigned*)S.hist)[i] = 0u;
    if (tid < 16) { S.cnt[tid] = 0; S.ovf[tid] = 0; S.bstar[tid] = 0; S.nabove[tid] = 0; }
    const int rowq = row0 + q;
    const h16* IQ = (const h16*)(p.ws + WS_IQ16) + (size_t)rowq * 256 + 8 * g;
    const float* Pf = (const float*)(p.ws + WS_P) + (size_t)rowq * LDP + PC_IW;
    h16x8 bq[8]; float wq[8];
    float hi = 0.f, lo = 0.f;
#pragma unroll
    for (int h = 0; h < 8; ++h) {
        bq[h] = *(const h16x8*)(IQ + h * 32);
        wq[h] = Pf[h];
        float n2 = 0.f;
#pragma unroll
        for (int e = 0; e < 8; ++e) { const float x = (float)bq[h][e]; n2 = fmaf(x, x, n2); }
        n2 += __shfl_xor(n2, 16); n2 += __shfl_xor(n2, 32);
        const float t = wq[h] * sqrtf(n2);
        if (t > 0.f) hi += t; else lo += t;
    }
    const float kmax = sqrtf(__uint_as_float(((const unsigned*)(p.ws + WS_CTL))[kslot])) * 1.01f;
    hi = hi * kmax + 1e-6f; lo = lo * kmax - 1e-6f;
    const float inv = 2048.0f / fmaxf(hi - lo, 1e-20f), off = -lo * inv;
    __syncthreads();
    for (int grp = w; grp < nw; grp += 4) {
#pragma unroll
        for (int t = 0; t < 2; ++t) {
            const int k0 = 32 * grp + 16 * t;
            const h16x8 a = *(const h16x8*)(IK + (size_t)(k0 + q) * 32 + 8 * g);
            float sc[4]; score_tile(a, bq, wq, sc);
#pragma unroll
            for (int i = 0; i < 4; ++i) {
                int b = (int)fmaf(sc[i], inv, off); b = b < 0 ? 0 : (b > 2047 ? 2047 : b);
                atomicAdd(&S.hist[q][b >> 1], 1u << ((b & 1) * 16));
            }
        }
    }
    __syncthreads();
    for (int qq = 0; qq < 4; ++qq) {
        const int qi = 4 * w + qq;
        unsigned c = 0;
#pragma unroll
        for (int e = 0; e < 16; ++e) { const unsigned v = S.hist[qi][16 * lane + e]; c += (v & 0xffffu) + (v >> 16); }
        int x = (int)c;
#pragma unroll
        for (int o = 1; o < 64; o <<= 1) { const int y = __shfl_down(x, o); if (lane + o < 64) x += y; }
        const int above = x - (int)c;
        if (above < 256 && 256 <= above + (int)c) {
            int acc = above, bs = 0; bool found = false;
            for (int e = 15; e >= 0 && !found; --e) {
                const unsigned v = S.hist[qi][16 * lane + e];
                const int h16c = (int)(v >> 16), l16c = (int)(v & 0xffffu);
                if (acc + h16c >= 256) { bs = 2 * (16 * lane + e) + 1; found = true; }
                else { acc += h16c; if (acc + l16c >= 256) { bs = 2 * (16 * lane + e); found = true; } else acc += l16c; }
            }
            S.bstar[qi] = bs; S.nabove[qi] = acc;
        }
    }
    __syncthreads();
    const int bst = S.bstar[q];
    for (int grp = w; grp < nw; grp += 4) {
        unsigned word = 0u;
#pragma unroll
        for (int t = 0; t < 2; ++t) {
            const int k0 = 32 * grp + 16 * t;
            const h16x8 a = *(const h16x8*)(IK + (size_t)(k0 + q) * 32 + 8 * g);
            float sc[4]; score_tile(a, bq, wq, sc);
            unsigned nib = 0u;
#pragma unroll
            for (int i = 0; i < 4; ++i) {
                int b = (int)fmaf(sc[i], inv, off); b = b < 0 ? 0 : (b > 2047 ? 2047 : b);
                if (b > bst) nib |= 1u << i;
                else if (b == bst) {
                    const int pos = atomicAdd(&S.cnt[q], 1);
                    if (pos < 64) { S.cand_s[q][pos] = sc[i]; S.cand_k[q][pos] = k0 + 4 * g + i; }
                }
            }
            unsigned v = nib << (4 * g);
            v |= (unsigned)__shfl_xor((int)v, 16); v |= (unsigned)__shfl_xor((int)v, 32);
            word |= v << (16 * t);
        }
        if (g == 0) mask[(size_t)q * ldm + grp] = word;
    }
    __threadfence();
    __syncthreads();
    for (int qq = 0; qq < 4; ++qq) {
        const int qi = 4 * w + qq;
        const int m = S.cnt[qi], r = 256 - S.nabove[qi];
        if (m > 64) { if (lane == 0) S.ovf[qi] = 1; continue; }
        const float s_me = lane < m ? S.cand_s[qi][lane] : 0.f;
        const int k_me = lane < m ? S.cand_k[qi][lane] : 0;
        int rank = 0;
        for (int j = 0; j < m; ++j) { const float sj = S.cand_s[qi][j]; const int kj = S.cand_k[qi][j]; rank += (sj > s_me || (sj == s_me && kj < k_me)) ? 1 : 0; }
        if (lane < m && rank < r) atomicOr(&mask[(size_t)qi * ldm + (k_me >> 5)], 1u << (k_me & 31));
    }
    __syncthreads();
    unsigned fl = 0u;
    for (int qi = 0; qi < 16; ++qi) fl |= (S.ovf[qi] ? 1u : 0u) << qi;
    if (fl) {
        __threadfence();
        for (int qi = 0; qi < 16; ++qi) if ((fl >> qi) & 1u) select_item(p, smem, row0 + qi);
    }
}

constexpr int ATT_TB_OFF = 32768;
constexpr int ATT_LDS = ATT_TB_OFF + 1024;

__device__ __forceinline__ int pi32(int r) { return (r & 0x13) | ((r & 4) << 1) | ((r & 8) >> 1); }
__device__ __forceinline__ unsigned pkrtz(float a, float b) { return __builtin_bit_cast(unsigned, __builtin_amdgcn_cvt_pkrtz(a, b)); }

struct AttnUnit {
    int row0, nwaves, ntiles, chunk0, chunk_step, qpos0, head;
    const h16* Kh; const h16* VTh; int ldk; int ldv;
    const float* Kc; const float* Vc; const float* Kn; const float* Vn; int ldf; int ntc;
    const unsigned* mask; int ldm;
};

template <int MODE, bool F32SRC>
__device__ __forceinline__ void attn_unit(const Params& p, unsigned char* smem, const AttnUnit& U, float lam) {
    int tid = threadIdx.x; asm volatile("" : "+v"(tid));
    const int lane = tid & 63, w = tid >> 6, l31 = lane & 31, hh = lane >> 5;
    const bool active = w < U.nwaves;
    const int chunk_w = U.chunk0 + U.chunk_step * (w >> 1);
    const int rowq = U.row0 + 32 * w + l31;
    const int qpos = U.qpos0 + 32 * w + l31;
    constexpr int NMAP = (MODE == 1) ? 2 : 1;
    float* tb = (float*)(smem + ATT_TB_OFF);
    __syncthreads();
    if (MODE != 2) {
        if (tid < 255) { const int hc = (MODE == 0 ? U.head : 8 + U.head); tb[tid] = (p.in[10][rel_bucket(tid - 191) * 12 + hc] - p.in[10][15 * 12 + hc]) * LOG2E; }
    }
    h16x8 qf[4];
    if (active) {
        const h16* Qb = (MODE == 0) ? (const h16*)(p.ws + WS_QA) + (size_t)rowq * 512 + U.head * 64
                      : (MODE == 1) ? (const h16*)(p.ws + WS_QB) + (size_t)rowq * 256 + U.head * 64
                                    : (const h16*)(p.ws + WS_QC) + (size_t)rowq * 256 + U.head * 64;
#pragma unroll
        for (int s = 0; s < 4; ++s) qf[s] = *(const h16x8*)(Qb + 16 * s + 8 * hh);
    } else {
#pragma unroll
        for (int s = 0; s < 4; ++s)
#pragma unroll
            for (int e = 0; e < 8; ++e) qf[s][e] = (h16)0.f;
    }
    f32x16 O[NMAP][2];
    float lsum[NMAP];
#pragma unroll
    for (int c = 0; c < NMAP; ++c) {
        lsum[c] = 0.f;
#pragma unroll
        for (int m = 0; m < 2; ++m)
#pragma unroll
            for (int r = 0; r < 16; ++r) O[c][m][r] = 0.f;
    }
    int crow[2], cch[2], so[2];
#pragma unroll
    for (int i = 0; i < 2; ++i) { const int c = tid + 256 * i; crow[i] = c >> 3; cch[i] = c & 7; so[i] = crow[i] * 128 + ((cch[i] ^ ((crow[i] >> 1) & 7)) << 4); }
    u32x4 rk[2], rv[2];
    f32x4 fk[2][2], fv[2][2];
#define ATT_LOAD(j) do { \
        if constexpr (!F32SRC) { \
            _Pragma("unroll") for (int i = 0; i < 2; ++i) { \
                rk[i] = *(const u32x4*)(U.Kh + (size_t)(64 * (j) + crow[i]) * U.ldk + cch[i] * 8); \
                rv[i] = *(const u32x4*)(U.VTh + (size_t)crow[i] * U.ldv + 64 * (j) + cch[i] * 8); } \
        } else { \
            const float* kb_ = ((j) < U.ntc) ? U.Kc + (size_t)(64 * (j)) * U.ldf : U.Kn + (size_t)(64 * ((j) - U.ntc)) * U.ldf; \
            const float* vb_ = ((j) < U.ntc) ? U.Vc + (size_t)(64 * (j)) * U.ldf : U.Vn + (size_t)(64 * ((j) - U.ntc)) * U.ldf; \
            _Pragma("unroll") for (int i = 0; i < 2; ++i) { \
                const float* ks_ = kb_ + (size_t)crow[i] * U.ldf + cch[i] * 8; const float* vs_ = vb_ + (size_t)crow[i] * U.ldf + cch[i] * 8; \
                fk[i][0] = *(const f32x4*)ks_; fk[i][1] = *(const f32x4*)(ks_ + 4); fv[i][0] = *(const f32x4*)vs_; fv[i][1] = *(const f32x4*)(vs_ + 4); } \
        } } while (0)
#define ATT_WRITE(b) do { \
        unsigned char* kt_ = smem + (b) * 16384; unsigned char* vt_ = kt_ + 8192; \
        if constexpr (!F32SRC) { \
            _Pragma("unroll") for (int i = 0; i < 2; ++i) { *(u32x4*)(kt_ + so[i]) = rk[i]; *(u32x4*)(vt_ + so[i]) = rv[i]; } \
        } else { \
            _Pragma("unroll") for (int i = 0; i < 2; ++i) { \
                h16x8 hk_; _Pragma("unroll") for (int e = 0; e < 4; ++e) { hk_[e] = (h16)fk[i][0][e]; hk_[4 + e] = (h16)fk[i][1][e]; } \
                *(h16x8*)(kt_ + so[i]) = hk_; \
                const int key_ = crow[i]; \
                _Pragma("unroll") for (int e = 0; e < 8; ++e) { const int dv_ = 8 * cch[i] + e; \
                    *(h16*)(vt_ + dv_ * 128 + (((key_ >> 3) ^ ((dv_ >> 1) & 7)) << 4) + (key_ & 7) * 2) = (h16)(e < 4 ? fv[i][0][e] : fv[i][1][e - 4]); } } \
        } } while (0)

    ATT_LOAD(0);
    ATT_WRITE(0);
    __syncthreads();
    const int pil = pi32(l31), ksw = (pil >> 1) & 7, vsw = (l31 >> 1) & 7;
    for (int j = 0; j < U.ntiles; ++j) {
        const int buf = j & 1;
        if (j + 1 < U.ntiles) ATT_LOAD(j + 1);
        if (active && (MODE == 2 || j <= chunk_w)) {
            const unsigned char* Kt = smem + buf * 16384;
            const unsigned char* Vt = Kt + 8192;
            unsigned mw[2] = {0xffffffffu, 0xffffffffu};
            if (MODE == 0) { mw[0] = U.mask[(size_t)(32 * w + l31) * U.ldm + 2 * j] >> (8 * hh); mw[1] = U.mask[(size_t)(32 * w + l31) * U.ldm + 2 * j + 1] >> (8 * hh); }
            h16x8 vf[2][4];
#pragma unroll
            for (int m = 0; m < 2; ++m)
#pragma unroll
                for (int sp = 0; sp < 4; ++sp) vf[m][sp] = *(const h16x8*)(Vt + (32 * m + l31) * 128 + (((2 * sp + hh) ^ vsw) << 4));
            const bool near = (MODE != 2) && (j >= chunk_w - 2);
#pragma unroll
            for (int c = 0; c < NMAP; ++c) {
                f32x16 S[2];
#pragma unroll
                for (int u = 0; u < 2; ++u) {
#pragma unroll
                    for (int r = 0; r < 16; ++r) S[u][r] = -P_SHIFT;
                    const unsigned char* kp = Kt + (32 * u + pil) * 128;
                    if (MODE == 1) {
#pragma unroll
                        for (int s = 0; s < 2; ++s) { const int idx = 2 * c + s; const h16x8 a = *(const h16x8*)(kp + (((2 * idx + hh) ^ ksw) << 4)); S[u] = __builtin_amdgcn_mfma_f32_32x32x16_f16(a, qf[idx], S[u], 0, 0, 0); }
                    } else {
#pragma unroll
                        for (int s = 0; s < 4; ++s) { const h16x8 a = *(const h16x8*)(kp + (((2 * s + hh) ^ ksw) << 4)); S[u] = __builtin_amdgcn_mfma_f32_32x32x16_f16(a, qf[s], S[u], 0, 0, 0); }
                    }
                }
                if (near) {
#pragma unroll
                    for (int u = 0; u < 2; ++u) {
                        const int base = 64 * j + 32 * u + 8 * hh - qpos + 191;
#pragma unroll
                        for (int i = 0; i < 16; ++i) S[u][i] += tb[base + (i & 7) + 16 * (i >> 3)];
                    }
                }
                float ls = 0.f;
#pragma unroll
                for (int u = 0; u < 2; ++u)
#pragma unroll
                    for (int i = 0; i < 16; ++i) {
                        float pv = __builtin_amdgcn_exp2f(S[u][i]);
                        if (MODE == 0) { const int mbit = __builtin_amdgcn_sbfe((int)mw[u], (i & 7) + 16 * (i >> 3), 1); pv = __uint_as_float(__float_as_uint(pv) & (unsigned)mbit); }
                        ls += pv; S[u][i] = pv;
                    }
                lsum[c] += ls;
                h16x8 pf[4];
#pragma unroll
                for (int sp = 0; sp < 4; ++sp) {
                    const int u = sp >> 1, b8 = 8 * (sp & 1);
                    u32x4 pk;
                    pk[0] = pkrtz(S[u][b8 + 0], S[u][b8 + 1]); pk[1] = pkrtz(S[u][b8 + 2], S[u][b8 + 3]);
                    pk[2] = pkrtz(S[u][b8 + 4], S[u][b8 + 5]); pk[3] = pkrtz(S[u][b8 + 6], S[u][b8 + 7]);
                    pf[sp] = __builtin_bit_cast(h16x8, pk);
                }
#pragma unroll
                for (int m = 0; m < 2; ++m)
#pragma unroll
                    for (int sp = 0; sp < 4; ++sp) O[c][m] = __builtin_amdgcn_mfma_f32_32x32x16_f16(vf[m][sp], pf[sp], O[c][m], 0, 0, 0);
            }
        }
        if (j + 1 < U.ntiles) ATT_WRITE(buf ^ 1);
        __syncthreads();
    }
#undef ATT_LOAD
#undef ATT_WRITE
    if (!active) return;
    const int colbase = (MODE == 0 ? 0 : (MODE == 1 ? 512 : 768)) + U.head * 64;
    const h16* G = (const h16*)(p.ws + WS_G) + (size_t)rowq * 1024 + colbase;
    h16* Oo = (h16*)(p.ws + WS_O16) + (size_t)rowq * 1024 + colbase;
    float inv[NMAP];
#pragma unroll
    for (int c = 0; c < NMAP; ++c) { const float l = lsum[c] + __shfl_xor(lsum[c], 32); inv[c] = 1.0f / l; }
    float ov[2][16];
    float ss = 0.f;
#pragma unroll
    for (int m = 0; m < 2; ++m)
#pragma unroll
        for (int i = 0; i < 16; ++i) {
            float o = O[0][m][i] * inv[0];
            if (MODE == 1) { o -= lam * (O[NMAP - 1][m][i] * inv[NMAP - 1]); ss += o * o; }
            ov[m][i] = o;
        }
    float sc = 1.f;
    if (MODE == 1) { ss += __shfl_xor(ss, 32); sc = (1.0f / sqrtf(ss * (1.0f / 64.0f) + EPS)) * 0.8f; }
#pragma unroll
    for (int m = 0; m < 2; ++m)
#pragma unroll
        for (int g4 = 0; g4 < 4; ++g4) {
            const int dv = 32 * m + 8 * g4 + 4 * hh;
            const h16x4 gv = *(const h16x4*)(G + dv);
            h16x4 o4;
#pragma unroll
            for (int e = 0; e < 4; ++e) {
                float o = ov[m][4 * g4 + e];
                if (MODE == 1) o = o * sc * p.in[18][dv + e];
                o4[e] = (h16)(o * silu((float)gv[e]));
            }
            *(h16x4*)(Oo + dv) = o4;
        }
}

__device__ __forceinline__ AttnUnit unit_zero() {
    AttnUnit U; U.row0 = 0; U.nwaves = 0; U.ntiles = 0; U.chunk0 = 0; U.chunk_step = 0; U.qpos0 = 0; U.head = 0; U.Kh = nullptr; U.VTh = nullptr; U.ldk = 0; U.ldv = 0;
    U.Kc = nullptr; U.Vc = nullptr; U.Kn = nullptr; U.Vn = nullptr; U.ldf = 0; U.ntc = 0; U.mask = nullptr; U.ldm = 0; return U;
}

__device__ void phase2(const Params& p, unsigned char* smem) {
    float s1 = 0.f, s2 = 0.f;
    for (int i = 0; i < 32; ++i) { s1 = fmaf(p.in[19][i], p.in[20][i], s1); s2 = fmaf(p.in[21][i], p.in[22][i], s2); }
    const float lam = expf(s1) - expf(s2) + 0.2f;
    constexpr int N_BP = 512, N_BS = 128, N_CP = 512, N_CS = 128, N_SEL = 1024 + 128;
    constexpr int N_ALL = N_BP + N_BS + N_CP + N_CS + N_SEL;
    for (int it0 = blockIdx.x; it0 < N_ALL; it0 += gridDim.x) {
        int it = it0;
        if (it < N_BP) {
            const int g = 127 - (it >> 2), head = it & 3;
            AttnUnit U = unit_zero();
            U.row0 = 128 * g; U.nwaves = 4; U.ntiles = 2 * g + 2; U.chunk0 = 2 * g; U.chunk_step = 1; U.qpos0 = 128 * g; U.head = head;
            U.Kh = (const h16*)(p.ws + WS_KB_P) + head * 64; U.ldk = 256;
            U.VTh = (const h16*)(p.ws + WS_VTB_P) + (size_t)(head * 64) * SEQ; U.ldv = SEQ;
            attn_unit<1, false>(p, smem, U, lam);
            continue;
        }
        it -= N_BP;
        if (it < N_BS) {
            const int b = it >> 2, head = it & 3;
            AttnUnit U = unit_zero();
            U.row0 = SEQ + 64 * b; U.nwaves = 2; U.ntiles = 17; U.chunk0 = 16; U.chunk_step = 0; U.qpos0 = PAST; U.head = head;
            U.Kc = p.in[6] + (size_t)b * PAST * 256 + head * 64; U.Vc = p.in[7] + (size_t)b * PAST * 256 + head * 64;
            U.Kn = p.out + O_SBK + (size_t)b * DECS * 256 + head * 64; U.Vn = p.out + O_SBV + (size_t)b * DECS * 256 + head * 64;
            U.ldf = 256; U.ntc = 16;
            attn_unit<1, true>(p, smem, U, lam);
            continue;
        }
        it -= N_BS;
        if (it < N_CP) {
            const int g = it >> 2, head = it & 3;
            AttnUnit U = unit_zero();
            U.row0 = 128 * g; U.nwaves = 4; U.ntiles = 4; U.head = head;
            U.Kh = (const h16*)(p.ws + WS_MK_P) + head * 64; U.ldk = 256;
            U.VTh = (const h16*)(p.ws + WS_MVT_P) + (size_t)(head * 64) * NMEM; U.ldv = NMEM;
            attn_unit<2, false>(p, smem, U, lam);
            continue;
        }
        it -= N_CP;
        if (it < N_CS) {
            const int b = it >> 2, head = it & 3;
            AttnUnit U = unit_zero();
            U.row0 = SEQ + 64 * b; U.nwaves = 2; U.ntiles = 4; U.head = head;
            U.Kc = p.in[8] + (size_t)b * NMEM * 256 + head * 64; U.Vc = p.in[9] + (size_t)b * NMEM * 256 + head * 64;
            U.Kn = U.Kc; U.Vn = U.Vc; U.ldf = 256; U.ntc = 4;
            attn_unit<2, true>(p, smem, U, lam);
            continue;
        }
        it -= N_CS;
        select_unit(p, smem, it);
    }
}

__device__ void phase3(const Params& p, unsigned char* smem) {
    constexpr int N_AP = 1024, N_AS = 256;
    for (int it0 = blockIdx.x; it0 < N_AP + N_AS; it0 += gridDim.x) {
        int it = it0;
        if (it < N_AP) {
            const int g = 127 - (it >> 3), head = it & 7;
            AttnUnit U = unit_zero();
            U.row0 = 128 * g; U.nwaves = 4; U.ntiles = 2 * g + 2; U.chunk0 = 2 * g; U.chunk_step = 1; U.qpos0 = 128 * g; U.head = head;
            U.Kh = (const h16*)(p.ws + WS_KA_P) + head * 64; U.ldk = 512;
            U.VTh = (const h16*)(p.ws + WS_VTA_P) + (size_t)(head * 64) * SEQ; U.ldv = SEQ;
            U.mask = (const unsigned*)(p.ws + WS_MASK_P) + (size_t)(128 * g) * 512; U.ldm = 512;
            attn_unit<0, false>(p, smem, U, 0.f);
            continue;
        }
        it -= N_AP;
        {
            const int b = it >> 3, head = it & 7;
            AttnUnit U = unit_zero();
            U.row0 = SEQ + 64 * b; U.nwaves = 2; U.ntiles = 17; U.chunk0 = 16; U.chunk_step = 0; U.qpos0 = PAST; U.head = head;
            U.Kc = p.in[3] + (size_t)b * PAST * 512 + head * 64; U.Vc = p.in[4] + (size_t)b * PAST * 512 + head * 64;
            U.Kn = p.out + O_SAK + (size_t)b * DECS * 512 + head * 64; U.Vn = p.out + O_SAV + (size_t)b * DECS * 512 + head * 64;
            U.ldf = 512; U.ntc = 16;
            U.mask = (const unsigned*)(p.ws + WS_MASK_S) + (size_t)(64 * b) * 34; U.ldm = 34;
            attn_unit<0, true>(p, smem, U, 0.f);
        }
    }
}

__device__ void phase4(const Params& p, unsigned char* smem) {
    const h16* O16 = (const h16*)(p.ws + WS_O16);
    const h16* WTOUT = (const h16*)(p.ws + WS_WTOUT);
    constexpr int NCT = D / 128, NRT = MROWS / 128;
    const EpiOut eo{};
    for (int it = blockIdx.x; it < NCT * NRT; it += gridDim.x) {
        const int rt = it / NCT, ct = it % NCT;
        gemm_tile(p, O16, WTOUT, rt * 128, ct * 128, smem, eo);
    }
}

constexpr int SMEM_BYTES = 80 * 1024;

__global__ void __launch_bounds__(NT) fwd_kernel(Params p) {
    __shared__ __attribute__((aligned(16))) unsigned char smem[SMEM_BYTES];
    static_assert(ATT_LDS <= SMEM_BYTES && sizeof(SmemDsa) <= SMEM_BYTES && sizeof(SelSm) <= SMEM_BYTES && CS_LD * 128 * 4 <= SMEM_BYTES, "smem");
    cg::grid_group grid = cg::this_grid();
    for (int ph = p.ph_lo; ph < p.ph_hi; ++ph) {
        if (ph == 0) phase0(p, smem);
        else if (ph == 1) phase1(p, smem);
        else if (ph == 2) phase2(p, smem);
        else if (ph == 3) phase3(p, smem);
        else phase4(p, smem);
        if (ph + 1 < p.ph_hi) grid.sync();
    }
}

extern "C" void kernel_launch(void* const* d_in, const int* in_sizes, int n_in, void* d_out, int out_size, void* d_ws, size_t ws_size, hipStream_t stream) {
    static int grid_blocks = 0;
    if (!grid_blocks) {
        int dev = 0, cus = 0, per_cu = 0;
        (void)hipGetDevice(&dev);
        (void)hipDeviceGetAttribute(&cus, hipDeviceAttributeMultiprocessorCount, dev);
        (void)hipOccupancyMaxActiveBlocksPerMultiprocessor(&per_cu, fwd_kernel, NT, 0);
        if (per_cu < 1) per_cu = 1;
        grid_blocks = cus * per_cu;
        if (ws_size < WS_END) fprintf(stderr, "kernel_launch: workspace too small: %zu < %zu\n", ws_size, (size_t)WS_END);
    }
    if (ws_size < WS_END) return;
    (void)hipMemsetAsync((unsigned char*)d_ws + WS_CTL, 0, 256, stream);
    Params p{};
    for (int i = 0; i < 27; ++i) p.in[i] = (const float*)d_in[i];
    p.out = (float*)d_out; p.ws = (unsigned char*)d_ws;
#if ONE_LAUNCH
    p.ph_lo = 0; p.ph_hi = 5;
    void* args[] = {&p};
    hipError_t e = hipLaunchCooperativeKernel((void*)fwd_kernel, dim3(grid_blocks), dim3(NT), args, 0, stream);
    if (e != hipSuccess) fprintf(stderr, "cooperative launch failed: %s (grid %d)\n", hipGetErrorString(e), grid_blocks);
#else
    for (int ph = 0; ph < 5; ++ph) {
        p.ph_lo = ph; p.ph_hi = ph + 1;
        hipLaunchKernelGGL(fwd_kernel, dim3(grid_blocks), dim3(NT), 0, stream, p);
    }
#endif
}
```

```cpp
#include <hip/hip_runtime.h>
#include <hip/hip_cooperative_groups.h>
#include <cstdio>
#include <cstdint>
namespace cg = cooperative_groups;

#define NT 256
#define ONE_LAUNCH 1

constexpr int D = 1024, SEQ = 16384, DECB = 32, DECS = 64, PAST = 1024, NMEM = 256;
constexpr int MROWS = SEQ + DECB * DECS;
constexpr int DIN = 3880;
constexpr int LDP = 264;
constexpr int PC_IQ = 0, PC_IW = 256;
constexpr float EPS = 1e-6f;

constexpr size_t O_YP = 0, O_YS = 16777216, O_PAK = 18874368, O_PAV = 27262976, O_PAKI = 35651584, O_PBK = 36175872,
                 O_PBV = 40370176, O_PMK = 44564480, O_PMV = 44630016, O_SAK = 44695552, O_SAV = 45744128,
                 O_SAKI = 46792704, O_SBK = 46858240, O_SBV = 47382528;

typedef _Float16 h16;
typedef h16 h16x2 __attribute__((ext_vector_type(2)));
typedef h16 h16x4 __attribute__((ext_vector_type(4)));
typedef h16 h16x8 __attribute__((ext_vector_type(8)));
typedef float f32x4 __attribute__((ext_vector_type(4)));
typedef unsigned u32x4 __attribute__((ext_vector_type(4)));
typedef float f32x16 __attribute__((ext_vector_type(16)));

constexpr int NPAD_IN = 3968;
constexpr float LOG2E = 1.4426950408889634f;
constexpr float P_SHIFT = 6.0f;
constexpr size_t WS_XH = 0;
constexpr size_t WS_O16 = WS_XH;
constexpr size_t WS_HMH = WS_XH + (size_t)MROWS * D * 2;
constexpr size_t WS_WTIN = WS_HMH + (size_t)NMEM * D * 2;
constexpr size_t WS_WTOUT = WS_WTIN + (size_t)NPAD_IN * D * 2;
constexpr size_t WS_WTMEM = WS_WTOUT + (size_t)D * D * 2;
constexpr size_t WS_QA = WS_WTMEM + (size_t)512 * D * 2;
constexpr size_t WS_QB = WS_QA + (size_t)MROWS * 512 * 2;
constexpr size_t WS_QC = WS_QB + (size_t)MROWS * 256 * 2;
constexpr size_t WS_G = WS_QC + (size_t)MROWS * 256 * 2;
constexpr size_t WS_KB_P = WS_G + (size_t)MROWS * 1024 * 2;
constexpr size_t WS_VTB_P = WS_KB_P + (size_t)SEQ * 256 * 2;
constexpr size_t WS_MK_P = WS_VTB_P + (size_t)SEQ * 256 * 2;
constexpr size_t WS_MVT_P = WS_MK_P + (size_t)NMEM * 256 * 2;
constexpr size_t WS_KA_P = WS_MVT_P + (size_t)NMEM * 256 * 2;
constexpr size_t WS_VTA_P = WS_KA_P + (size_t)SEQ * 512 * 2;
constexpr size_t WS_MASK_P = WS_VTA_P + (size_t)SEQ * 512 * 2;
constexpr size_t WS_MASK_S = WS_MASK_P + (size_t)SEQ * 512 * 4;
constexpr size_t WS_IQ16 = WS_MASK_S + (size_t)DECB * DECS * 34 * 4;
constexpr size_t WS_IK_P = WS_IQ16 + (size_t)MROWS * 256 * 2;
constexpr size_t WS_IK_S = WS_IK_P + (size_t)SEQ * 32 * 2;
constexpr size_t WS_CTL = WS_IK_S + (size_t)DECB * (PAST + DECS) * 32 * 2;
constexpr size_t WS_P = WS_CTL + 256;
constexpr size_t WS_END = WS_P + (size_t)MROWS * LDP * 4;

struct Params {
    const float* in[27];
    float* out;
    unsigned char* ws;
    int ph_lo, ph_hi;
};

__device__ __forceinline__ float wave_sum(float v) {
#pragma unroll
    for (int o = 1; o < 64; o <<= 1) v += __shfl_xor(v, o);
    return v;
}
__device__ __forceinline__ float wave_max(float v) {
#pragma unroll
    for (int o = 1; o < 64; o <<= 1) v = fmaxf(v, __shfl_xor(v, o));
    return v;
}
__device__ __forceinline__ float silu(float x) { return x / (1.0f + expf(-x)); }

__device__ __forceinline__ int rel_bucket(int rel) {
    const int ret = rel > 0 ? 16 : 0;
    const int n = rel < 0 ? -rel : rel;
    int b;
    if (n < 8) b = n;
    else if (n < 12) b = 8;
    else if (n < 16) b = 9;
    else if (n < 23) b = 10;
    else if (n < 32) b = 11;
    else if (n < 46) b = 12;
    else if (n < 64) b = 13;
    else if (n < 91) b = 14;
    else b = 15;
    return ret + b;
}

__device__ __forceinline__ void rms_row_h(const float* x, const float* g, h16* o, int lane) {
    const float4* xr = (const float4*)x;
    const float4* gr = (const float4*)g;
    float4 v[4];
    float s = 0.f;
#pragma unroll
    for (int j = 0; j < 4; ++j) { v[j] = xr[lane + 64 * j]; s += v[j].x * v[j].x + v[j].y * v[j].y + v[j].z * v[j].z + v[j].w * v[j].w; }
    s = wave_sum(s);
    const float r = 1.0f / sqrtf(s * (1.0f / 1024.0f) + EPS);
#pragma unroll
    for (int j = 0; j < 4; ++j) {
        const float4 gg = gr[lane + 64 * j];
        h16x4 o4; o4.x = (h16)(v[j].x * r * gg.x); o4.y = (h16)(v[j].y * r * gg.y); o4.z = (h16)(v[j].z * r * gg.z); o4.w = (h16)(v[j].w * r * gg.w);
        ((h16x4*)o)[lane + 64 * j] = o4;
    }
}

__device__ __forceinline__ void transpose_item(const float* __restrict__ W, int ldw, int c0, int nvalid, int k0, h16* __restrict__ WT, int r0, float* scr, int lane) {
#pragma unroll 8
    for (int i = 0; i < 32; ++i) {
        const int kk = 2 * i + (lane >> 5), n = lane & 31;
        scr[kk * 33 + n] = (n < nvalid) ? W[(size_t)(k0 + kk) * ldw + c0 + n] : 0.f;
    }
    asm volatile("s_waitcnt lgkmcnt(0)" ::: "memory");
    const int c = lane & 7;
#pragma unroll
    for (int j = 0; j < 4; ++j) {
        const int n = (lane >> 3) + 8 * j;
        const float* s = scr + (8 * c) * 33 + n;
        h16x8 o;
#pragma unroll
        for (int e = 0; e < 8; ++e) o[e] = (h16)s[e * 33];
        *(h16x8*)(WT + (size_t)(r0 + n) * 1024 + k0 + 8 * c) = o;
    }
    asm volatile("s_waitcnt lgkmcnt(0)" ::: "memory");
}

__device__ __forceinline__ int inproj_col(int np) { return np < 2304 ? np : (np < 3840 ? np + 40 : np - 3840 + 2304); }

__device__ void phase0(const Params& p, unsigned char* smem) {
    const int lane = threadIdx.x & 63, w = threadIdx.x >> 6;
    const int gw = blockIdx.x * 4 + w, ngw = gridDim.x * 4;
    h16* XH = (h16*)(p.ws + WS_XH);
    h16* HMH = (h16*)(p.ws + WS_HMH);
    h16* WTIN = (h16*)(p.ws + WS_WTIN);
    h16* WTOUT = (h16*)(p.ws + WS_WTOUT);
    h16* WTMEM = (h16*)(p.ws + WS_WTMEM);
    float* scr = (float*)smem + w * (64 * 33);
    constexpr int N_ROWS = MROWS + NMEM;
    constexpr int I_IN = 16 * (NPAD_IN / 32), I_OUT = 16 * 32, I_MEM = 16 * 16, I_KIDX = DECB * (PAST / 64);
    for (int it = gw; it < N_ROWS + I_IN + I_OUT + I_MEM + I_KIDX; it += ngw) {
        if (it < N_ROWS) {
            const int r = it;
            if (r < SEQ) rms_row_h(p.in[0] + (size_t)r * D, p.in[11], XH + (size_t)r * D, lane);
            else if (r < MROWS) rms_row_h(p.in[1] + (size_t)(r - SEQ) * D, p.in[11], XH + (size_t)r * D, lane);
            else rms_row_h(p.in[2] + (size_t)(r - MROWS) * D, p.in[25], HMH + (size_t)(r - MROWS) * D, lane);
        } else if (it < N_ROWS + I_IN) {
            const int r = it - N_ROWS, nb = r % (NPAD_IN / 32), kb = r / (NPAD_IN / 32);
            const int np0 = nb * 32;
            int nvalid = DIN - np0; nvalid = nvalid < 0 ? 0 : (nvalid > 32 ? 32 : nvalid);
            const int c0 = nvalid > 0 ? inproj_col(np0) : 0;
            transpose_item(p.in[12], DIN, c0, nvalid, kb * 64, WTIN, np0, scr, lane);
        } else if (it < N_ROWS + I_IN + I_OUT) {
            const int r = it - N_ROWS - I_IN, nb = r % 32, kb = r / 32;
            transpose_item(p.in[13], D, nb * 32, 32, kb * 64, WTOUT, nb * 32, scr, lane);
        } else if (it < N_ROWS + I_IN + I_OUT + I_MEM) {
            const int r = it - N_ROWS - I_IN - I_OUT, nb = r % 16, kb = r / 16;
            transpose_item(p.in[26], 512, nb * 32, 32, kb * 64, WTMEM, nb * 32, scr, lane);
        } else {
            const int r = it - N_ROWS - I_IN - I_OUT - I_MEM, b = r / (PAST / 64), key = (r % (PAST / 64)) * 64 + lane;
            const f32x4* src = (const f32x4*)(p.in[5] + ((size_t)b * PAST + key) * 32);
            h16* dst = (h16*)(p.ws + WS_IK_S) + ((size_t)b * (PAST + DECS) + key) * 32;
            float ss = 0.f;
#pragma unroll
            for (int c = 0; c < 4; ++c) {
                const f32x4 x0 = src[2 * c], x1 = src[2 * c + 1];
                h16x8 o;
#pragma unroll
                for (int e = 0; e < 4; ++e) { o[e] = (h16)x0[e]; o[4 + e] = (h16)x1[e]; ss = fmaf(x0[e], x0[e], ss); ss = fmaf(x1[e], x1[e], ss); }
                *(h16x8*)(dst + 8 * c) = o;
            }
            ss = wave_max(ss);
            if (lane == 0) atomicMax((unsigned*)(p.ws + WS_CTL) + 1 + b, __float_as_uint(ss));
        }
    }
}

constexpr int CS_LD = 132;
template <class Epi>
__device__ __forceinline__ void gemm_tile(const Params& p, const h16* __restrict__ A, const h16* __restrict__ Bt, int m0, int n0, unsigned char* smem, const Epi& epi) {
    int tid = threadIdx.x; asm volatile("" : "+v"(tid));
    const int lane = tid & 63, wid = tid >> 6, wm = wid >> 1, wn = wid & 1;
    const int l31 = lane & 31, hh = lane >> 5;
    f32x16 acc[2][2];
#pragma unroll
    for (int a = 0; a < 2; ++a)
#pragma unroll
        for (int b = 0; b < 2; ++b)
#pragma unroll
            for (int r = 0; r < 16; ++r) acc[a][b][r] = 0.f;
    const h16* ag[4]; const h16* bg[4]; int so[4];
#pragma unroll
    for (int i = 0; i < 4; ++i) {
        const int c = tid + 256 * i, row = c >> 3, ch = c & 7;
        ag[i] = A + (size_t)(m0 + row) * 1024 + ch * 8;
        bg[i] = Bt + (size_t)(n0 + row) * 1024 + ch * 8;
        so[i] = row * 128 + ((ch ^ ((row >> 1) & 7)) << 4);
    }
    unsigned char* As = smem; unsigned char* Bs = smem + 16384;
    u32x4 ra[4], rb[4];
#pragma unroll
    for (int i = 0; i < 4; ++i) { ra[i] = *(const u32x4*)(ag[i]); rb[i] = *(const u32x4*)(bg[i]); }
    __syncthreads();
#pragma unroll
    for (int i = 0; i < 4; ++i) { *(u32x4*)(As + so[i]) = ra[i]; *(u32x4*)(Bs + so[i]) = rb[i]; }
    __syncthreads();
    const int sw = (l31 >> 1) & 7;
    const int arow = (wm * 64 + l31) * 128, brow = (wn * 64 + l31) * 128;
    for (int kt = 0; kt < 16; ++kt) {
        if (kt < 15) {
#pragma unroll
            for (int i = 0; i < 4; ++i) { ra[i] = *(const u32x4*)(ag[i] + (kt + 1) * 64); rb[i] = *(const u32x4*)(bg[i] + (kt + 1) * 64); }
        }
#pragma unroll
        for (int s = 0; s < 4; ++s) {
            const int co = (((2 * s + hh) ^ sw) << 4);
            h16x8 a[2], b[2];
#pragma unroll
            for (int mt = 0; mt < 2; ++mt) a[mt] = *(const h16x8*)(As + arow + mt * 32 * 128 + co);
#pragma unroll
            for (int nt = 0; nt < 2; ++nt) b[nt] = *(const h16x8*)(Bs + brow + nt * 32 * 128 + co);
#pragma unroll
            for (int mt = 0; mt < 2; ++mt)
#pragma unroll
                for (int nt = 0; nt < 2; ++nt) acc[mt][nt] = __builtin_amdgcn_mfma_f32_32x32x16_f16(a[mt], b[nt], acc[mt][nt], 0, 0, 0);
        }
        __syncthreads();
        if (kt < 15) {
#pragma unroll
            for (int i = 0; i < 4; ++i) { *(u32x4*)(As + so[i]) = ra[i]; *(u32x4*)(Bs + so[i]) = rb[i]; }
            __syncthreads();
        }
    }
    float* Cs = (float*)smem;
#pragma unroll
    for (int mt = 0; mt < 2; ++mt)
#pragma unroll
        for (int nt = 0; nt < 2; ++nt)
#pragma unroll
            for (int r = 0; r < 16; ++r) {
                const int row = wm * 64 + mt * 32 + (r & 3) + 8 * (r >> 2) + 4 * hh, col = wn * 64 + nt * 32 + l31;
                Cs[row * CS_LD + col] = acc[mt][nt][r];
            }
    __syncthreads();
    epi(p, Cs, m0, n0, tid);
}

__device__ __forceinline__ float group_sum16(float v) { v += __shfl_xor(v, 1); v += __shfl_xor(v, 2); v += __shfl_xor(v, 4); v += __shfl_xor(v, 8); return v; }
__device__ __forceinline__ float group_sum8(float v) { v += __shfl_xor(v, 1); v += __shfl_xor(v, 2); v += __shfl_xor(v, 4); return v; }

struct Seg {
    float* bp; float* bs; int ld; int col; int norm; const float* gain;
    h16* hp; h16* hs; int hld; int hcol; float hscale;
    int vt; int head;
};

__device__ __forceinline__ Seg seg_of(const Params& p, int n0) {
    float* P = (float*)(p.ws + WS_P);
    float* out = p.out;
    h16* QA = (h16*)(p.ws + WS_QA); h16* QB = (h16*)(p.ws + WS_QB); h16* QC = (h16*)(p.ws + WS_QC); h16* G = (h16*)(p.ws + WS_G);
    Seg s; s.norm = 0; s.gain = nullptr; s.hp = nullptr; s.hs = nullptr; s.hld = 0; s.hcol = 0; s.hscale = 1.f; s.vt = 0; s.head = 0;
    s.bp = nullptr; s.bs = nullptr; s.ld = 0; s.col = 0;
#define SEG_O(op, os, ldv, c) do { s.bp = out + (op); s.bs = out + (os) - (size_t)SEQ * (ldv); s.ld = (ldv); s.col = (c); } while (0)
#define SEG_H(ptr, ldv, c, sc) do { s.hp = (ptr); s.hs = (ptr); s.hld = (ldv); s.hcol = (c); s.hscale = (sc); } while (0)
    if (n0 < 512) { s.norm = 64; s.gain = p.in[14]; SEG_H(QA, 512, n0, 0.125f * LOG2E); }
    else if (n0 < 1024) { SEG_O(O_PAK, O_SAK, 512, n0 - 512); s.norm = 64; s.gain = p.in[15]; s.hp = (h16*)(p.ws + WS_KA_P); s.hs = nullptr; s.hld = 512; s.hcol = n0 - 512; }
    else if (n0 < 1536) { SEG_O(O_PAV, O_SAV, 512, n0 - 1024); s.vt = 1; s.head = (n0 - 1024) >> 6; }
    else if (n0 < 2048) { SEG_H(G, 1024, n0 - 1536, 1.f); }
    else if (n0 < 2304) { s.bp = P; s.bs = P; s.ld = LDP; s.col = PC_IQ + n0 - 2048; SEG_H((h16*)(p.ws + WS_IQ16), 256, n0 - 2048, 1.f); }
    else if (n0 < 2560) { s.norm = 32; s.gain = p.in[16]; SEG_H(QB, 256, n0 - 2304, 0.17677669529663687f * LOG2E); }
    else if (n0 < 2816) { SEG_O(O_PBK, O_SBK, 256, n0 - 2560); s.norm = 32; s.gain = p.in[17]; s.hp = (h16*)(p.ws + WS_KB_P); s.hs = nullptr; s.hld = 256; s.hcol = n0 - 2560; }
    else if (n0 < 3072) { SEG_O(O_PBV, O_SBV, 256, n0 - 2816); s.vt = 2; s.head = (n0 - 2816) >> 6; }
    else if (n0 < 3328) { SEG_H(G, 1024, 512 + n0 - 3072, 1.f); }
    else if (n0 < 3584) { s.norm = 64; s.gain = p.in[23]; SEG_H(QC, 256, n0 - 3328, 0.125f * LOG2E); }
    else { SEG_H(G, 1024, 768 + n0 - 3584, 1.f); }
#undef SEG_O
#undef SEG_H
    return s;
}

__device__ __forceinline__ void vt_store(const float* Cs, int j, h16* dst_base, size_t ldv, int tid) {
    const int dv = tid & 63, rq = tid >> 6;
    h16* dst = dst_base + (size_t)dv * ldv + 32 * rq;
#pragma unroll
    for (int e8 = 0; e8 < 4; ++e8) {
        h16x8 o;
#pragma unroll
        for (int e = 0; e < 8; ++e) o[e] = (h16)Cs[(32 * rq + 8 * e8 + e) * CS_LD + 64 * j + dv];
        *(h16x8*)(dst + 8 * e8) = o;
    }
}

struct EpiIn {
    __device__ __forceinline__ void operator()(const Params& p, const float* Cs, int m0, int n0, int tid) const {
        const int cg = tid & 15, r0 = tid >> 4;
#pragma unroll 1
        for (int j = 0; j < 2; ++j) {
            const int n0j = n0 + 64 * j;
            if (n0j >= DIN) continue;
            if (n0j == 3840) {
                float* P = (float*)(p.ws + WS_P);
                float mx0 = 0.f, mx1 = 0.f;
#pragma unroll 1
                for (int i = 0; i < 8; ++i) {
                    const int rl = r0 + 16 * i, row = m0 + rl;
                    const float4 v = *(const float4*)&Cs[rl * CS_LD + 4 * cg];
                    float ss = (cg < 8) ? (v.x * v.x + v.y * v.y + v.z * v.z + v.w * v.w) : 0.f;
                    ss = group_sum8(ss);
                    if (i < 4) mx0 = fmaxf(mx0, ss); else mx1 = fmaxf(mx1, ss);
                    if (cg < 8) {
                        float* dst = (row < SEQ ? p.out + O_PAKI + (size_t)row * 32 : p.out + O_SAKI + (size_t)(row - SEQ) * 32) + 4 * cg; *(float4*)dst = v;
                        h16x4 hv; hv.x = (h16)v.x; hv.y = (h16)v.y; hv.z = (h16)v.z; hv.w = (h16)v.w;
                        h16* hd = row < SEQ ? (h16*)(p.ws + WS_IK_P) + (size_t)row * 32 : (h16*)(p.ws + WS_IK_S) + ((size_t)((row - SEQ) >> 6) * (PAST + DECS) + PAST + ((row - SEQ) & 63)) * 32;
                        *(h16x4*)(hd + 4 * cg) = hv;
                    }
                    else if (cg < 10) { *(float4*)(P + (size_t)row * LDP + PC_IW + 4 * (cg - 8)) = v; }
                }
                if (cg == 0) {
                    unsigned* ctl = (unsigned*)(p.ws + WS_CTL);
                    if (m0 < SEQ) atomicMax(ctl, __float_as_uint(fmaxf(mx0, mx1)));
                    else { const int b0 = (m0 - SEQ) >> 6; atomicMax(ctl + 1 + b0, __float_as_uint(mx0)); atomicMax(ctl + 2 + b0, __float_as_uint(mx1)); }
                }
                continue;
            }
            const Seg s = seg_of(p, n0j);
            float4 g4 = make_float4(1.f, 1.f, 1.f, 1.f);
            if (s.norm == 64) g4 = *(const float4*)(s.gain + 4 * cg);
            else if (s.norm == 32) g4 = *(const float4*)(s.gain + ((4 * cg) & 31));
#pragma unroll 1
            for (int i = 0; i < 8; ++i) {
                const int rl = r0 + 16 * i, row = m0 + rl;
                float4 v = *(const float4*)&Cs[rl * CS_LD + 64 * j + 4 * cg];
                if (s.norm) {
                    float ss = v.x * v.x + v.y * v.y + v.z * v.z + v.w * v.w;
                    float sc;
                    if (s.norm == 64) { ss = group_sum16(ss); sc = 1.0f / sqrtf(ss * (1.0f / 64.0f) + EPS); }
                    else { ss = group_sum8(ss); sc = 1.0f / sqrtf(ss * (1.0f / 32.0f) + EPS); }
                    v.x *= sc * g4.x; v.y *= sc * g4.y; v.z *= sc * g4.z; v.w *= sc * g4.w;
                }
                if (s.bp) *(float4*)((row < SEQ ? s.bp : s.bs) + (size_t)row * s.ld + s.col + 4 * cg) = v;
                h16* hb = row < SEQ ? s.hp : s.hs;
                if (hb) {
                    h16x4 hv; hv.x = (h16)(v.x * s.hscale); hv.y = (h16)(v.y * s.hscale); hv.z = (h16)(v.z * s.hscale); hv.w = (h16)(v.w * s.hscale);
                    *(h16x4*)(hb + (size_t)row * s.hld + s.hcol + 4 * cg) = hv;
                }
            }
            if (s.vt == 2 && m0 < SEQ) vt_store(Cs, j, (h16*)(p.ws + WS_VTB_P) + (size_t)(s.head * 64) * SEQ + m0, SEQ, tid);
            if (s.vt == 1 && m0 < SEQ) vt_store(Cs, j, (h16*)(p.ws + WS_VTA_P) + (size_t)(s.head * 64) * SEQ + m0, SEQ, tid);
        }
    }
};

struct EpiMem {
    __device__ __forceinline__ void operator()(const Params& p, const float* Cs, int m0, int n0, int tid) const {
        const int cg = tid & 15, r0 = tid >> 4;
#pragma unroll 1
        for (int j = 0; j < 2; ++j) {
            const int n0j = n0 + 64 * j;
            const bool isk = n0j < 256;
            const float4 g4 = isk ? *(const float4*)(p.in[24] + 4 * cg) : make_float4(1.f, 1.f, 1.f, 1.f);
#pragma unroll 1
            for (int i = 0; i < 8; ++i) {
                const int rl = r0 + 16 * i, row = m0 + rl;
                float4 v = *(const float4*)&Cs[rl * CS_LD + 64 * j + 4 * cg];
                if (isk) {
                    float ss = group_sum16(v.x * v.x + v.y * v.y + v.z * v.z + v.w * v.w);
                    const float sc = 1.0f / sqrtf(ss * (1.0f / 64.0f) + EPS);
                    v.x *= sc * g4.x; v.y *= sc * g4.y; v.z *= sc * g4.z; v.w *= sc * g4.w;
                    h16x4 hv; hv.x = (h16)v.x; hv.y = (h16)v.y; hv.z = (h16)v.z; hv.w = (h16)v.w;
                    *(h16x4*)((h16*)(p.ws + WS_MK_P) + (size_t)row * 256 + n0j + 4 * cg) = hv;
                }
                float* dst = p.out + (isk ? O_PMK : O_PMV) + (size_t)row * 256 + (isk ? n0j : n0j - 256) + 4 * cg;
                *(float4*)dst = v;
            }
            if (!isk) vt_store(Cs, j, (h16*)(p.ws + WS_MVT_P) + (size_t)(((n0j - 256) >> 6) * 64) * NMEM + m0, NMEM, tid);
        }
    }
};

struct EpiOut {
    __device__ __forceinline__ void operator()(const Params& p, const float* Cs, int m0, int n0, int tid) const {
        const int cg = tid & 15, r0 = tid >> 4;
#pragma unroll 1
        for (int i = 0; i < 8; ++i) {
            const int rl = r0 + 16 * i, row = m0 + rl;
            const float* x = (row < SEQ ? p.in[0] + (size_t)row * D : p.in[1] + (size_t)(row - SEQ) * D) + n0 + 4 * cg;
            float* y = (row < SEQ ? p.out + O_YP + (size_t)row * D : p.out + O_YS + (size_t)(row - SEQ) * D) + n0 + 4 * cg;
#pragma unroll
            for (int j = 0; j < 2; ++j) {
                const float4 v = *(const float4*)&Cs[rl * CS_LD + 64 * j + 4 * cg];
                const float4 xv = *(const float4*)(x + 64 * j);
                *(float4*)(y + 64 * j) = make_float4(xv.x + v.x, xv.y + v.y, xv.z + v.z, xv.w + v.w);
            }
        }
    }
};

__device__ void phase1(const Params& p, unsigned char* smem) {
    const h16* XH = (const h16*)(p.ws + WS_XH);
    const h16* HMH = (const h16*)(p.ws + WS_HMH);
    const h16* WTIN = (const h16*)(p.ws + WS_WTIN);
    const h16* WTMEM = (const h16*)(p.ws + WS_WTMEM);
    const EpiIn ein{}; const EpiMem emem{};
    const int G = gridDim.x;
    if ((G & 7) == 0) {
        const int xcd = blockIdx.x & 7, local = blockIdx.x >> 3, LG = G >> 3;
        for (int lin = local; lin < 6 * 96; lin += LG) {
            const int rgroup = lin / 96, rem = lin % 96, chalf = rem / 48, rem2 = rem % 48, r = rem2 >> 4, c = chalf * 16 + (rem2 & 15);
            if (c >= 31) continue;
            const int rt = xcd + 8 * (rgroup * 3 + r);
            gemm_tile(p, XH, WTIN, rt * 128, c * 128, smem, ein);
        }
        if (blockIdx.x < 8) { const int rt = blockIdx.x / 4, ct = blockIdx.x % 4; gemm_tile(p, HMH, WTMEM, rt * 128, ct * 128, smem, emem); }
    } else {
        constexpr int NCT = NPAD_IN / 128, NRT = MROWS / 128;
        constexpr int N_IN = NCT * NRT, N_MEM = 2 * 4;
        for (int it = blockIdx.x; it < N_IN + N_MEM; it += gridDim.x) {
            if (it < N_IN) { const int rt = it / NCT, ct = it % NCT; gemm_tile(p, XH, WTIN, rt * 128, ct * 128, smem, ein); }
            else { const int im = it - N_IN, rt = im / 4, ct = im % 4; gemm_tile(p, HMH, WTMEM, rt * 128, ct * 128, smem, emem); }
        }
    }
}

struct KeySrc {
    const float* cache; const float* fresh; int past; int ld;
    __device__ __forceinline__ const float* row(int k) const { return k < past ? cache + (size_t)k * ld : fresh + (size_t)(k - past) * ld; }
};

__device__ __forceinline__ unsigned fkey(float f) { const unsigned u = __float_as_uint(f); return (u & 0x80000000u) ? ~u : (u | 0x80000000u); }

struct SmemDsa {
    float sc[16384];
    float iq[256]; float iw[8];
    unsigned hist[256]; unsigned mw[512];
    int wcnt[4]; int wcnt2[4]; int misc[4];
};

__device__ void select_item(const Params& p, unsigned char* smem, int item) {
    SmemDsa& S = *(SmemDsa*)smem;
    int tid = threadIdx.x; asm volatile("" : "+v"(tid));
    const int lane = tid & 63, w = tid >> 6;
    const float* P = (const float*)(p.ws + WS_P);
    int row, N; KeySrc ki; unsigned* mout;
    if (item < SEQ) {
        row = item; N = 64 * (item / 64 + 1);
        ki = KeySrc{nullptr, p.out + O_PAKI, 0, 32};
        mout = (unsigned*)(p.ws + WS_MASK_P) + (size_t)item * 512;
    } else {
        const int bt = item - SEQ, b = bt / DECS;
        row = item; N = PAST + DECS;
        ki = KeySrc{p.in[5] + (size_t)b * PAST * 32, p.out + O_SAKI + (size_t)b * DECS * 32, PAST, 32};
        mout = (unsigned*)(p.ws + WS_MASK_S) + (size_t)bt * 34;
    }
    const int nw = N / 32;
    __syncthreads();
    if (N <= 256) {
        if (tid < nw) mout[tid] = 0xffffffffu;
        return;
    }
    S.iq[tid] = P[(size_t)row * LDP + PC_IQ + tid];
    if (tid < 8) S.iw[tid] = P[(size_t)row * LDP + PC_IW + tid];
    S.mw[tid] = 0u; S.mw[tid + 256] = 0u;
    __syncthreads();
    for (int k = tid; k < N; k += NT) {
        const float4* kr = (const float4*)ki.row(k);
        float kd[32];
#pragma unroll
        for (int i = 0; i < 8; ++i) { const float4 t4 = kr[i]; kd[4 * i] = t4.x; kd[4 * i + 1] = t4.y; kd[4 * i + 2] = t4.z; kd[4 * i + 3] = t4.w; }
        float score = 0.f;
#pragma unroll 1
        for (int h = 0; h < 8; ++h) {
            float d = 0.f;
#pragma unroll
            for (int i = 0; i < 32; ++i) d = fmaf(S.iq[h * 32 + i], kd[i], d);
            score = fmaf(S.iw[h], fmaxf(d, 0.f), score);
        }
        S.sc[k] = score;
    }
    __syncthreads();
    unsigned prefix = 0; int remaining = 256;
    for (int pass = 0; pass < 4; ++pass) {
        const int shift = 24 - 8 * pass;
        S.hist[tid] = 0;
        __syncthreads();
        for (int k = tid; k < N; k += NT) {
            const unsigned key = fkey(S.sc[k]);
            if (pass == 0 || (key >> (shift + 8)) == prefix) atomicAdd(&S.hist[(key >> shift) & 255u], 1u);
        }
        __syncthreads();
        const int hv = (int)S.hist[tid];
        int x = hv;
#pragma unroll
        for (int o = 1; o < 64; o <<= 1) { const int y = __shfl_down(x, o); if (lane + o < 64) x += y; }
        if (lane == 0) S.wcnt[w] = x;
        __syncthreads();
        int above = x - hv;
        for (int w2 = w + 1; w2 < 4; ++w2) above += S.wcnt[w2];
        if (above < remaining && remaining <= above + hv) { S.misc[0] = (int)((prefix << 8) | (unsigned)tid); S.misc[1] = remaining - above; }
        __syncthreads();
        prefix = (unsigned)S.misc[0]; remaining = S.misc[1];
        __syncthreads();
    }
    const unsigned T = prefix; const int r = remaining;
    int base_eq = 0;
    const unsigned long long lt = (lane == 0) ? 0ull : (~0ull >> (64 - lane));
    for (int k0 = 0; k0 < N; k0 += NT) {
        const int k = k0 + tid;
        const unsigned key = (k < N) ? fkey(S.sc[k]) : 0u;
        const bool gt = (k < N) && key > T, eq = (k < N) && key == T;
        const unsigned long long beq = __ballot(eq);
        const int eqpre = __popcll(beq & lt);
        if (lane == 0) S.wcnt[w] = __popcll(beq);
        __syncthreads();
        int eqbase = base_eq, eqtot = 0;
        for (int w2 = 0; w2 < 4; ++w2) { const int c = S.wcnt[w2]; if (w2 < w) eqbase += c; eqtot += c; }
        const bool sel = gt || (eq && (eqbase + eqpre) < r);
        const unsigned long long bs = __ballot(sel);
        if (lane == 0) S.mw[(k0 >> 5) + 2 * w] = (unsigned)bs;
        if (lane == 32) S.mw[(k0 >> 5) + 2 * w + 1] = (unsigned)(bs >> 32);
        base_eq += eqtot;
        __syncthreads();
    }
    for (int i = tid; i < nw; i += NT) mout[i] = S.mw[i];
}

typedef float f32x4m __attribute__((ext_vector_type(4)));
struct SelSm {
    unsigned hist[16][1024];
    float cand_s[16][64]; int cand_k[16][64];
    int cnt[16]; int bstar[16]; int nabove[16]; int ovf[16];
};

__device__ __forceinline__ void score_tile(const h16x8& a, const h16x8 (&bq)[8], const float (&wq)[8], float (&sc)[4]) {
    sc[0] = 0.f; sc[1] = 0.f; sc[2] = 0.f; sc[3] = 0.f;
#pragma unroll
    for (int h = 0; h < 8; ++h) {
        f32x4m z = {0.f, 0.f, 0.f, 0.f};
        const f32x4m d = __builtin_amdgcn_mfma_f32_16x16x32_f16(a, bq[h], z, 0, 0, 0);
#pragma unroll
        for (int i = 0; i < 4; ++i) { const int bits = (int)__float_as_uint(d[i]); sc[i] = fmaf(wq[h], __uint_as_float((unsigned)(bits > 0 ? bits : 0)), sc[i]); }
    }
}

__device__ void select_unit(const Params& p, unsigned char* smem, int u) {
    SelSm& S = *(SelSm*)smem;
    int tid = threadIdx.x; asm volatile("" : "+v"(tid));
    const int lane = tid & 63, w = __builtin_amdgcn_readfirstlane(tid >> 6), q = lane & 15, g = lane >> 4;
    int row0, N, ldm, kslot; const h16* IK; unsigned* mask;
    if (u < 1024) {
        const int q0 = 16 * (1023 - u);
        row0 = q0; N = 64 * (q0 / 64 + 1); IK = (const h16*)(p.ws + WS_IK_P); mask = (unsigned*)(p.ws + WS_MASK_P) + (size_t)q0 * 512; ldm = 512; kslot = 0;
    } else {
        const int bu = u - 1024, b = bu >> 2, t0 = 16 * (bu & 3);
        row0 = SEQ + 64 * b + t0; N = PAST + DECS; IK = (const h16*)(p.ws + WS_IK_S) + (size_t)b * (PAST + DECS) * 32;
        mask = (unsigned*)(p.ws + WS_MASK_S) + (size_t)(64 * b + t0) * 34; ldm = 34; kslot = 1 + b;
    }
    const int nw = N / 32;
    __syncthreads();
    if (N <= 256) {
        for (int i = tid; i < 16 * nw; i += NT) mask[(size_t)(i / nw) * ldm + (i % nw)] = 0xffffffffu;
        return;
    }
    for (int i = tid; i < 16 * 1024; i += NT) ((unsigned*)S.hist)[i] = 0u;
    if (tid < 16) { S.cnt[tid] = 0; S.ovf[tid] = 0; S.bstar[tid] = 0; S.nabove[tid] = 0; }
    const int rowq = row0 + q;
    const h16* IQ = (const h16*)(p.ws + WS_IQ16) + (size_t)rowq * 256 + 8 * g;
    const float* Pf = (const float*)(p.ws + WS_P) + (size_t)rowq * LDP + PC_IW;
    h16x8 bq[8]; float wq[8];
    float hi = 0.f, lo = 0.f;
#pragma unroll
    for (int h = 0; h < 8; ++h) {
        bq[h] = *(const h16x8*)(IQ + h * 32);
        wq[h] = Pf[h];
        float n2 = 0.f;
#pragma unroll
        for (int e = 0; e < 8; ++e) { const float x = (float)bq[h][e]; n2 = fmaf(x, x, n2); }
        n2 += __shfl_xor(n2, 16); n2 += __shfl_xor(n2, 32);
        const float t = wq[h] * sqrtf(n2);
        if (t > 0.f) hi += t; else lo += t;
    }
    const float kmax = sqrtf(__uint_as_float(((const unsigned*)(p.ws + WS_CTL))[kslot])) * 1.01f;
    hi = hi * kmax + 1e-6f; lo = lo * kmax - 1e-6f;
    const float inv = 1024.0f / fmaxf(hi - lo, 1e-20f), off = -lo * inv;
    __syncthreads();
    {
        const h16* ikp = IK + (size_t)q * 32 + 8 * g;
        h16x8 a0 = *(const h16x8*)(ikp + (size_t)(32 * w) * 32), a1 = *(const h16x8*)(ikp + (size_t)(32 * w + 16) * 32);
        for (int grp = w; grp < nw; grp += 4) {
            const int gn = grp + 4 < nw ? grp + 4 : grp;
            const h16x8 n0 = *(const h16x8*)(ikp + (size_t)(32 * gn) * 32), n1 = *(const h16x8*)(ikp + (size_t)(32 * gn + 16) * 32);
#pragma unroll
            for (int t = 0; t < 2; ++t) {
                float sc[4]; score_tile(t == 0 ? a0 : a1, bq, wq, sc);
#pragma unroll
                for (int i = 0; i < 4; ++i) {
                    int b = (int)fmaf(sc[i], inv, off); b = b < 0 ? 0 : (b > 1023 ? 1023 : b);
                    atomicAdd(&S.hist[q][b], 1u);
                }
            }
            a0 = n0; a1 = n1;
        }
    }
    __syncthreads();
    for (int qq = 0; qq < 4; ++qq) {
        const int qi = 4 * w + qq;
        unsigned c = 0;
#pragma unroll
        for (int e = 0; e < 16; ++e) c += S.hist[qi][16 * lane + e];
        int x = (int)c;
#pragma unroll
        for (int o = 1; o < 64; o <<= 1) { const int y = __shfl_down(x, o); if (lane + o < 64) x += y; }
        const int above = x - (int)c;
        if (above < 256 && 256 <= above + (int)c) {
            int acc = above, bs = 16 * lane;
            for (int e = 15; e >= 0; --e) {
                const int v = (int)S.hist[qi][16 * lane + e];
                if (acc + v >= 256) { bs = 16 * lane + e; break; }
                acc += v;
            }
            S.bstar[qi] = bs; S.nabove[qi] = acc;
        }
    }
    __syncthreads();
    const int bst = S.bstar[q];
    {
        const h16* ikp = IK + (size_t)q * 32 + 8 * g;
        h16x8 a0 = *(const h16x8*)(ikp + (size_t)(32 * w) * 32), a1 = *(const h16x8*)(ikp + (size_t)(32 * w + 16) * 32);
        for (int grp = w; grp < nw; grp += 4) {
            const int gn = grp + 4 < nw ? grp + 4 : grp;
            const h16x8 n0 = *(const h16x8*)(ikp + (size_t)(32 * gn) * 32), n1 = *(const h16x8*)(ikp + (size_t)(32 * gn + 16) * 32);
            unsigned word = 0u;
#pragma unroll
            for (int t = 0; t < 2; ++t) {
                const int k0 = 32 * grp + 16 * t;
                float sc[4]; score_tile(t == 0 ? a0 : a1, bq, wq, sc);
                unsigned nib = 0u;
#pragma unroll
                for (int i = 0; i < 4; ++i) {
                    int b = (int)fmaf(sc[i], inv, off); b = b < 0 ? 0 : (b > 1023 ? 1023 : b);
                    if (b > bst) nib |= 1u << i;
                    else if (b == bst) {
                        const int pos = atomicAdd(&S.cnt[q], 1);
                        if (pos < 64) { S.cand_s[q][pos] = sc[i]; S.cand_k[q][pos] = k0 + 4 * g + i; }
                    }
                }
                unsigned v = nib << (4 * g);
                v |= (unsigned)__shfl_xor((int)v, 16); v |= (unsigned)__shfl_xor((int)v, 32);
                word |= v << (16 * t);
            }
            if (g == 0) mask[(size_t)q * ldm + grp] = word;
            a0 = n0; a1 = n1;
        }
    }
    __threadfence();
    __syncthreads();
    for (int qq = 0; qq < 4; ++qq) {
        const int qi = 4 * w + qq;
        const int m = S.cnt[qi], r = 256 - S.nabove[qi];
        if (m > 64) { if (lane == 0) S.ovf[qi] = 1; continue; }
        const float s_me = lane < m ? S.cand_s[qi][lane] : 0.f;
        const int k_me = lane < m ? S.cand_k[qi][lane] : 0;
        int rank = 0;
        for (int j = 0; j < m; ++j) { const float sj = S.cand_s[qi][j]; const int kj = S.cand_k[qi][j]; rank += (sj > s_me || (sj == s_me && kj < k_me)) ? 1 : 0; }
        if (lane < m && rank < r) atomicOr(&mask[(size_t)qi * ldm + (k_me >> 5)], 1u << (k_me & 31));
    }
    __syncthreads();
    unsigned fl = 0u;
    for (int qi = 0; qi < 16; ++qi) fl |= (S.ovf[qi] ? 1u : 0u) << qi;
    if (fl) {
        __threadfence();
        for (int qi = 0; qi < 16; ++qi) if ((fl >> qi) & 1u) select_item(p, smem, row0 + qi);
    }
}

constexpr int ATT_TB_OFF = 32768;
constexpr int ATT_LDS = ATT_TB_OFF + 1024;

__device__ __forceinline__ int pi32(int r) { return (r & 0x13) | ((r & 4) << 1) | ((r & 8) >> 1); }
__device__ __forceinline__ unsigned pkrtz(float a, float b) { return __builtin_bit_cast(unsigned, __builtin_amdgcn_cvt_pkrtz(a, b)); }

struct AttnUnit {
    int row0, nwaves, ntiles, chunk0, chunk_step, qpos0, head;
    const h16* Kh; const h16* VTh; int ldk; int ldv;
    const float* Kc; const float* Vc; const float* Kn; const float* Vn; int ldf; int ntc;
    const unsigned* mask; int ldm;
};

template <int MODE, bool F32SRC>
__device__ __forceinline__ void attn_unit(const Params& p, unsigned char* smem, const AttnUnit& U, float lam) {
    int tid = threadIdx.x; asm volatile("" : "+v"(tid));
    const int lane = tid & 63, w = __builtin_amdgcn_readfirstlane(tid >> 6), l31 = lane & 31, hh = lane >> 5;
    const int qt = (MODE == 1) ? (w & 1) : w, cmap = (MODE == 1) ? (w >> 1) : 0;
    const bool active = qt < U.nwaves;
    const int chunk_w = U.chunk0 + U.chunk_step * (qt >> 1);
    const int rowq = U.row0 + 32 * qt + l31;
    const int qpos = U.qpos0 + 32 * qt + l31;
    float* tb = (float*)(smem + ATT_TB_OFF);
    __syncthreads();
    if (MODE != 2) {
        if (tid < 255) { const int hc = (MODE == 0 ? U.head : 8 + U.head); tb[tid] = (p.in[10][rel_bucket(tid - 191) * 12 + hc] - p.in[10][15 * 12 + hc]) * LOG2E; }
    }
    constexpr int NQF = (MODE == 1) ? 2 : 4;
    h16x8 qf[NQF];
    if (active) {
        const h16* Qb = (MODE == 0) ? (const h16*)(p.ws + WS_QA) + (size_t)rowq * 512 + U.head * 64
                      : (MODE == 1) ? (const h16*)(p.ws + WS_QB) + (size_t)rowq * 256 + U.head * 64 + 32 * cmap
                                    : (const h16*)(p.ws + WS_QC) + (size_t)rowq * 256 + U.head * 64;
#pragma unroll
        for (int s = 0; s < NQF; ++s) qf[s] = *(const h16x8*)(Qb + 16 * s + 8 * hh);
    } else {
#pragma unroll
        for (int s = 0; s < NQF; ++s)
#pragma unroll
            for (int e = 0; e < 8; ++e) qf[s][e] = (h16)0.f;
    }
    f32x16 O[2];
    float lsum = 0.f;
#pragma unroll
    for (int m = 0; m < 2; ++m)
#pragma unroll
        for (int r = 0; r < 16; ++r) O[m][r] = 0.f;
    int crow[2], cch[2], so[2];
#pragma unroll
    for (int i = 0; i < 2; ++i) { const int c = tid + 256 * i; crow[i] = c >> 3; cch[i] = c & 7; so[i] = crow[i] * 128 + ((cch[i] ^ ((crow[i] >> 1) & 7)) << 4); }
    u32x4 rk[2], rv[2];
    f32x4 fk[2][2], fv[2][2];
#define ATT_LOAD(j) do { \
        if constexpr (!F32SRC) { \
            _Pragma("unroll") for (int i = 0; i < 2; ++i) { \
                rk[i] = *(const u32x4*)(U.Kh + (size_t)(64 * (j) + crow[i]) * U.ldk + cch[i] * 8); \
                rv[i] = *(const u32x4*)(U.VTh + (size_t)crow[i] * U.ldv + 64 * (j) + cch[i] * 8); } \
        } else { \
            const float* kb_ = ((j) < U.ntc) ? U.Kc + (size_t)(64 * (j)) * U.ldf : U.Kn + (size_t)(64 * ((j) - U.ntc)) * U.ldf; \
            const float* vb_ = ((j) < U.ntc) ? U.Vc + (size_t)(64 * (j)) * U.ldf : U.Vn + (size_t)(64 * ((j) - U.ntc)) * U.ldf; \
            _Pragma("unroll") for (int i = 0; i < 2; ++i) { \
                const float* ks_ = kb_ + (size_t)crow[i] * U.ldf + cch[i] * 8; const float* vs_ = vb_ + (size_t)crow[i] * U.ldf + cch[i] * 8; \
                fk[i][0] = *(const f32x4*)ks_; fk[i][1] = *(const f32x4*)(ks_ + 4); fv[i][0] = *(const f32x4*)vs_; fv[i][1] = *(const f32x4*)(vs_ + 4); } \
        } } while (0)
#define ATT_WRITE(b) do { \
        unsigned char* kt_ = smem + (b) * 16384; unsigned char* vt_ = kt_ + 8192; \
        if constexpr (!F32SRC) { \
            _Pragma("unroll") for (int i = 0; i < 2; ++i) { *(u32x4*)(kt_ + so[i]) = rk[i]; *(u32x4*)(vt_ + so[i]) = rv[i]; } \
        } else { \
            _Pragma("unroll") for (int i = 0; i < 2; ++i) { \
                h16x8 hk_; _Pragma("unroll") for (int e = 0; e < 4; ++e) { hk_[e] = (h16)fk[i][0][e]; hk_[4 + e] = (h16)fk[i][1][e]; } \
                *(h16x8*)(kt_ + so[i]) = hk_; \
                const int key_ = crow[i]; \
                _Pragma("unroll") for (int e = 0; e < 8; ++e) { const int dv_ = 8 * cch[i] + e; \
                    *(h16*)(vt_ + dv_ * 128 + (((key_ >> 3) ^ ((dv_ >> 1) & 7)) << 4) + (key_ & 7) * 2) = (h16)(e < 4 ? fv[i][0][e] : fv[i][1][e - 4]); } } \
        } } while (0)

    ATT_LOAD(0);
    ATT_WRITE(0);
    const unsigned* mrow = (MODE == 0) ? U.mask + (size_t)(32 * qt + l31) * U.ldm : nullptr;
    unsigned mwn0 = 0xffffffffu, mwn1 = 0xffffffffu;
    if (MODE == 0) { mwn0 = mrow[0]; mwn1 = mrow[1]; }
    __syncthreads();
    const int pil = pi32(l31), ksw = (pil >> 1) & 7, vsw = (l31 >> 1) & 7;
    const int jlast = U.ntiles - 1;
    for (int j = 0; j < U.ntiles; ++j) {
        const int buf = j & 1;
        const int jn = j < jlast ? j + 1 : jlast;
        unsigned mw[2] = {mwn0 >> (8 * hh), mwn1 >> (8 * hh)};
        if (MODE == 0) { mwn0 = mrow[2 * jn]; mwn1 = mrow[2 * jn + 1]; }
        if (!F32SRC) ATT_LOAD(jn);
        if (active && (MODE == 2 || j <= chunk_w)) {
            const unsigned char* Kt = smem + buf * 16384;
            const unsigned char* Vt = Kt + 8192;
            const bool near = (MODE != 2) && (j >= chunk_w - 2);
            h16x8 pf[4];
            float ls = 0.f;
#pragma unroll
            for (int u = 0; u < 2; ++u) {
                f32x16 S;
#pragma unroll
                for (int r = 0; r < 16; ++r) S[r] = -P_SHIFT;
                const unsigned char* kp = Kt + (32 * u + pil) * 128;
#pragma unroll
                for (int s = 0; s < NQF; ++s) {
                    const int ch = (MODE == 1) ? (4 * cmap + 2 * s + hh) : (2 * s + hh);
                    const h16x8 a = *(const h16x8*)(kp + ((ch ^ ksw) << 4));
                    S = __builtin_amdgcn_mfma_f32_32x32x16_f16(a, qf[s], S, 0, 0, 0);
                }
                if (near) {
                    const int base = 64 * j + 32 * u + 8 * hh - qpos + 191;
#pragma unroll
                    for (int i = 0; i < 16; ++i) S[i] += tb[base + (i & 7) + 16 * (i >> 3)];
                }
#pragma unroll
                for (int i = 0; i < 16; ++i) {
                    float pv = __builtin_amdgcn_exp2f(S[i]);
                    if (MODE == 0) pv = ((mw[u] >> ((i & 7) + 16 * (i >> 3))) & 1u) ? pv : 0.f;
                    ls += pv; S[i] = pv;
                }
#pragma unroll
                for (int s2 = 0; s2 < 2; ++s2) {
                    u32x4 pk;
                    pk[0] = pkrtz(S[8 * s2 + 0], S[8 * s2 + 1]); pk[1] = pkrtz(S[8 * s2 + 2], S[8 * s2 + 3]);
                    pk[2] = pkrtz(S[8 * s2 + 4], S[8 * s2 + 5]); pk[3] = pkrtz(S[8 * s2 + 6], S[8 * s2 + 7]);
                    pf[2 * u + s2] = __builtin_bit_cast(h16x8, pk);
                }
            }
            lsum += ls;
#pragma unroll
            for (int m = 0; m < 2; ++m)
#pragma unroll
                for (int sp = 0; sp < 4; ++sp) {
                    const h16x8 vfr = *(const h16x8*)(Vt + (32 * m + l31) * 128 + (((2 * sp + hh) ^ vsw) << 4));
                    O[m] = __builtin_amdgcn_mfma_f32_32x32x16_f16(vfr, pf[sp], O[m], 0, 0, 0);
                }
        }
        if (F32SRC) ATT_LOAD(jn);
        ATT_WRITE(buf ^ 1);
        __syncthreads();
    }
#undef ATT_LOAD
#undef ATT_WRITE
    const float l = lsum + __shfl_xor(lsum, 32);
    const float inv = 1.0f / l;
    if (MODE == 1) {
        float* X = (float*)smem;
        if (cmap == 1) {
#pragma unroll
            for (int m = 0; m < 2; ++m)
#pragma unroll
                for (int i = 0; i < 16; ++i) X[(qt * 32 + m * 16 + i) * 64 + lane] = O[m][i] * inv;
        }
        __syncthreads();
        if (cmap == 1) return;
#pragma unroll
        for (int m = 0; m < 2; ++m)
#pragma unroll
            for (int i = 0; i < 16; ++i) O[m][i] = O[m][i] * inv - lam * X[(qt * 32 + m * 16 + i) * 64 + lane];
    } else {
        if (!active) return;
#pragma unroll
        for (int m = 0; m < 2; ++m)
#pragma unroll
            for (int i = 0; i < 16; ++i) O[m][i] *= inv;
    }
    const int colbase = (MODE == 0 ? 0 : (MODE == 1 ? 512 : 768)) + U.head * 64;
    const h16* G = (const h16*)(p.ws + WS_G) + (size_t)rowq * 1024 + colbase;
    h16* Oo = (h16*)(p.ws + WS_O16) + (size_t)rowq * 1024 + colbase;
    float sc = 1.f;
    if (MODE == 1) {
        float ss = 0.f;
#pragma unroll
        for (int m = 0; m < 2; ++m)
#pragma unroll
            for (int i = 0; i < 16; ++i) ss = fmaf(O[m][i], O[m][i], ss);
        ss += __shfl_xor(ss, 32);
        sc = (1.0f / sqrtf(ss * (1.0f / 64.0f) + EPS)) * 0.8f;
    }
#pragma unroll
    for (int m = 0; m < 2; ++m)
#pragma unroll
        for (int g4 = 0; g4 < 4; ++g4) {
            const int dv = 32 * m + 8 * g4 + 4 * hh;
            const h16x4 gv = *(const h16x4*)(G + dv);
            h16x4 o4;
#pragma unroll
            for (int e = 0; e < 4; ++e) {
                float o = O[m][4 * g4 + e];
                if (MODE == 1) o = o * sc * p.in[18][dv + e];
                o4[e] = (h16)(o * silu((float)gv[e]));
            }
            *(h16x4*)(Oo + dv) = o4;
        }
}

__device__ __forceinline__ AttnUnit unit_zero() {
    AttnUnit U; U.row0 = 0; U.nwaves = 0; U.ntiles = 0; U.chunk0 = 0; U.chunk_step = 0; U.qpos0 = 0; U.head = 0; U.Kh = nullptr; U.VTh = nullptr; U.ldk = 0; U.ldv = 0;
    U.Kc = nullptr; U.Vc = nullptr; U.Kn = nullptr; U.Vn = nullptr; U.ldf = 0; U.ntc = 0; U.mask = nullptr; U.ldm = 0; return U;
}

#define ZIGZAG_LOOP(NALL) for (int zk_ = 0, pos_ = 0; zk_ * (int)gridDim.x < (NALL); ++zk_) \
    if ((pos_ = (zk_ & 1) ? (zk_ + 1) * (int)gridDim.x - 1 - (int)blockIdx.x : zk_ * (int)gridDim.x + (int)blockIdx.x) < (NALL))

__device__ void phase2(const Params& p, unsigned char* smem) {
    float s1 = 0.f, s2 = 0.f;
    for (int i = 0; i < 32; ++i) { s1 = fmaf(p.in[19][i], p.in[20][i], s1); s2 = fmaf(p.in[21][i], p.in[22][i], s2); }
    const float lam = expf(s1) - expf(s2) + 0.2f;
    constexpr int N_BP = 1024, N_SP = 1024, N_BS = 128, N_CS = 128, N_SS = 128, N_CP = 512;
    constexpr int N_ALL = N_BP + N_SP + N_BS + N_CS + N_SS + N_CP;
    ZIGZAG_LOOP(N_ALL) {
        int it = pos_;
        if (it < N_BP) {
            const int g = 255 - (it >> 2), head = blockIdx.x & 3;
            AttnUnit U = unit_zero();
            U.row0 = 64 * g; U.nwaves = 2; U.ntiles = g + 1; U.chunk0 = g; U.chunk_step = 0; U.qpos0 = 64 * g; U.head = head;
            U.Kh = (const h16*)(p.ws + WS_KB_P) + head * 64; U.ldk = 256;
            U.VTh = (const h16*)(p.ws + WS_VTB_P) + (size_t)(head * 64) * SEQ; U.ldv = SEQ;
            attn_unit<1, false>(p, smem, U, lam);
            continue;
        }
        it -= N_BP;
        if (it < N_SP) { select_unit(p, smem, it); continue; }
        it -= N_SP;
        if (it < N_BS) {
            const int b = it >> 2, head = it & 3;
            AttnUnit U = unit_zero();
            U.row0 = SEQ + 64 * b; U.nwaves = 2; U.ntiles = 17; U.chunk0 = 16; U.chunk_step = 0; U.qpos0 = PAST; U.head = head;
            U.Kc = p.in[6] + (size_t)b * PAST * 256 + head * 64; U.Vc = p.in[7] + (size_t)b * PAST * 256 + head * 64;
            U.Kn = p.out + O_SBK + (size_t)b * DECS * 256 + head * 64; U.Vn = p.out + O_SBV + (size_t)b * DECS * 256 + head * 64;
            U.ldf = 256; U.ntc = 16;
            attn_unit<1, true>(p, smem, U, lam);
            continue;
        }
        it -= N_BS;
        if (it < N_CS) {
            const int b = it >> 2, head = it & 3;
            AttnUnit U = unit_zero();
            U.row0 = SEQ + 64 * b; U.nwaves = 2; U.ntiles = 4; U.head = head;
            U.Kc = p.in[8] + (size_t)b * NMEM * 256 + head * 64; U.Vc = p.in[9] + (size_t)b * NMEM * 256 + head * 64;
            U.Kn = U.Kc; U.Vn = U.Vc; U.ldf = 256; U.ntc = 4;
            attn_unit<2, true>(p, smem, U, lam);
            continue;
        }
        it -= N_CS;
        if (it < N_SS) { select_unit(p, smem, 1024 + it); continue; }
        it -= N_SS;
        {
            const int g = it >> 2, head = it & 3;
            AttnUnit U = unit_zero();
            U.row0 = 128 * g; U.nwaves = 4; U.ntiles = 4; U.head = head;
            U.Kh = (const h16*)(p.ws + WS_MK_P) + head * 64; U.ldk = 256;
            U.VTh = (const h16*)(p.ws + WS_MVT_P) + (size_t)(head * 64) * NMEM; U.ldv = NMEM;
            attn_unit<2, false>(p, smem, U, lam);
        }
    }
}

__device__ void phase3(const Params& p, unsigned char* smem) {
    constexpr int N_AP = 1024, N_AS = 256;
    ZIGZAG_LOOP(N_AP + N_AS) {
        int it = pos_;
        if (it < N_AP) {
            const int g = 127 - (it >> 3), head = blockIdx.x & 7;
            AttnUnit U = unit_zero();
            U.row0 = 128 * g; U.nwaves = 4; U.ntiles = 2 * g + 2; U.chunk0 = 2 * g; U.chunk_step = 1; U.qpos0 = 128 * g; U.head = head;
            U.Kh = (const h16*)(p.ws + WS_KA_P) + head * 64; U.ldk = 512;
            U.VTh = (const h16*)(p.ws + WS_VTA_P) + (size_t)(head * 64) * SEQ; U.ldv = SEQ;
            U.mask = (const unsigned*)(p.ws + WS_MASK_P) + (size_t)(128 * g) * 512; U.ldm = 512;
            attn_unit<0, false>(p, smem, U, 0.f);
            continue;
        }
        it -= N_AP;
        {
            const int b = it >> 3, head = it & 7;
            AttnUnit U = unit_zero();
            U.row0 = SEQ + 64 * b; U.nwaves = 2; U.ntiles = 17; U.chunk0 = 16; U.chunk_step = 0; U.qpos0 = PAST; U.head = head;
            U.Kc = p.in[3] + (size_t)b * PAST * 512 + head * 64; U.Vc = p.in[4] + (size_t)b * PAST * 512 + head * 64;
            U.Kn = p.out + O_SAK + (size_t)b * DECS * 512 + head * 64; U.Vn = p.out + O_SAV + (size_t)b * DECS * 512 + head * 64;
            U.ldf = 512; U.ntc = 16;
            U.mask = (const unsigned*)(p.ws + WS_MASK_S) + (size_t)(64 * b) * 34; U.ldm = 34;
            attn_unit<0, true>(p, smem, U, 0.f);
        }
    }
}

__device__ void phase4(const Params& p, unsigned char* smem) {
    const h16* O16 = (const h16*)(p.ws + WS_O16);
    const h16* WTOUT = (const h16*)(p.ws + WS_WTOUT);
    constexpr int NCT = D / 128, NRT = MROWS / 128;
    const EpiOut eo{};
    const int G = gridDim.x;
    if ((G & 7) == 0) {
        const int xcd = blockIdx.x & 7, local = blockIdx.x >> 3, LG = G >> 3;
        for (int lin = local; lin < (NRT / 8) * NCT; lin += LG) {
            const int rt = xcd + 8 * (lin / NCT), ct = lin % NCT;
            gemm_tile(p, O16, WTOUT, rt * 128, ct * 128, smem, eo);
        }
    } else {
        for (int it = blockIdx.x; it < NCT * NRT; it += gridDim.x) {
            const int rt = it / NCT, ct = it % NCT;
            gemm_tile(p, O16, WTOUT, rt * 128, ct * 128, smem, eo);
        }
    }
}

constexpr int SMEM_BYTES = 80 * 1024;

__device__ __forceinline__ void grid_barrier(unsigned* cnt, unsigned target) {
    asm volatile("s_waitcnt vmcnt(0)" ::: "memory");
    __syncthreads();
    if (threadIdx.x == 0) {
        __builtin_amdgcn_fence(__ATOMIC_RELEASE, "agent");
        asm volatile("s_waitcnt vmcnt(0)" ::: "memory");
        __hip_atomic_fetch_add(cnt, 1u, __ATOMIC_RELAXED, __HIP_MEMORY_SCOPE_AGENT);
        while (__hip_atomic_load(cnt, __ATOMIC_RELAXED, __HIP_MEMORY_SCOPE_AGENT) < target) __builtin_amdgcn_s_sleep(2);
        __builtin_amdgcn_fence(__ATOMIC_ACQUIRE, "agent");
        asm volatile("s_waitcnt vmcnt(0)" ::: "memory");
    }
    __syncthreads();
}

__global__ void __launch_bounds__(NT, 2) fwd_kernel(Params p) {
    __shared__ __attribute__((aligned(16))) unsigned char smem[SMEM_BYTES];
    static_assert(ATT_LDS <= SMEM_BYTES && sizeof(SmemDsa) <= SMEM_BYTES && sizeof(SelSm) <= SMEM_BYTES && CS_LD * 128 * 4 <= SMEM_BYTES, "smem");
    cg::grid_group grid = cg::this_grid();
    unsigned nbar = 0;
    for (int ph = p.ph_lo; ph < p.ph_hi; ++ph) {
#ifndef REP_PHASE
#define REP_PHASE -1
#endif
        const int nrep = (ph == REP_PHASE) ? 2 : 1;
        for (int rep = 0; rep < nrep; ++rep) {
            if (ph == 0) phase0(p, smem);
            else if (ph == 1) phase1(p, smem);
            else if (ph == 2) phase2(p, smem);
            else if (ph == 3) phase3(p, smem);
            else phase4(p, smem);
            if (rep + 1 < nrep) grid.sync();
        }
        if (ph + 1 < p.ph_hi) {
            if (ph == p.ph_lo) grid.sync();
            else grid_barrier((unsigned*)(p.ws + WS_CTL) + 48, ++nbar * gridDim.x);
        }
    }
}

extern "C" void kernel_launch(void* const* d_in, const int* in_sizes, int n_in, void* d_out, int out_size, void* d_ws, size_t ws_size, hipStream_t stream) {
    static int grid_blocks = 0;
    if (!grid_blocks) {
        int dev = 0, cus = 0, per_cu = 0;
        (void)hipGetDevice(&dev);
        (void)hipDeviceGetAttribute(&cus, hipDeviceAttributeMultiprocessorCount, dev);
        (void)hipOccupancyMaxActiveBlocksPerMultiprocessor(&per_cu, fwd_kernel, NT, 0);
        if (per_cu < 1) per_cu = 1;
        grid_blocks = cus * per_cu;
        if (ws_size < WS_END) fprintf(stderr, "kernel_launch: workspace too small: %zu < %zu\n", ws_size, (size_t)WS_END);
    }
    if (ws_size < WS_END) return;
    (void)hipMemsetAsync((unsigned char*)d_ws + WS_CTL, 0, 256, stream);
    Params p{};
    for (int i = 0; i < 27; ++i) p.in[i] = (const float*)d_in[i];
    p.out = (float*)d_out; p.ws = (unsigned char*)d_ws;
#if ONE_LAUNCH
    p.ph_lo = 0; p.ph_hi = 5;
    void* args[] = {&p};
    hipError_t e = hipLaunchCooperativeKernel((void*)fwd_kernel, dim3(grid_blocks), dim3(NT), args, 0, stream);
    if (e != hipSuccess) fprintf(stderr, "cooperative launch failed: %s (grid %d)\n", hipGetErrorString(e), grid_blocks);
#else
    for (int ph = 0; ph < 5; ++ph) {
        p.ph_lo = ph; p.ph_hi = ph + 1;
        hipLaunchKernelGGL(fwd_kernel, dim3(grid_blocks), dim3(NT), 0, stream, p);
    }
#endif
}
```

```cpp
#include <hip/hip_runtime.h>
#include <hip/hip_cooperative_groups.h>
#include <cstdio>
#include <cstdint>
namespace cg = cooperative_groups;

#define NT 256
#define ONE_LAUNCH 1

constexpr int D = 1024, SEQ = 16384, DECB = 32, DECS = 64, PAST = 1024, NMEM = 256;
constexpr int MROWS = SEQ + DECB * DECS;
constexpr int DIN = 3880;
constexpr int LDP = 264;
constexpr int PC_IQ = 0, PC_IW = 256;
constexpr float EPS = 1e-6f;

constexpr size_t O_YP = 0, O_YS = 16777216, O_PAK = 18874368, O_PAV = 27262976, O_PAKI = 35651584, O_PBK = 36175872,
                 O_PBV = 40370176, O_PMK = 44564480, O_PMV = 44630016, O_SAK = 44695552, O_SAV = 45744128,
                 O_SAKI = 46792704, O_SBK = 46858240, O_SBV = 47382528;

typedef _Float16 h16;
typedef h16 h16x2 __attribute__((ext_vector_type(2)));
typedef h16 h16x4 __attribute__((ext_vector_type(4)));
typedef h16 h16x8 __attribute__((ext_vector_type(8)));
typedef float f32x4 __attribute__((ext_vector_type(4)));
typedef unsigned u32x4 __attribute__((ext_vector_type(4)));
typedef __bf16 bf16x8 __attribute__((ext_vector_type(8)));
typedef __bf16 bf16x2 __attribute__((ext_vector_type(2)));
typedef float f32x2 __attribute__((ext_vector_type(2)));
__device__ __forceinline__ unsigned pkbf(float a, float b) { const f32x2 v = {a, b}; return __builtin_bit_cast(unsigned, __builtin_convertvector(v, bf16x2)); }
typedef float f32x16 __attribute__((ext_vector_type(16)));

constexpr int NPAD_IN = 3968;
constexpr float LOG2E = 1.4426950408889634f;
constexpr size_t WS_XH = 0;
constexpr size_t WS_O16 = WS_XH;
constexpr size_t WS_HMH = WS_XH + (size_t)MROWS * D * 2;
constexpr size_t WS_WTIN = WS_HMH + (size_t)NMEM * D * 2;
constexpr size_t WS_WTOUT = WS_WTIN + (size_t)NPAD_IN * D * 2;
constexpr size_t WS_WTMEM = WS_WTOUT + (size_t)D * D * 2;
constexpr size_t WS_QA = WS_WTMEM + (size_t)512 * D * 2;
constexpr size_t WS_QB = WS_QA + (size_t)MROWS * 512 * 2;
constexpr size_t WS_QC = WS_QB + (size_t)MROWS * 256 * 2;
constexpr size_t WS_G = WS_QC + (size_t)MROWS * 256 * 2;
constexpr size_t WS_KB_P = WS_G + (size_t)MROWS * 1024 * 2;
constexpr size_t WS_VTB_P = WS_KB_P + (size_t)SEQ * 256 * 2;
constexpr size_t WS_MK_P = WS_VTB_P + (size_t)SEQ * 256 * 2;
constexpr size_t WS_MVT_P = WS_MK_P + (size_t)NMEM * 256 * 2;
constexpr size_t WS_KA_P = WS_MVT_P + (size_t)NMEM * 256 * 2;
constexpr size_t WS_VTA_P = WS_KA_P + (size_t)SEQ * 512 * 2;
constexpr size_t WS_MASK_P = WS_VTA_P + (size_t)SEQ * 512 * 2;
constexpr size_t WS_MASK_S = WS_MASK_P + (size_t)SEQ * 512 * 4;
constexpr size_t WS_IQ16 = WS_MASK_S + (size_t)DECB * DECS * 34 * 4;
constexpr size_t WS_IK_P = WS_IQ16 + (size_t)MROWS * 256 * 2;
constexpr size_t WS_IK_S = WS_IK_P + (size_t)SEQ * 32 * 2;
constexpr size_t WS_CTL = WS_IK_S + (size_t)DECB * (PAST + DECS) * 32 * 2;
constexpr int REDO_LD = 64;
constexpr size_t WS_REDO = WS_CTL + 256;
constexpr size_t WS_P = WS_REDO + (size_t)2048 * REDO_LD * 4;
constexpr size_t WS_END = WS_P + (size_t)MROWS * LDP * 4;

struct Params {
    const float* in[27];
    float* out;
    unsigned char* ws;
    int ph_lo, ph_hi;
};

__device__ __forceinline__ float wave_sum(float v) {
#pragma unroll
    for (int o = 1; o < 64; o <<= 1) v += __shfl_xor(v, o);
    return v;
}
__device__ __forceinline__ float wave_max(float v) {
#pragma unroll
    for (int o = 1; o < 64; o <<= 1) v = fmaxf(v, __shfl_xor(v, o));
    return v;
}
__device__ __forceinline__ float silu(float x) { return x / (1.0f + expf(-x)); }

__device__ __forceinline__ int rel_bucket(int rel) {
    const int ret = rel > 0 ? 16 : 0;
    const int n = rel < 0 ? -rel : rel;
    int b;
    if (n < 8) b = n;
    else if (n < 12) b = 8;
    else if (n < 16) b = 9;
    else if (n < 23) b = 10;
    else if (n < 32) b = 11;
    else if (n < 46) b = 12;
    else if (n < 64) b = 13;
    else if (n < 91) b = 14;
    else b = 15;
    return ret + b;
}

__device__ __forceinline__ void rms_row_h(const float* x, const float* g, h16* o, int lane) {
    const float4* xr = (const float4*)x;
    const float4* gr = (const float4*)g;
    float4 v[4];
    float s = 0.f;
#pragma unroll
    for (int j = 0; j < 4; ++j) { v[j] = xr[lane + 64 * j]; s += v[j].x * v[j].x + v[j].y * v[j].y + v[j].z * v[j].z + v[j].w * v[j].w; }
    s = wave_sum(s);
    const float r = 1.0f / sqrtf(s * (1.0f / 1024.0f) + EPS);
#pragma unroll
    for (int j = 0; j < 4; ++j) {
        const float4 gg = gr[lane + 64 * j];
        h16x4 o4; o4.x = (h16)(v[j].x * r * gg.x); o4.y = (h16)(v[j].y * r * gg.y); o4.z = (h16)(v[j].z * r * gg.z); o4.w = (h16)(v[j].w * r * gg.w);
        ((h16x4*)o)[lane + 64 * j] = o4;
    }
}

__device__ __forceinline__ void transpose_item(const float* __restrict__ W, int ldw, int c0, int nvalid, int k0, h16* __restrict__ WT, int r0, float* scr, int lane) {
#pragma unroll 8
    for (int i = 0; i < 32; ++i) {
        const int kk = 2 * i + (lane >> 5), n = lane & 31;
        scr[kk * 33 + n] = (n < nvalid) ? W[(size_t)(k0 + kk) * ldw + c0 + n] : 0.f;
    }
    asm volatile("s_waitcnt lgkmcnt(0)" ::: "memory");
    const int c = lane & 7;
#pragma unroll
    for (int j = 0; j < 4; ++j) {
        const int n = (lane >> 3) + 8 * j;
        const float* s = scr + (8 * c) * 33 + n;
        h16x8 o;
#pragma unroll
        for (int e = 0; e < 8; ++e) o[e] = (h16)s[e * 33];
        *(h16x8*)(WT + (size_t)(r0 + n) * 1024 + k0 + 8 * c) = o;
    }
    asm volatile("s_waitcnt lgkmcnt(0)" ::: "memory");
}

__device__ __forceinline__ int inproj_col(int np) { return np < 2304 ? np : (np < 3840 ? np + 40 : np - 3840 + 2304); }

__device__ void phase0(const Params& p, unsigned char* smem) {
    const int lane = threadIdx.x & 63, w = threadIdx.x >> 6;
    const int gw = blockIdx.x * 4 + w, ngw = gridDim.x * 4;
    h16* XH = (h16*)(p.ws + WS_XH);
    h16* HMH = (h16*)(p.ws + WS_HMH);
    h16* WTIN = (h16*)(p.ws + WS_WTIN);
    h16* WTOUT = (h16*)(p.ws + WS_WTOUT);
    h16* WTMEM = (h16*)(p.ws + WS_WTMEM);
    float* scr = (float*)smem + w * (64 * 33);
    constexpr int N_ROWS = MROWS + NMEM;
    constexpr int I_IN = 16 * (NPAD_IN / 32), I_OUT = 16 * 32, I_MEM = 16 * 16, I_KIDX = DECB * (PAST / 64);
    for (int it = gw; it < N_ROWS + I_IN + I_OUT + I_MEM + I_KIDX; it += ngw) {
        if (it < N_ROWS) {
            const int r = it;
            if (r < SEQ) rms_row_h(p.in[0] + (size_t)r * D, p.in[11], XH + (size_t)r * D, lane);
            else if (r < MROWS) rms_row_h(p.in[1] + (size_t)(r - SEQ) * D, p.in[11], XH + (size_t)r * D, lane);
            else rms_row_h(p.in[2] + (size_t)(r - MROWS) * D, p.in[25], HMH + (size_t)(r - MROWS) * D, lane);
        } else if (it < N_ROWS + I_IN) {
            const int r = it - N_ROWS, nb = r % (NPAD_IN / 32), kb = r / (NPAD_IN / 32);
            const int np0 = nb * 32;
            int nvalid = DIN - np0; nvalid = nvalid < 0 ? 0 : (nvalid > 32 ? 32 : nvalid);
            const int c0 = nvalid > 0 ? inproj_col(np0) : 0;
            transpose_item(p.in[12], DIN, c0, nvalid, kb * 64, WTIN, np0, scr, lane);
        } else if (it < N_ROWS + I_IN + I_OUT) {
            const int r = it - N_ROWS - I_IN, nb = r % 32, kb = r / 32;
            transpose_item(p.in[13], D, nb * 32, 32, kb * 64, WTOUT, nb * 32, scr, lane);
        } else if (it < N_ROWS + I_IN + I_OUT + I_MEM) {
            const int r = it - N_ROWS - I_IN - I_OUT, nb = r % 16, kb = r / 16;
            transpose_item(p.in[26], 512, nb * 32, 32, kb * 64, WTMEM, nb * 32, scr, lane);
        } else {
            const int r = it - N_ROWS - I_IN - I_OUT - I_MEM, b = r / (PAST / 64), key = (r % (PAST / 64)) * 64 + lane;
            const f32x4* src = (const f32x4*)(p.in[5] + ((size_t)b * PAST + key) * 32);
            h16* dst = (h16*)(p.ws + WS_IK_S) + ((size_t)b * (PAST + DECS) + key) * 32;
            float ss = 0.f;
#pragma unroll
            for (int c = 0; c < 4; ++c) {
                const f32x4 x0 = src[2 * c], x1 = src[2 * c + 1];
                h16x8 o;
#pragma unroll
                for (int e = 0; e < 4; ++e) { o[e] = (h16)x0[e]; o[4 + e] = (h16)x1[e]; ss = fmaf(x0[e], x0[e], ss); ss = fmaf(x1[e], x1[e], ss); }
                *(h16x8*)(dst + 8 * c) = o;
            }
            ss = wave_max(ss);
            if (lane == 0) atomicMax((unsigned*)(p.ws + WS_CTL) + 1 + b, __float_as_uint(ss));
        }
    }
}

constexpr int CS_LD = 132;
template <class Epi>
__device__ __forceinline__ void gemm_tile(const Params& p, const h16* __restrict__ A, const h16* __restrict__ Bt, int m0, int n0, unsigned char* smem, const Epi& epi) {
    int tid = threadIdx.x; asm volatile("" : "+v"(tid));
    const int lane = tid & 63, wid = tid >> 6, wm = wid >> 1, wn = wid & 1;
    const int l31 = lane & 31, hh = lane >> 5;
    f32x16 acc[2][2];
#pragma unroll
    for (int a = 0; a < 2; ++a)
#pragma unroll
        for (int b = 0; b < 2; ++b)
#pragma unroll
            for (int r = 0; r < 16; ++r) acc[a][b][r] = 0.f;
    const h16* ag[4]; const h16* bg[4]; int so[4];
#pragma unroll
    for (int i = 0; i < 4; ++i) {
        const int c = tid + 256 * i, row = c >> 3, ch = c & 7;
        ag[i] = A + (size_t)(m0 + row) * 1024 + ch * 8;
        bg[i] = Bt + (size_t)(n0 + row) * 1024 + ch * 8;
        so[i] = row * 128 + ((ch ^ ((row >> 1) & 7)) << 4);
    }
    unsigned char* As = smem; unsigned char* Bs = smem + 16384;
    u32x4 ra0[4], rb0[4], ra1[4], rb1[4];
#define GT_LOAD(RA, RB, kt_) do { const int ko_ = ((kt_) < 15 ? (kt_) : 15) * 64; _Pragma("unroll") for (int i = 0; i < 4; ++i) { RA[i] = *(const u32x4*)(ag[i] + ko_); RB[i] = *(const u32x4*)(bg[i] + ko_); } } while (0)
#define GT_WRITE(RA, RB) do { _Pragma("unroll") for (int i = 0; i < 4; ++i) { *(u32x4*)(As + so[i]) = RA[i]; *(u32x4*)(Bs + so[i]) = RB[i]; } } while (0)
    const int sw = (l31 >> 1) & 7;
    const int arow = (wm * 64 + l31) * 128, brow = (wn * 64 + l31) * 128;
#define GT_COMPUTE() do { _Pragma("unroll") for (int s = 0; s < 4; ++s) { \
            const int co = (((2 * s + hh) ^ sw) << 4); \
            h16x8 a[2], b[2]; \
            _Pragma("unroll") for (int mt = 0; mt < 2; ++mt) a[mt] = *(const h16x8*)(As + arow + mt * 32 * 128 + co); \
            _Pragma("unroll") for (int nt = 0; nt < 2; ++nt) b[nt] = *(const h16x8*)(Bs + brow + nt * 32 * 128 + co); \
            _Pragma("unroll") for (int mt = 0; mt < 2; ++mt) _Pragma("unroll") for (int nt = 0; nt < 2; ++nt) \
                acc[mt][nt] = __builtin_amdgcn_mfma_f32_32x32x16_f16(a[mt], b[nt], acc[mt][nt], 0, 0, 0); } } while (0)
    GT_LOAD(ra0, rb0, 0);
    __syncthreads();
    GT_WRITE(ra0, rb0);
    asm volatile("" ::: "memory");
    GT_LOAD(ra0, rb0, 1);
    asm volatile("" ::: "memory");
    GT_LOAD(ra1, rb1, 2);
    asm volatile("" ::: "memory");
    __syncthreads();
    for (int kt = 0; kt < 16; kt += 2) {
        GT_COMPUTE();
        __syncthreads();
        GT_WRITE(ra0, rb0);
        asm volatile("" ::: "memory");
        GT_LOAD(ra0, rb0, kt + 3);
        asm volatile("" ::: "memory");
        __syncthreads();
        GT_COMPUTE();
        __syncthreads();
        GT_WRITE(ra1, rb1);
        asm volatile("" ::: "memory");
        GT_LOAD(ra1, rb1, kt + 4);
        asm volatile("" ::: "memory");
        __syncthreads();
    }
#undef GT_LOAD
#undef GT_WRITE
#undef GT_COMPUTE
    float* Cs = (float*)smem;
#pragma unroll
    for (int mt = 0; mt < 2; ++mt)
#pragma unroll
        for (int nt = 0; nt < 2; ++nt)
#pragma unroll
            for (int r = 0; r < 16; ++r) {
                const int row = wm * 64 + mt * 32 + (r & 3) + 8 * (r >> 2) + 4 * hh, col = wn * 64 + nt * 32 + l31;
                Cs[row * CS_LD + col] = acc[mt][nt][r];
            }
    __syncthreads();
    epi(p, Cs, m0, n0, tid);
}

__device__ __forceinline__ float group_sum16(float v) { v += __shfl_xor(v, 1); v += __shfl_xor(v, 2); v += __shfl_xor(v, 4); v += __shfl_xor(v, 8); return v; }
__device__ __forceinline__ float group_sum8(float v) { v += __shfl_xor(v, 1); v += __shfl_xor(v, 2); v += __shfl_xor(v, 4); return v; }

struct Seg {
    float* bp; float* bs; int ld; int col; int norm; const float* gain;
    h16* hp; h16* hs; int hld; int hcol; float hscale;
    int vt; int head;
};

__device__ __forceinline__ Seg seg_of(const Params& p, int n0) {
    float* P = (float*)(p.ws + WS_P);
    float* out = p.out;
    h16* QA = (h16*)(p.ws + WS_QA); h16* QB = (h16*)(p.ws + WS_QB); h16* QC = (h16*)(p.ws + WS_QC); h16* G = (h16*)(p.ws + WS_G);
    Seg s; s.norm = 0; s.gain = nullptr; s.hp = nullptr; s.hs = nullptr; s.hld = 0; s.hcol = 0; s.hscale = 1.f; s.vt = 0; s.head = 0;
    s.bp = nullptr; s.bs = nullptr; s.ld = 0; s.col = 0;
#define SEG_O(op, os, ldv, c) do { s.bp = out + (op); s.bs = out + (os) - (size_t)SEQ * (ldv); s.ld = (ldv); s.col = (c); } while (0)
#define SEG_H(ptr, ldv, c, sc) do { s.hp = (ptr); s.hs = (ptr); s.hld = (ldv); s.hcol = (c); s.hscale = (sc); } while (0)
    if (n0 < 512) { s.norm = 64; s.gain = p.in[14]; SEG_H(QA, 512, n0, 0.125f * LOG2E); }
    else if (n0 < 1024) { SEG_O(O_PAK, O_SAK, 512, n0 - 512); s.norm = 64; s.gain = p.in[15]; s.hp = (h16*)(p.ws + WS_KA_P); s.hs = nullptr; s.hld = 512; s.hcol = n0 - 512; }
    else if (n0 < 1536) { SEG_O(O_PAV, O_SAV, 512, n0 - 1024); s.vt = 1; s.head = (n0 - 1024) >> 6; }
    else if (n0 < 2048) { SEG_H(G, 1024, n0 - 1536, 1.f); }
    else if (n0 < 2304) { s.bp = P; s.bs = P; s.ld = LDP; s.col = PC_IQ + n0 - 2048; SEG_H((h16*)(p.ws + WS_IQ16), 256, n0 - 2048, 1.f); }
    else if (n0 < 2560) { s.norm = 32; s.gain = p.in[16]; SEG_H(QB, 256, n0 - 2304, 0.17677669529663687f * LOG2E); }
    else if (n0 < 2816) { SEG_O(O_PBK, O_SBK, 256, n0 - 2560); s.norm = 32; s.gain = p.in[17]; s.hp = (h16*)(p.ws + WS_KB_P); s.hs = nullptr; s.hld = 256; s.hcol = n0 - 2560; }
    else if (n0 < 3072) { SEG_O(O_PBV, O_SBV, 256, n0 - 2816); s.vt = 2; s.head = (n0 - 2816) >> 6; }
    else if (n0 < 3328) { SEG_H(G, 1024, 512 + n0 - 3072, 1.f); }
    else if (n0 < 3584) { s.norm = 64; s.gain = p.in[23]; SEG_H(QC, 256, n0 - 3328, 0.125f * LOG2E); }
    else { SEG_H(G, 1024, 768 + n0 - 3584, 1.f); }
#undef SEG_O
#undef SEG_H
    return s;
}

__device__ __forceinline__ void vt_store(const float* Cs, int j, h16* dst_base, size_t ldv, int tid) {
    const int dv = tid & 63, rq = tid >> 6;
    h16* dst = dst_base + (size_t)dv * ldv + 32 * rq;
#pragma unroll
    for (int e8 = 0; e8 < 4; ++e8) {
        u32x4 o;
#pragma unroll
        for (int e = 0; e < 4; ++e) o[e] = pkbf(Cs[(32 * rq + 8 * e8 + 2 * e) * CS_LD + 64 * j + dv], Cs[(32 * rq + 8 * e8 + 2 * e + 1) * CS_LD + 64 * j + dv]);
        *(u32x4*)(dst + 8 * e8) = o;
    }
}

struct EpiIn {
    __device__ __forceinline__ void operator()(const Params& p, const float* Cs, int m0, int n0, int tid) const {
        const int cg = tid & 15, r0 = tid >> 4;
#pragma unroll 1
        for (int j = 0; j < 2; ++j) {
            const int n0j = n0 + 64 * j;
            if (n0j >= DIN) continue;
            if (n0j == 3840) {
                float* P = (float*)(p.ws + WS_P);
                float mx0 = 0.f, mx1 = 0.f;
#pragma unroll 1
                for (int i = 0; i < 8; ++i) {
                    const int rl = r0 + 16 * i, row = m0 + rl;
                    const float4 v = *(const float4*)&Cs[rl * CS_LD + 4 * cg];
                    float ss = (cg < 8) ? (v.x * v.x + v.y * v.y + v.z * v.z + v.w * v.w) : 0.f;
                    ss = group_sum8(ss);
                    if (i < 4) mx0 = fmaxf(mx0, ss); else mx1 = fmaxf(mx1, ss);
                    if (cg < 8) {
                        float* dst = (row < SEQ ? p.out + O_PAKI + (size_t)row * 32 : p.out + O_SAKI + (size_t)(row - SEQ) * 32) + 4 * cg; *(float4*)dst = v;
                        h16x4 hv; hv.x = (h16)v.x; hv.y = (h16)v.y; hv.z = (h16)v.z; hv.w = (h16)v.w;
                        h16* hd = row < SEQ ? (h16*)(p.ws + WS_IK_P) + (size_t)row * 32 : (h16*)(p.ws + WS_IK_S) + ((size_t)((row - SEQ) >> 6) * (PAST + DECS) + PAST + ((row - SEQ) & 63)) * 32;
                        *(h16x4*)(hd + 4 * cg) = hv;
                    }
                    else if (cg < 10) { *(float4*)(P + (size_t)row * LDP + PC_IW + 4 * (cg - 8)) = v; }
                }
                if (cg == 0) {
                    unsigned* ctl = (unsigned*)(p.ws + WS_CTL);
                    if (m0 < SEQ) atomicMax(ctl, __float_as_uint(fmaxf(mx0, mx1)));
                    else { const int b0 = (m0 - SEQ) >> 6; atomicMax(ctl + 1 + b0, __float_as_uint(mx0)); atomicMax(ctl + 2 + b0, __float_as_uint(mx1)); }
                }
                continue;
            }
            const Seg s = seg_of(p, n0j);
            float4 g4 = make_float4(1.f, 1.f, 1.f, 1.f);
            if (s.norm == 64) g4 = *(const float4*)(s.gain + 4 * cg);
            else if (s.norm == 32) g4 = *(const float4*)(s.gain + ((4 * cg) & 31));
#pragma unroll 1
            for (int i = 0; i < 8; ++i) {
                const int rl = r0 + 16 * i, row = m0 + rl;
                float4 v = *(const float4*)&Cs[rl * CS_LD + 64 * j + 4 * cg];
                if (s.norm) {
                    float ss = v.x * v.x + v.y * v.y + v.z * v.z + v.w * v.w;
                    float sc;
                    if (s.norm == 64) { ss = group_sum16(ss); sc = 1.0f / sqrtf(ss * (1.0f / 64.0f) + EPS); }
                    else { ss = group_sum8(ss); sc = 1.0f / sqrtf(ss * (1.0f / 32.0f) + EPS); }
                    v.x *= sc * g4.x; v.y *= sc * g4.y; v.z *= sc * g4.z; v.w *= sc * g4.w;
                }
                if (s.bp) *(float4*)((row < SEQ ? s.bp : s.bs) + (size_t)row * s.ld + s.col + 4 * cg) = v;
                h16* hb = row < SEQ ? s.hp : s.hs;
                if (hb) {
                    h16x4 hv; hv.x = (h16)(v.x * s.hscale); hv.y = (h16)(v.y * s.hscale); hv.z = (h16)(v.z * s.hscale); hv.w = (h16)(v.w * s.hscale);
                    *(h16x4*)(hb + (size_t)row * s.hld + s.hcol + 4 * cg) = hv;
                }
            }
            if (s.vt == 2 && m0 < SEQ) vt_store(Cs, j, (h16*)(p.ws + WS_VTB_P) + (size_t)(s.head * 64) * SEQ + m0, SEQ, tid);
            if (s.vt == 1 && m0 < SEQ) vt_store(Cs, j, (h16*)(p.ws + WS_VTA_P) + (size_t)(s.head * 64) * SEQ + m0, SEQ, tid);
        }
    }
};

struct EpiMem {
    __device__ __forceinline__ void operator()(const Params& p, const float* Cs, int m0, int n0, int tid) const {
        const int cg = tid & 15, r0 = tid >> 4;
#pragma unroll 1
        for (int j = 0; j < 2; ++j) {
            const int n0j = n0 + 64 * j;
            const bool isk = n0j < 256;
            const float4 g4 = isk ? *(const float4*)(p.in[24] + 4 * cg) : make_float4(1.f, 1.f, 1.f, 1.f);
#pragma unroll 1
            for (int i = 0; i < 8; ++i) {
                const int rl = r0 + 16 * i, row = m0 + rl;
                float4 v = *(const float4*)&Cs[rl * CS_LD + 64 * j + 4 * cg];
                if (isk) {
                    float ss = group_sum16(v.x * v.x + v.y * v.y + v.z * v.z + v.w * v.w);
                    const float sc = 1.0f / sqrtf(ss * (1.0f / 64.0f) + EPS);
                    v.x *= sc * g4.x; v.y *= sc * g4.y; v.z *= sc * g4.z; v.w *= sc * g4.w;
                    h16x4 hv; hv.x = (h16)v.x; hv.y = (h16)v.y; hv.z = (h16)v.z; hv.w = (h16)v.w;
                    *(h16x4*)((h16*)(p.ws + WS_MK_P) + (size_t)row * 256 + n0j + 4 * cg) = hv;
                }
                float* dst = p.out + (isk ? O_PMK : O_PMV) + (size_t)row * 256 + (isk ? n0j : n0j - 256) + 4 * cg;
                *(float4*)dst = v;
            }
            if (!isk) vt_store(Cs, j, (h16*)(p.ws + WS_MVT_P) + (size_t)(((n0j - 256) >> 6) * 64) * NMEM + m0, NMEM, tid);
        }
    }
};

struct EpiOut {
    __device__ __forceinline__ void operator()(const Params& p, const float* Cs, int m0, int n0, int tid) const {
        const int cg = tid & 15, r0 = tid >> 4;
#pragma unroll 1
        for (int i = 0; i < 8; ++i) {
            const int rl = r0 + 16 * i, row = m0 + rl;
            const float* x = (row < SEQ ? p.in[0] + (size_t)row * D : p.in[1] + (size_t)(row - SEQ) * D) + n0 + 4 * cg;
            float* y = (row < SEQ ? p.out + O_YP + (size_t)row * D : p.out + O_YS + (size_t)(row - SEQ) * D) + n0 + 4 * cg;
#pragma unroll
            for (int j = 0; j < 2; ++j) {
                const float4 v = *(const float4*)&Cs[rl * CS_LD + 64 * j + 4 * cg];
                const float4 xv = *(const float4*)(x + 64 * j);
                *(float4*)(y + 64 * j) = make_float4(xv.x + v.x, xv.y + v.y, xv.z + v.z, xv.w + v.w);
            }
        }
    }
};

__device__ void phase1(const Params& p, unsigned char* smem) {
    const h16* XH = (const h16*)(p.ws + WS_XH);
    const h16* HMH = (const h16*)(p.ws + WS_HMH);
    const h16* WTIN = (const h16*)(p.ws + WS_WTIN);
    const h16* WTMEM = (const h16*)(p.ws + WS_WTMEM);
    const EpiIn ein{}; const EpiMem emem{};
    const int G = gridDim.x;
    if ((G & 7) == 0) {
        const int xcd = blockIdx.x & 7, local = blockIdx.x >> 3, LG = G >> 3;
        for (int lin = local; lin < 6 * 96; lin += LG) {
            const int rgroup = lin / 96, rem = lin % 96, chalf = rem / 48, rem2 = rem % 48, r = rem2 >> 4, c = chalf * 16 + (rem2 & 15);
            if (c >= 31) continue;
            const int rt = xcd + 8 * (rgroup * 3 + r);
            gemm_tile(p, XH, WTIN, rt * 128, c * 128, smem, ein);
        }
        if (blockIdx.x < 8) { const int rt = blockIdx.x / 4, ct = blockIdx.x % 4; gemm_tile(p, HMH, WTMEM, rt * 128, ct * 128, smem, emem); }
    } else {
        constexpr int NCT = NPAD_IN / 128, NRT = MROWS / 128;
        constexpr int N_IN = NCT * NRT, N_MEM = 2 * 4;
        for (int it = blockIdx.x; it < N_IN + N_MEM; it += gridDim.x) {
            if (it < N_IN) { const int rt = it / NCT, ct = it % NCT; gemm_tile(p, XH, WTIN, rt * 128, ct * 128, smem, ein); }
            else { const int im = it - N_IN, rt = im / 4, ct = im % 4; gemm_tile(p, HMH, WTMEM, rt * 128, ct * 128, smem, emem); }
        }
    }
}

struct KeySrc {
    const float* cache; const float* fresh; int past; int ld;
    __device__ __forceinline__ const float* row(int k) const { return k < past ? cache + (size_t)k * ld : fresh + (size_t)(k - past) * ld; }
};

__device__ __forceinline__ unsigned fkey(float f) { const unsigned u = __float_as_uint(f); return (u & 0x80000000u) ? ~u : (u | 0x80000000u); }

struct SmemDsa {
    float sc[16384];
    float iq[256]; float iw[8];
    unsigned hist[256]; unsigned mw[512];
    int wcnt[4]; int wcnt2[4]; int misc[4];
};

__device__ void select_item(const Params& p, unsigned char* smem, int item) {
    SmemDsa& S = *(SmemDsa*)smem;
    int tid = threadIdx.x; asm volatile("" : "+v"(tid));
    const int lane = tid & 63, w = tid >> 6;
    const float* P = (const float*)(p.ws + WS_P);
    int row, N; KeySrc ki; unsigned* mout;
    if (item < SEQ) {
        row = item; N = 64 * (item / 64 + 1);
        ki = KeySrc{nullptr, p.out + O_PAKI, 0, 32};
        mout = (unsigned*)(p.ws + WS_MASK_P) + (size_t)item * 512;
    } else {
        const int bt = item - SEQ, b = bt / DECS;
        row = item; N = PAST + DECS;
        ki = KeySrc{p.in[5] + (size_t)b * PAST * 32, p.out + O_SAKI + (size_t)b * DECS * 32, PAST, 32};
        mout = (unsigned*)(p.ws + WS_MASK_S) + (size_t)bt * 34;
    }
    const int nw = N / 32;
    __syncthreads();
    if (N <= 256) {
        if (tid < nw) mout[tid] = 0xffffffffu;
        return;
    }
    S.iq[tid] = P[(size_t)row * LDP + PC_IQ + tid];
    if (tid < 8) S.iw[tid] = P[(size_t)row * LDP + PC_IW + tid];
    S.mw[tid] = 0u; S.mw[tid + 256] = 0u;
    __syncthreads();
    for (int k = tid; k < N; k += NT) {
        const float4* kr = (const float4*)ki.row(k);
        float kd[32];
#pragma unroll
        for (int i = 0; i < 8; ++i) { const float4 t4 = kr[i]; kd[4 * i] = t4.x; kd[4 * i + 1] = t4.y; kd[4 * i + 2] = t4.z; kd[4 * i + 3] = t4.w; }
        float score = 0.f;
#pragma unroll 1
        for (int h = 0; h < 8; ++h) {
            float d = 0.f;
#pragma unroll
            for (int i = 0; i < 32; ++i) d = fmaf(S.iq[h * 32 + i], kd[i], d);
            score = fmaf(S.iw[h], fmaxf(d, 0.f), score);
        }
        S.sc[k] = score;
    }
    __syncthreads();
    unsigned prefix = 0; int remaining = 256;
    for (int pass = 0; pass < 4; ++pass) {
        const int shift = 24 - 8 * pass;
        S.hist[tid] = 0;
        __syncthreads();
        for (int k = tid; k < N; k += NT) {
            const unsigned key = fkey(S.sc[k]);
            if (pass == 0 || (key >> (shift + 8)) == prefix) atomicAdd(&S.hist[(key >> shift) & 255u], 1u);
        }
        __syncthreads();
        const int hv = (int)S.hist[tid];
        int x = hv;
#pragma unroll
        for (int o = 1; o < 64; o <<= 1) { const int y = __shfl_down(x, o); if (lane + o < 64) x += y; }
        if (lane == 0) S.wcnt[w] = x;
        __syncthreads();
        int above = x - hv;
        for (int w2 = w + 1; w2 < 4; ++w2) above += S.wcnt[w2];
        if (above < remaining && remaining <= above + hv) { S.misc[0] = (int)((prefix << 8) | (unsigned)tid); S.misc[1] = remaining - above; }
        __syncthreads();
        prefix = (unsigned)S.misc[0]; remaining = S.misc[1];
        __syncthreads();
    }
    const unsigned T = prefix; const int r = remaining;
    int base_eq = 0;
    const unsigned long long lt = (lane == 0) ? 0ull : (~0ull >> (64 - lane));
    for (int k0 = 0; k0 < N; k0 += NT) {
        const int k = k0 + tid;
        const unsigned key = (k < N) ? fkey(S.sc[k]) : 0u;
        const bool gt = (k < N) && key > T, eq = (k < N) && key == T;
        const unsigned long long beq = __ballot(eq);
        const int eqpre = __popcll(beq & lt);
        if (lane == 0) S.wcnt[w] = __popcll(beq);
        __syncthreads();
        int eqbase = base_eq, eqtot = 0;
        for (int w2 = 0; w2 < 4; ++w2) { const int c = S.wcnt[w2]; if (w2 < w) eqbase += c; eqtot += c; }
        const bool sel = gt || (eq && (eqbase + eqpre) < r);
        const unsigned long long bs = __ballot(sel);
        if (lane == 0) S.mw[(k0 >> 5) + 2 * w] = (unsigned)bs;
        if (lane == 32) S.mw[(k0 >> 5) + 2 * w + 1] = (unsigned)(bs >> 32);
        base_eq += eqtot;
        __syncthreads();
    }
    for (int i = tid; i < nw; i += NT) mout[i] = S.mw[i];
}

typedef float f32x4m __attribute__((ext_vector_type(4)));
constexpr int CAND_CAP = 120;
struct SelSm {
    unsigned hist[16][1025];
    float cand_s[16][CAND_CAP]; int cand_k[16][CAND_CAP];
    int cnt[16]; int bstar[16]; int nabove[16]; int ovf[16];
};

__device__ __forceinline__ void score_tile(const h16x8& a, const h16x8 (&bq)[8], const float (&wq)[8], float (&sc)[4]) {
    sc[0] = 0.f; sc[1] = 0.f; sc[2] = 0.f; sc[3] = 0.f;
#pragma unroll
    for (int h = 0; h < 8; ++h) {
        f32x4m z = {0.f, 0.f, 0.f, 0.f};
        const f32x4m d = __builtin_amdgcn_mfma_f32_16x16x32_f16(a, bq[h], z, 0, 0, 0);
#pragma unroll
        for (int i = 0; i < 4; ++i) { const int bits = (int)__float_as_uint(d[i]); sc[i] = fmaf(wq[h], __uint_as_float((unsigned)(bits > 0 ? bits : 0)), sc[i]); }
    }
}

__device__ __forceinline__ int bin_of(float sc, float inv, float off) {
    int b = (int)fmaf(sc, inv, off);
    b = b < 0 ? 0 : (b > 1021 ? 1021 : b);
    return b + (sc > 0.f ? 2 : (sc == 0.f ? 1 : 0));
}

__device__ void select_unit(const Params& p, unsigned char* smem, int u) {
    SelSm& S = *(SelSm*)smem;
    int tid = threadIdx.x; asm volatile("" : "+v"(tid));
    const int lane = tid & 63, w = __builtin_amdgcn_readfirstlane(tid >> 6), q = lane & 15, g = lane >> 4;
    int row0, N, ldm, kslot; const h16* IK; unsigned* mask;
    if (u < 1024) {
        const int q0 = 16 * (1023 - u);
        row0 = q0; N = 64 * (q0 / 64 + 1); IK = (const h16*)(p.ws + WS_IK_P); mask = (unsigned*)(p.ws + WS_MASK_P) + (size_t)q0 * 512; ldm = 512; kslot = 0;
    } else {
        const int bu = u - 1024, b = bu >> 2, t0 = 16 * (bu & 3);
        row0 = SEQ + 64 * b + t0; N = PAST + DECS; IK = (const h16*)(p.ws + WS_IK_S) + (size_t)b * (PAST + DECS) * 32;
        mask = (unsigned*)(p.ws + WS_MASK_S) + (size_t)(64 * b + t0) * 34; ldm = 34; kslot = 1 + b;
    }
    const int nw = N / 32;
    __syncthreads();
    if (N <= 256) {
        for (int i = tid; i < 16 * nw; i += NT) mask[(size_t)(i / nw) * ldm + (i % nw)] = 0xffffffffu;
        return;
    }
    for (int i = tid; i < 16 * 1025; i += NT) ((unsigned*)S.hist)[i] = 0u;
    if (tid < 16) { S.cnt[tid] = 0; S.ovf[tid] = 0; S.bstar[tid] = 0; S.nabove[tid] = 0; }
    const int rowq = row0 + q;
    const h16* IQ = (const h16*)(p.ws + WS_IQ16) + (size_t)rowq * 256 + 8 * g;
    const float* Pf = (const float*)(p.ws + WS_P) + (size_t)rowq * LDP + PC_IW;
    h16x8 bq[8]; float wq[8];
    float hi = 0.f, lo = 0.f;
#pragma unroll
    for (int h = 0; h < 8; ++h) {
        bq[h] = *(const h16x8*)(IQ + h * 32);
        wq[h] = Pf[h];
        float n2 = 0.f;
#pragma unroll
        for (int e = 0; e < 8; ++e) { const float x = (float)bq[h][e]; n2 = fmaf(x, x, n2); }
        n2 += __shfl_xor(n2, 16); n2 += __shfl_xor(n2, 32);
        const float t = wq[h] * sqrtf(n2);
        if (t > 0.f) hi += t; else lo += t;
    }
    const float kmax = sqrtf(__uint_as_float(((const unsigned*)(p.ws + WS_CTL))[kslot])) * 1.01f;
    hi = hi * kmax + 1e-6f; lo = lo * kmax - 1e-6f;
    const float inv = 1022.0f / fmaxf(hi - lo, 1e-20f), off = -lo * inv;
    __syncthreads();
    constexpr int PF = 4;
    const h16* ikp = IK + (size_t)q * 32 + 8 * g;
    const int ngw = (nw - w + 3) >> 2;
#define SEL_LD(slot, it_) do { const int gi_ = w + 4 * ((it_) < ngw ? (it_) : ngw - 1); \
        ring0[slot] = *(const h16x8*)(ikp + (size_t)(32 * gi_) * 32); ring1[slot] = *(const h16x8*)(ikp + (size_t)(32 * gi_ + 16) * 32); } while (0)
    {
        h16x8 ring0[PF], ring1[PF];
#pragma unroll
        for (int s_ = 0; s_ < PF; ++s_) { SEL_LD(s_, s_); asm volatile("" ::: "memory"); }
        for (int it = 0; it < ngw; ++it) {
            const h16x8 a0 = ring0[0], a1 = ring1[0];
#pragma unroll
            for (int s_ = 0; s_ + 1 < PF; ++s_) { ring0[s_] = ring0[s_ + 1]; ring1[s_] = ring1[s_ + 1]; }
            asm volatile("" ::: "memory");
            SEL_LD(PF - 1, it + PF);
            asm volatile("" ::: "memory");
#pragma unroll
            for (int t = 0; t < 2; ++t) {
                float sc[4]; score_tile(t == 0 ? a0 : a1, bq, wq, sc);
#pragma unroll
                for (int i = 0; i < 4; ++i) { const int b = bin_of(sc[i], inv, off); atomicAdd(&S.hist[q][b], 1u); }
            }
        }
    }
    __syncthreads();
    for (int qq = 0; qq < 4; ++qq) {
        const int qi = 4 * w + qq;
        unsigned c = 0;
#pragma unroll
        for (int e = 0; e < 16; ++e) c += S.hist[qi][16 * lane + e];
        int x = (int)c;
#pragma unroll
        for (int o = 1; o < 64; o <<= 1) { const int y = __shfl_down(x, o); if (lane + o < 64) x += y; }
        const int above = x - (int)c;
        if (above < 256 && 256 <= above + (int)c) {
            int acc = above, bs = 16 * lane;
            for (int e = 15; e >= 0; --e) {
                const int v = (int)S.hist[qi][16 * lane + e];
                if (acc + v >= 256) { bs = 16 * lane + e; break; }
                acc += v;
            }
            S.bstar[qi] = bs; S.nabove[qi] = acc;
        }
    }
    __syncthreads();
    const int bst = S.bstar[q];
    unsigned* mrow = (unsigned*)S.hist;
    {
        h16x8 ring0[PF], ring1[PF];
#pragma unroll
        for (int s_ = 0; s_ < PF; ++s_) { SEL_LD(s_, s_); asm volatile("" ::: "memory"); }
        for (int it = 0; it < ngw; ++it) {
            const h16x8 a0 = ring0[0], a1 = ring1[0];
#pragma unroll
            for (int s_ = 0; s_ + 1 < PF; ++s_) { ring0[s_] = ring0[s_ + 1]; ring1[s_] = ring1[s_ + 1]; }
            asm volatile("" ::: "memory");
            SEL_LD(PF - 1, it + PF);
            asm volatile("" ::: "memory");
            const int grp = w + 4 * it;
            unsigned word = 0u;
#pragma unroll
            for (int t = 0; t < 2; ++t) {
                const int k0 = 32 * grp + 16 * t;
                float sc[4]; score_tile(t == 0 ? a0 : a1, bq, wq, sc);
                unsigned nib = 0u;
#pragma unroll
                for (int i = 0; i < 4; ++i) {
                    const int b = bin_of(sc[i], inv, off);
                    if (b > bst) nib |= 1u << i;
                    else if (b == bst) {
                        const int pos = atomicAdd(&S.cnt[q], 1);
                        if (pos < CAND_CAP) { S.cand_s[q][pos] = sc[i]; S.cand_k[q][pos] = k0 + 4 * g + i; }
                    }
                }
                unsigned v = nib << (4 * g);
                v |= (unsigned)__shfl_xor((int)v, 16); v |= (unsigned)__shfl_xor((int)v, 32);
                word |= v << (16 * t);
            }
            if (g == 0) mrow[q * 512 + grp] = word;
        }
    }
#undef SEL_LD
    __syncthreads();
    for (int qq = 0; qq < 4; ++qq) {
        const int qi = 4 * w + qq;
        const int m = S.cnt[qi], r = 256 - S.nabove[qi];
        if (m > CAND_CAP) { if (lane == 0) S.ovf[qi] = 1; continue; }
#pragma unroll
        for (int part = 0; part < 2; ++part) {
            const int me = lane + 64 * part;
            const float s_me = me < m ? S.cand_s[qi][me] : 0.f;
            const int k_me = me < m ? S.cand_k[qi][me] : 0;
            int rank = 0;
            for (int j = 0; j < m; ++j) { const float sj = S.cand_s[qi][j]; const int kj = S.cand_k[qi][j]; rank += (sj > s_me || (sj == s_me && kj < k_me)) ? 1 : 0; }
            if (me < m && rank < r) atomicOr(&mrow[qi * 512 + (k_me >> 5)], 1u << (k_me & 31));
        }
    }
    __syncthreads();
    for (int i = tid; i < 16 * nw; i += NT) { const int qi = i / nw, wd = i - qi * nw; mask[(size_t)qi * ldm + wd] = mrow[qi * 512 + wd]; }
    __syncthreads();
    if (tid == 0) {
        unsigned* fl = (unsigned*)(p.ws + WS_REDO) + (size_t)blockIdx.x * REDO_LD;
        unsigned n = fl[0];
        for (int qi = 0; qi < 16; ++qi) if (S.ovf[qi] && n + 1 < (unsigned)REDO_LD) { fl[1 + n] = (unsigned)(row0 + qi); ++n; }
        fl[0] = n;
    }
}

constexpr int ATT_TB_OFF = 32768;
constexpr int ATT_LDS = ATT_TB_OFF + 1024;

__device__ __forceinline__ int pi32(int r) { return (r & 0x13) | ((r & 4) << 1) | ((r & 8) >> 1); }
__device__ __forceinline__ unsigned pkrtz(float a, float b) { return __builtin_bit_cast(unsigned, __builtin_amdgcn_cvt_pkrtz(a, b)); }

struct AttnUnit {
    int row0, nwaves, ntiles, chunk0, chunk_step, qpos0, head;
    const h16* Kh; const h16* VTh; int ldk; int ldv;
    const float* Kc; const float* Vc; const float* Kn; const float* Vn; int ldf; int ntc;
    const unsigned* mask; int ldm;
};

template <int MODE, bool F32SRC>
__device__ __forceinline__ void attn_unit(const Params& p, unsigned char* smem, const AttnUnit& U, float lam) {
    int tid = threadIdx.x; asm volatile("" : "+v"(tid));
    const int lane = tid & 63, w = __builtin_amdgcn_readfirstlane(tid >> 6), l31 = lane & 31, hh = lane >> 5;
    const int qt = (MODE == 1) ? (w & 1) : w, cmap = (MODE == 1) ? (w >> 1) : 0;
    const bool active = qt < U.nwaves;
    const int chunk_w = U.chunk0 + U.chunk_step * (qt >> 1);
    const int rowq = U.row0 + 32 * qt + l31;
    const int qpos = U.qpos0 + 32 * qt + l31;
    float* tb = (float*)(smem + ATT_TB_OFF);
    __syncthreads();
    if (MODE != 2) {
        if (tid < 255) { const int hc = (MODE == 0 ? U.head : 8 + U.head); tb[tid] = (p.in[10][rel_bucket(tid - 191) * 12 + hc] - p.in[10][15 * 12 + hc]) * LOG2E; }
    }
    constexpr int NQF = (MODE == 1) ? 2 : 4;
    h16x8 qf[NQF];
    if (active) {
        const h16* Qb = (MODE == 0) ? (const h16*)(p.ws + WS_QA) + (size_t)rowq * 512 + U.head * 64
                      : (MODE == 1) ? (const h16*)(p.ws + WS_QB) + (size_t)rowq * 256 + U.head * 64 + 32 * cmap
                                    : (const h16*)(p.ws + WS_QC) + (size_t)rowq * 256 + U.head * 64;
#pragma unroll
        for (int s = 0; s < NQF; ++s) qf[s] = *(const h16x8*)(Qb + 16 * s + 8 * hh);
    } else {
#pragma unroll
        for (int s = 0; s < NQF; ++s)
#pragma unroll
            for (int e = 0; e < 8; ++e) qf[s][e] = (h16)0.f;
    }
    f32x16 O[2];
    float lsum = 0.f;
#pragma unroll
    for (int m = 0; m < 2; ++m)
#pragma unroll
        for (int r = 0; r < 16; ++r) O[m][r] = 0.f;
    int crow[2], cch[2], so[2];
#pragma unroll
    for (int i = 0; i < 2; ++i) { const int c = tid + 256 * i; crow[i] = c >> 3; cch[i] = c & 7; so[i] = crow[i] * 128 + ((cch[i] ^ ((crow[i] >> 1) & 7)) << 4); }
    u32x4 rk[2], rv[2];
    f32x4 fk[2][2], fv[2][2];
#define ATT_LOAD(j) do { \
        if constexpr (!F32SRC) { \
            _Pragma("unroll") for (int i = 0; i < 2; ++i) { \
                rk[i] = *(const u32x4*)(U.Kh + (size_t)(64 * (j) + crow[i]) * U.ldk + cch[i] * 8); \
                rv[i] = *(const u32x4*)(U.VTh + (size_t)crow[i] * U.ldv + 64 * (j) + cch[i] * 8); } \
        } else { \
            const float* kb_ = ((j) < U.ntc) ? U.Kc + (size_t)(64 * (j)) * U.ldf : U.Kn + (size_t)(64 * ((j) - U.ntc)) * U.ldf; \
            const float* vb_ = ((j) < U.ntc) ? U.Vc + (size_t)(64 * (j)) * U.ldf : U.Vn + (size_t)(64 * ((j) - U.ntc)) * U.ldf; \
            _Pragma("unroll") for (int i = 0; i < 2; ++i) { \
                const float* ks_ = kb_ + (size_t)crow[i] * U.ldf + cch[i] * 8; const float* vs_ = vb_ + (size_t)crow[i] * U.ldf + cch[i] * 8; \
                fk[i][0] = *(const f32x4*)ks_; fk[i][1] = *(const f32x4*)(ks_ + 4); fv[i][0] = *(const f32x4*)vs_; fv[i][1] = *(const f32x4*)(vs_ + 4); } \
        } } while (0)
#define ATT_WRITE(b) do { \
        unsigned char* kt_ = smem + (b) * 16384; unsigned char* vt_ = kt_ + 8192; \
        if constexpr (!F32SRC) { \
            _Pragma("unroll") for (int i = 0; i < 2; ++i) { *(u32x4*)(kt_ + so[i]) = rk[i]; *(u32x4*)(vt_ + so[i]) = rv[i]; } \
        } else { \
            _Pragma("unroll") for (int i = 0; i < 2; ++i) { \
                h16x8 hk_; _Pragma("unroll") for (int e = 0; e < 4; ++e) { hk_[e] = (h16)fk[i][0][e]; hk_[4 + e] = (h16)fk[i][1][e]; } \
                *(h16x8*)(kt_ + so[i]) = hk_; \
                const int key_ = crow[i]; \
                _Pragma("unroll") for (int e = 0; e < 8; ++e) { const int dv_ = 8 * cch[i] + e; \
                    *(__bf16*)(vt_ + dv_ * 128 + (((key_ >> 3) ^ ((dv_ >> 1) & 7)) << 4) + (key_ & 7) * 2) = (__bf16)(e < 4 ? fv[i][0][e] : fv[i][1][e - 4]); } } \
        } } while (0)

    ATT_LOAD(0);
    ATT_WRITE(0);
    const unsigned* mrow = (MODE == 0) ? U.mask + (size_t)(32 * qt + l31) * U.ldm : nullptr;
    unsigned mwn0 = 0xffffffffu, mwn1 = 0xffffffffu;
    if (MODE == 0) { mwn0 = mrow[0]; mwn1 = mrow[1]; }
    __syncthreads();
    const int pil = pi32(l31), ksw = (pil >> 1) & 7, vsw = (l31 >> 1) & 7;
    const int jlast = U.ntiles - 1;
    for (int j = 0; j < U.ntiles; ++j) {
        const int buf = j & 1;
        const int jn = j < jlast ? j + 1 : jlast;
        unsigned mw[2] = {mwn0 >> (8 * hh), mwn1 >> (8 * hh)};
        if (MODE == 0) { mwn0 = mrow[2 * jn]; mwn1 = mrow[2 * jn + 1]; }
        if (!F32SRC) ATT_LOAD(jn);
        if (active && (MODE == 2 || j <= chunk_w)) {
            const unsigned char* Kt = smem + buf * 16384;
            const unsigned char* Vt = Kt + 8192;
            const bool near = (MODE != 2) && (j >= chunk_w - 2);
            bf16x8 pf[4];
            float ls = 0.f;
#pragma unroll
            for (int u = 0; u < 2; ++u) {
                f32x16 S;
#pragma unroll
                for (int r = 0; r < 16; ++r) S[r] = 0.f;
                const unsigned char* kp = Kt + (32 * u + pil) * 128;
#pragma unroll
                for (int s = 0; s < NQF; ++s) {
                    const int ch = (MODE == 1) ? (4 * cmap + 2 * s + hh) : (2 * s + hh);
                    const h16x8 a = *(const h16x8*)(kp + ((ch ^ ksw) << 4));
                    S = __builtin_amdgcn_mfma_f32_32x32x16_f16(a, qf[s], S, 0, 0, 0);
                }
                if (near) {
                    const int base = 64 * j + 32 * u + 8 * hh - qpos + 191;
#pragma unroll
                    for (int i = 0; i < 16; ++i) S[i] += tb[base + (i & 7) + 16 * (i >> 3)];
                }
#pragma unroll
                for (int i = 0; i < 16; ++i) {
                    float pv = __builtin_amdgcn_exp2f(S[i]);
                    if (MODE == 0) pv = ((mw[u] >> ((i & 7) + 16 * (i >> 3))) & 1u) ? pv : 0.f;
                    ls += pv; S[i] = pv;
                }
#pragma unroll
                for (int s2 = 0; s2 < 2; ++s2) {
                    u32x4 pk;
                    pk[0] = pkbf(S[8 * s2 + 0], S[8 * s2 + 1]); pk[1] = pkbf(S[8 * s2 + 2], S[8 * s2 + 3]);
                    pk[2] = pkbf(S[8 * s2 + 4], S[8 * s2 + 5]); pk[3] = pkbf(S[8 * s2 + 6], S[8 * s2 + 7]);
                    pf[2 * u + s2] = __builtin_bit_cast(bf16x8, pk);
                }
            }
            lsum += ls;
#pragma unroll
            for (int m = 0; m < 2; ++m)
#pragma unroll
                for (int sp = 0; sp < 4; ++sp) {
                    const bf16x8 vfr = *(const bf16x8*)(Vt + (32 * m + l31) * 128 + (((2 * sp + hh) ^ vsw) << 4));
                    O[m] = __builtin_amdgcn_mfma_f32_32x32x16_bf16(vfr, pf[sp], O[m], 0, 0, 0);
                }
        }
        if (F32SRC) ATT_LOAD(jn);
        ATT_WRITE(buf ^ 1);
        __syncthreads();
    }
#undef ATT_LOAD
#undef ATT_WRITE
    const float l = lsum + __shfl_xor(lsum, 32);
    const float inv = 1.0f / l;
    if (MODE == 1) {
        float* X = (float*)smem;
        if (cmap == 1) {
#pragma unroll
            for (int m = 0; m < 2; ++m)
#pragma unroll
                for (int i = 0; i < 16; ++i) X[(qt * 32 + m * 16 + i) * 64 + lane] = O[m][i] * inv;
        }
        __syncthreads();
        if (cmap == 1) return;
#pragma unroll
        for (int m = 0; m < 2; ++m)
#pragma unroll
            for (int i = 0; i < 16; ++i) O[m][i] = O[m][i] * inv - lam * X[(qt * 32 + m * 16 + i) * 64 + lane];
    } else {
        if (!active) return;
#pragma unroll
        for (int m = 0; m < 2; ++m)
#pragma unroll
            for (int i = 0; i < 16; ++i) O[m][i] *= inv;
    }
    const int colbase = (MODE == 0 ? 0 : (MODE == 1 ? 512 : 768)) + U.head * 64;
    const h16* G = (const h16*)(p.ws + WS_G) + (size_t)rowq * 1024 + colbase;
    h16* Oo = (h16*)(p.ws + WS_O16) + (size_t)rowq * 1024 + colbase;
    float sc = 1.f;
    if (MODE == 1) {
        float ss = 0.f;
#pragma unroll
        for (int m = 0; m < 2; ++m)
#pragma unroll
            for (int i = 0; i < 16; ++i) ss = fmaf(O[m][i], O[m][i], ss);
        ss += __shfl_xor(ss, 32);
        sc = (1.0f / sqrtf(ss * (1.0f / 64.0f) + EPS)) * 0.8f;
    }
#pragma unroll
    for (int m = 0; m < 2; ++m)
#pragma unroll
        for (int g4 = 0; g4 < 4; ++g4) {
            const int dv = 32 * m + 8 * g4 + 4 * hh;
            const h16x4 gv = *(const h16x4*)(G + dv);
            h16x4 o4;
#pragma unroll
            for (int e = 0; e < 4; ++e) {
                float o = O[m][4 * g4 + e];
                if (MODE == 1) o = o * sc * p.in[18][dv + e];
                o4[e] = (h16)(o * silu((float)gv[e]));
            }
            *(h16x4*)(Oo + dv) = o4;
        }
}

__device__ __forceinline__ AttnUnit unit_zero() {
    AttnUnit U; U.row0 = 0; U.nwaves = 0; U.ntiles = 0; U.chunk0 = 0; U.chunk_step = 0; U.qpos0 = 0; U.head = 0; U.Kh = nullptr; U.VTh = nullptr; U.ldk = 0; U.ldv = 0;
    U.Kc = nullptr; U.Vc = nullptr; U.Kn = nullptr; U.Vn = nullptr; U.ldf = 0; U.ntc = 0; U.mask = nullptr; U.ldm = 0; return U;
}

#define ZIGZAG_LOOP(NALL) for (int zk_ = 0, pos_ = 0; zk_ * (int)gridDim.x < (NALL); ++zk_) \
    if ((pos_ = (zk_ & 1) ? (zk_ + 1) * (int)gridDim.x - 1 - (int)blockIdx.x : zk_ * (int)gridDim.x + (int)blockIdx.x) < (NALL))

__device__ void phase2(const Params& p, unsigned char* smem) {
    float s1 = 0.f, s2 = 0.f;
    for (int i = 0; i < 32; ++i) { s1 = fmaf(p.in[19][i], p.in[20][i], s1); s2 = fmaf(p.in[21][i], p.in[22][i], s2); }
    const float lam = expf(s1) - expf(s2) + 0.2f;
    constexpr int N_BP = 1024, N_SP = 1024, N_BS = 128, N_CS = 128, N_SS = 128, N_CP = 512;
    constexpr int N_ALL = N_BP + N_SP + N_BS + N_CS + N_SS + N_CP;
    ZIGZAG_LOOP(N_ALL) {
        int it = pos_;
        if (it < N_BP) {
            const int g = 255 - (it >> 2), head = blockIdx.x & 3;
            AttnUnit U = unit_zero();
            U.row0 = 64 * g; U.nwaves = 2; U.ntiles = g + 1; U.chunk0 = g; U.chunk_step = 0; U.qpos0 = 64 * g; U.head = head;
            U.Kh = (const h16*)(p.ws + WS_KB_P) + head * 64; U.ldk = 256;
            U.VTh = (const h16*)(p.ws + WS_VTB_P) + (size_t)(head * 64) * SEQ; U.ldv = SEQ;
            attn_unit<1, false>(p, smem, U, lam);
            continue;
        }
        it -= N_BP;
        if (it < N_SP) { select_unit(p, smem, it); continue; }
        it -= N_SP;
        if (it < N_BS) {
            const int b = it >> 2, head = it & 3;
            AttnUnit U = unit_zero();
            U.row0 = SEQ + 64 * b; U.nwaves = 2; U.ntiles = 17; U.chunk0 = 16; U.chunk_step = 0; U.qpos0 = PAST; U.head = head;
            U.Kc = p.in[6] + (size_t)b * PAST * 256 + head * 64; U.Vc = p.in[7] + (size_t)b * PAST * 256 + head * 64;
            U.Kn = p.out + O_SBK + (size_t)b * DECS * 256 + head * 64; U.Vn = p.out + O_SBV + (size_t)b * DECS * 256 + head * 64;
            U.ldf = 256; U.ntc = 16;
            attn_unit<1, true>(p, smem, U, lam);
            continue;
        }
        it -= N_BS;
        if (it < N_CS) {
            const int b = it >> 2, head = it & 3;
            AttnUnit U = unit_zero();
            U.row0 = SEQ + 64 * b; U.nwaves = 2; U.ntiles = 4; U.head = head;
            U.Kc = p.in[8] + (size_t)b * NMEM * 256 + head * 64; U.Vc = p.in[9] + (size_t)b * NMEM * 256 + head * 64;
            U.Kn = U.Kc; U.Vn = U.Vc; U.ldf = 256; U.ntc = 4;
            attn_unit<2, true>(p, smem, U, lam);
            continue;
        }
        it -= N_CS;
        if (it < N_SS) { select_unit(p, smem, 1024 + it); continue; }
        it -= N_SS;
        {
            const int g = it >> 2, head = it & 3;
            AttnUnit U = unit_zero();
            U.row0 = 128 * g; U.nwaves = 4; U.ntiles = 4; U.head = head;
            U.Kh = (const h16*)(p.ws + WS_MK_P) + head * 64; U.ldk = 256;
            U.VTh = (const h16*)(p.ws + WS_MVT_P) + (size_t)(head * 64) * NMEM; U.ldv = NMEM;
            attn_unit<2, false>(p, smem, U, lam);
        }
    }
    {
        __syncthreads();
        const unsigned* fl = (const unsigned*)(p.ws + WS_REDO) + (size_t)blockIdx.x * REDO_LD;
        const unsigned n = __builtin_amdgcn_readfirstlane((int)__hip_atomic_load(fl, __ATOMIC_RELAXED, __HIP_MEMORY_SCOPE_AGENT));
        for (unsigned i = 0; i < n; ++i) {
            const int row = __builtin_amdgcn_readfirstlane((int)__hip_atomic_load(fl + 1 + i, __ATOMIC_RELAXED, __HIP_MEMORY_SCOPE_AGENT));
            select_item(p, smem, row);
        }
    }
}

__device__ void phase3(const Params& p, unsigned char* smem) {
    constexpr int N_AP = 1024, N_AS = 256;
    ZIGZAG_LOOP(N_AP + N_AS) {
        int it = pos_;
        if (it < N_AP) {
            const int g = 127 - (it >> 3), head = blockIdx.x & 7;
            AttnUnit U = unit_zero();
            U.row0 = 128 * g; U.nwaves = 4; U.ntiles = 2 * g + 2; U.chunk0 = 2 * g; U.chunk_step = 1; U.qpos0 = 128 * g; U.head = head;
            U.Kh = (const h16*)(p.ws + WS_KA_P) + head * 64; U.ldk = 512;
            U.VTh = (const h16*)(p.ws + WS_VTA_P) + (size_t)(head * 64) * SEQ; U.ldv = SEQ;
            U.mask = (const unsigned*)(p.ws + WS_MASK_P) + (size_t)(128 * g) * 512; U.ldm = 512;
            attn_unit<0, false>(p, smem, U, 0.f);
            continue;
        }
        it -= N_AP;
        {
            const int b = it >> 3, head = it & 7;
            AttnUnit U = unit_zero();
            U.row0 = SEQ + 64 * b; U.nwaves = 2; U.ntiles = 17; U.chunk0 = 16; U.chunk_step = 0; U.qpos0 = PAST; U.head = head;
            U.Kc = p.in[3] + (size_t)b * PAST * 512 + head * 64; U.Vc = p.in[4] + (size_t)b * PAST * 512 + head * 64;
            U.Kn = p.out + O_SAK + (size_t)b * DECS * 512 + head * 64; U.Vn = p.out + O_SAV + (size_t)b * DECS * 512 + head * 64;
            U.ldf = 512; U.ntc = 16;
            U.mask = (const unsigned*)(p.ws + WS_MASK_S) + (size_t)(64 * b) * 34; U.ldm = 34;
            attn_unit<0, true>(p, smem, U, 0.f);
        }
    }
}

__device__ void phase4(const Params& p, unsigned char* smem) {
    const h16* O16 = (const h16*)(p.ws + WS_O16);
    const h16* WTOUT = (const h16*)(p.ws + WS_WTOUT);
    constexpr int NCT = D / 128, NRT = MROWS / 128;
    const EpiOut eo{};
    const int G = gridDim.x;
    if ((G & 7) == 0) {
        const int xcd = blockIdx.x & 7, local = blockIdx.x >> 3, LG = G >> 3;
        for (int lin = local; lin < (NRT / 8) * NCT; lin += LG) {
            const int rt = xcd + 8 * (lin / NCT), ct = lin % NCT;
            gemm_tile(p, O16, WTOUT, rt * 128, ct * 128, smem, eo);
        }
    } else {
        for (int it = blockIdx.x; it < NCT * NRT; it += gridDim.x) {
            const int rt = it / NCT, ct = it % NCT;
            gemm_tile(p, O16, WTOUT, rt * 128, ct * 128, smem, eo);
        }
    }
}

constexpr int SMEM_BYTES = 80 * 1024;

__device__ __forceinline__ void grid_barrier(unsigned* cnt, unsigned target) {
    asm volatile("s_waitcnt vmcnt(0)" ::: "memory");
    __syncthreads();
    if (threadIdx.x == 0) {
        __builtin_amdgcn_fence(__ATOMIC_RELEASE, "agent");
        asm volatile("s_waitcnt vmcnt(0)" ::: "memory");
        __hip_atomic_fetch_add(cnt, 1u, __ATOMIC_RELAXED, __HIP_MEMORY_SCOPE_AGENT);
        while (__hip_atomic_load(cnt, __ATOMIC_RELAXED, __HIP_MEMORY_SCOPE_AGENT) < target) __builtin_amdgcn_s_sleep(2);
        __builtin_amdgcn_fence(__ATOMIC_ACQUIRE, "agent");
        asm volatile("s_waitcnt vmcnt(0)" ::: "memory");
    }
    __syncthreads();
}

__global__ void __launch_bounds__(NT, 2) fwd_kernel(Params p) {
    __shared__ __attribute__((aligned(16))) unsigned char smem[SMEM_BYTES];
    static_assert(ATT_LDS <= SMEM_BYTES && sizeof(SmemDsa) <= SMEM_BYTES && sizeof(SelSm) <= SMEM_BYTES && CS_LD * 128 * 4 <= SMEM_BYTES, "smem");
    cg::grid_group grid = cg::this_grid();
    unsigned nbar = 0;
    for (int ph = p.ph_lo; ph < p.ph_hi; ++ph) {
#ifndef REP_PHASE
#define REP_PHASE -1
#endif
        const int nrep = (ph == REP_PHASE) ? 2 : 1;
        for (int rep = 0; rep < nrep; ++rep) {
            if (ph == 0) phase0(p, smem);
            else if (ph == 1) phase1(p, smem);
            else if (ph == 2) phase2(p, smem);
            else if (ph == 3) phase3(p, smem);
            else phase4(p, smem);
            if (rep + 1 < nrep) grid.sync();
        }
        if (ph + 1 < p.ph_hi) {
            if (ph == p.ph_lo) grid.sync();
            else grid_barrier((unsigned*)(p.ws + WS_CTL) + 48, ++nbar * gridDim.x);
        }
    }
}

extern "C" void kernel_launch(void* const* d_in, const int* in_sizes, int n_in, void* d_out, int out_size, void* d_ws, size_t ws_size, hipStream_t stream) {
    static int grid_blocks = 0;
    if (!grid_blocks) {
        int dev = 0, cus = 0, per_cu = 0;
        (void)hipGetDevice(&dev);
        (void)hipDeviceGetAttribute(&cus, hipDeviceAttributeMultiprocessorCount, dev);
        (void)hipOccupancyMaxActiveBlocksPerMultiprocessor(&per_cu, fwd_kernel, NT, 0);
        if (per_cu < 1) per_cu = 1;
        grid_blocks = cus * per_cu;
        if (ws_size < WS_END) fprintf(stderr, "kernel_launch: workspace too small: %zu < %zu\n", ws_size, (size_t)WS_END);
    }
    if (ws_size < WS_END) return;
    (void)hipMemsetAsync((unsigned char*)d_ws + WS_CTL, 0, 256 + (size_t)2048 * REDO_LD * 4, stream);
    Params p{};
    for (int i = 0; i < 27; ++i) p.in[i] = (const float*)d_in[i];
    p.out = (float*)d_out; p.ws = (unsigned char*)d_ws;
#if ONE_LAUNCH
    p.ph_lo = 0; p.ph_hi = 5;
    void* args[] = {&p};
    hipError_t e = hipLaunchCooperativeKernel((void*)fwd_kernel, dim3(grid_blocks), dim3(NT), args, 0, stream);
    if (e != hipSuccess) fprintf(stderr, "cooperative launch failed: %s (grid %d)\n", hipGetErrorString(e), grid_blocks);
#else
    for (int ph = 0; ph < 5; ++ph) {
        p.ph_lo = ph; p.ph_hi = ph + 1;
        hipLaunchKernelGGL(fwd_kernel, dim3(grid_blocks), dim3(NT), 0, stream, p);
    }
#endif
}
```

```cpp
#include <hip/hip_runtime.h>
#include <hip/hip_cooperative_groups.h>
#include <cstdio>
#include <cstdint>
namespace cg = cooperative_groups;

#define NT 256
#define ONE_LAUNCH 1

constexpr int D = 1024, SEQ = 16384, DECB = 32, DECS = 64, PAST = 1024, NMEM = 256;
constexpr int MROWS = SEQ + DECB * DECS;
constexpr int DIN = 3880;
constexpr int LDP = 264;
constexpr int PC_IQ = 0, PC_IW = 256;
constexpr float EPS = 1e-6f;

constexpr size_t O_YP = 0, O_YS = 16777216, O_PAK = 18874368, O_PAV = 27262976, O_PAKI = 35651584, O_PBK = 36175872,
                 O_PBV = 40370176, O_PMK = 44564480, O_PMV = 44630016, O_SAK = 44695552, O_SAV = 45744128,
                 O_SAKI = 46792704, O_SBK = 46858240, O_SBV = 47382528;

typedef _Float16 h16;
typedef h16 h16x2 __attribute__((ext_vector_type(2)));
typedef h16 h16x4 __attribute__((ext_vector_type(4)));
typedef h16 h16x8 __attribute__((ext_vector_type(8)));
typedef float f32x4 __attribute__((ext_vector_type(4)));
typedef unsigned u32x4 __attribute__((ext_vector_type(4)));
typedef __bf16 bf16x8 __attribute__((ext_vector_type(8)));
typedef __bf16 bf16x2 __attribute__((ext_vector_type(2)));
typedef float f32x2 __attribute__((ext_vector_type(2)));
__device__ __forceinline__ unsigned pkbf(float a, float b) { const f32x2 v = {a, b}; return __builtin_bit_cast(unsigned, __builtin_convertvector(v, bf16x2)); }
typedef float f32x16 __attribute__((ext_vector_type(16)));

constexpr int NPAD_IN = 3968;
constexpr float LOG2E = 1.4426950408889634f;
constexpr size_t WS_XH = 0;
constexpr size_t WS_O16 = WS_XH;
constexpr size_t WS_HMH = WS_XH + (size_t)MROWS * D * 2;
constexpr size_t WS_WTIN = WS_HMH + (size_t)NMEM * D * 2;
constexpr size_t WS_WTOUT = WS_WTIN + (size_t)NPAD_IN * D * 2;
constexpr size_t WS_WTMEM = WS_WTOUT + (size_t)D * D * 2;
constexpr size_t WS_QA = WS_WTMEM + (size_t)512 * D * 2;
constexpr size_t WS_QB = WS_QA + (size_t)MROWS * 512 * 2;
constexpr size_t WS_QC = WS_QB + (size_t)MROWS * 256 * 2;
constexpr size_t WS_G = WS_QC + (size_t)MROWS * 256 * 2;
constexpr size_t WS_KB_P = WS_G + (size_t)MROWS * 1024 * 2;
constexpr size_t WS_VTB_P = WS_KB_P + (size_t)SEQ * 256 * 2;
constexpr size_t WS_MK_P = WS_VTB_P + (size_t)SEQ * 256 * 2;
constexpr size_t WS_MVT_P = WS_MK_P + (size_t)NMEM * 256 * 2;
constexpr size_t WS_KA_P = WS_MVT_P + (size_t)NMEM * 256 * 2;
constexpr size_t WS_VTA_P = WS_KA_P + (size_t)SEQ * 512 * 2;
constexpr size_t WS_MASK_P = WS_VTA_P + (size_t)SEQ * 512 * 2;
constexpr size_t WS_MASK_S = WS_MASK_P + (size_t)SEQ * 512 * 4;
constexpr size_t WS_IQ16 = WS_MASK_S + (size_t)DECB * DECS * 34 * 4;
constexpr size_t WS_IK_P = WS_IQ16 + (size_t)MROWS * 256 * 2;
constexpr size_t WS_IK_S = WS_IK_P + (size_t)SEQ * 32 * 2;
constexpr size_t WS_CTL = WS_IK_S + (size_t)DECB * (PAST + DECS) * 32 * 2;
constexpr int REDO_LD = 64;
constexpr size_t WS_REDO = WS_CTL + 256;
constexpr size_t WS_P = WS_REDO + (size_t)2048 * REDO_LD * 4;
constexpr size_t WS_END = WS_P + (size_t)MROWS * LDP * 4;

struct Params {
    const float* in[27];
    float* out;
    unsigned char* ws;
    int ph_lo, ph_hi;
};

__device__ __forceinline__ float wave_sum(float v) {
#pragma unroll
    for (int o = 1; o < 64; o <<= 1) v += __shfl_xor(v, o);
    return v;
}
__device__ __forceinline__ float wave_max(float v) {
#pragma unroll
    for (int o = 1; o < 64; o <<= 1) v = fmaxf(v, __shfl_xor(v, o));
    return v;
}
__device__ __forceinline__ float silu(float x) { return x / (1.0f + expf(-x)); }

__device__ __forceinline__ int rel_bucket(int rel) {
    const int ret = rel > 0 ? 16 : 0;
    const int n = rel < 0 ? -rel : rel;
    int b;
    if (n < 8) b = n;
    else if (n < 12) b = 8;
    else if (n < 16) b = 9;
    else if (n < 23) b = 10;
    else if (n < 32) b = 11;
    else if (n < 46) b = 12;
    else if (n < 64) b = 13;
    else if (n < 91) b = 14;
    else b = 15;
    return ret + b;
}

__device__ __forceinline__ void rms_row_h(const float* x, const float* g, h16* o, int lane) {
    const float4* xr = (const float4*)x;
    const float4* gr = (const float4*)g;
    float4 v[4];
    float s = 0.f;
#pragma unroll
    for (int j = 0; j < 4; ++j) { v[j] = xr[lane + 64 * j]; s += v[j].x * v[j].x + v[j].y * v[j].y + v[j].z * v[j].z + v[j].w * v[j].w; }
    s = wave_sum(s);
    const float r = 1.0f / sqrtf(s * (1.0f / 1024.0f) + EPS);
#pragma unroll
    for (int j = 0; j < 4; ++j) {
        const float4 gg = gr[lane + 64 * j];
        h16x4 o4; o4.x = (h16)(v[j].x * r * gg.x); o4.y = (h16)(v[j].y * r * gg.y); o4.z = (h16)(v[j].z * r * gg.z); o4.w = (h16)(v[j].w * r * gg.w);
        ((h16x4*)o)[lane + 64 * j] = o4;
    }
}

__device__ __forceinline__ void transpose_item(const float* __restrict__ W, int ldw, int c0, int nvalid, int k0, h16* __restrict__ WT, int r0, float* scr, int lane) {
#pragma unroll 8
    for (int i = 0; i < 32; ++i) {
        const int kk = 2 * i + (lane >> 5), n = lane & 31;
        scr[kk * 33 + n] = (n < nvalid) ? W[(size_t)(k0 + kk) * ldw + c0 + n] : 0.f;
    }
    asm volatile("s_waitcnt lgkmcnt(0)" ::: "memory");
    const int c = lane & 7;
#pragma unroll
    for (int j = 0; j < 4; ++j) {
        const int n = (lane >> 3) + 8 * j;
        const float* s = scr + (8 * c) * 33 + n;
        h16x8 o;
#pragma unroll
        for (int e = 0; e < 8; ++e) o[e] = (h16)s[e * 33];
        *(h16x8*)(WT + (size_t)(r0 + n) * 1024 + k0 + 8 * c) = o;
    }
    asm volatile("s_waitcnt lgkmcnt(0)" ::: "memory");
}

__device__ __forceinline__ int inproj_col(int np) { return np < 2304 ? np : (np < 3840 ? np + 40 : np - 3840 + 2304); }

__device__ void phase0(const Params& p, unsigned char* smem) {
    const int lane = threadIdx.x & 63, w = threadIdx.x >> 6;
    const int gw = blockIdx.x * 4 + w, ngw = gridDim.x * 4;
    h16* XH = (h16*)(p.ws + WS_XH);
    h16* HMH = (h16*)(p.ws + WS_HMH);
    h16* WTIN = (h16*)(p.ws + WS_WTIN);
    h16* WTOUT = (h16*)(p.ws + WS_WTOUT);
    h16* WTMEM = (h16*)(p.ws + WS_WTMEM);
    float* scr = (float*)smem + w * (64 * 33);
    constexpr int N_ROWS = MROWS + NMEM;
    constexpr int I_IN = 16 * (NPAD_IN / 32), I_OUT = 16 * 32, I_MEM = 16 * 16, I_KIDX = DECB * (PAST / 64);
    for (int it = gw; it < N_ROWS + I_IN + I_OUT + I_MEM + I_KIDX; it += ngw) {
        if (it < N_ROWS) {
            const int r = it;
            if (r < SEQ) rms_row_h(p.in[0] + (size_t)r * D, p.in[11], XH + (size_t)r * D, lane);
            else if (r < MROWS) rms_row_h(p.in[1] + (size_t)(r - SEQ) * D, p.in[11], XH + (size_t)r * D, lane);
            else rms_row_h(p.in[2] + (size_t)(r - MROWS) * D, p.in[25], HMH + (size_t)(r - MROWS) * D, lane);
        } else if (it < N_ROWS + I_IN) {
            const int r = it - N_ROWS, nb = r % (NPAD_IN / 32), kb = r / (NPAD_IN / 32);
            const int np0 = nb * 32;
            int nvalid = DIN - np0; nvalid = nvalid < 0 ? 0 : (nvalid > 32 ? 32 : nvalid);
            const int c0 = nvalid > 0 ? inproj_col(np0) : 0;
            transpose_item(p.in[12], DIN, c0, nvalid, kb * 64, WTIN, np0, scr, lane);
        } else if (it < N_ROWS + I_IN + I_OUT) {
            const int r = it - N_ROWS - I_IN, nb = r % 32, kb = r / 32;
            transpose_item(p.in[13], D, nb * 32, 32, kb * 64, WTOUT, nb * 32, scr, lane);
        } else if (it < N_ROWS + I_IN + I_OUT + I_MEM) {
            const int r = it - N_ROWS - I_IN - I_OUT, nb = r % 16, kb = r / 16;
            transpose_item(p.in[26], 512, nb * 32, 32, kb * 64, WTMEM, nb * 32, scr, lane);
        } else {
            const int r = it - N_ROWS - I_IN - I_OUT - I_MEM, b = r / (PAST / 64), key = (r % (PAST / 64)) * 64 + lane;
            const f32x4* src = (const f32x4*)(p.in[5] + ((size_t)b * PAST + key) * 32);
            h16* dst = (h16*)(p.ws + WS_IK_S) + ((size_t)b * (PAST + DECS) + key) * 32;
            float ss = 0.f;
#pragma unroll
            for (int c = 0; c < 4; ++c) {
                const f32x4 x0 = src[2 * c], x1 = src[2 * c + 1];
                h16x8 o;
#pragma unroll
                for (int e = 0; e < 4; ++e) { o[e] = (h16)x0[e]; o[4 + e] = (h16)x1[e]; ss = fmaf(x0[e], x0[e], ss); ss = fmaf(x1[e], x1[e], ss); }
                *(h16x8*)(dst + 8 * c) = o;
            }
            ss = wave_max(ss);
            if (lane == 0) atomicMax((unsigned*)(p.ws + WS_CTL) + 1 + b, __float_as_uint(ss));
        }
    }
}

constexpr int CS_LD = 132;
template <class Epi>
__device__ __forceinline__ void gemm_tile(const Params& p, const h16* __restrict__ A, const h16* __restrict__ Bt, int m0, int n0, unsigned char* smem, const Epi& epi) {
    int tid = threadIdx.x; asm volatile("" : "+v"(tid));
    const int lane = tid & 63, wid = tid >> 6, wm = wid >> 1, wn = wid & 1;
    const int l31 = lane & 31, hh = lane >> 5;
    f32x16 acc[2][2];
#pragma unroll
    for (int a = 0; a < 2; ++a)
#pragma unroll
        for (int b = 0; b < 2; ++b)
#pragma unroll
            for (int r = 0; r < 16; ++r) acc[a][b][r] = 0.f;
    const unsigned char* agl[4]; const unsigned char* bgl[4]; int ldo[4];
#pragma unroll
    for (int i = 0; i < 4; ++i) {
        const int row = 32 * wid + 8 * i + (lane >> 3), slot = lane & 7, ch = slot ^ ((row >> 1) & 7);
        agl[i] = (const unsigned char*)(A + (size_t)(m0 + row) * 1024 + ch * 8);
        bgl[i] = (const unsigned char*)(Bt + (size_t)(n0 + row) * 1024 + ch * 8);
        ldo[i] = (32 * wid + 8 * i) * 128;
    }
#define GT_DMA(stage_, kt_) do { const int ko_ = ((kt_) < 15 ? (kt_) : 15) * 128; \
        _Pragma("unroll") for (int i = 0; i < 4; ++i) { \
            __builtin_amdgcn_global_load_lds((const unsigned*)(agl[i] + ko_), (__attribute__((address_space(3))) unsigned*)(smem + (stage_) * 32768 + ldo[i]), 16, 0, 0); \
            __builtin_amdgcn_global_load_lds((const unsigned*)(bgl[i] + ko_), (__attribute__((address_space(3))) unsigned*)(smem + (stage_) * 32768 + 16384 + ldo[i]), 16, 0, 0); } } while (0)
    const int sw = (l31 >> 1) & 7;
    const int arow = (wm * 64 + l31) * 128, brow = (wn * 64 + l31) * 128;
    __syncthreads();
    GT_DMA(0, 0);
    __syncthreads();
    for (int kt = 0; kt < 16; ++kt) {
        const unsigned char* As = smem + (kt & 1) * 32768; const unsigned char* Bs = As + 16384;
        GT_DMA((kt + 1) & 1, kt + 1);
#pragma unroll
        for (int s = 0; s < 4; ++s) {
            const int co = (((2 * s + hh) ^ sw) << 4);
            h16x8 a[2], b[2];
#pragma unroll
            for (int mt = 0; mt < 2; ++mt) a[mt] = *(const h16x8*)(As + arow + mt * 32 * 128 + co);
#pragma unroll
            for (int nt = 0; nt < 2; ++nt) b[nt] = *(const h16x8*)(Bs + brow + nt * 32 * 128 + co);
#pragma unroll
            for (int mt = 0; mt < 2; ++mt)
#pragma unroll
                for (int nt = 0; nt < 2; ++nt) acc[mt][nt] = __builtin_amdgcn_mfma_f32_32x32x16_f16(a[mt], b[nt], acc[mt][nt], 0, 0, 0);
        }
        __syncthreads();
    }
#undef GT_DMA
    float* Cs = (float*)smem;
#pragma unroll
    for (int mt = 0; mt < 2; ++mt)
#pragma unroll
        for (int nt = 0; nt < 2; ++nt)
#pragma unroll
            for (int r = 0; r < 16; ++r) {
                const int row = wm * 64 + mt * 32 + (r & 3) + 8 * (r >> 2) + 4 * hh, col = wn * 64 + nt * 32 + l31;
                Cs[row * CS_LD + col] = acc[mt][nt][r];
            }
    __syncthreads();
    epi(p, Cs, m0, n0, tid);
}

__device__ __forceinline__ float group_sum16(float v) { v += __shfl_xor(v, 1); v += __shfl_xor(v, 2); v += __shfl_xor(v, 4); v += __shfl_xor(v, 8); return v; }
__device__ __forceinline__ float group_sum8(float v) { v += __shfl_xor(v, 1); v += __shfl_xor(v, 2); v += __shfl_xor(v, 4); return v; }

struct Seg {
    float* bp; float* bs; int ld; int col; int norm; const float* gain;
    h16* hp; h16* hs; int hld; int hcol; float hscale;
    int vt; int head;
};

__device__ __forceinline__ Seg seg_of(const Params& p, int n0) {
    float* P = (float*)(p.ws + WS_P);
    float* out = p.out;
    h16* QA = (h16*)(p.ws + WS_QA); h16* QB = (h16*)(p.ws + WS_QB); h16* QC = (h16*)(p.ws + WS_QC); h16* G = (h16*)(p.ws + WS_G);
    Seg s; s.norm = 0; s.gain = nullptr; s.hp = nullptr; s.hs = nullptr; s.hld = 0; s.hcol = 0; s.hscale = 1.f; s.vt = 0; s.head = 0;
    s.bp = nullptr; s.bs = nullptr; s.ld = 0; s.col = 0;
#define SEG_O(op, os, ldv, c) do { s.bp = out + (op); s.bs = out + (os) - (size_t)SEQ * (ldv); s.ld = (ldv); s.col = (c); } while (0)
#define SEG_H(ptr, ldv, c, sc) do { s.hp = (ptr); s.hs = (ptr); s.hld = (ldv); s.hcol = (c); s.hscale = (sc); } while (0)
    if (n0 < 512) { s.norm = 64; s.gain = p.in[14]; SEG_H(QA, 512, n0, 0.125f * LOG2E); }
    else if (n0 < 1024) { SEG_O(O_PAK, O_SAK, 512, n0 - 512); s.norm = 64; s.gain = p.in[15]; s.hp = (h16*)(p.ws + WS_KA_P); s.hs = nullptr; s.hld = 512; s.hcol = n0 - 512; }
    else if (n0 < 1536) { SEG_O(O_PAV, O_SAV, 512, n0 - 1024); s.vt = 1; s.head = (n0 - 1024) >> 6; }
    else if (n0 < 2048) { SEG_H(G, 1024, n0 - 1536, 1.f); }
    else if (n0 < 2304) { s.bp = P; s.bs = P; s.ld = LDP; s.col = PC_IQ + n0 - 2048; SEG_H((h16*)(p.ws + WS_IQ16), 256, n0 - 2048, 1.f); }
    else if (n0 < 2560) { s.norm = 32; s.gain = p.in[16]; SEG_H(QB, 256, n0 - 2304, 0.17677669529663687f * LOG2E); }
    else if (n0 < 2816) { SEG_O(O_PBK, O_SBK, 256, n0 - 2560); s.norm = 32; s.gain = p.in[17]; s.hp = (h16*)(p.ws + WS_KB_P); s.hs = nullptr; s.hld = 256; s.hcol = n0 - 2560; }
    else if (n0 < 3072) { SEG_O(O_PBV, O_SBV, 256, n0 - 2816); s.vt = 2; s.head = (n0 - 2816) >> 6; }
    else if (n0 < 3328) { SEG_H(G, 1024, 512 + n0 - 3072, 1.f); }
    else if (n0 < 3584) { s.norm = 64; s.gain = p.in[23]; SEG_H(QC, 256, n0 - 3328, 0.125f * LOG2E); }
    else { SEG_H(G, 1024, 768 + n0 - 3584, 1.f); }
#undef SEG_O
#undef SEG_H
    return s;
}

__device__ __forceinline__ void vt_store(const float* Cs, int j, h16* dst_base, size_t ldv, int tid) {
    const int dv = tid & 63, rq = tid >> 6;
    h16* dst = dst_base + (size_t)dv * ldv + 32 * rq;
#pragma unroll
    for (int e8 = 0; e8 < 4; ++e8) {
        u32x4 o;
#pragma unroll
        for (int e = 0; e < 4; ++e) o[e] = pkbf(Cs[(32 * rq + 8 * e8 + 2 * e) * CS_LD + 64 * j + dv], Cs[(32 * rq + 8 * e8 + 2 * e + 1) * CS_LD + 64 * j + dv]);
        *(u32x4*)(dst + 8 * e8) = o;
    }
}

struct EpiIn {
    __device__ __forceinline__ void operator()(const Params& p, const float* Cs, int m0, int n0, int tid) const {
        const int cg = tid & 15, r0 = tid >> 4;
#pragma unroll 1
        for (int j = 0; j < 2; ++j) {
            const int n0j = n0 + 64 * j;
            if (n0j >= DIN) continue;
            if (n0j == 3840) {
                float* P = (float*)(p.ws + WS_P);
                float mx0 = 0.f, mx1 = 0.f;
#pragma unroll 1
                for (int i = 0; i < 8; ++i) {
                    const int rl = r0 + 16 * i, row = m0 + rl;
                    const float4 v = *(const float4*)&Cs[rl * CS_LD + 4 * cg];
                    float ss = (cg < 8) ? (v.x * v.x + v.y * v.y + v.z * v.z + v.w * v.w) : 0.f;
                    ss = group_sum8(ss);
                    if (i < 4) mx0 = fmaxf(mx0, ss); else mx1 = fmaxf(mx1, ss);
                    if (cg < 8) {
                        float* dst = (row < SEQ ? p.out + O_PAKI + (size_t)row * 32 : p.out + O_SAKI + (size_t)(row - SEQ) * 32) + 4 * cg; *(float4*)dst = v;
                        h16x4 hv; hv.x = (h16)v.x; hv.y = (h16)v.y; hv.z = (h16)v.z; hv.w = (h16)v.w;
                        h16* hd = row < SEQ ? (h16*)(p.ws + WS_IK_P) + (size_t)row * 32 : (h16*)(p.ws + WS_IK_S) + ((size_t)((row - SEQ) >> 6) * (PAST + DECS) + PAST + ((row - SEQ) & 63)) * 32;
                        *(h16x4*)(hd + 4 * cg) = hv;
                    }
                    else if (cg < 10) { *(float4*)(P + (size_t)row * LDP + PC_IW + 4 * (cg - 8)) = v; }
                }
                if (cg == 0) {
                    unsigned* ctl = (unsigned*)(p.ws + WS_CTL);
                    if (m0 < SEQ) atomicMax(ctl, __float_as_uint(fmaxf(mx0, mx1)));
                    else { const int b0 = (m0 - SEQ) >> 6; atomicMax(ctl + 1 + b0, __float_as_uint(mx0)); atomicMax(ctl + 2 + b0, __float_as_uint(mx1)); }
                }
                continue;
            }
            const Seg s = seg_of(p, n0j);
            float4 g4 = make_float4(1.f, 1.f, 1.f, 1.f);
            if (s.norm == 64) g4 = *(const float4*)(s.gain + 4 * cg);
            else if (s.norm == 32) g4 = *(const float4*)(s.gain + ((4 * cg) & 31));
#pragma unroll 1
            for (int i = 0; i < 8; ++i) {
                const int rl = r0 + 16 * i, row = m0 + rl;
                float4 v = *(const float4*)&Cs[rl * CS_LD + 64 * j + 4 * cg];
                if (s.norm) {
                    float ss = v.x * v.x + v.y * v.y + v.z * v.z + v.w * v.w;
                    float sc;
                    if (s.norm == 64) { ss = group_sum16(ss); sc = 1.0f / sqrtf(ss * (1.0f / 64.0f) + EPS); }
                    else { ss = group_sum8(ss); sc = 1.0f / sqrtf(ss * (1.0f / 32.0f) + EPS); }
                    v.x *= sc * g4.x; v.y *= sc * g4.y; v.z *= sc * g4.z; v.w *= sc * g4.w;
                }
                if (s.bp) *(float4*)((row < SEQ ? s.bp : s.bs) + (size_t)row * s.ld + s.col + 4 * cg) = v;
                h16* hb = row < SEQ ? s.hp : s.hs;
                if (hb) {
                    h16x4 hv; hv.x = (h16)(v.x * s.hscale); hv.y = (h16)(v.y * s.hscale); hv.z = (h16)(v.z * s.hscale); hv.w = (h16)(v.w * s.hscale);
                    *(h16x4*)(hb + (size_t)row * s.hld + s.hcol + 4 * cg) = hv;
                }
            }
            if (s.vt == 2 && m0 < SEQ) vt_store(Cs, j, (h16*)(p.ws + WS_VTB_P) + (size_t)(s.head * 64) * SEQ + m0, SEQ, tid);
            if (s.vt == 1 && m0 < SEQ) vt_store(Cs, j, (h16*)(p.ws + WS_VTA_P) + (size_t)(s.head * 64) * SEQ + m0, SEQ, tid);
        }
    }
};

struct EpiMem {
    __device__ __forceinline__ void operator()(const Params& p, const float* Cs, int m0, int n0, int tid) const {
        const int cg = tid & 15, r0 = tid >> 4;
#pragma unroll 1
        for (int j = 0; j < 2; ++j) {
            const int n0j = n0 + 64 * j;
            const bool isk = n0j < 256;
            const float4 g4 = isk ? *(const float4*)(p.in[24] + 4 * cg) : make_float4(1.f, 1.f, 1.f, 1.f);
#pragma unroll 1
            for (int i = 0; i < 8; ++i) {
                const int rl = r0 + 16 * i, row = m0 + rl;
                float4 v = *(const float4*)&Cs[rl * CS_LD + 64 * j + 4 * cg];
                if (isk) {
                    float ss = group_sum16(v.x * v.x + v.y * v.y + v.z * v.z + v.w * v.w);
                    const float sc = 1.0f / sqrtf(ss * (1.0f / 64.0f) + EPS);
                    v.x *= sc * g4.x; v.y *= sc * g4.y; v.z *= sc * g4.z; v.w *= sc * g4.w;
                    h16x4 hv; hv.x = (h16)v.x; hv.y = (h16)v.y; hv.z = (h16)v.z; hv.w = (h16)v.w;
                    *(h16x4*)((h16*)(p.ws + WS_MK_P) + (size_t)row * 256 + n0j + 4 * cg) = hv;
                }
                float* dst = p.out + (isk ? O_PMK : O_PMV) + (size_t)row * 256 + (isk ? n0j : n0j - 256) + 4 * cg;
                *(float4*)dst = v;
            }
            if (!isk) vt_store(Cs, j, (h16*)(p.ws + WS_MVT_P) + (size_t)(((n0j - 256) >> 6) * 64) * NMEM + m0, NMEM, tid);
        }
    }
};

struct EpiOut {
    __device__ __forceinline__ void operator()(const Params& p, const float* Cs, int m0, int n0, int tid) const {
        const int cg = tid & 15, r0 = tid >> 4;
#pragma unroll 1
        for (int i = 0; i < 8; ++i) {
            const int rl = r0 + 16 * i, row = m0 + rl;
            const float* x = (row < SEQ ? p.in[0] + (size_t)row * D : p.in[1] + (size_t)(row - SEQ) * D) + n0 + 4 * cg;
            float* y = (row < SEQ ? p.out + O_YP + (size_t)row * D : p.out + O_YS + (size_t)(row - SEQ) * D) + n0 + 4 * cg;
#pragma unroll
            for (int j = 0; j < 2; ++j) {
                const float4 v = *(const float4*)&Cs[rl * CS_LD + 64 * j + 4 * cg];
                const float4 xv = *(const float4*)(x + 64 * j);
                *(float4*)(y + 64 * j) = make_float4(xv.x + v.x, xv.y + v.y, xv.z + v.z, xv.w + v.w);
            }
        }
    }
};

__device__ void phase1(const Params& p, unsigned char* smem) {
    const h16* XH = (const h16*)(p.ws + WS_XH);
    const h16* HMH = (const h16*)(p.ws + WS_HMH);
    const h16* WTIN = (const h16*)(p.ws + WS_WTIN);
    const h16* WTMEM = (const h16*)(p.ws + WS_WTMEM);
    const EpiIn ein{}; const EpiMem emem{};
    const int G = gridDim.x;
    if ((G & 7) == 0) {
        const int xcd = blockIdx.x & 7, local = blockIdx.x >> 3, LG = G >> 3;
        for (int lin = local; lin < 6 * 96; lin += LG) {
            const int rgroup = lin / 96, rem = lin % 96, chalf = rem / 48, rem2 = rem % 48, r = rem2 >> 4, c = chalf * 16 + (rem2 & 15);
            if (c >= 31) continue;
            const int rt = xcd + 8 * (rgroup * 3 + r);
            gemm_tile(p, XH, WTIN, rt * 128, c * 128, smem, ein);
        }
        if (blockIdx.x < 8) { const int rt = blockIdx.x / 4, ct = blockIdx.x % 4; gemm_tile(p, HMH, WTMEM, rt * 128, ct * 128, smem, emem); }
    } else {
        constexpr int NCT = NPAD_IN / 128, NRT = MROWS / 128;
        constexpr int N_IN = NCT * NRT, N_MEM = 2 * 4;
        for (int it = blockIdx.x; it < N_IN + N_MEM; it += gridDim.x) {
            if (it < N_IN) { const int rt = it / NCT, ct = it % NCT; gemm_tile(p, XH, WTIN, rt * 128, ct * 128, smem, ein); }
            else { const int im = it - N_IN, rt = im / 4, ct = im % 4; gemm_tile(p, HMH, WTMEM, rt * 128, ct * 128, smem, emem); }
        }
    }
}

struct KeySrc {
    const float* cache; const float* fresh; int past; int ld;
    __device__ __forceinline__ const float* row(int k) const { return k < past ? cache + (size_t)k * ld : fresh + (size_t)(k - past) * ld; }
};

__device__ __forceinline__ unsigned fkey(float f) { const unsigned u = __float_as_uint(f); return (u & 0x80000000u) ? ~u : (u | 0x80000000u); }

struct SmemDsa {
    float sc[16384];
    float iq[256]; float iw[8];
    unsigned hist[256]; unsigned mw[512];
    int wcnt[4]; int wcnt2[4]; int misc[4];
};

__device__ void select_item(const Params& p, unsigned char* smem, int item) {
    SmemDsa& S = *(SmemDsa*)smem;
    int tid = threadIdx.x; asm volatile("" : "+v"(tid));
    const int lane = tid & 63, w = tid >> 6;
    const float* P = (const float*)(p.ws + WS_P);
    int row, N; KeySrc ki; unsigned* mout;
    if (item < SEQ) {
        row = item; N = 64 * (item / 64 + 1);
        ki = KeySrc{nullptr, p.out + O_PAKI, 0, 32};
        mout = (unsigned*)(p.ws + WS_MASK_P) + (size_t)item * 512;
    } else {
        const int bt = item - SEQ, b = bt / DECS;
        row = item; N = PAST + DECS;
        ki = KeySrc{p.in[5] + (size_t)b * PAST * 32, p.out + O_SAKI + (size_t)b * DECS * 32, PAST, 32};
        mout = (unsigned*)(p.ws + WS_MASK_S) + (size_t)bt * 34;
    }
    const int nw = N / 32;
    __syncthreads();
    if (N <= 256) {
        if (tid < nw) mout[tid] = 0xffffffffu;
        return;
    }
    S.iq[tid] = P[(size_t)row * LDP + PC_IQ + tid];
    if (tid < 8) S.iw[tid] = P[(size_t)row * LDP + PC_IW + tid];
    S.mw[tid] = 0u; S.mw[tid + 256] = 0u;
    __syncthreads();
    for (int k = tid; k < N; k += NT) {
        const float4* kr = (const float4*)ki.row(k);
        float kd[32];
#pragma unroll
        for (int i = 0; i < 8; ++i) { const float4 t4 = kr[i]; kd[4 * i] = t4.x; kd[4 * i + 1] = t4.y; kd[4 * i + 2] = t4.z; kd[4 * i + 3] = t4.w; }
        float score = 0.f;
#pragma unroll 1
        for (int h = 0; h < 8; ++h) {
            float d = 0.f;
#pragma unroll
            for (int i = 0; i < 32; ++i) d = fmaf(S.iq[h * 32 + i], kd[i], d);
            score = fmaf(S.iw[h], fmaxf(d, 0.f), score);
        }
        S.sc[k] = score;
    }
    __syncthreads();
    unsigned prefix = 0; int remaining = 256;
    for (int pass = 0; pass < 4; ++pass) {
        const int shift = 24 - 8 * pass;
        S.hist[tid] = 0;
        __syncthreads();
        for (int k = tid; k < N; k += NT) {
            const unsigned key = fkey(S.sc[k]);
            if (pass == 0 || (key >> (shift + 8)) == prefix) atomicAdd(&S.hist[(key >> shift) & 255u], 1u);
        }
        __syncthreads();
        const int hv = (int)S.hist[tid];
        int x = hv;
#pragma unroll
        for (int o = 1; o < 64; o <<= 1) { const int y = __shfl_down(x, o); if (lane + o < 64) x += y; }
        if (lane == 0) S.wcnt[w] = x;
        __syncthreads();
        int above = x - hv;
        for (int w2 = w + 1; w2 < 4; ++w2) above += S.wcnt[w2];
        if (above < remaining && remaining <= above + hv) { S.misc[0] = (int)((prefix << 8) | (unsigned)tid); S.misc[1] = remaining - above; }
        __syncthreads();
        prefix = (unsigned)S.misc[0]; remaining = S.misc[1];
        __syncthreads();
    }
    const unsigned T = prefix; const int r = remaining;
    int base_eq = 0;
    const unsigned long long lt = (lane == 0) ? 0ull : (~0ull >> (64 - lane));
    for (int k0 = 0; k0 < N; k0 += NT) {
        const int k = k0 + tid;
        const unsigned key = (k < N) ? fkey(S.sc[k]) : 0u;
        const bool gt = (k < N) && key > T, eq = (k < N) && key == T;
        const unsigned long long beq = __ballot(eq);
        const int eqpre = __popcll(beq & lt);
        if (lane == 0) S.wcnt[w] = __popcll(beq);
        __syncthreads();
        int eqbase = base_eq, eqtot = 0;
        for (int w2 = 0; w2 < 4; ++w2) { const int c = S.wcnt[w2]; if (w2 < w) eqbase += c; eqtot += c; }
        const bool sel = gt || (eq && (eqbase + eqpre) < r);
        const unsigned long long bs = __ballot(sel);
        if (lane == 0) S.mw[(k0 >> 5) + 2 * w] = (unsigned)bs;
        if (lane == 32) S.mw[(k0 >> 5) + 2 * w + 1] = (unsigned)(bs >> 32);
        base_eq += eqtot;
        __syncthreads();
    }
    for (int i = tid; i < nw; i += NT) mout[i] = S.mw[i];
}

typedef float f32x4m __attribute__((ext_vector_type(4)));
constexpr int CAND_CAP = 120;
struct SelSm {
    unsigned hist[16][1025];
    float cand_s[16][CAND_CAP]; int cand_k[16][CAND_CAP];
    int cnt[16]; int bstar[16]; int nabove[16]; int ovf[16];
};

__device__ __forceinline__ void score_tile(const h16x8& a, const h16x8 (&bq)[8], const float (&wq)[8], float (&sc)[4]) {
    sc[0] = 0.f; sc[1] = 0.f; sc[2] = 0.f; sc[3] = 0.f;
#pragma unroll
    for (int h = 0; h < 8; ++h) {
        f32x4m z = {0.f, 0.f, 0.f, 0.f};
        const f32x4m d = __builtin_amdgcn_mfma_f32_16x16x32_f16(a, bq[h], z, 0, 0, 0);
#pragma unroll
        for (int i = 0; i < 4; ++i) { const int bits = (int)__float_as_uint(d[i]); sc[i] = fmaf(wq[h], __uint_as_float((unsigned)(bits > 0 ? bits : 0)), sc[i]); }
    }
}

__device__ __forceinline__ int bin_of(float sc, float inv, float off) {
    int b = (int)fmaf(sc, inv, off);
    b = b < 0 ? 0 : (b > 1021 ? 1021 : b);
    return b + (sc > 0.f ? 2 : (sc == 0.f ? 1 : 0));
}

__device__ void select_unit(const Params& p, unsigned char* smem, int u) {
    SelSm& S = *(SelSm*)smem;
    int tid = threadIdx.x; asm volatile("" : "+v"(tid));
    const int lane = tid & 63, w = __builtin_amdgcn_readfirstlane(tid >> 6), q = lane & 15, g = lane >> 4;
    int row0, N, ldm, kslot; const h16* IK; unsigned* mask;
    if (u < 1024) {
        const int q0 = 16 * (1023 - u);
        row0 = q0; N = 64 * (q0 / 64 + 1); IK = (const h16*)(p.ws + WS_IK_P); mask = (unsigned*)(p.ws + WS_MASK_P) + (size_t)q0 * 512; ldm = 512; kslot = 0;
    } else {
        const int bu = u - 1024, b = bu >> 2, t0 = 16 * (bu & 3);
        row0 = SEQ + 64 * b + t0; N = PAST + DECS; IK = (const h16*)(p.ws + WS_IK_S) + (size_t)b * (PAST + DECS) * 32;
        mask = (unsigned*)(p.ws + WS_MASK_S) + (size_t)(64 * b + t0) * 34; ldm = 34; kslot = 1 + b;
    }
    const int nw = N / 32;
    __syncthreads();
    if (N <= 256) {
        for (int i = tid; i < 16 * nw; i += NT) mask[(size_t)(i / nw) * ldm + (i % nw)] = 0xffffffffu;
        return;
    }
    for (int i = tid; i < 16 * 1025; i += NT) ((unsigned*)S.hist)[i] = 0u;
    if (tid < 16) { S.cnt[tid] = 0; S.ovf[tid] = 0; S.bstar[tid] = 0; S.nabove[tid] = 0; }
    const int rowq = row0 + q;
    const h16* IQ = (const h16*)(p.ws + WS_IQ16) + (size_t)rowq * 256 + 8 * g;
    const float* Pf = (const float*)(p.ws + WS_P) + (size_t)rowq * LDP + PC_IW;
    h16x8 bq[8]; float wq[8];
    float hi = 0.f, lo = 0.f;
#pragma unroll
    for (int h = 0; h < 8; ++h) {
        bq[h] = *(const h16x8*)(IQ + h * 32);
        wq[h] = Pf[h];
        float n2 = 0.f;
#pragma unroll
        for (int e = 0; e < 8; ++e) { const float x = (float)bq[h][e]; n2 = fmaf(x, x, n2); }
        n2 += __shfl_xor(n2, 16); n2 += __shfl_xor(n2, 32);
        const float t = wq[h] * sqrtf(n2);
        if (t > 0.f) hi += t; else lo += t;
    }
    const float kmax = sqrtf(__uint_as_float(((const unsigned*)(p.ws + WS_CTL))[kslot])) * 1.01f;
    hi = hi * kmax + 1e-6f; lo = lo * kmax - 1e-6f;
    const float inv = 1022.0f / fmaxf(hi - lo, 1e-20f), off = -lo * inv;
    __syncthreads();
    constexpr int PF = 4;
    const h16* ikp = IK + (size_t)q * 32 + 8 * g;
    const int ngw = (nw - w + 3) >> 2;
#define SEL_LD(slot, it_) do { const int gi_ = w + 4 * ((it_) < ngw ? (it_) : ngw - 1); \
        ring0[slot] = *(const h16x8*)(ikp + (size_t)(32 * gi_) * 32); ring1[slot] = *(const h16x8*)(ikp + (size_t)(32 * gi_ + 16) * 32); } while (0)
    {
        h16x8 ring0[PF], ring1[PF];
#pragma unroll
        for (int s_ = 0; s_ < PF; ++s_) { SEL_LD(s_, s_); asm volatile("" ::: "memory"); }
        for (int it = 0; it < ngw; ++it) {
            const h16x8 a0 = ring0[0], a1 = ring1[0];
#pragma unroll
            for (int s_ = 0; s_ + 1 < PF; ++s_) { ring0[s_] = ring0[s_ + 1]; ring1[s_] = ring1[s_ + 1]; }
            asm volatile("" ::: "memory");
            SEL_LD(PF - 1, it + PF);
            asm volatile("" ::: "memory");
#pragma unroll
            for (int t = 0; t < 2; ++t) {
                float sc[4]; score_tile(t == 0 ? a0 : a1, bq, wq, sc);
#pragma unroll
                for (int i = 0; i < 4; ++i) { const int b = bin_of(sc[i], inv, off); atomicAdd(&S.hist[q][b], 1u); }
            }
        }
    }
    __syncthreads();
    for (int qq = 0; qq < 4; ++qq) {
        const int qi = 4 * w + qq;
        unsigned c = 0;
#pragma unroll
        for (int e = 0; e < 16; ++e) c += S.hist[qi][16 * lane + e];
        int x = (int)c;
#pragma unroll
        for (int o = 1; o < 64; o <<= 1) { const int y = __shfl_down(x, o); if (lane + o < 64) x += y; }
        const int above = x - (int)c;
        if (above < 256 && 256 <= above + (int)c) {
            int acc = above, bs = 16 * lane;
            for (int e = 15; e >= 0; --e) {
                const int v = (int)S.hist[qi][16 * lane + e];
                if (acc + v >= 256) { bs = 16 * lane + e; break; }
                acc += v;
            }
            S.bstar[qi] = bs; S.nabove[qi] = acc;
        }
    }
    __syncthreads();
    const int bst = S.bstar[q];
    unsigned* mrow = (unsigned*)S.hist;
    {
        h16x8 ring0[PF], ring1[PF];
#pragma unroll
        for (int s_ = 0; s_ < PF; ++s_) { SEL_LD(s_, s_); asm volatile("" ::: "memory"); }
        for (int it = 0; it < ngw; ++it) {
            const h16x8 a0 = ring0[0], a1 = ring1[0];
#pragma unroll
            for (int s_ = 0; s_ + 1 < PF; ++s_) { ring0[s_] = ring0[s_ + 1]; ring1[s_] = ring1[s_ + 1]; }
            asm volatile("" ::: "memory");
            SEL_LD(PF - 1, it + PF);
            asm volatile("" ::: "memory");
            const int grp = w + 4 * it;
            unsigned word = 0u;
#pragma unroll
            for (int t = 0; t < 2; ++t) {
                const int k0 = 32 * grp + 16 * t;
                float sc[4]; score_tile(t == 0 ? a0 : a1, bq, wq, sc);
                unsigned nib = 0u;
#pragma unroll
                for (int i = 0; i < 4; ++i) {
                    const int b = bin_of(sc[i], inv, off);
                    if (b > bst) nib |= 1u << i;
                    else if (b == bst) {
                        const int pos = atomicAdd(&S.cnt[q], 1);
                        if (pos < CAND_CAP) { S.cand_s[q][pos] = sc[i]; S.cand_k[q][pos] = k0 + 4 * g + i; }
                    }
                }
                unsigned v = nib << (4 * g);
                v |= (unsigned)__shfl_xor((int)v, 16); v |= (unsigned)__shfl_xor((int)v, 32);
                word |= v << (16 * t);
            }
            if (g == 0) mrow[q * 512 + grp] = word;
        }
    }
#undef SEL_LD
    __syncthreads();
    for (int qq = 0; qq < 4; ++qq) {
        const int qi = 4 * w + qq;
        const int m = S.cnt[qi], r = 256 - S.nabove[qi];
        if (m > CAND_CAP) { if (lane == 0) S.ovf[qi] = 1; continue; }
#pragma unroll
        for (int part = 0; part < 2; ++part) {
            const int me = lane + 64 * part;
            const float s_me = me < m ? S.cand_s[qi][me] : 0.f;
            const int k_me = me < m ? S.cand_k[qi][me] : 0;
            int rank = 0;
            for (int j = 0; j < m; ++j) { const float sj = S.cand_s[qi][j]; const int kj = S.cand_k[qi][j]; rank += (sj > s_me || (sj == s_me && kj < k_me)) ? 1 : 0; }
            if (me < m && rank < r) atomicOr(&mrow[qi * 512 + (k_me >> 5)], 1u << (k_me & 31));
        }
    }
    __syncthreads();
    for (int i = tid; i < 16 * nw; i += NT) { const int qi = i / nw, wd = i - qi * nw; mask[(size_t)qi * ldm + wd] = mrow[qi * 512 + wd]; }
    __syncthreads();
    if (tid == 0) {
        unsigned* fl = (unsigned*)(p.ws + WS_REDO) + (size_t)blockIdx.x * REDO_LD;
        unsigned n = fl[0];
        for (int qi = 0; qi < 16; ++qi) if (S.ovf[qi] && n + 1 < (unsigned)REDO_LD) { fl[1 + n] = (unsigned)(row0 + qi); ++n; }
        fl[0] = n;
    }
}

constexpr int ATT_TB_OFF = 32768;
constexpr int ATT_LDS = ATT_TB_OFF + 1024 + 16;

__device__ __forceinline__ int pi32(int r) { return (r & 0x13) | ((r & 4) << 1) | ((r & 8) >> 1); }
__device__ __forceinline__ unsigned pkrtz(float a, float b) { return __builtin_bit_cast(unsigned, __builtin_amdgcn_cvt_pkrtz(a, b)); }

struct AttnUnit {
    int row0, nwaves, ntiles, chunk0, chunk_step, qpos0, head;
    const h16* Kh; const h16* VTh; int ldk; int ldv;
    const float* Kc; const float* Vc; const float* Kn; const float* Vn; int ldf; int ntc;
    const unsigned* mask; int ldm;
};

template <int MODE, bool F32SRC>
__device__ __forceinline__ void attn_unit(const Params& p, unsigned char* smem, const AttnUnit& U, float lam) {
    int tid = threadIdx.x; asm volatile("" : "+v"(tid));
    const int lane = tid & 63, w = __builtin_amdgcn_readfirstlane(tid >> 6), l31 = lane & 31, hh = lane >> 5;
    const int qt = (MODE == 1) ? (w & 1) : w, cmap = (MODE == 1) ? (w >> 1) : 0;
    const bool active = qt < U.nwaves;
    const int chunk_w = U.chunk0 + U.chunk_step * (qt >> 1);
    const int rowq = U.row0 + 32 * qt + l31;
    const int qpos = U.qpos0 + 32 * qt + l31;
    float* tb = (float*)(smem + ATT_TB_OFF);
    __syncthreads();
    if (MODE != 2) {
        if (tid < 255) { const int hc = (MODE == 0 ? U.head : 8 + U.head); tb[tid] = (p.in[10][rel_bucket(tid - 191) * 12 + hc] - p.in[10][15 * 12 + hc]) * LOG2E; }
    }
    if (MODE == 0 && tid < 4) ((unsigned*)(smem + ATT_TB_OFF + 1024))[tid] = ((tid & 1) ? 0x0000ffffu : 0u) | ((tid & 2) ? 0xffff0000u : 0u);
    constexpr int NQF = (MODE == 1) ? 2 : 4;
    h16x8 qf[NQF];
    if (active) {
        const h16* Qb = (MODE == 0) ? (const h16*)(p.ws + WS_QA) + (size_t)rowq * 512 + U.head * 64
                      : (MODE == 1) ? (const h16*)(p.ws + WS_QB) + (size_t)rowq * 256 + U.head * 64 + 32 * cmap
                                    : (const h16*)(p.ws + WS_QC) + (size_t)rowq * 256 + U.head * 64;
#pragma unroll
        for (int s = 0; s < NQF; ++s) qf[s] = *(const h16x8*)(Qb + 16 * s + 8 * hh);
    } else {
#pragma unroll
        for (int s = 0; s < NQF; ++s)
#pragma unroll
            for (int e = 0; e < 8; ++e) qf[s][e] = (h16)0.f;
    }
    f32x16 O[2];
    f32x16 L;
#pragma unroll
    for (int r = 0; r < 16; ++r) L[r] = 0.f;
    u32x4 ones_u; { const unsigned o2 = (l31 == 0) ? 0x3f803f80u : 0u; ones_u[0] = o2; ones_u[1] = o2; ones_u[2] = o2; ones_u[3] = o2; }
    const bf16x8 onesf = __builtin_bit_cast(bf16x8, ones_u);
    const unsigned* lut = (const unsigned*)(smem + ATT_TB_OFF + 1024);
#pragma unroll
    for (int m = 0; m < 2; ++m)
#pragma unroll
        for (int r = 0; r < 16; ++r) O[m][r] = 0.f;
    int crow[2], cch[2], so[2];
#pragma unroll
    for (int i = 0; i < 2; ++i) { const int c = tid + 256 * i; crow[i] = c >> 3; cch[i] = c & 7; so[i] = crow[i] * 128 + ((cch[i] ^ ((crow[i] >> 1) & 7)) << 4); }
    u32x4 rk[2], rv[2], rk2[2], rv2[2];
    f32x4 fk[2][2], fv[2][2];
#define ATT_LOADR(RK, RV, j) do { \
        _Pragma("unroll") for (int i = 0; i < 2; ++i) { \
            RK[i] = *(const u32x4*)(U.Kh + (size_t)(64 * (j) + crow[i]) * U.ldk + cch[i] * 8); \
            RV[i] = *(const u32x4*)(U.VTh + (size_t)crow[i] * U.ldv + 64 * (j) + cch[i] * 8); } } while (0)
#define ATT_WRITER(RK, RV, b) do { unsigned char* kt_ = smem + (b) * 16384; unsigned char* vt_ = kt_ + 8192; \
        _Pragma("unroll") for (int i = 0; i < 2; ++i) { *(u32x4*)(kt_ + so[i]) = RK[i]; *(u32x4*)(vt_ + so[i]) = RV[i]; } } while (0)
#define ATT_LOAD(j) do { \
        if constexpr (!F32SRC) { ATT_LOADR(rk, rv, j); \
        } else { \
            const float* kb_ = ((j) < U.ntc) ? U.Kc + (size_t)(64 * (j)) * U.ldf : U.Kn + (size_t)(64 * ((j) - U.ntc)) * U.ldf; \
            const float* vb_ = ((j) < U.ntc) ? U.Vc + (size_t)(64 * (j)) * U.ldf : U.Vn + (size_t)(64 * ((j) - U.ntc)) * U.ldf; \
            _Pragma("unroll") for (int i = 0; i < 2; ++i) { \
                const float* ks_ = kb_ + (size_t)crow[i] * U.ldf + cch[i] * 8; const float* vs_ = vb_ + (size_t)crow[i] * U.ldf + cch[i] * 8; \
                fk[i][0] = *(const f32x4*)ks_; fk[i][1] = *(const f32x4*)(ks_ + 4); fv[i][0] = *(const f32x4*)vs_; fv[i][1] = *(const f32x4*)(vs_ + 4); } \
        } } while (0)
#define ATT_WRITE(b) do { \
        unsigned char* kt_ = smem + (b) * 16384; unsigned char* vt_ = kt_ + 8192; \
        if constexpr (!F32SRC) { \
            _Pragma("unroll") for (int i = 0; i < 2; ++i) { *(u32x4*)(kt_ + so[i]) = rk[i]; *(u32x4*)(vt_ + so[i]) = rv[i]; } \
        } else { \
            _Pragma("unroll") for (int i = 0; i < 2; ++i) { \
                h16x8 hk_; _Pragma("unroll") for (int e = 0; e < 4; ++e) { hk_[e] = (h16)fk[i][0][e]; hk_[4 + e] = (h16)fk[i][1][e]; } \
                *(h16x8*)(kt_ + so[i]) = hk_; \
                const int key_ = crow[i]; \
                _Pragma("unroll") for (int e = 0; e < 8; ++e) { const int dv_ = 8 * cch[i] + e; \
                    *(__bf16*)(vt_ + dv_ * 128 + (((key_ >> 3) ^ ((dv_ >> 1) & 7)) << 4) + (key_ & 7) * 2) = (__bf16)(e < 4 ? fv[i][0][e] : fv[i][1][e - 4]); } } \
        } } while (0)

    const unsigned char* kdma[2]; const unsigned char* vdma[2]; int dmo[2];
#pragma unroll
    for (int i = 0; i < 2; ++i) {
        const int row = 16 * w + 8 * i + (lane >> 3), ch = (lane & 7) ^ ((row >> 1) & 7);
        kdma[i] = F32SRC ? nullptr : (const unsigned char*)(U.Kh + (size_t)row * U.ldk + ch * 8);
        vdma[i] = F32SRC ? nullptr : (const unsigned char*)(U.VTh + (size_t)row * U.ldv + ch * 8);
        dmo[i] = (16 * w + 8 * i) * 128;
    }
#define ATT_DMA(b, j) do { _Pragma("unroll") for (int i = 0; i < 2; ++i) { \
        __builtin_amdgcn_global_load_lds((const unsigned*)(kdma[i] + (size_t)(64 * (j)) * U.ldk * 2), (__attribute__((address_space(3))) unsigned*)(smem + (b) * 16384 + dmo[i]), 16, 0, 0); \
        __builtin_amdgcn_global_load_lds((const unsigned*)(vdma[i] + (size_t)(64 * (j)) * 2), (__attribute__((address_space(3))) unsigned*)(smem + (b) * 16384 + 8192 + dmo[i]), 16, 0, 0); } } while (0)
    if constexpr (!F32SRC) { ATT_DMA(0, 0); } else { ATT_LOAD(0); ATT_WRITE(0); }
    const unsigned* mrow = (MODE == 0) ? U.mask + (size_t)(32 * qt + l31) * U.ldm : nullptr;
    unsigned mwn0 = 0xffffffffu, mwn1 = 0xffffffffu;
    if (MODE == 0) { mwn0 = mrow[0]; mwn1 = mrow[1]; }
    __syncthreads();
    const int pil = pi32(l31), ksw = (pil >> 1) & 7, vsw = (l31 >> 1) & 7;
    const int jlast = U.ntiles - 1;
    auto clampj = [&](int x) { return x < jlast ? x : jlast; };
    if constexpr (!F32SRC) {
        for (int j = 0; j < U.ntiles; ++j) {
            const int buf = j & 1;
            const int jn = clampj(j + 1);
            unsigned mw[2] = {mwn0 >> (8 * hh), mwn1 >> (8 * hh)};
            if (MODE == 0) { mwn0 = mrow[2 * jn]; mwn1 = mrow[2 * jn + 1]; }
            ATT_DMA(buf ^ 1, jn);
        if (active && (MODE == 2 || j <= chunk_w)) {
            const unsigned char* Kt = smem + buf * 16384;
            const unsigned char* Vt = Kt + 8192;
            const bool near = (MODE != 2) && (j >= chunk_w - 2);
            bf16x8 pf[4];
#pragma unroll
            for (int u = 0; u < 2; ++u) {
                f32x16 S;
#pragma unroll
                for (int r = 0; r < 16; ++r) S[r] = 0.f;
                const unsigned char* kp = Kt + (32 * u + pil) * 128;
#pragma unroll
                for (int s = 0; s < NQF; ++s) {
                    const int ch = (MODE == 1) ? (4 * cmap + 2 * s + hh) : (2 * s + hh);
                    const h16x8 a = *(const h16x8*)(kp + ((ch ^ ksw) << 4));
                    S = __builtin_amdgcn_mfma_f32_32x32x16_f16(a, qf[s], S, 0, 0, 0);
                }
                if (near) {
                    const int base = 64 * j + 32 * u + 8 * hh - qpos + 191;
#pragma unroll
                    for (int i = 0; i < 16; ++i) S[i] += tb[base + (i & 7) + 16 * (i >> 3)];
                }
#pragma unroll
                for (int i = 0; i < 16; ++i) S[i] = __builtin_amdgcn_exp2f(S[i]);
#pragma unroll
                for (int s2 = 0; s2 < 2; ++s2) {
                    u32x4 pk;
#pragma unroll
                    for (int e = 0; e < 4; ++e) {
                        unsigned v = pkbf(S[8 * s2 + 2 * e], S[8 * s2 + 2 * e + 1]);
                        if (MODE == 0) {
                            const unsigned idx = (mw[u] >> (16 * s2 + 2 * e)) & 3u;
                            v &= lut[idx];
                        }
                        pk[e] = v;
                    }
                    pf[2 * u + s2] = __builtin_bit_cast(bf16x8, pk);
                }
            }
#pragma unroll
            for (int sp = 0; sp < 4; ++sp) L = __builtin_amdgcn_mfma_f32_32x32x16_bf16(onesf, pf[sp], L, 0, 0, 0);
#pragma unroll
            for (int m = 0; m < 2; ++m)
#pragma unroll
                for (int sp = 0; sp < 4; ++sp) {
                    const bf16x8 vfr = *(const bf16x8*)(Vt + (32 * m + l31) * 128 + (((2 * sp + hh) ^ vsw) << 4));
                    O[m] = __builtin_amdgcn_mfma_f32_32x32x16_bf16(vfr, pf[sp], O[m], 0, 0, 0);
                }
        }
            __syncthreads();
        }
    } else {
    for (int j = 0; j < U.ntiles; ++j) {
        const int buf = j & 1;
        const int jn = j < jlast ? j + 1 : jlast;
        unsigned mw[2] = {mwn0 >> (8 * hh), mwn1 >> (8 * hh)};
        if (MODE == 0) { mwn0 = mrow[2 * jn]; mwn1 = mrow[2 * jn + 1]; }
        if (active && (MODE == 2 || j <= chunk_w)) {
            const unsigned char* Kt = smem + buf * 16384;
            const unsigned char* Vt = Kt + 8192;
            const bool near = (MODE != 2) && (j >= chunk_w - 2);
            bf16x8 pf[4];
#pragma unroll
            for (int u = 0; u < 2; ++u) {
                f32x16 S;
#pragma unroll
                for (int r = 0; r < 16; ++r) S[r] = 0.f;
                const unsigned char* kp = Kt + (32 * u + pil) * 128;
#pragma unroll
                for (int s = 0; s < NQF; ++s) {
                    const int ch = (MODE == 1) ? (4 * cmap + 2 * s + hh) : (2 * s + hh);
                    const h16x8 a = *(const h16x8*)(kp + ((ch ^ ksw) << 4));
                    S = __builtin_amdgcn_mfma_f32_32x32x16_f16(a, qf[s], S, 0, 0, 0);
                }
                if (near) {
                    const int base = 64 * j + 32 * u + 8 * hh - qpos + 191;
#pragma unroll
                    for (int i = 0; i < 16; ++i) S[i] += tb[base + (i & 7) + 16 * (i >> 3)];
                }
#pragma unroll
                for (int i = 0; i < 16; ++i) S[i] = __builtin_amdgcn_exp2f(S[i]);
#pragma unroll
                for (int s2 = 0; s2 < 2; ++s2) {
                    u32x4 pk;
#pragma unroll
                    for (int e = 0; e < 4; ++e) {
                        unsigned v = pkbf(S[8 * s2 + 2 * e], S[8 * s2 + 2 * e + 1]);
                        if (MODE == 0) {
                            const unsigned idx = (mw[u] >> (16 * s2 + 2 * e)) & 3u;
                            v &= lut[idx];
                        }
                        pk[e] = v;
                    }
                    pf[2 * u + s2] = __builtin_bit_cast(bf16x8, pk);
                }
            }
#pragma unroll
            for (int sp = 0; sp < 4; ++sp) L = __builtin_amdgcn_mfma_f32_32x32x16_bf16(onesf, pf[sp], L, 0, 0, 0);
#pragma unroll
            for (int m = 0; m < 2; ++m)
#pragma unroll
                for (int sp = 0; sp < 4; ++sp) {
                    const bf16x8 vfr = *(const bf16x8*)(Vt + (32 * m + l31) * 128 + (((2 * sp + hh) ^ vsw) << 4));
                    O[m] = __builtin_amdgcn_mfma_f32_32x32x16_bf16(vfr, pf[sp], O[m], 0, 0, 0);
                }
        }
        ATT_LOAD(jn);
        ATT_WRITE(buf ^ 1);
        __syncthreads();
    }
    }
#undef ATT_LOAD
#undef ATT_WRITE
#undef ATT_LOADR
#undef ATT_WRITER
#undef ATT_DMA
    const float l = __shfl(L[0], l31);
    const float inv = 1.0f / l;
    if (MODE == 1) {
        float* X = (float*)smem;
        if (cmap == 1) {
#pragma unroll
            for (int m = 0; m < 2; ++m)
#pragma unroll
                for (int i = 0; i < 16; ++i) X[(qt * 32 + m * 16 + i) * 64 + lane] = O[m][i] * inv;
        }
        __syncthreads();
        if (cmap == 1) return;
#pragma unroll
        for (int m = 0; m < 2; ++m)
#pragma unroll
            for (int i = 0; i < 16; ++i) O[m][i] = O[m][i] * inv - lam * X[(qt * 32 + m * 16 + i) * 64 + lane];
    } else {
        if (!active) return;
#pragma unroll
        for (int m = 0; m < 2; ++m)
#pragma unroll
            for (int i = 0; i < 16; ++i) O[m][i] *= inv;
    }
    const int colbase = (MODE == 0 ? 0 : (MODE == 1 ? 512 : 768)) + U.head * 64;
    const h16* G = (const h16*)(p.ws + WS_G) + (size_t)rowq * 1024 + colbase;
    h16* Oo = (h16*)(p.ws + WS_O16) + (size_t)rowq * 1024 + colbase;
    float sc = 1.f;
    if (MODE == 1) {
        float ss = 0.f;
#pragma unroll
        for (int m = 0; m < 2; ++m)
#pragma unroll
            for (int i = 0; i < 16; ++i) ss = fmaf(O[m][i], O[m][i], ss);
        ss += __shfl_xor(ss, 32);
        sc = (1.0f / sqrtf(ss * (1.0f / 64.0f) + EPS)) * 0.8f;
    }
#pragma unroll
    for (int m = 0; m < 2; ++m)
#pragma unroll
        for (int g4 = 0; g4 < 4; ++g4) {
            const int dv = 32 * m + 8 * g4 + 4 * hh;
            const h16x4 gv = *(const h16x4*)(G + dv);
            h16x4 o4;
#pragma unroll
            for (int e = 0; e < 4; ++e) {
                float o = O[m][4 * g4 + e];
                if (MODE == 1) o = o * sc * p.in[18][dv + e];
                o4[e] = (h16)(o * silu((float)gv[e]));
            }
            *(h16x4*)(Oo + dv) = o4;
        }
}

__device__ __forceinline__ AttnUnit unit_zero() {
    AttnUnit U; U.row0 = 0; U.nwaves = 0; U.ntiles = 0; U.chunk0 = 0; U.chunk_step = 0; U.qpos0 = 0; U.head = 0; U.Kh = nullptr; U.VTh = nullptr; U.ldk = 0; U.ldv = 0;
    U.Kc = nullptr; U.Vc = nullptr; U.Kn = nullptr; U.Vn = nullptr; U.ldf = 0; U.ntc = 0; U.mask = nullptr; U.ldm = 0; return U;
}

#define ZIGZAG_LOOP(NALL) for (int zk_ = 0, pos_ = 0; zk_ * (int)gridDim.x < (NALL); ++zk_) \
    if ((pos_ = (zk_ & 1) ? (zk_ + 1) * (int)gridDim.x - 1 - (int)blockIdx.x : zk_ * (int)gridDim.x + (int)blockIdx.x) < (NALL))

__device__ void phase2(const Params& p, unsigned char* smem) {
    float s1 = 0.f, s2 = 0.f;
    for (int i = 0; i < 32; ++i) { s1 = fmaf(p.in[19][i], p.in[20][i], s1); s2 = fmaf(p.in[21][i], p.in[22][i], s2); }
    const float lam = expf(s1) - expf(s2) + 0.2f;
    constexpr int N_BP = 1024, N_SP = 1024, N_BS = 128, N_CS = 128, N_SS = 128, N_CP = 512;
    constexpr int N_ALL = N_BP + N_SP + N_BS + N_CS + N_SS + N_CP;
    ZIGZAG_LOOP(N_ALL) {
        int it = pos_;
        if (it < N_BP) {
            const int g = 255 - (it >> 2), head = blockIdx.x & 3;
            AttnUnit U = unit_zero();
            U.row0 = 64 * g; U.nwaves = 2; U.ntiles = g + 1; U.chunk0 = g; U.chunk_step = 0; U.qpos0 = 64 * g; U.head = head;
            U.Kh = (const h16*)(p.ws + WS_KB_P) + head * 64; U.ldk = 256;
            U.VTh = (const h16*)(p.ws + WS_VTB_P) + (size_t)(head * 64) * SEQ; U.ldv = SEQ;
            attn_unit<1, false>(p, smem, U, lam);
            continue;
        }
        it -= N_BP;
        if (it < N_SP) { select_unit(p, smem, it); continue; }
        it -= N_SP;
        if (it < N_BS) {
            const int b = it >> 2, head = it & 3;
            AttnUnit U = unit_zero();
            U.row0 = SEQ + 64 * b; U.nwaves = 2; U.ntiles = 17; U.chunk0 = 16; U.chunk_step = 0; U.qpos0 = PAST; U.head = head;
            U.Kc = p.in[6] + (size_t)b * PAST * 256 + head * 64; U.Vc = p.in[7] + (size_t)b * PAST * 256 + head * 64;
            U.Kn = p.out + O_SBK + (size_t)b * DECS * 256 + head * 64; U.Vn = p.out + O_SBV + (size_t)b * DECS * 256 + head * 64;
            U.ldf = 256; U.ntc = 16;
            attn_unit<1, true>(p, smem, U, lam);
            continue;
        }
        it -= N_BS;
        if (it < N_CS) {
            const int b = it >> 2, head = it & 3;
            AttnUnit U = unit_zero();
            U.row0 = SEQ + 64 * b; U.nwaves = 2; U.ntiles = 4; U.head = head;
            U.Kc = p.in[8] + (size_t)b * NMEM * 256 + head * 64; U.Vc = p.in[9] + (size_t)b * NMEM * 256 + head * 64;
            U.Kn = U.Kc; U.Vn = U.Vc; U.ldf = 256; U.ntc = 4;
            attn_unit<2, true>(p, smem, U, lam);
            continue;
        }
        it -= N_CS;
        if (it < N_SS) { select_unit(p, smem, 1024 + it); continue; }
        it -= N_SS;
        {
            const int g = it >> 2, head = it & 3;
            AttnUnit U = unit_zero();
            U.row0 = 128 * g; U.nwaves = 4; U.ntiles = 4; U.head = head;
            U.Kh = (const h16*)(p.ws + WS_MK_P) + head * 64; U.ldk = 256;
            U.VTh = (const h16*)(p.ws + WS_MVT_P) + (size_t)(head * 64) * NMEM; U.ldv = NMEM;
            attn_unit<2, false>(p, smem, U, lam);
        }
    }
    {
        __syncthreads();
        const unsigned* fl = (const unsigned*)(p.ws + WS_REDO) + (size_t)blockIdx.x * REDO_LD;
        const unsigned n = __builtin_amdgcn_readfirstlane((int)__hip_atomic_load(fl, __ATOMIC_RELAXED, __HIP_MEMORY_SCOPE_AGENT));
        for (unsigned i = 0; i < n; ++i) {
            const int row = __builtin_amdgcn_readfirstlane((int)__hip_atomic_load(fl + 1 + i, __ATOMIC_RELAXED, __HIP_MEMORY_SCOPE_AGENT));
            select_item(p, smem, row);
        }
    }
}

__device__ void phase3(const Params& p, unsigned char* smem) {
    constexpr int G_SPLIT = 18, N_HI = (128 - G_SPLIT) * 8, N_AS = 256, N_LO = G_SPLIT * 8;
    ZIGZAG_LOOP(N_HI + N_AS + N_LO) {
        int it = pos_;
        if (it >= N_HI && it < N_HI + N_AS) {
            it -= N_HI;
            const int b = it >> 3, head = blockIdx.x & 7;
            AttnUnit U = unit_zero();
            U.row0 = SEQ + 64 * b; U.nwaves = 2; U.ntiles = 17; U.chunk0 = 16; U.chunk_step = 0; U.qpos0 = PAST; U.head = head;
            U.Kc = p.in[3] + (size_t)b * PAST * 512 + head * 64; U.Vc = p.in[4] + (size_t)b * PAST * 512 + head * 64;
            U.Kn = p.out + O_SAK + (size_t)b * DECS * 512 + head * 64; U.Vn = p.out + O_SAV + (size_t)b * DECS * 512 + head * 64;
            U.ldf = 512; U.ntc = 16;
            U.mask = (const unsigned*)(p.ws + WS_MASK_S) + (size_t)(64 * b) * 34; U.ldm = 34;
            attn_unit<0, true>(p, smem, U, 0.f);
            continue;
        }
        if (it >= N_HI) it -= N_AS;
        {
            const int g = 127 - (it >> 3), head = blockIdx.x & 7;
            AttnUnit U = unit_zero();
            U.row0 = 128 * g; U.nwaves = 4; U.ntiles = 2 * g + 2; U.chunk0 = 2 * g; U.chunk_step = 1; U.qpos0 = 128 * g; U.head = head;
            U.Kh = (const h16*)(p.ws + WS_KA_P) + head * 64; U.ldk = 512;
            U.VTh = (const h16*)(p.ws + WS_VTA_P) + (size_t)(head * 64) * SEQ; U.ldv = SEQ;
            U.mask = (const unsigned*)(p.ws + WS_MASK_P) + (size_t)(128 * g) * 512; U.ldm = 512;
            attn_unit<0, false>(p, smem, U, 0.f);
        }
    }
}

__device__ void phase4(const Params& p, unsigned char* smem) {
    const h16* O16 = (const h16*)(p.ws + WS_O16);
    const h16* WTOUT = (const h16*)(p.ws + WS_WTOUT);
    constexpr int NCT = D / 128, NRT = MROWS / 128;
    const EpiOut eo{};
    const int G = gridDim.x;
    if ((G & 7) == 0) {
        const int xcd = blockIdx.x & 7, local = blockIdx.x >> 3, LG = G >> 3;
        for (int lin = local; lin < (NRT / 8) * NCT; lin += LG) {
            const int rt = xcd + 8 * (lin / NCT), ct = lin % NCT;
            gemm_tile(p, O16, WTOUT, rt * 128, ct * 128, smem, eo);
        }
    } else {
        for (int it = blockIdx.x; it < NCT * NRT; it += gridDim.x) {
            const int rt = it / NCT, ct = it % NCT;
            gemm_tile(p, O16, WTOUT, rt * 128, ct * 128, smem, eo);
        }
    }
}

constexpr int SMEM_BYTES = 80 * 1024;

__device__ __forceinline__ void grid_barrier(unsigned* cnt, unsigned target) {
    asm volatile("s_waitcnt vmcnt(0)" ::: "memory");
    __syncthreads();
    if (threadIdx.x == 0) {
        __builtin_amdgcn_fence(__ATOMIC_RELEASE, "agent");
        asm volatile("s_waitcnt vmcnt(0)" ::: "memory");
        __hip_atomic_fetch_add(cnt, 1u, __ATOMIC_RELAXED, __HIP_MEMORY_SCOPE_AGENT);
        while (__hip_atomic_load(cnt, __ATOMIC_RELAXED, __HIP_MEMORY_SCOPE_AGENT) < target) __builtin_amdgcn_s_sleep(2);
        __builtin_amdgcn_fence(__ATOMIC_ACQUIRE, "agent");
        asm volatile("s_waitcnt vmcnt(0)" ::: "memory");
    }
    __syncthreads();
}

__global__ void __launch_bounds__(NT, 2) fwd_kernel(Params p) {
    __shared__ __attribute__((aligned(16))) unsigned char smem[SMEM_BYTES];
    static_assert(ATT_LDS <= SMEM_BYTES && sizeof(SmemDsa) <= SMEM_BYTES && sizeof(SelSm) <= SMEM_BYTES && CS_LD * 128 * 4 <= SMEM_BYTES, "smem");
    cg::grid_group grid = cg::this_grid();
    unsigned nbar = 0;
    for (int ph = p.ph_lo; ph < p.ph_hi; ++ph) {
#ifndef REP_PHASE
#define REP_PHASE -1
#endif
        const int nrep = (ph == REP_PHASE) ? 2 : 1;
        for (int rep = 0; rep < nrep; ++rep) {
            if (ph == 0) phase0(p, smem);
            else if (ph == 1) phase1(p, smem);
            else if (ph == 2) phase2(p, smem);
            else if (ph == 3) phase3(p, smem);
            else phase4(p, smem);
            if (rep + 1 < nrep) grid.sync();
        }
        if (ph + 1 < p.ph_hi) {
            if (p.ph_lo > 0) grid.sync();
            else grid_barrier((unsigned*)(p.ws + WS_CTL) + 48, ++nbar * gridDim.x);
        }
    }
}

extern "C" void kernel_launch(void* const* d_in, const int* in_sizes, int n_in, void* d_out, int out_size, void* d_ws, size_t ws_size, hipStream_t stream) {
    static int grid_blocks = 0;
    if (!grid_blocks) {
        int dev = 0, cus = 0, per_cu = 0;
        (void)hipGetDevice(&dev);
        (void)hipDeviceGetAttribute(&cus, hipDeviceAttributeMultiprocessorCount, dev);
        (void)hipOccupancyMaxActiveBlocksPerMultiprocessor(&per_cu, fwd_kernel, NT, 0);
        if (per_cu < 1) per_cu = 1;
        grid_blocks = cus * per_cu;
        if (ws_size < WS_END) fprintf(stderr, "kernel_launch: workspace too small: %zu < %zu\n", ws_size, (size_t)WS_END);
    }
    if (ws_size < WS_END) return;
    (void)hipMemsetAsync((unsigned char*)d_ws + WS_CTL, 0, 256 + (size_t)2048 * REDO_LD * 4, stream);
    Params p{};
    for (int i = 0; i < 27; ++i) p.in[i] = (const float*)d_in[i];
    p.out = (float*)d_out; p.ws = (unsigned char*)d_ws;
#if ONE_LAUNCH
    p.ph_lo = 0; p.ph_hi = 5;
    void* args[] = {&p};
    hipError_t e = hipLaunchCooperativeKernel((void*)fwd_kernel, dim3(grid_blocks), dim3(NT), args, 0, stream);
    if (e != hipSuccess) fprintf(stderr, "cooperative launch failed: %s (grid %d)\n", hipGetErrorString(e), grid_blocks);
#else
    for (int ph = 0; ph < 5; ++ph) {
        p.ph_lo = ph; p.ph_hi = ph + 1;
        hipLaunchKernelGGL(fwd_kernel, dim3(grid_blocks), dim3(NT), 0, stream, p);
    }
#endif
}
```

```cpp
#include <hip/hip_runtime.h>
#include <hip/hip_cooperative_groups.h>
#include <cstdio>
#include <cstdint>
namespace cg = cooperative_groups;

#define NT 256
#define ONE_LAUNCH 1

constexpr int D = 1024, SEQ = 16384, DECB = 32, DECS = 64, PAST = 1024, NMEM = 256;
constexpr int MROWS = SEQ + DECB * DECS;
constexpr int DIN = 3880;
constexpr int LDP = 264;
constexpr int PC_IQ = 0, PC_IW = 256;
constexpr float EPS = 1e-6f;

constexpr size_t O_YP = 0, O_YS = 16777216, O_PAK = 18874368, O_PAV = 27262976, O_PAKI = 35651584, O_PBK = 36175872,
                 O_PBV = 40370176, O_PMK = 44564480, O_PMV = 44630016, O_SAK = 44695552, O_SAV = 45744128,
                 O_SAKI = 46792704, O_SBK = 46858240, O_SBV = 47382528;

typedef _Float16 h16;
typedef h16 h16x2 __attribute__((ext_vector_type(2)));
typedef h16 h16x4 __attribute__((ext_vector_type(4)));
typedef h16 h16x8 __attribute__((ext_vector_type(8)));
typedef float f32x4 __attribute__((ext_vector_type(4)));
typedef unsigned u32x4 __attribute__((ext_vector_type(4)));
typedef __bf16 bf16x8 __attribute__((ext_vector_type(8)));
typedef __bf16 bf16x2 __attribute__((ext_vector_type(2)));
typedef float f32x2 __attribute__((ext_vector_type(2)));
__device__ __forceinline__ unsigned pkbf(float a, float b) { const f32x2 v = {a, b}; return __builtin_bit_cast(unsigned, __builtin_convertvector(v, bf16x2)); }
typedef float f32x16 __attribute__((ext_vector_type(16)));

constexpr int NPAD_IN = 3968;
constexpr float LOG2E = 1.4426950408889634f;
constexpr size_t WS_XH = 0;
constexpr size_t WS_O16 = WS_XH;
constexpr size_t WS_HMH = WS_XH + (size_t)MROWS * D * 2;
constexpr size_t WS_WTIN = WS_HMH + (size_t)NMEM * D * 2;
constexpr size_t WS_WTOUT = WS_WTIN + (size_t)NPAD_IN * D * 2;
constexpr size_t WS_WTMEM = WS_WTOUT + (size_t)D * D * 2;
constexpr size_t WS_QA = WS_WTMEM + (size_t)512 * D * 2;
constexpr size_t WS_QB = WS_QA + (size_t)MROWS * 512 * 2;
constexpr size_t WS_QC = WS_QB + (size_t)MROWS * 256 * 2;
constexpr size_t WS_G = WS_QC + (size_t)MROWS * 256 * 2;
constexpr size_t WS_KB_P = WS_G + (size_t)MROWS * 1024 * 2;
constexpr size_t WS_VTB_P = WS_KB_P + (size_t)SEQ * 256 * 2;
constexpr size_t WS_MK_P = WS_VTB_P + (size_t)SEQ * 256 * 2;
constexpr size_t WS_MVT_P = WS_MK_P + (size_t)NMEM * 256 * 2;
constexpr size_t WS_KA_P = WS_MVT_P + (size_t)NMEM * 256 * 2;
constexpr size_t WS_VTA_P = WS_KA_P + (size_t)SEQ * 512 * 2;
constexpr size_t WS_MASK_P = WS_VTA_P + (size_t)SEQ * 512 * 2;
constexpr size_t WS_MASK_S = WS_MASK_P + (size_t)SEQ * 512 * 4;
constexpr size_t WS_IQ16 = WS_MASK_S + (size_t)DECB * DECS * 34 * 4;
constexpr size_t WS_IK_P = WS_IQ16 + (size_t)MROWS * 256 * 2;
constexpr size_t WS_IK_S = WS_IK_P + (size_t)SEQ * 32 * 2;
constexpr size_t WS_CTL = WS_IK_S + (size_t)DECB * (PAST + DECS) * 32 * 2;
constexpr int REDO_LD = 64;
constexpr size_t WS_REDO = WS_CTL + 256;
constexpr size_t WS_P = WS_REDO + (size_t)2048 * REDO_LD * 4;
constexpr size_t WS_END = WS_P + (size_t)MROWS * LDP * 4;

struct Params {
    const float* in[27];
    float* out;
    unsigned char* ws;
    int ph_lo, ph_hi;
};

__device__ __forceinline__ float wave_sum(float v) {
#pragma unroll
    for (int o = 1; o < 64; o <<= 1) v += __shfl_xor(v, o);
    return v;
}
__device__ __forceinline__ float wave_max(float v) {
#pragma unroll
    for (int o = 1; o < 64; o <<= 1) v = fmaxf(v, __shfl_xor(v, o));
    return v;
}
__device__ __forceinline__ float silu(float x) { return x / (1.0f + expf(-x)); }

__device__ __forceinline__ int rel_bucket(int rel) {
    const int ret = rel > 0 ? 16 : 0;
    const int n = rel < 0 ? -rel : rel;
    int b;
    if (n < 8) b = n;
    else if (n < 12) b = 8;
    else if (n < 16) b = 9;
    else if (n < 23) b = 10;
    else if (n < 32) b = 11;
    else if (n < 46) b = 12;
    else if (n < 64) b = 13;
    else if (n < 91) b = 14;
    else b = 15;
    return ret + b;
}

__device__ __forceinline__ void rms_row_h(const float* x, const float* g, h16* o, int lane) {
    const float4* xr = (const float4*)x;
    const float4* gr = (const float4*)g;
    float4 v[4];
    float s = 0.f;
#pragma unroll
    for (int j = 0; j < 4; ++j) { v[j] = xr[lane + 64 * j]; s += v[j].x * v[j].x + v[j].y * v[j].y + v[j].z * v[j].z + v[j].w * v[j].w; }
    s = wave_sum(s);
    const float r = 1.0f / sqrtf(s * (1.0f / 1024.0f) + EPS);
#pragma unroll
    for (int j = 0; j < 4; ++j) {
        const float4 gg = gr[lane + 64 * j];
        h16x4 o4; o4.x = (h16)(v[j].x * r * gg.x); o4.y = (h16)(v[j].y * r * gg.y); o4.z = (h16)(v[j].z * r * gg.z); o4.w = (h16)(v[j].w * r * gg.w);
        ((h16x4*)o)[lane + 64 * j] = o4;
    }
}

__device__ __forceinline__ void transpose_item(const float* __restrict__ W, int ldw, int c0, int nvalid, int k0, h16* __restrict__ WT, int r0, float* scr, int lane) {
#pragma unroll 8
    for (int i = 0; i < 32; ++i) {
        const int kk = 2 * i + (lane >> 5), n = lane & 31;
        scr[kk * 33 + n] = (n < nvalid) ? W[(size_t)(k0 + kk) * ldw + c0 + n] : 0.f;
    }
    asm volatile("s_waitcnt lgkmcnt(0)" ::: "memory");
    const int c = lane & 7;
#pragma unroll
    for (int j = 0; j < 4; ++j) {
        const int n = (lane >> 3) + 8 * j;
        const float* s = scr + (8 * c) * 33 + n;
        h16x8 o;
#pragma unroll
        for (int e = 0; e < 8; ++e) o[e] = (h16)s[e * 33];
        *(h16x8*)(WT + (size_t)(r0 + n) * 1024 + k0 + 8 * c) = o;
    }
    asm volatile("s_waitcnt lgkmcnt(0)" ::: "memory");
}

__device__ __forceinline__ int inproj_col(int np) { return np < 2304 ? np : (np < 3840 ? np + 40 : np - 3840 + 2304); }

__device__ void phase0(const Params& p, unsigned char* smem) {
    const int lane = threadIdx.x & 63, w = threadIdx.x >> 6;
    const int gw = blockIdx.x * 4 + w, ngw = gridDim.x * 4;
    h16* XH = (h16*)(p.ws + WS_XH);
    h16* HMH = (h16*)(p.ws + WS_HMH);
    h16* WTIN = (h16*)(p.ws + WS_WTIN);
    h16* WTOUT = (h16*)(p.ws + WS_WTOUT);
    h16* WTMEM = (h16*)(p.ws + WS_WTMEM);
    float* scr = (float*)smem + w * (64 * 33);
    constexpr int N_ROWS = MROWS + NMEM;
    constexpr int I_IN = 16 * (NPAD_IN / 32), I_OUT = 16 * 32, I_MEM = 16 * 16, I_KIDX = DECB * (PAST / 64);
    for (int it = gw; it < N_ROWS + I_IN + I_OUT + I_MEM + I_KIDX; it += ngw) {
        if (it < N_ROWS) {
            const int r = it;
            if (r < SEQ) rms_row_h(p.in[0] + (size_t)r * D, p.in[11], XH + (size_t)r * D, lane);
            else if (r < MROWS) rms_row_h(p.in[1] + (size_t)(r - SEQ) * D, p.in[11], XH + (size_t)r * D, lane);
            else rms_row_h(p.in[2] + (size_t)(r - MROWS) * D, p.in[25], HMH + (size_t)(r - MROWS) * D, lane);
        } else if (it < N_ROWS + I_IN) {
            const int r = it - N_ROWS, nb = r % (NPAD_IN / 32), kb = r / (NPAD_IN / 32);
            const int np0 = nb * 32;
            int nvalid = DIN - np0; nvalid = nvalid < 0 ? 0 : (nvalid > 32 ? 32 : nvalid);
            const int c0 = nvalid > 0 ? inproj_col(np0) : 0;
            transpose_item(p.in[12], DIN, c0, nvalid, kb * 64, WTIN, np0, scr, lane);
        } else if (it < N_ROWS + I_IN + I_OUT) {
            const int r = it - N_ROWS - I_IN, nb = r % 32, kb = r / 32;
            transpose_item(p.in[13], D, nb * 32, 32, kb * 64, WTOUT, nb * 32, scr, lane);
        } else if (it < N_ROWS + I_IN + I_OUT + I_MEM) {
            const int r = it - N_ROWS - I_IN - I_OUT, nb = r % 16, kb = r / 16;
            transpose_item(p.in[26], 512, nb * 32, 32, kb * 64, WTMEM, nb * 32, scr, lane);
        } else {
            const int r = it - N_ROWS - I_IN - I_OUT - I_MEM, b = r / (PAST / 64), key = (r % (PAST / 64)) * 64 + lane;
            const f32x4* src = (const f32x4*)(p.in[5] + ((size_t)b * PAST + key) * 32);
            h16* dst = (h16*)(p.ws + WS_IK_S) + ((size_t)b * (PAST + DECS) + key) * 32;
            float ss = 0.f;
#pragma unroll
            for (int c = 0; c < 4; ++c) {
                const f32x4 x0 = src[2 * c], x1 = src[2 * c + 1];
                h16x8 o;
#pragma unroll
                for (int e = 0; e < 4; ++e) { o[e] = (h16)x0[e]; o[4 + e] = (h16)x1[e]; ss = fmaf(x0[e], x0[e], ss); ss = fmaf(x1[e], x1[e], ss); }
                *(h16x8*)(dst + 8 * c) = o;
            }
            ss = wave_max(ss);
            if (lane == 0) atomicMax((unsigned*)(p.ws + WS_CTL) + 1 + b, __float_as_uint(ss));
        }
    }
}

constexpr int CS_LD = 132;
template <class Epi>
__device__ __forceinline__ void gemm_tile(const Params& p, const h16* __restrict__ A, const h16* __restrict__ Bt, int m0, int n0, unsigned char* smem, const Epi& epi) {
    int tid = threadIdx.x; asm volatile("" : "+v"(tid));
    const int lane = tid & 63, wid = tid >> 6, wm = wid >> 1, wn = wid & 1;
    const int l31 = lane & 31, hh = lane >> 5;
    f32x16 acc[2][2];
#pragma unroll
    for (int a = 0; a < 2; ++a)
#pragma unroll
        for (int b = 0; b < 2; ++b)
#pragma unroll
            for (int r = 0; r < 16; ++r) acc[a][b][r] = 0.f;
    const unsigned char* agl[4]; const unsigned char* bgl[4]; int ldo[4];
#pragma unroll
    for (int i = 0; i < 4; ++i) {
        const int row = 32 * wid + 8 * i + (lane >> 3), slot = lane & 7, ch = slot ^ ((row >> 1) & 7);
        agl[i] = (const unsigned char*)(A + (size_t)(m0 + row) * 1024 + ch * 8);
        bgl[i] = (const unsigned char*)(Bt + (size_t)(n0 + row) * 1024 + ch * 8);
        ldo[i] = (32 * wid + 8 * i) * 128;
    }
#define GT_DMA(stage_, kt_) do { const int ko_ = ((kt_) < 15 ? (kt_) : 15) * 128; \
        _Pragma("unroll") for (int i = 0; i < 4; ++i) { \
            __builtin_amdgcn_global_load_lds((const unsigned*)(agl[i] + ko_), (__attribute__((address_space(3))) unsigned*)(smem + (stage_) * 32768 + ldo[i]), 16, 0, 0); \
            __builtin_amdgcn_global_load_lds((const unsigned*)(bgl[i] + ko_), (__attribute__((address_space(3))) unsigned*)(smem + (stage_) * 32768 + 16384 + ldo[i]), 16, 0, 0); } } while (0)
    const int sw = (l31 >> 1) & 7;
    const int arow = (wm * 64 + l31) * 128, brow = (wn * 64 + l31) * 128;
    __syncthreads();
    GT_DMA(0, 0);
    __syncthreads();
    for (int kt = 0; kt < 16; ++kt) {
        const unsigned char* As = smem + (kt & 1) * 32768; const unsigned char* Bs = As + 16384;
        GT_DMA((kt + 1) & 1, kt + 1);
#pragma unroll
        for (int s = 0; s < 4; ++s) {
            const int co = (((2 * s + hh) ^ sw) << 4);
            h16x8 a[2], b[2];
#pragma unroll
            for (int mt = 0; mt < 2; ++mt) a[mt] = *(const h16x8*)(As + arow + mt * 32 * 128 + co);
#pragma unroll
            for (int nt = 0; nt < 2; ++nt) b[nt] = *(const h16x8*)(Bs + brow + nt * 32 * 128 + co);
#pragma unroll
            for (int mt = 0; mt < 2; ++mt)
#pragma unroll
                for (int nt = 0; nt < 2; ++nt) acc[mt][nt] = __builtin_amdgcn_mfma_f32_32x32x16_f16(a[mt], b[nt], acc[mt][nt], 0, 0, 0);
        }
        __syncthreads();
    }
#undef GT_DMA
    float* Cs = (float*)smem;
#pragma unroll
    for (int mt = 0; mt < 2; ++mt)
#pragma unroll
        for (int nt = 0; nt < 2; ++nt)
#pragma unroll
            for (int r = 0; r < 16; ++r) {
                const int row = wm * 64 + mt * 32 + (r & 3) + 8 * (r >> 2) + 4 * hh, col = wn * 64 + nt * 32 + l31;
                Cs[row * CS_LD + col] = acc[mt][nt][r];
            }
    __syncthreads();
    epi(p, Cs, m0, n0, tid);
}

__device__ __forceinline__ float group_sum16(float v) { v += __shfl_xor(v, 1); v += __shfl_xor(v, 2); v += __shfl_xor(v, 4); v += __shfl_xor(v, 8); return v; }
__device__ __forceinline__ float group_sum8(float v) { v += __shfl_xor(v, 1); v += __shfl_xor(v, 2); v += __shfl_xor(v, 4); return v; }

struct Seg {
    float* bp; float* bs; int ld; int col; int norm; const float* gain;
    h16* hp; h16* hs; int hld; int hcol; float hscale;
    int vt; int head;
};

__device__ __forceinline__ Seg seg_of(const Params& p, int n0) {
    float* P = (float*)(p.ws + WS_P);
    float* out = p.out;
    h16* QA = (h16*)(p.ws + WS_QA); h16* QB = (h16*)(p.ws + WS_QB); h16* QC = (h16*)(p.ws + WS_QC); h16* G = (h16*)(p.ws + WS_G);
    Seg s; s.norm = 0; s.gain = nullptr; s.hp = nullptr; s.hs = nullptr; s.hld = 0; s.hcol = 0; s.hscale = 1.f; s.vt = 0; s.head = 0;
    s.bp = nullptr; s.bs = nullptr; s.ld = 0; s.col = 0;
#define SEG_O(op, os, ldv, c) do { s.bp = out + (op); s.bs = out + (os) - (size_t)SEQ * (ldv); s.ld = (ldv); s.col = (c); } while (0)
#define SEG_H(ptr, ldv, c, sc) do { s.hp = (ptr); s.hs = (ptr); s.hld = (ldv); s.hcol = (c); s.hscale = (sc); } while (0)
    if (n0 < 512) { s.norm = 64; s.gain = p.in[14]; SEG_H(QA, 512, n0, 0.125f * LOG2E); }
    else if (n0 < 1024) { SEG_O(O_PAK, O_SAK, 512, n0 - 512); s.norm = 64; s.gain = p.in[15]; s.hp = (h16*)(p.ws + WS_KA_P); s.hs = nullptr; s.hld = 512; s.hcol = n0 - 512; }
    else if (n0 < 1536) { SEG_O(O_PAV, O_SAV, 512, n0 - 1024); s.vt = 1; s.head = (n0 - 1024) >> 6; }
    else if (n0 < 2048) { SEG_H(G, 1024, n0 - 1536, 1.f); }
    else if (n0 < 2304) { s.bp = P; s.bs = P; s.ld = LDP; s.col = PC_IQ + n0 - 2048; SEG_H((h16*)(p.ws + WS_IQ16), 256, n0 - 2048, 1.f); }
    else if (n0 < 2560) { s.norm = 32; s.gain = p.in[16]; SEG_H(QB, 256, n0 - 2304, 0.17677669529663687f * LOG2E); }
    else if (n0 < 2816) { SEG_O(O_PBK, O_SBK, 256, n0 - 2560); s.norm = 32; s.gain = p.in[17]; s.hp = (h16*)(p.ws + WS_KB_P); s.hs = nullptr; s.hld = 256; s.hcol = n0 - 2560; }
    else if (n0 < 3072) { SEG_O(O_PBV, O_SBV, 256, n0 - 2816); s.vt = 2; s.head = (n0 - 2816) >> 6; }
    else if (n0 < 3328) { SEG_H(G, 1024, 512 + n0 - 3072, 1.f); }
    else if (n0 < 3584) { s.norm = 64; s.gain = p.in[23]; SEG_H(QC, 256, n0 - 3328, 0.125f * LOG2E); }
    else { SEG_H(G, 1024, 768 + n0 - 3584, 1.f); }
#undef SEG_O
#undef SEG_H
    return s;
}

__device__ __forceinline__ void vt_store(const float* Cs, int j, h16* dst_base, size_t ldv, int tid) {
    const int dv = tid & 63, rq = tid >> 6;
    h16* dst = dst_base + (size_t)dv * ldv + 32 * rq;
#pragma unroll
    for (int e8 = 0; e8 < 4; ++e8) {
        u32x4 o;
#pragma unroll
        for (int e = 0; e < 4; ++e) o[e] = pkbf(Cs[(32 * rq + 8 * e8 + 2 * e) * CS_LD + 64 * j + dv], Cs[(32 * rq + 8 * e8 + 2 * e + 1) * CS_LD + 64 * j + dv]);
        *(u32x4*)(dst + 8 * e8) = o;
    }
}

struct EpiIn {
    __device__ __forceinline__ void operator()(const Params& p, const float* Cs, int m0, int n0, int tid) const {
        const int cg = tid & 15, r0 = tid >> 4;
#pragma unroll 1
        for (int j = 0; j < 2; ++j) {
            const int n0j = n0 + 64 * j;
            if (n0j >= DIN) continue;
            if (n0j == 3840) {
                float* P = (float*)(p.ws + WS_P);
                float mx0 = 0.f, mx1 = 0.f;
#pragma unroll 1
                for (int i = 0; i < 8; ++i) {
                    const int rl = r0 + 16 * i, row = m0 + rl;
                    const float4 v = *(const float4*)&Cs[rl * CS_LD + 4 * cg];
                    float ss = (cg < 8) ? (v.x * v.x + v.y * v.y + v.z * v.z + v.w * v.w) : 0.f;
                    ss = group_sum8(ss);
                    if (i < 4) mx0 = fmaxf(mx0, ss); else mx1 = fmaxf(mx1, ss);
                    if (cg < 8) {
                        float* dst = (row < SEQ ? p.out + O_PAKI + (size_t)row * 32 : p.out + O_SAKI + (size_t)(row - SEQ) * 32) + 4 * cg; *(float4*)dst = v;
                        h16x4 hv; hv.x = (h16)v.x; hv.y = (h16)v.y; hv.z = (h16)v.z; hv.w = (h16)v.w;
                        h16* hd = row < SEQ ? (h16*)(p.ws + WS_IK_P) + (size_t)row * 32 : (h16*)(p.ws + WS_IK_S) + ((size_t)((row - SEQ) >> 6) * (PAST + DECS) + PAST + ((row - SEQ) & 63)) * 32;
                        *(h16x4*)(hd + 4 * cg) = hv;
                    }
                    else if (cg < 10) { *(float4*)(P + (size_t)row * LDP + PC_IW + 4 * (cg - 8)) = v; }
                }
                if (cg == 0) {
                    unsigned* ctl = (unsigned*)(p.ws + WS_CTL);
                    if (m0 < SEQ) atomicMax(ctl, __float_as_uint(fmaxf(mx0, mx1)));
                    else { const int b0 = (m0 - SEQ) >> 6; atomicMax(ctl + 1 + b0, __float_as_uint(mx0)); atomicMax(ctl + 2 + b0, __float_as_uint(mx1)); }
                }
                continue;
            }
            const Seg s = seg_of(p, n0j);
            float4 g4 = make_float4(1.f, 1.f, 1.f, 1.f);
            if (s.norm == 64) g4 = *(const float4*)(s.gain + 4 * cg);
            else if (s.norm == 32) g4 = *(const float4*)(s.gain + ((4 * cg) & 31));
#pragma unroll 1
            for (int i = 0; i < 8; ++i) {
                const int rl = r0 + 16 * i, row = m0 + rl;
                float4 v = *(const float4*)&Cs[rl * CS_LD + 64 * j + 4 * cg];
                if (s.norm) {
                    float ss = v.x * v.x + v.y * v.y + v.z * v.z + v.w * v.w;
                    float sc;
                    if (s.norm == 64) { ss = group_sum16(ss); sc = 1.0f / sqrtf(ss * (1.0f / 64.0f) + EPS); }
                    else { ss = group_sum8(ss); sc = 1.0f / sqrtf(ss * (1.0f / 32.0f) + EPS); }
                    v.x *= sc * g4.x; v.y *= sc * g4.y; v.z *= sc * g4.z; v.w *= sc * g4.w;
                }
                if (s.bp) *(float4*)((row < SEQ ? s.bp : s.bs) + (size_t)row * s.ld + s.col + 4 * cg) = v;
                h16* hb = row < SEQ ? s.hp : s.hs;
                if (hb) {
                    h16x4 hv; hv.x = (h16)(v.x * s.hscale); hv.y = (h16)(v.y * s.hscale); hv.z = (h16)(v.z * s.hscale); hv.w = (h16)(v.w * s.hscale);
                    *(h16x4*)(hb + (size_t)row * s.hld + s.hcol + 4 * cg) = hv;
                }
            }
            if (s.vt == 2 && m0 < SEQ) vt_store(Cs, j, (h16*)(p.ws + WS_VTB_P) + (size_t)(s.head * 64) * SEQ + m0, SEQ, tid);
            if (s.vt == 1 && m0 < SEQ) vt_store(Cs, j, (h16*)(p.ws + WS_VTA_P) + (size_t)(s.head * 64) * SEQ + m0, SEQ, tid);
        }
    }
};

struct EpiMem {
    __device__ __forceinline__ void operator()(const Params& p, const float* Cs, int m0, int n0, int tid) const {
        const int cg = tid & 15, r0 = tid >> 4;
#pragma unroll 1
        for (int j = 0; j < 2; ++j) {
            const int n0j = n0 + 64 * j;
            const bool isk = n0j < 256;
            const float4 g4 = isk ? *(const float4*)(p.in[24] + 4 * cg) : make_float4(1.f, 1.f, 1.f, 1.f);
#pragma unroll 1
            for (int i = 0; i < 8; ++i) {
                const int rl = r0 + 16 * i, row = m0 + rl;
                float4 v = *(const float4*)&Cs[rl * CS_LD + 64 * j + 4 * cg];
                if (isk) {
                    float ss = group_sum16(v.x * v.x + v.y * v.y + v.z * v.z + v.w * v.w);
                    const float sc = 1.0f / sqrtf(ss * (1.0f / 64.0f) + EPS);
                    v.x *= sc * g4.x; v.y *= sc * g4.y; v.z *= sc * g4.z; v.w *= sc * g4.w;
                    h16x4 hv; hv.x = (h16)v.x; hv.y = (h16)v.y; hv.z = (h16)v.z; hv.w = (h16)v.w;
                    *(h16x4*)((h16*)(p.ws + WS_MK_P) + (size_t)row * 256 + n0j + 4 * cg) = hv;
                }
                float* dst = p.out + (isk ? O_PMK : O_PMV) + (size_t)row * 256 + (isk ? n0j : n0j - 256) + 4 * cg;
                *(float4*)dst = v;
            }
            if (!isk) vt_store(Cs, j, (h16*)(p.ws + WS_MVT_P) + (size_t)(((n0j - 256) >> 6) * 64) * NMEM + m0, NMEM, tid);
        }
    }
};

struct EpiOut {
    __device__ __forceinline__ void operator()(const Params& p, const float* Cs, int m0, int n0, int tid) const {
        const int cg = tid & 15, r0 = tid >> 4;
#pragma unroll 1
        for (int i = 0; i < 8; ++i) {
            const int rl = r0 + 16 * i, row = m0 + rl;
            const float* x = (row < SEQ ? p.in[0] + (size_t)row * D : p.in[1] + (size_t)(row - SEQ) * D) + n0 + 4 * cg;
            float* y = (row < SEQ ? p.out + O_YP + (size_t)row * D : p.out + O_YS + (size_t)(row - SEQ) * D) + n0 + 4 * cg;
#pragma unroll
            for (int j = 0; j < 2; ++j) {
                const float4 v = *(const float4*)&Cs[rl * CS_LD + 64 * j + 4 * cg];
                const float4 xv = *(const float4*)(x + 64 * j);
                *(float4*)(y + 64 * j) = make_float4(xv.x + v.x, xv.y + v.y, xv.z + v.z, xv.w + v.w);
            }
        }
    }
};

__device__ void phase1(const Params& p, unsigned char* smem) {
    const h16* XH = (const h16*)(p.ws + WS_XH);
    const h16* HMH = (const h16*)(p.ws + WS_HMH);
    const h16* WTIN = (const h16*)(p.ws + WS_WTIN);
    const h16* WTMEM = (const h16*)(p.ws + WS_WTMEM);
    const EpiIn ein{}; const EpiMem emem{};
    const int G = gridDim.x;
    if ((G & 7) == 0) {
        const int xcd = blockIdx.x & 7, local = blockIdx.x >> 3, LG = G >> 3;
        for (int lin = local; lin < 6 * 96; lin += LG) {
            const int rgroup = lin / 96, rem = lin % 96, chalf = rem / 48, rem2 = rem % 48, r = rem2 >> 4, c = chalf * 16 + (rem2 & 15);
            if (c >= 31) continue;
            const int rt = xcd + 8 * (rgroup * 3 + r);
            gemm_tile(p, XH, WTIN, rt * 128, c * 128, smem, ein);
        }
        if (blockIdx.x < 8) { const int rt = blockIdx.x / 4, ct = blockIdx.x % 4; gemm_tile(p, HMH, WTMEM, rt * 128, ct * 128, smem, emem); }
    } else {
        constexpr int NCT = NPAD_IN / 128, NRT = MROWS / 128;
        constexpr int N_IN = NCT * NRT, N_MEM = 2 * 4;
        for (int it = blockIdx.x; it < N_IN + N_MEM; it += gridDim.x) {
            if (it < N_IN) { const int rt = it / NCT, ct = it % NCT; gemm_tile(p, XH, WTIN, rt * 128, ct * 128, smem, ein); }
            else { const int im = it - N_IN, rt = im / 4, ct = im % 4; gemm_tile(p, HMH, WTMEM, rt * 128, ct * 128, smem, emem); }
        }
    }
}

struct KeySrc {
    const float* cache; const float* fresh; int past; int ld;
    __device__ __forceinline__ const float* row(int k) const { return k < past ? cache + (size_t)k * ld : fresh + (size_t)(k - past) * ld; }
};

__device__ __forceinline__ unsigned fkey(float f) { const unsigned u = __float_as_uint(f); return (u & 0x80000000u) ? ~u : (u | 0x80000000u); }

struct SmemDsa {
    float sc[16384];
    float iq[256]; float iw[8];
    unsigned hist[256]; unsigned mw[512];
    int wcnt[4]; int wcnt2[4]; int misc[4];
};

__device__ void select_item(const Params& p, unsigned char* smem, int item) {
    SmemDsa& S = *(SmemDsa*)smem;
    int tid = threadIdx.x; asm volatile("" : "+v"(tid));
    const int lane = tid & 63, w = tid >> 6;
    const float* P = (const float*)(p.ws + WS_P);
    int row, N; KeySrc ki; unsigned* mout;
    if (item < SEQ) {
        row = item; N = 64 * (item / 64 + 1);
        ki = KeySrc{nullptr, p.out + O_PAKI, 0, 32};
        mout = (unsigned*)(p.ws + WS_MASK_P) + (size_t)item * 512;
    } else {
        const int bt = item - SEQ, b = bt / DECS;
        row = item; N = PAST + DECS;
        ki = KeySrc{p.in[5] + (size_t)b * PAST * 32, p.out + O_SAKI + (size_t)b * DECS * 32, PAST, 32};
        mout = (unsigned*)(p.ws + WS_MASK_S) + (size_t)bt * 34;
    }
    const int nw = N / 32;
    __syncthreads();
    if (N <= 256) {
        if (tid < nw) mout[tid] = 0xffffffffu;
        return;
    }
    S.iq[tid] = P[(size_t)row * LDP + PC_IQ + tid];
    if (tid < 8) S.iw[tid] = P[(size_t)row * LDP + PC_IW + tid];
    S.mw[tid] = 0u; S.mw[tid + 256] = 0u;
    __syncthreads();
    for (int k = tid; k < N; k += NT) {
        const float4* kr = (const float4*)ki.row(k);
        float kd[32];
#pragma unroll
        for (int i = 0; i < 8; ++i) { const float4 t4 = kr[i]; kd[4 * i] = t4.x; kd[4 * i + 1] = t4.y; kd[4 * i + 2] = t4.z; kd[4 * i + 3] = t4.w; }
        float score = 0.f;
#pragma unroll 1
        for (int h = 0; h < 8; ++h) {
            float d = 0.f;
#pragma unroll
            for (int i = 0; i < 32; ++i) d = fmaf(S.iq[h * 32 + i], kd[i], d);
            score = fmaf(S.iw[h], fmaxf(d, 0.f), score);
        }
        S.sc[k] = score;
    }
    __syncthreads();
    unsigned prefix = 0; int remaining = 256;
    for (int pass = 0; pass < 4; ++pass) {
        const int shift = 24 - 8 * pass;
        S.hist[tid] = 0;
        __syncthreads();
        for (int k = tid; k < N; k += NT) {
            const unsigned key = fkey(S.sc[k]);
            if (pass == 0 || (key >> (shift + 8)) == prefix) atomicAdd(&S.hist[(key >> shift) & 255u], 1u);
        }
        __syncthreads();
        const int hv = (int)S.hist[tid];
        int x = hv;
#pragma unroll
        for (int o = 1; o < 64; o <<= 1) { const int y = __shfl_down(x, o); if (lane + o < 64) x += y; }
        if (lane == 0) S.wcnt[w] = x;
        __syncthreads();
        int above = x - hv;
        for (int w2 = w + 1; w2 < 4; ++w2) above += S.wcnt[w2];
        if (above < remaining && remaining <= above + hv) { S.misc[0] = (int)((prefix << 8) | (unsigned)tid); S.misc[1] = remaining - above; }
        __syncthreads();
        prefix = (unsigned)S.misc[0]; remaining = S.misc[1];
        __syncthreads();
    }
    const unsigned T = prefix; const int r = remaining;
    int base_eq = 0;
    const unsigned long long lt = (lane == 0) ? 0ull : (~0ull >> (64 - lane));
    for (int k0 = 0; k0 < N; k0 += NT) {
        const int k = k0 + tid;
        const unsigned key = (k < N) ? fkey(S.sc[k]) : 0u;
        const bool gt = (k < N) && key > T, eq = (k < N) && key == T;
        const unsigned long long beq = __ballot(eq);
        const int eqpre = __popcll(beq & lt);
        if (lane == 0) S.wcnt[w] = __popcll(beq);
        __syncthreads();
        int eqbase = base_eq, eqtot = 0;
        for (int w2 = 0; w2 < 4; ++w2) { const int c = S.wcnt[w2]; if (w2 < w) eqbase += c; eqtot += c; }
        const bool sel = gt || (eq && (eqbase + eqpre) < r);
        const unsigned long long bs = __ballot(sel);
        if (lane == 0) S.mw[(k0 >> 5) + 2 * w] = (unsigned)bs;
        if (lane == 32) S.mw[(k0 >> 5) + 2 * w + 1] = (unsigned)(bs >> 32);
        base_eq += eqtot;
        __syncthreads();
    }
    for (int i = tid; i < nw; i += NT) mout[i] = S.mw[i];
}

typedef float f32x4m __attribute__((ext_vector_type(4)));
constexpr int CAND_CAP = 120;
struct SelSm {
    unsigned hist[16][1025];
    float cand_s[16][CAND_CAP]; int cand_k[16][CAND_CAP];
    int cnt[16]; int bstar[16]; int nabove[16]; int ovf[16];
};

__device__ __forceinline__ void score_tile(const h16x8& a, const h16x8 (&bq)[8], const float (&wq)[8], float (&sc)[4]) {
    sc[0] = 0.f; sc[1] = 0.f; sc[2] = 0.f; sc[3] = 0.f;
#pragma unroll
    for (int h = 0; h < 8; ++h) {
        f32x4m z = {0.f, 0.f, 0.f, 0.f};
        const f32x4m d = __builtin_amdgcn_mfma_f32_16x16x32_f16(a, bq[h], z, 0, 0, 0);
#pragma unroll
        for (int i = 0; i < 4; ++i) { const int bits = (int)__float_as_uint(d[i]); sc[i] = fmaf(wq[h], __uint_as_float((unsigned)(bits > 0 ? bits : 0)), sc[i]); }
    }
}

__device__ __forceinline__ int bin_of(float sc, float inv, float off) {
    int b = (int)fmaf(sc, inv, off);
    b = b < 0 ? 0 : (b > 1021 ? 1021 : b);
    return b + (sc > 0.f ? 2 : (sc == 0.f ? 1 : 0));
}

__device__ void select_unit(const Params& p, unsigned char* smem, int u) {
    SelSm& S = *(SelSm*)smem;
    int tid = threadIdx.x; asm volatile("" : "+v"(tid));
    const int lane = tid & 63, w = __builtin_amdgcn_readfirstlane(tid >> 6), q = lane & 15, g = lane >> 4;
    int row0, N, ldm, kslot; const h16* IK; unsigned* mask;
    if (u < 1024) {
        const int q0 = 16 * (1023 - u);
        row0 = q0; N = 64 * (q0 / 64 + 1); IK = (const h16*)(p.ws + WS_IK_P); mask = (unsigned*)(p.ws + WS_MASK_P) + (size_t)q0 * 512; ldm = 512; kslot = 0;
    } else {
        const int bu = u - 1024, b = bu >> 2, t0 = 16 * (bu & 3);
        row0 = SEQ + 64 * b + t0; N = PAST + DECS; IK = (const h16*)(p.ws + WS_IK_S) + (size_t)b * (PAST + DECS) * 32;
        mask = (unsigned*)(p.ws + WS_MASK_S) + (size_t)(64 * b + t0) * 34; ldm = 34; kslot = 1 + b;
    }
    const int nw = N / 32;
    __syncthreads();
    if (N <= 256) {
        for (int i = tid; i < 16 * nw; i += NT) mask[(size_t)(i / nw) * ldm + (i % nw)] = 0xffffffffu;
        return;
    }
    for (int i = tid; i < 16 * 1025; i += NT) ((unsigned*)S.hist)[i] = 0u;
    if (tid < 16) { S.cnt[tid] = 0; S.ovf[tid] = 0; S.bstar[tid] = 0; S.nabove[tid] = 0; }
    const int rowq = row0 + q;
    const h16* IQ = (const h16*)(p.ws + WS_IQ16) + (size_t)rowq * 256 + 8 * g;
    const float* Pf = (const float*)(p.ws + WS_P) + (size_t)rowq * LDP + PC_IW;
    h16x8 bq[8]; float wq[8];
    float hi = 0.f, lo = 0.f;
#pragma unroll
    for (int h = 0; h < 8; ++h) {
        bq[h] = *(const h16x8*)(IQ + h * 32);
        wq[h] = Pf[h];
        float n2 = 0.f;
#pragma unroll
        for (int e = 0; e < 8; ++e) { const float x = (float)bq[h][e]; n2 = fmaf(x, x, n2); }
        n2 += __shfl_xor(n2, 16); n2 += __shfl_xor(n2, 32);
        const float t = wq[h] * sqrtf(n2);
        if (t > 0.f) hi += t; else lo += t;
    }
    const float kmax = sqrtf(__uint_as_float(((const unsigned*)(p.ws + WS_CTL))[kslot])) * 1.01f;
    hi = hi * kmax + 1e-6f; lo = lo * kmax - 1e-6f;
    const float inv = 1022.0f / fmaxf(hi - lo, 1e-20f), off = -lo * inv;
    __syncthreads();
    const h16* ikp = IK + (size_t)q * 32 + 8 * g;
    const int ngw = (nw - w + 3) >> 2;
#define SEL_LD(dst0, dst1, it_) do { const int gi_ = w + 4 * ((it_) < ngw ? (it_) : ngw - 1); \
        dst0 = *(const h16x8*)(ikp + (size_t)(32 * gi_) * 32); dst1 = *(const h16x8*)(ikp + (size_t)(32 * gi_ + 16) * 32); } while (0)
    {
        h16x8 a0, a1; SEL_LD(a0, a1, 0);
        for (int it = 0; it < ngw; ++it) {
            h16x8 n0, n1; SEL_LD(n0, n1, it + 1);
#pragma unroll
            for (int t = 0; t < 2; ++t) {
                float sc[4]; score_tile(t == 0 ? a0 : a1, bq, wq, sc);
#pragma unroll
                for (int i = 0; i < 4; ++i) { const int b = bin_of(sc[i], inv, off); atomicAdd(&S.hist[q][b], 1u); }
            }
            a0 = n0; a1 = n1;
        }
    }
    __syncthreads();
    for (int qq = 0; qq < 4; ++qq) {
        const int qi = 4 * w + qq;
        unsigned c = 0;
#pragma unroll
        for (int e = 0; e < 16; ++e) c += S.hist[qi][16 * lane + e];
        int x = (int)c;
#pragma unroll
        for (int o = 1; o < 64; o <<= 1) { const int y = __shfl_down(x, o); if (lane + o < 64) x += y; }
        const int above = x - (int)c;
        if (above < 256 && 256 <= above + (int)c) {
            int acc = above, bs = 16 * lane;
            for (int e = 15; e >= 0; --e) {
                const int v = (int)S.hist[qi][16 * lane + e];
                if (acc + v >= 256) { bs = 16 * lane + e; break; }
                acc += v;
            }
            S.bstar[qi] = bs; S.nabove[qi] = acc;
        }
    }
    __syncthreads();
    const int bst = S.bstar[q];
    unsigned* mrow = (unsigned*)S.hist;
    {
        h16x8 a0, a1; SEL_LD(a0, a1, 0);
        for (int it = 0; it < ngw; ++it) {
            h16x8 n0, n1; SEL_LD(n0, n1, it + 1);
            const int grp = w + 4 * it;
            unsigned word = 0u;
#pragma unroll
            for (int t = 0; t < 2; ++t) {
                const int k0 = 32 * grp + 16 * t;
                float sc[4]; score_tile(t == 0 ? a0 : a1, bq, wq, sc);
                unsigned nib = 0u;
#pragma unroll
                for (int i = 0; i < 4; ++i) {
                    const int b = bin_of(sc[i], inv, off);
                    if (b > bst) nib |= 1u << i;
                    else if (b == bst) {
                        const int pos = atomicAdd(&S.cnt[q], 1);
                        if (pos < CAND_CAP) { S.cand_s[q][pos] = sc[i]; S.cand_k[q][pos] = k0 + 4 * g + i; }
                    }
                }
                unsigned v = nib << (4 * g);
                v |= (unsigned)__shfl_xor((int)v, 16); v |= (unsigned)__shfl_xor((int)v, 32);
                word |= v << (16 * t);
            }
            if (g == 0) mrow[q * 512 + grp] = word;
            a0 = n0; a1 = n1;
        }
    }
#undef SEL_LD
    __syncthreads();
    for (int qq = 0; qq < 4; ++qq) {
        const int qi = 4 * w + qq;
        const int m = S.cnt[qi], r = 256 - S.nabove[qi];
        if (m > CAND_CAP) { if (lane == 0) S.ovf[qi] = 1; continue; }
        const int nparts = m > 64 ? 2 : 1;
        for (int part = 0; part < nparts; ++part) {
            const int me = lane + 64 * part;
            const float s_me = me < m ? S.cand_s[qi][me] : 0.f;
            const int k_me = me < m ? S.cand_k[qi][me] : 0;
            int rank = 0;
#pragma unroll 4
            for (int j = 0; j < m; ++j) { const float sj = S.cand_s[qi][j]; const int kj = S.cand_k[qi][j]; rank += (sj > s_me || (sj == s_me && kj < k_me)) ? 1 : 0; }
            if (me < m && rank < r) atomicOr(&mrow[qi * 512 + (k_me >> 5)], 1u << (k_me & 31));
        }
    }
    __syncthreads();
    for (int i = tid; i < 16 * nw; i += NT) { const int qi = i / nw, wd = i - qi * nw; mask[(size_t)qi * ldm + wd] = mrow[qi * 512 + wd]; }
    __syncthreads();
    if (tid == 0) {
        unsigned* fl = (unsigned*)(p.ws + WS_REDO) + (size_t)blockIdx.x * REDO_LD;
        unsigned n = fl[0];
        for (int qi = 0; qi < 16; ++qi) if (S.ovf[qi] && n + 1 < (unsigned)REDO_LD) { fl[1 + n] = (unsigned)(row0 + qi); ++n; }
        fl[0] = n;
    }
}

constexpr int ATT_TB_OFF = 32768;
constexpr int ATT_LDS = ATT_TB_OFF + 1024 + 16;

__device__ __forceinline__ int pi32(int r) { return (r & 0x13) | ((r & 4) << 1) | ((r & 8) >> 1); }
__device__ __forceinline__ unsigned pkrtz(float a, float b) { return __builtin_bit_cast(unsigned, __builtin_amdgcn_cvt_pkrtz(a, b)); }

struct AttnUnit {
    int row0, nwaves, ntiles, chunk0, chunk_step, qpos0, head;
    const h16* Kh; const h16* VTh; int ldk; int ldv;
    const float* Kc; const float* Vc; const float* Kn; const float* Vn; int ldf; int ntc;
    const unsigned* mask; int ldm;
};

template <int MODE, bool F32SRC>
__device__ __forceinline__ void attn_unit(const Params& p, unsigned char* smem, const AttnUnit& U, float lam) {
    int tid = threadIdx.x; asm volatile("" : "+v"(tid));
    const int lane = tid & 63, w = __builtin_amdgcn_readfirstlane(tid >> 6), l31 = lane & 31, hh = lane >> 5;
    const int qt = (MODE == 1) ? (w & 1) : w, cmap = (MODE == 1) ? (w >> 1) : 0;
    const bool active = qt < U.nwaves;
    const int chunk_w = U.chunk0 + U.chunk_step * (qt >> 1);
    const int rowq = U.row0 + 32 * qt + l31;
    const int qpos = U.qpos0 + 32 * qt + l31;
    float* tb = (float*)(smem + ATT_TB_OFF);
    __syncthreads();
    if (MODE != 2) {
        if (tid < 255) { const int hc = (MODE == 0 ? U.head : 8 + U.head); tb[tid] = (p.in[10][rel_bucket(tid - 191) * 12 + hc] - p.in[10][15 * 12 + hc]) * LOG2E; }
    }
    if (MODE == 0 && tid < 4) ((unsigned*)(smem + ATT_TB_OFF + 1024))[tid] = ((tid & 1) ? 0x0000ffffu : 0u) | ((tid & 2) ? 0xffff0000u : 0u);
    constexpr int NQF = (MODE == 1) ? 2 : 4;
    h16x8 qf[NQF];
    if (active) {
        const h16* Qb = (MODE == 0) ? (const h16*)(p.ws + WS_QA) + (size_t)rowq * 512 + U.head * 64
                      : (MODE == 1) ? (const h16*)(p.ws + WS_QB) + (size_t)rowq * 256 + U.head * 64 + 32 * cmap
                                    : (const h16*)(p.ws + WS_QC) + (size_t)rowq * 256 + U.head * 64;
#pragma unroll
        for (int s = 0; s < NQF; ++s) qf[s] = *(const h16x8*)(Qb + 16 * s + 8 * hh);
    } else {
#pragma unroll
        for (int s = 0; s < NQF; ++s)
#pragma unroll
            for (int e = 0; e < 8; ++e) qf[s][e] = (h16)0.f;
    }
    f32x16 O[2];
    float lsum = 0.f;
    const unsigned* lut = (const unsigned*)(smem + ATT_TB_OFF + 1024);
#pragma unroll
    for (int m = 0; m < 2; ++m)
#pragma unroll
        for (int r = 0; r < 16; ++r) O[m][r] = 0.f;
    int crow[2], cch[2], so[2];
#pragma unroll
    for (int i = 0; i < 2; ++i) { const int c = tid + 256 * i; crow[i] = c >> 3; cch[i] = c & 7; so[i] = crow[i] * 128 + ((cch[i] ^ ((crow[i] >> 1) & 7)) << 4); }
    u32x4 rk[2], rv[2], rk2[2], rv2[2];
    f32x4 fk[2][2], fv[2][2];
#define ATT_LOADR(RK, RV, j) do { \
        _Pragma("unroll") for (int i = 0; i < 2; ++i) { \
            RK[i] = *(const u32x4*)(U.Kh + (size_t)(64 * (j) + crow[i]) * U.ldk + cch[i] * 8); \
            RV[i] = *(const u32x4*)(U.VTh + (size_t)crow[i] * U.ldv + 64 * (j) + cch[i] * 8); } } while (0)
#define ATT_WRITER(RK, RV, b) do { unsigned char* kt_ = smem + (b) * 16384; unsigned char* vt_ = kt_ + 8192; \
        _Pragma("unroll") for (int i = 0; i < 2; ++i) { *(u32x4*)(kt_ + so[i]) = RK[i]; *(u32x4*)(vt_ + so[i]) = RV[i]; } } while (0)
#define ATT_LOAD(j) do { \
        if constexpr (!F32SRC) { ATT_LOADR(rk, rv, j); \
        } else { \
            const float* kb_ = ((j) < U.ntc) ? U.Kc + (size_t)(64 * (j)) * U.ldf : U.Kn + (size_t)(64 * ((j) - U.ntc)) * U.ldf; \
            const float* vb_ = ((j) < U.ntc) ? U.Vc + (size_t)(64 * (j)) * U.ldf : U.Vn + (size_t)(64 * ((j) - U.ntc)) * U.ldf; \
            _Pragma("unroll") for (int i = 0; i < 2; ++i) { \
                const float* ks_ = kb_ + (size_t)crow[i] * U.ldf + cch[i] * 8; const float* vs_ = vb_ + (size_t)crow[i] * U.ldf + cch[i] * 8; \
                fk[i][0] = *(const f32x4*)ks_; fk[i][1] = *(const f32x4*)(ks_ + 4); fv[i][0] = *(const f32x4*)vs_; fv[i][1] = *(const f32x4*)(vs_ + 4); } \
        } } while (0)
#define ATT_WRITE(b) do { \
        unsigned char* kt_ = smem + (b) * 16384; unsigned char* vt_ = kt_ + 8192; \
        if constexpr (!F32SRC) { \
            _Pragma("unroll") for (int i = 0; i < 2; ++i) { *(u32x4*)(kt_ + so[i]) = rk[i]; *(u32x4*)(vt_ + so[i]) = rv[i]; } \
        } else { \
            _Pragma("unroll") for (int i = 0; i < 2; ++i) { \
                h16x8 hk_; _Pragma("unroll") for (int e = 0; e < 4; ++e) { hk_[e] = (h16)fk[i][0][e]; hk_[4 + e] = (h16)fk[i][1][e]; } \
                *(h16x8*)(kt_ + so[i]) = hk_; \
                const int key_ = crow[i]; \
                _Pragma("unroll") for (int e = 0; e < 8; ++e) { const int dv_ = 8 * cch[i] + e; \
                    *(__bf16*)(vt_ + dv_ * 128 + (((key_ >> 3) ^ ((dv_ >> 1) & 7)) << 4) + (key_ & 7) * 2) = (__bf16)(e < 4 ? fv[i][0][e] : fv[i][1][e - 4]); } } \
        } } while (0)

    const unsigned char* kdma[2]; const unsigned char* vdma[2]; int dmo[2];
#pragma unroll
    for (int i = 0; i < 2; ++i) {
        const int row = 16 * w + 8 * i + (lane >> 3), ch = (lane & 7) ^ ((row >> 1) & 7);
        kdma[i] = F32SRC ? nullptr : (const unsigned char*)(U.Kh + (size_t)row * U.ldk + ch * 8);
        vdma[i] = F32SRC ? nullptr : (const unsigned char*)(U.VTh + (size_t)row * U.ldv + ch * 8);
        dmo[i] = (16 * w + 8 * i) * 128;
    }
#define ATT_DMA(b, j) do { _Pragma("unroll") for (int i = 0; i < 2; ++i) { \
        __builtin_amdgcn_global_load_lds((const unsigned*)(kdma[i] + (size_t)(64 * (j)) * U.ldk * 2), (__attribute__((address_space(3))) unsigned*)(smem + (b) * 16384 + dmo[i]), 16, 0, 0); \
        __builtin_amdgcn_global_load_lds((const unsigned*)(vdma[i] + (size_t)(64 * (j)) * 2), (__attribute__((address_space(3))) unsigned*)(smem + (b) * 16384 + 8192 + dmo[i]), 16, 0, 0); } } while (0)
    if constexpr (!F32SRC) { ATT_DMA(0, 0); } else { ATT_LOAD(0); ATT_WRITE(0); }
    const unsigned* mrow = (MODE == 0) ? U.mask + (size_t)(32 * qt + l31) * U.ldm : nullptr;
    unsigned mwn0 = 0xffffffffu, mwn1 = 0xffffffffu;
    if (MODE == 0) { mwn0 = mrow[0]; mwn1 = mrow[1]; }
    __syncthreads();
    const int pil = pi32(l31), ksw = (pil >> 1) & 7, vsw = (l31 >> 1) & 7;
    const int jlast = U.ntiles - 1;
    auto clampj = [&](int x) { return x < jlast ? x : jlast; };
    if constexpr (!F32SRC) {
        for (int j = 0; j < U.ntiles; ++j) {
            const int buf = j & 1;
            const int jn = clampj(j + 1);
            unsigned mw[2] = {mwn0 >> (8 * hh), mwn1 >> (8 * hh)};
            if (MODE == 0) { mwn0 = mrow[2 * jn]; mwn1 = mrow[2 * jn + 1]; }
            ATT_DMA(buf ^ 1, jn);
        if (active && (MODE == 2 || j <= chunk_w)) {
            const unsigned char* Kt = smem + buf * 16384;
            const unsigned char* Vt = Kt + 8192;
            const bool near = (MODE != 2) && (j >= chunk_w - 2);
            bf16x8 pf[4];
#pragma unroll
            for (int u = 0; u < 2; ++u) {
                f32x16 S;
#pragma unroll
                for (int r = 0; r < 16; ++r) S[r] = 0.f;
                const unsigned char* kp = Kt + (32 * u + pil) * 128;
#pragma unroll
                for (int s = 0; s < NQF; ++s) {
                    const int ch = (MODE == 1) ? (4 * cmap + 2 * s + hh) : (2 * s + hh);
                    const h16x8 a = *(const h16x8*)(kp + ((ch ^ ksw) << 4));
                    S = __builtin_amdgcn_mfma_f32_32x32x16_f16(a, qf[s], S, 0, 0, 0);
                }
                if (near) {
                    const int base = 64 * j + 32 * u + 8 * hh - qpos + 191;
#pragma unroll
                    for (int i = 0; i < 16; ++i) S[i] += tb[base + (i & 7) + 16 * (i >> 3)];
                }
#pragma unroll
                for (int i = 0; i < 16; ++i) S[i] = __builtin_amdgcn_exp2f(S[i]);
#pragma unroll
                for (int s2 = 0; s2 < 2; ++s2) {
                    u32x4 pk;
#pragma unroll
                    for (int e = 0; e < 4; ++e) {
                        unsigned v = pkbf(S[8 * s2 + 2 * e], S[8 * s2 + 2 * e + 1]);
                        if (MODE == 0) {
                            const unsigned idx = (mw[u] >> (16 * s2 + 2 * e)) & 3u;
                            v &= lut[idx];
                        }
                        lsum = __builtin_amdgcn_fdot2_f32_bf16(__builtin_bit_cast(bf16x2, v), __builtin_bit_cast(bf16x2, 0x3f803f80u), lsum, false);
                        pk[e] = v;
                    }
                    pf[2 * u + s2] = __builtin_bit_cast(bf16x8, pk);
                }
            }
#pragma unroll
            for (int m = 0; m < 2; ++m)
#pragma unroll
                for (int sp = 0; sp < 4; ++sp) {
                    const bf16x8 vfr = *(const bf16x8*)(Vt + (32 * m + l31) * 128 + (((2 * sp + hh) ^ vsw) << 4));
                    O[m] = __builtin_amdgcn_mfma_f32_32x32x16_bf16(vfr, pf[sp], O[m], 0, 0, 0);
                }
        }
            __syncthreads();
        }
    } else {
    for (int j = 0; j < U.ntiles; ++j) {
        const int buf = j & 1;
        const int jn = j < jlast ? j + 1 : jlast;
        unsigned mw[2] = {mwn0 >> (8 * hh), mwn1 >> (8 * hh)};
        if (MODE == 0) { mwn0 = mrow[2 * jn]; mwn1 = mrow[2 * jn + 1]; }
        if (active && (MODE == 2 || j <= chunk_w)) {
            const unsigned char* Kt = smem + buf * 16384;
            const unsigned char* Vt = Kt + 8192;
            const bool near = (MODE != 2) && (j >= chunk_w - 2);
            bf16x8 pf[4];
#pragma unroll
            for (int u = 0; u < 2; ++u) {
                f32x16 S;
#pragma unroll
                for (int r = 0; r < 16; ++r) S[r] = 0.f;
                const unsigned char* kp = Kt + (32 * u + pil) * 128;
#pragma unroll
                for (int s = 0; s < NQF; ++s) {
                    const int ch = (MODE == 1) ? (4 * cmap + 2 * s + hh) : (2 * s + hh);
                    const h16x8 a = *(const h16x8*)(kp + ((ch ^ ksw) << 4));
                    S = __builtin_amdgcn_mfma_f32_32x32x16_f16(a, qf[s], S, 0, 0, 0);
                }
                if (near) {
                    const int base = 64 * j + 32 * u + 8 * hh - qpos + 191;
#pragma unroll
                    for (int i = 0; i < 16; ++i) S[i] += tb[base + (i & 7) + 16 * (i >> 3)];
                }
#pragma unroll
                for (int i = 0; i < 16; ++i) S[i] = __builtin_amdgcn_exp2f(S[i]);
#pragma unroll
                for (int s2 = 0; s2 < 2; ++s2) {
                    u32x4 pk;
#pragma unroll
                    for (int e = 0; e < 4; ++e) {
                        unsigned v = pkbf(S[8 * s2 + 2 * e], S[8 * s2 + 2 * e + 1]);
                        if (MODE == 0) {
                            const unsigned idx = (mw[u] >> (16 * s2 + 2 * e)) & 3u;
                            v &= lut[idx];
                        }
                        lsum = __builtin_amdgcn_fdot2_f32_bf16(__builtin_bit_cast(bf16x2, v), __builtin_bit_cast(bf16x2, 0x3f803f80u), lsum, false);
                        pk[e] = v;
                    }
                    pf[2 * u + s2] = __builtin_bit_cast(bf16x8, pk);
                }
            }
#pragma unroll
            for (int m = 0; m < 2; ++m)
#pragma unroll
                for (int sp = 0; sp < 4; ++sp) {
                    const bf16x8 vfr = *(const bf16x8*)(Vt + (32 * m + l31) * 128 + (((2 * sp + hh) ^ vsw) << 4));
                    O[m] = __builtin_amdgcn_mfma_f32_32x32x16_bf16(vfr, pf[sp], O[m], 0, 0, 0);
                }
        }
        ATT_LOAD(jn);
        ATT_WRITE(buf ^ 1);
        __syncthreads();
    }
    }
#undef ATT_LOAD
#undef ATT_WRITE
#undef ATT_LOADR
#undef ATT_WRITER
#undef ATT_DMA
    const float l = lsum + __shfl_xor(lsum, 32);
    const float inv = 1.0f / l;
    if (MODE == 1) {
        float* X = (float*)smem;
        if (cmap == 1) {
#pragma unroll
            for (int m = 0; m < 2; ++m)
#pragma unroll
                for (int i = 0; i < 16; ++i) X[(qt * 32 + m * 16 + i) * 64 + lane] = O[m][i] * inv;
        }
        __syncthreads();
        if (cmap == 1) return;
#pragma unroll
        for (int m = 0; m < 2; ++m)
#pragma unroll
            for (int i = 0; i < 16; ++i) O[m][i] = O[m][i] * inv - lam * X[(qt * 32 + m * 16 + i) * 64 + lane];
    } else {
        if (!active) return;
#pragma unroll
        for (int m = 0; m < 2; ++m)
#pragma unroll
            for (int i = 0; i < 16; ++i) O[m][i] *= inv;
    }
    const int colbase = (MODE == 0 ? 0 : (MODE == 1 ? 512 : 768)) + U.head * 64;
    const h16* G = (const h16*)(p.ws + WS_G) + (size_t)rowq * 1024 + colbase;
    h16* Oo = (h16*)(p.ws + WS_O16) + (size_t)rowq * 1024 + colbase;
    float sc = 1.f;
    if (MODE == 1) {
        float ss = 0.f;
#pragma unroll
        for (int m = 0; m < 2; ++m)
#pragma unroll
            for (int i = 0; i < 16; ++i) ss = fmaf(O[m][i], O[m][i], ss);
        ss += __shfl_xor(ss, 32);
        sc = (1.0f / sqrtf(ss * (1.0f / 64.0f) + EPS)) * 0.8f;
    }
#pragma unroll
    for (int m = 0; m < 2; ++m)
#pragma unroll
        for (int g4 = 0; g4 < 4; ++g4) {
            const int dv = 32 * m + 8 * g4 + 4 * hh;
            const h16x4 gv = *(const h16x4*)(G + dv);
            h16x4 o4;
#pragma unroll
            for (int e = 0; e < 4; ++e) {
                float o = O[m][4 * g4 + e];
                if (MODE == 1) o = o * sc * p.in[18][dv + e];
                o4[e] = (h16)(o * silu((float)gv[e]));
            }
            *(h16x4*)(Oo + dv) = o4;
        }
}

__device__ __forceinline__ AttnUnit unit_zero() {
    AttnUnit U; U.row0 = 0; U.nwaves = 0; U.ntiles = 0; U.chunk0 = 0; U.chunk_step = 0; U.qpos0 = 0; U.head = 0; U.Kh = nullptr; U.VTh = nullptr; U.ldk = 0; U.ldv = 0;
    U.Kc = nullptr; U.Vc = nullptr; U.Kn = nullptr; U.Vn = nullptr; U.ldf = 0; U.ntc = 0; U.mask = nullptr; U.ldm = 0; return U;
}

#define ZIGZAG_LOOP(NALL) for (int zk_ = 0, pos_ = 0; zk_ * (int)gridDim.x < (NALL); ++zk_) \
    if ((pos_ = (zk_ & 1) ? (zk_ + 1) * (int)gridDim.x - 1 - (int)blockIdx.x : zk_ * (int)gridDim.x + (int)blockIdx.x) < (NALL))
#define ZIGZAG_LOOP_SWAP(NALL) for (int zi_ = 0, zk_ = 0, pos_ = 0; zi_ * (int)gridDim.x < (NALL); ++zi_) \
    if ((zk_ = (blockIdx.x >= gridDim.x / 2 && zi_ < 4) ? (zi_ ^ 2) : zi_, \
         pos_ = (zk_ & 1) ? (zk_ + 1) * (int)gridDim.x - 1 - (int)blockIdx.x : zk_ * (int)gridDim.x + (int)blockIdx.x) < (NALL))

__device__ void phase2(const Params& p, unsigned char* smem) {
    float s1 = 0.f, s2 = 0.f;
    for (int i = 0; i < 32; ++i) { s1 = fmaf(p.in[19][i], p.in[20][i], s1); s2 = fmaf(p.in[21][i], p.in[22][i], s2); }
    const float lam = expf(s1) - expf(s2) + 0.2f;
    constexpr int N_BP = 1024, N_SP = 1024, N_BS = 128, N_CS = 128, N_SS = 128, N_CP = 512;
    constexpr int N_ALL = N_BP + N_SP + N_BS + N_CS + N_SS + N_CP;
    ZIGZAG_LOOP_SWAP(N_ALL) {
        int it = pos_;
        if (it < N_BP) {
            const int g = 255 - (it >> 2), head = blockIdx.x & 3;
            AttnUnit U = unit_zero();
            U.row0 = 64 * g; U.nwaves = 2; U.ntiles = g + 1; U.chunk0 = g; U.chunk_step = 0; U.qpos0 = 64 * g; U.head = head;
            U.Kh = (const h16*)(p.ws + WS_KB_P) + head * 64; U.ldk = 256;
            U.VTh = (const h16*)(p.ws + WS_VTB_P) + (size_t)(head * 64) * SEQ; U.ldv = SEQ;
            attn_unit<1, false>(p, smem, U, lam);
            continue;
        }
        it -= N_BP;
        if (it < N_SP) { select_unit(p, smem, it); continue; }
        it -= N_SP;
        if (it < N_BS) {
            const int b = it >> 2, head = it & 3;
            AttnUnit U = unit_zero();
            U.row0 = SEQ + 64 * b; U.nwaves = 2; U.ntiles = 17; U.chunk0 = 16; U.chunk_step = 0; U.qpos0 = PAST; U.head = head;
            U.Kc = p.in[6] + (size_t)b * PAST * 256 + head * 64; U.Vc = p.in[7] + (size_t)b * PAST * 256 + head * 64;
            U.Kn = p.out + O_SBK + (size_t)b * DECS * 256 + head * 64; U.Vn = p.out + O_SBV + (size_t)b * DECS * 256 + head * 64;
            U.ldf = 256; U.ntc = 16;
            attn_unit<1, true>(p, smem, U, lam);
            continue;
        }
        it -= N_BS;
        if (it < N_CS) {
            const int b = it >> 2, head = it & 3;
            AttnUnit U = unit_zero();
            U.row0 = SEQ + 64 * b; U.nwaves = 2; U.ntiles = 4; U.head = head;
            U.Kc = p.in[8] + (size_t)b * NMEM * 256 + head * 64; U.Vc = p.in[9] + (size_t)b * NMEM * 256 + head * 64;
            U.Kn = U.Kc; U.Vn = U.Vc; U.ldf = 256; U.ntc = 4;
            attn_unit<2, true>(p, smem, U, lam);
            continue;
        }
        it -= N_CS;
        if (it < N_SS) { select_unit(p, smem, 1024 + it); continue; }
        it -= N_SS;
        {
            const int g = it >> 2, head = it & 3;
            AttnUnit U = unit_zero();
            U.row0 = 128 * g; U.nwaves = 4; U.ntiles = 4; U.head = head;
            U.Kh = (const h16*)(p.ws + WS_MK_P) + head * 64; U.ldk = 256;
            U.VTh = (const h16*)(p.ws + WS_MVT_P) + (size_t)(head * 64) * NMEM; U.ldv = NMEM;
            attn_unit<2, false>(p, smem, U, lam);
        }
    }
    {
        __syncthreads();
        const unsigned* fl = (const unsigned*)(p.ws + WS_REDO) + (size_t)blockIdx.x * REDO_LD;
        const unsigned n = __builtin_amdgcn_readfirstlane((int)__hip_atomic_load(fl, __ATOMIC_RELAXED, __HIP_MEMORY_SCOPE_AGENT));
        for (unsigned i = 0; i < n; ++i) {
            const int row = __builtin_amdgcn_readfirstlane((int)__hip_atomic_load(fl + 1 + i, __ATOMIC_RELAXED, __HIP_MEMORY_SCOPE_AGENT));
            select_item(p, smem, row);
        }
    }
}

__device__ void phase3(const Params& p, unsigned char* smem) {
    constexpr int G_SPLIT = 18, N_HI = (128 - G_SPLIT) * 8, N_AS = 256, N_LO = G_SPLIT * 8;
    ZIGZAG_LOOP(N_HI + N_AS + N_LO) {
        int it = pos_;
        if (it >= N_HI && it < N_HI + N_AS) {
            it -= N_HI;
            const int b = it >> 3, head = blockIdx.x & 7;
            AttnUnit U = unit_zero();
            U.row0 = SEQ + 64 * b; U.nwaves = 2; U.ntiles = 17; U.chunk0 = 16; U.chunk_step = 0; U.qpos0 = PAST; U.head = head;
            U.Kc = p.in[3] + (size_t)b * PAST * 512 + head * 64; U.Vc = p.in[4] + (size_t)b * PAST * 512 + head * 64;
            U.Kn = p.out + O_SAK + (size_t)b * DECS * 512 + head * 64; U.Vn = p.out + O_SAV + (size_t)b * DECS * 512 + head * 64;
            U.ldf = 512; U.ntc = 16;
            U.mask = (const unsigned*)(p.ws + WS_MASK_S) + (size_t)(64 * b) * 34; U.ldm = 34;
            attn_unit<0, true>(p, smem, U, 0.f);
            continue;
        }
        if (it >= N_HI) it -= N_AS;
        {
            const int g = 127 - (it >> 3), head = blockIdx.x & 7;
            AttnUnit U = unit_zero();
            U.row0 = 128 * g; U.nwaves = 4; U.ntiles = 2 * g + 2; U.chunk0 = 2 * g; U.chunk_step = 1; U.qpos0 = 128 * g; U.head = head;
            U.Kh = (const h16*)(p.ws + WS_KA_P) + head * 64; U.ldk = 512;
            U.VTh = (const h16*)(p.ws + WS_VTA_P) + (size_t)(head * 64) * SEQ; U.ldv = SEQ;
            U.mask = (const unsigned*)(p.ws + WS_MASK_P) + (size_t)(128 * g) * 512; U.ldm = 512;
            attn_unit<0, false>(p, smem, U, 0.f);
        }
    }
}

__device__ void phase4(const Params& p, unsigned char* smem) {
    const h16* O16 = (const h16*)(p.ws + WS_O16);
    const h16* WTOUT = (const h16*)(p.ws + WS_WTOUT);
    constexpr int NCT = D / 128, NRT = MROWS / 128;
    const EpiOut eo{};
    const int G = gridDim.x;
    if ((G & 7) == 0) {
        const int xcd = blockIdx.x & 7, local = blockIdx.x >> 3, LG = G >> 3;
        for (int lin = local; lin < (NRT / 8) * NCT; lin += LG) {
            const int rt = xcd + 8 * (lin / NCT), ct = lin % NCT;
            gemm_tile(p, O16, WTOUT, rt * 128, ct * 128, smem, eo);
        }
    } else {
        for (int it = blockIdx.x; it < NCT * NRT; it += gridDim.x) {
            const int rt = it / NCT, ct = it % NCT;
            gemm_tile(p, O16, WTOUT, rt * 128, ct * 128, smem, eo);
        }
    }
}

constexpr int SMEM_BYTES = 80 * 1024;

__device__ __forceinline__ void grid_barrier(unsigned* cnt, unsigned target) {
    asm volatile("s_waitcnt vmcnt(0)" ::: "memory");
    __syncthreads();
    if (threadIdx.x == 0) {
        __builtin_amdgcn_fence(__ATOMIC_RELEASE, "agent");
        asm volatile("s_waitcnt vmcnt(0)" ::: "memory");
        __hip_atomic_fetch_add(cnt, 1u, __ATOMIC_RELAXED, __HIP_MEMORY_SCOPE_AGENT);
        while (__hip_atomic_load(cnt, __ATOMIC_RELAXED, __HIP_MEMORY_SCOPE_AGENT) < target) __builtin_amdgcn_s_sleep(2);
        __builtin_amdgcn_fence(__ATOMIC_ACQUIRE, "agent");
        asm volatile("s_waitcnt vmcnt(0)" ::: "memory");
    }
    __syncthreads();
}

__global__ void __launch_bounds__(NT, 2) fwd_kernel(Params p) {
    __shared__ __attribute__((aligned(16))) unsigned char smem[SMEM_BYTES];
    static_assert(ATT_LDS <= SMEM_BYTES && sizeof(SmemDsa) <= SMEM_BYTES && sizeof(SelSm) <= SMEM_BYTES && CS_LD * 128 * 4 <= SMEM_BYTES, "smem");
    cg::grid_group grid = cg::this_grid();
    unsigned nbar = 0;
    for (int ph = p.ph_lo; ph < p.ph_hi; ++ph) {
#ifndef REP_PHASE
#define REP_PHASE -1
#endif
        const int nrep = (ph == REP_PHASE) ? 2 : 1;
        for (int rep = 0; rep < nrep; ++rep) {
            if (ph == 0) phase0(p, smem);
            else if (ph == 1) phase1(p, smem);
            else if (ph == 2) phase2(p, smem);
            else if (ph == 3) phase3(p, smem);
            else phase4(p, smem);
            if (rep + 1 < nrep) grid.sync();
        }
        if (ph + 1 < p.ph_hi) {
            if (p.ph_lo > 0) grid.sync();
            else grid_barrier((unsigned*)(p.ws + WS_CTL) + 48, ++nbar * gridDim.x);
        }
    }
}

extern "C" void kernel_launch(void* const* d_in, const int* in_sizes, int n_in, void* d_out, int out_size, void* d_ws, size_t ws_size, hipStream_t stream) {
    static int grid_blocks = 0;
    if (!grid_blocks) {
        int dev = 0, cus = 0, per_cu = 0;
        (void)hipGetDevice(&dev);
        (void)hipDeviceGetAttribute(&cus, hipDeviceAttributeMultiprocessorCount, dev);
        (void)hipOccupancyMaxActiveBlocksPerMultiprocessor(&per_cu, fwd_kernel, NT, 0);
        if (per_cu < 1) per_cu = 1;
        grid_blocks = cus * per_cu;
        if (ws_size < WS_END) fprintf(stderr, "kernel_launch: workspace too small: %zu < %zu\n", ws_size, (size_t)WS_END);
    }
    if (ws_size < WS_END) return;
    (void)hipMemsetAsync((unsigned char*)d_ws + WS_CTL, 0, 256 + (size_t)2048 * REDO_LD * 4, stream);
    Params p{};
    for (int i = 0; i < 27; ++i) p.in[i] = (const float*)d_in[i];
    p.out = (float*)d_out; p.ws = (unsigned char*)d_ws;
#if ONE_LAUNCH
    p.ph_lo = 0; p.ph_hi = 5;
    void* args[] = {&p};
    hipError_t e = hipLaunchCooperativeKernel((void*)fwd_kernel, dim3(grid_blocks), dim3(NT), args, 0, stream);
    if (e != hipSuccess) fprintf(stderr, "cooperative launch failed: %s (grid %d)\n", hipGetErrorString(e), grid_blocks);
#else
    for (int ph = 0; ph < 5; ++ph) {
        p.ph_lo = ph; p.ph_hi = ph + 1;
        hipLaunchKernelGGL(fwd_kernel, dim3(grid_blocks), dim3(NT), 0, stream, p);
    }
#endif
}
```

```cpp
#include <hip/hip_runtime.h>
#include <hip/hip_cooperative_groups.h>
#include <cstdio>
#include <cstdint>
namespace cg = cooperative_groups;

#define NT 256
#define ONE_LAUNCH 1

constexpr int D = 1024, SEQ = 16384, DECB = 32, DECS = 64, PAST = 1024, NMEM = 256;
constexpr int MROWS = SEQ + DECB * DECS;
constexpr int DIN = 3880;
constexpr int LDP = 264;
constexpr int PC_IQ = 0, PC_IW = 256;
constexpr float EPS = 1e-6f;

constexpr size_t O_YP = 0, O_YS = 16777216, O_PAK = 18874368, O_PAV = 27262976, O_PAKI = 35651584, O_PBK = 36175872,
                 O_PBV = 40370176, O_PMK = 44564480, O_PMV = 44630016, O_SAK = 44695552, O_SAV = 45744128,
                 O_SAKI = 46792704, O_SBK = 46858240, O_SBV = 47382528;

typedef _Float16 h16;
typedef h16 h16x2 __attribute__((ext_vector_type(2)));
typedef h16 h16x4 __attribute__((ext_vector_type(4)));
typedef h16 h16x8 __attribute__((ext_vector_type(8)));
typedef float f32x4 __attribute__((ext_vector_type(4)));
typedef unsigned u32x4 __attribute__((ext_vector_type(4)));
typedef __bf16 bf16x8 __attribute__((ext_vector_type(8)));
typedef __bf16 bf16x2 __attribute__((ext_vector_type(2)));
typedef float f32x2 __attribute__((ext_vector_type(2)));
__device__ __forceinline__ unsigned pkbf(float a, float b) { const f32x2 v = {a, b}; return __builtin_bit_cast(unsigned, __builtin_convertvector(v, bf16x2)); }
typedef float f32x16 __attribute__((ext_vector_type(16)));

constexpr int NPAD_IN = 3968;
constexpr float LOG2E = 1.4426950408889634f;
constexpr size_t WS_XH = 0;
constexpr size_t WS_O16 = WS_XH;
constexpr size_t WS_HMH = WS_XH + (size_t)MROWS * D * 2;
constexpr size_t WS_WTIN = WS_HMH + (size_t)NMEM * D * 2;
constexpr size_t WS_WTOUT = WS_WTIN + (size_t)NPAD_IN * D * 2;
constexpr size_t WS_WTMEM = WS_WTOUT + (size_t)D * D * 2;
constexpr size_t WS_QA = WS_WTMEM + (size_t)512 * D * 2;
constexpr size_t WS_QB = WS_QA + (size_t)MROWS * 512 * 2;
constexpr size_t WS_QC = WS_QB + (size_t)MROWS * 256 * 2;
constexpr size_t WS_G = WS_QC + (size_t)MROWS * 256 * 2;
constexpr size_t WS_KB_P = WS_G + (size_t)MROWS * 1024 * 2;
constexpr size_t WS_VTB_P = WS_KB_P + (size_t)SEQ * 256 * 2;
constexpr size_t WS_MK_P = WS_VTB_P + (size_t)SEQ * 256 * 2;
constexpr size_t WS_MVT_P = WS_MK_P + (size_t)NMEM * 256 * 2;
constexpr size_t WS_KA_P = WS_MVT_P + (size_t)NMEM * 256 * 2;
constexpr size_t WS_VTA_P = WS_KA_P + (size_t)SEQ * 512 * 2;
constexpr size_t WS_MASK_P = WS_VTA_P + (size_t)SEQ * 512 * 2;
constexpr size_t WS_MASK_S = WS_MASK_P + (size_t)SEQ * 512 * 4;
constexpr size_t WS_IQ16 = WS_MASK_S + (size_t)DECB * DECS * 34 * 4;
constexpr size_t WS_IK_P = WS_IQ16 + (size_t)MROWS * 256 * 2;
constexpr size_t WS_IK_S = WS_IK_P + (size_t)SEQ * 32 * 2;
constexpr size_t WS_CTL = WS_IK_S + (size_t)DECB * (PAST + DECS) * 32 * 2;
constexpr int REDO_LD = 64;
constexpr size_t WS_REDO = WS_CTL + 256;
constexpr size_t WS_P = WS_REDO + (size_t)2048 * REDO_LD * 4;
constexpr size_t WS_END = WS_P + (size_t)MROWS * LDP * 4;

struct Params {
    const float* in[27];
    float* out;
    unsigned char* ws;
    int ph_lo, ph_hi;
};

__device__ __forceinline__ float wave_sum(float v) {
#pragma unroll
    for (int o = 1; o < 64; o <<= 1) v += __shfl_xor(v, o);
    return v;
}
__device__ __forceinline__ float wave_max(float v) {
#pragma unroll
    for (int o = 1; o < 64; o <<= 1) v = fmaxf(v, __shfl_xor(v, o));
    return v;
}
__device__ __forceinline__ float silu(float x) { return x / (1.0f + expf(-x)); }

__device__ __forceinline__ int rel_bucket(int rel) {
    const int ret = rel > 0 ? 16 : 0;
    const int n = rel < 0 ? -rel : rel;
    int b;
    if (n < 8) b = n;
    else if (n < 12) b = 8;
    else if (n < 16) b = 9;
    else if (n < 23) b = 10;
    else if (n < 32) b = 11;
    else if (n < 46) b = 12;
    else if (n < 64) b = 13;
    else if (n < 91) b = 14;
    else b = 15;
    return ret + b;
}

__device__ __forceinline__ void rms_row_h(const float* x, const float* g, h16* o, int lane) {
    const float4* xr = (const float4*)x;
    const float4* gr = (const float4*)g;
    float4 v[4];
    float s = 0.f;
#pragma unroll
    for (int j = 0; j < 4; ++j) { v[j] = xr[lane + 64 * j]; s += v[j].x * v[j].x + v[j].y * v[j].y + v[j].z * v[j].z + v[j].w * v[j].w; }
    s = wave_sum(s);
    const float r = 1.0f / sqrtf(s * (1.0f / 1024.0f) + EPS);
#pragma unroll
    for (int j = 0; j < 4; ++j) {
        const float4 gg = gr[lane + 64 * j];
        h16x4 o4; o4.x = (h16)(v[j].x * r * gg.x); o4.y = (h16)(v[j].y * r * gg.y); o4.z = (h16)(v[j].z * r * gg.z); o4.w = (h16)(v[j].w * r * gg.w);
        ((h16x4*)o)[lane + 64 * j] = o4;
    }
}

__device__ __forceinline__ void transpose_item(const float* __restrict__ W, int ldw, int c0, int nvalid, int k0, h16* __restrict__ WT, int r0, float* scr, int lane) {
#pragma unroll 8
    for (int i = 0; i < 32; ++i) {
        const int kk = 2 * i + (lane >> 5), n = lane & 31;
        scr[kk * 33 + n] = (n < nvalid) ? W[(size_t)(k0 + kk) * ldw + c0 + n] : 0.f;
    }
    asm volatile("s_waitcnt lgkmcnt(0)" ::: "memory");
    const int c = lane & 7;
#pragma unroll
    for (int j = 0; j < 4; ++j) {
        const int n = (lane >> 3) + 8 * j;
        const float* s = scr + (8 * c) * 33 + n;
        h16x8 o;
#pragma unroll
        for (int e = 0; e < 8; ++e) o[e] = (h16)s[e * 33];
        *(h16x8*)(WT + (size_t)(r0 + n) * 1024 + k0 + 8 * c) = o;
    }
    asm volatile("s_waitcnt lgkmcnt(0)" ::: "memory");
}

__device__ __forceinline__ int inproj_col(int np) { return np < 2304 ? np : (np < 3840 ? np + 40 : np - 3840 + 2304); }

__device__ void phase0(const Params& p, unsigned char* smem) {
    const int lane = threadIdx.x & 63, w = threadIdx.x >> 6;
    const int gw = blockIdx.x * 4 + w, ngw = gridDim.x * 4;
    h16* XH = (h16*)(p.ws + WS_XH);
    h16* HMH = (h16*)(p.ws + WS_HMH);
    h16* WTIN = (h16*)(p.ws + WS_WTIN);
    h16* WTOUT = (h16*)(p.ws + WS_WTOUT);
    h16* WTMEM = (h16*)(p.ws + WS_WTMEM);
    float* scr = (float*)smem + w * (64 * 33);
    constexpr int N_ROWS = MROWS + NMEM;
    constexpr int I_IN = 16 * (NPAD_IN / 32), I_OUT = 16 * 32, I_MEM = 16 * 16, I_KIDX = DECB * (PAST / 64);
    for (int it = gw; it < N_ROWS + I_IN + I_OUT + I_MEM + I_KIDX; it += ngw) {
        if (it < N_ROWS) {
            const int r = it;
            if (r < SEQ) rms_row_h(p.in[0] + (size_t)r * D, p.in[11], XH + (size_t)r * D, lane);
            else if (r < MROWS) rms_row_h(p.in[1] + (size_t)(r - SEQ) * D, p.in[11], XH + (size_t)r * D, lane);
            else rms_row_h(p.in[2] + (size_t)(r - MROWS) * D, p.in[25], HMH + (size_t)(r - MROWS) * D, lane);
        } else if (it < N_ROWS + I_IN) {
            const int r = it - N_ROWS, nb = r % (NPAD_IN / 32), kb = r / (NPAD_IN / 32);
            const int np0 = nb * 32;
            int nvalid = DIN - np0; nvalid = nvalid < 0 ? 0 : (nvalid > 32 ? 32 : nvalid);
            const int c0 = nvalid > 0 ? inproj_col(np0) : 0;
            transpose_item(p.in[12], DIN, c0, nvalid, kb * 64, WTIN, np0, scr, lane);
        } else if (it < N_ROWS + I_IN + I_OUT) {
            const int r = it - N_ROWS - I_IN, nb = r % 32, kb = r / 32;
            transpose_item(p.in[13], D, nb * 32, 32, kb * 64, WTOUT, nb * 32, scr, lane);
        } else if (it < N_ROWS + I_IN + I_OUT + I_MEM) {
            const int r = it - N_ROWS - I_IN - I_OUT, nb = r % 16, kb = r / 16;
            transpose_item(p.in[26], 512, nb * 32, 32, kb * 64, WTMEM, nb * 32, scr, lane);
        } else {
            const int r = it - N_ROWS - I_IN - I_OUT - I_MEM, b = r / (PAST / 64), key = (r % (PAST / 64)) * 64 + lane;
            const f32x4* src = (const f32x4*)(p.in[5] + ((size_t)b * PAST + key) * 32);
            h16* dst = (h16*)(p.ws + WS_IK_S) + ((size_t)b * (PAST + DECS) + key) * 32;
            float ss = 0.f;
#pragma unroll
            for (int c = 0; c < 4; ++c) {
                const f32x4 x0 = src[2 * c], x1 = src[2 * c + 1];
                h16x8 o;
#pragma unroll
                for (int e = 0; e < 4; ++e) { o[e] = (h16)x0[e]; o[4 + e] = (h16)x1[e]; ss = fmaf(x0[e], x0[e], ss); ss = fmaf(x1[e], x1[e], ss); }
                *(h16x8*)(dst + 8 * c) = o;
            }
            ss = wave_max(ss);
            if (lane == 0) atomicMax((unsigned*)(p.ws + WS_CTL) + 1 + b, __float_as_uint(ss));
        }
    }
}

constexpr int CS_LD = 132;
template <class Epi>
__device__ __forceinline__ void gemm_tile(const Params& p, const h16* __restrict__ A, const h16* __restrict__ Bt, int m0, int n0, unsigned char* smem, const Epi& epi) {
    int tid = threadIdx.x; asm volatile("" : "+v"(tid));
    const int lane = tid & 63, wid = tid >> 6, wm = wid >> 1, wn = wid & 1;
    const int l31 = lane & 31, hh = lane >> 5;
    f32x16 acc[2][2];
#pragma unroll
    for (int a = 0; a < 2; ++a)
#pragma unroll
        for (int b = 0; b < 2; ++b)
#pragma unroll
            for (int r = 0; r < 16; ++r) acc[a][b][r] = 0.f;
    const unsigned char* agl[4]; const unsigned char* bgl[4]; int ldo[4];
#pragma unroll
    for (int i = 0; i < 4; ++i) {
        const int row = 32 * wid + 8 * i + (lane >> 3), slot = lane & 7, ch = slot ^ ((row >> 1) & 7);
        agl[i] = (const unsigned char*)(A + (size_t)(m0 + row) * 1024 + ch * 8);
        bgl[i] = (const unsigned char*)(Bt + (size_t)(n0 + row) * 1024 + ch * 8);
        ldo[i] = (32 * wid + 8 * i) * 128;
    }
#define GT_DMA(stage_, kt_) do { const int ko_ = ((kt_) < 15 ? (kt_) : 15) * 128; \
        _Pragma("unroll") for (int i = 0; i < 4; ++i) { \
            __builtin_amdgcn_global_load_lds((const unsigned*)(agl[i] + ko_), (__attribute__((address_space(3))) unsigned*)(smem + (stage_) * 32768 + ldo[i]), 16, 0, 0); \
            __builtin_amdgcn_global_load_lds((const unsigned*)(bgl[i] + ko_), (__attribute__((address_space(3))) unsigned*)(smem + (stage_) * 32768 + 16384 + ldo[i]), 16, 0, 0); } } while (0)
    const int sw = (l31 >> 1) & 7;
    const int arow = (wm * 64 + l31) * 128, brow = (wn * 64 + l31) * 128;
    __syncthreads();
    GT_DMA(0, 0);
    __syncthreads();
    for (int kt = 0; kt < 16; ++kt) {
        const unsigned char* As = smem + (kt & 1) * 32768; const unsigned char* Bs = As + 16384;
        GT_DMA((kt + 1) & 1, kt + 1);
#pragma unroll
        for (int s = 0; s < 4; ++s) {
            const int co = (((2 * s + hh) ^ sw) << 4);
            h16x8 a[2], b[2];
#pragma unroll
            for (int mt = 0; mt < 2; ++mt) a[mt] = *(const h16x8*)(As + arow + mt * 32 * 128 + co);
#pragma unroll
            for (int nt = 0; nt < 2; ++nt) b[nt] = *(const h16x8*)(Bs + brow + nt * 32 * 128 + co);
#pragma unroll
            for (int mt = 0; mt < 2; ++mt)
#pragma unroll
                for (int nt = 0; nt < 2; ++nt) acc[mt][nt] = __builtin_amdgcn_mfma_f32_32x32x16_f16(a[mt], b[nt], acc[mt][nt], 0, 0, 0);
        }
        __syncthreads();
    }
#undef GT_DMA
    float* Cs = (float*)smem;
#pragma unroll
    for (int mt = 0; mt < 2; ++mt)
#pragma unroll
        for (int nt = 0; nt < 2; ++nt)
#pragma unroll
            for (int r = 0; r < 16; ++r) {
                const int row = wm * 64 + mt * 32 + (r & 3) + 8 * (r >> 2) + 4 * hh, col = wn * 64 + nt * 32 + l31;
                Cs[row * CS_LD + col] = acc[mt][nt][r];
            }
    __syncthreads();
    epi(p, Cs, m0, n0, tid);
}

__device__ __forceinline__ float group_sum16(float v) { v += __shfl_xor(v, 1); v += __shfl_xor(v, 2); v += __shfl_xor(v, 4); v += __shfl_xor(v, 8); return v; }
__device__ __forceinline__ float group_sum8(float v) { v += __shfl_xor(v, 1); v += __shfl_xor(v, 2); v += __shfl_xor(v, 4); return v; }

struct Seg {
    float* bp; float* bs; int ld; int col; int norm; const float* gain;
    h16* hp; h16* hs; int hld; int hcol; float hscale;
    int vt; int head;
};

__device__ __forceinline__ Seg seg_of(const Params& p, int n0) {
    float* P = (float*)(p.ws + WS_P);
    float* out = p.out;
    h16* QA = (h16*)(p.ws + WS_QA); h16* QB = (h16*)(p.ws + WS_QB); h16* QC = (h16*)(p.ws + WS_QC); h16* G = (h16*)(p.ws + WS_G);
    Seg s; s.norm = 0; s.gain = nullptr; s.hp = nullptr; s.hs = nullptr; s.hld = 0; s.hcol = 0; s.hscale = 1.f; s.vt = 0; s.head = 0;
    s.bp = nullptr; s.bs = nullptr; s.ld = 0; s.col = 0;
#define SEG_O(op, os, ldv, c) do { s.bp = out + (op); s.bs = out + (os) - (size_t)SEQ * (ldv); s.ld = (ldv); s.col = (c); } while (0)
#define SEG_H(ptr, ldv, c, sc) do { s.hp = (ptr); s.hs = (ptr); s.hld = (ldv); s.hcol = (c); s.hscale = (sc); } while (0)
    if (n0 < 512) { s.norm = 64; s.gain = p.in[14]; SEG_H(QA, 512, n0, 0.125f * LOG2E); }
    else if (n0 < 1024) { SEG_O(O_PAK, O_SAK, 512, n0 - 512); s.norm = 64; s.gain = p.in[15]; s.hp = (h16*)(p.ws + WS_KA_P); s.hs = nullptr; s.hld = 512; s.hcol = n0 - 512; }
    else if (n0 < 1536) { SEG_O(O_PAV, O_SAV, 512, n0 - 1024); s.vt = 1; s.head = (n0 - 1024) >> 6; }
    else if (n0 < 2048) { SEG_H(G, 1024, n0 - 1536, 1.f); }
    else if (n0 < 2304) { s.bp = P; s.bs = P; s.ld = LDP; s.col = PC_IQ + n0 - 2048; SEG_H((h16*)(p.ws + WS_IQ16), 256, n0 - 2048, 1.f); }
    else if (n0 < 2560) { s.norm = 32; s.gain = p.in[16]; SEG_H(QB, 256, n0 - 2304, 0.17677669529663687f * LOG2E); }
    else if (n0 < 2816) { SEG_O(O_PBK, O_SBK, 256, n0 - 2560); s.norm = 32; s.gain = p.in[17]; s.hp = (h16*)(p.ws + WS_KB_P); s.hs = nullptr; s.hld = 256; s.hcol = n0 - 2560; }
    else if (n0 < 3072) { SEG_O(O_PBV, O_SBV, 256, n0 - 2816); s.vt = 2; s.head = (n0 - 2816) >> 6; }
    else if (n0 < 3328) { SEG_H(G, 1024, 512 + n0 - 3072, 1.f); }
    else if (n0 < 3584) { s.norm = 64; s.gain = p.in[23]; SEG_H(QC, 256, n0 - 3328, 0.125f * LOG2E); }
    else { SEG_H(G, 1024, 768 + n0 - 3584, 1.f); }
#undef SEG_O
#undef SEG_H
    return s;
}

__device__ __forceinline__ void vt_store(const float* Cs, int j, h16* dst_base, size_t ldv, int tid) {
    const int dv = tid & 63, rq = tid >> 6;
    h16* dst = dst_base + (size_t)dv * ldv + 32 * rq;
#pragma unroll
    for (int e8 = 0; e8 < 4; ++e8) {
        u32x4 o;
#pragma unroll
        for (int e = 0; e < 4; ++e) o[e] = pkbf(Cs[(32 * rq + 8 * e8 + 2 * e) * CS_LD + 64 * j + dv], Cs[(32 * rq + 8 * e8 + 2 * e + 1) * CS_LD + 64 * j + dv]);
        *(u32x4*)(dst + 8 * e8) = o;
    }
}

struct EpiIn {
    __device__ __forceinline__ void operator()(const Params& p, const float* Cs, int m0, int n0, int tid) const {
        const int cg = tid & 15, r0 = tid >> 4;
#pragma unroll 1
        for (int j = 0; j < 2; ++j) {
            const int n0j = n0 + 64 * j;
            if (n0j >= DIN) continue;
            if (n0j == 3840) {
                float* P = (float*)(p.ws + WS_P);
                float mx0 = 0.f, mx1 = 0.f;
#pragma unroll 1
                for (int i = 0; i < 8; ++i) {
                    const int rl = r0 + 16 * i, row = m0 + rl;
                    const float4 v = *(const float4*)&Cs[rl * CS_LD + 4 * cg];
                    float ss = (cg < 8) ? (v.x * v.x + v.y * v.y + v.z * v.z + v.w * v.w) : 0.f;
                    ss = group_sum8(ss);
                    if (i < 4) mx0 = fmaxf(mx0, ss); else mx1 = fmaxf(mx1, ss);
                    if (cg < 8) {
                        float* dst = (row < SEQ ? p.out + O_PAKI + (size_t)row * 32 : p.out + O_SAKI + (size_t)(row - SEQ) * 32) + 4 * cg; *(float4*)dst = v;
                        h16x4 hv; hv.x = (h16)v.x; hv.y = (h16)v.y; hv.z = (h16)v.z; hv.w = (h16)v.w;
                        h16* hd = row < SEQ ? (h16*)(p.ws + WS_IK_P) + (size_t)row * 32 : (h16*)(p.ws + WS_IK_S) + ((size_t)((row - SEQ) >> 6) * (PAST + DECS) + PAST + ((row - SEQ) & 63)) * 32;
                        *(h16x4*)(hd + 4 * cg) = hv;
                    }
                    else if (cg < 10) { *(float4*)(P + (size_t)row * LDP + PC_IW + 4 * (cg - 8)) = v; }
                }
                if (cg == 0) {
                    unsigned* ctl = (unsigned*)(p.ws + WS_CTL);
                    if (m0 < SEQ) atomicMax(ctl, __float_as_uint(fmaxf(mx0, mx1)));
                    else { const int b0 = (m0 - SEQ) >> 6; atomicMax(ctl + 1 + b0, __float_as_uint(mx0)); atomicMax(ctl + 2 + b0, __float_as_uint(mx1)); }
                }
                continue;
            }
            const Seg s = seg_of(p, n0j);
            float4 g4 = make_float4(1.f, 1.f, 1.f, 1.f);
            if (s.norm == 64) g4 = *(const float4*)(s.gain + 4 * cg);
            else if (s.norm == 32) g4 = *(const float4*)(s.gain + ((4 * cg) & 31));
#pragma unroll 1
            for (int i = 0; i < 8; ++i) {
                const int rl = r0 + 16 * i, row = m0 + rl;
                float4 v = *(const float4*)&Cs[rl * CS_LD + 64 * j + 4 * cg];
                if (s.norm) {
                    float ss = v.x * v.x + v.y * v.y + v.z * v.z + v.w * v.w;
                    float sc;
                    if (s.norm == 64) { ss = group_sum16(ss); sc = 1.0f / sqrtf(ss * (1.0f / 64.0f) + EPS); }
                    else { ss = group_sum8(ss); sc = 1.0f / sqrtf(ss * (1.0f / 32.0f) + EPS); }
                    v.x *= sc * g4.x; v.y *= sc * g4.y; v.z *= sc * g4.z; v.w *= sc * g4.w;
                }
                if (s.bp) *(float4*)((row < SEQ ? s.bp : s.bs) + (size_t)row * s.ld + s.col + 4 * cg) = v;
                h16* hb = row < SEQ ? s.hp : s.hs;
                if (hb) {
                    h16x4 hv; hv.x = (h16)(v.x * s.hscale); hv.y = (h16)(v.y * s.hscale); hv.z = (h16)(v.z * s.hscale); hv.w = (h16)(v.w * s.hscale);
                    *(h16x4*)(hb + (size_t)row * s.hld + s.hcol + 4 * cg) = hv;
                }
            }
            if (s.vt == 2 && m0 < SEQ) vt_store(Cs, j, (h16*)(p.ws + WS_VTB_P) + (size_t)(s.head * 64) * SEQ + m0, SEQ, tid);
            if (s.vt == 1 && m0 < SEQ) vt_store(Cs, j, (h16*)(p.ws + WS_VTA_P) + (size_t)(s.head * 64) * SEQ + m0, SEQ, tid);
        }
    }
};

struct EpiMem {
    __device__ __forceinline__ void operator()(const Params& p, const float* Cs, int m0, int n0, int tid) const {
        const int cg = tid & 15, r0 = tid >> 4;
#pragma unroll 1
        for (int j = 0; j < 2; ++j) {
            const int n0j = n0 + 64 * j;
            const bool isk = n0j < 256;
            const float4 g4 = isk ? *(const float4*)(p.in[24] + 4 * cg) : make_float4(1.f, 1.f, 1.f, 1.f);
#pragma unroll 1
            for (int i = 0; i < 8; ++i) {
                const int rl = r0 + 16 * i, row = m0 + rl;
                float4 v = *(const float4*)&Cs[rl * CS_LD + 64 * j + 4 * cg];
                if (isk) {
                    float ss = group_sum16(v.x * v.x + v.y * v.y + v.z * v.z + v.w * v.w);
                    const float sc = 1.0f / sqrtf(ss * (1.0f / 64.0f) + EPS);
                    v.x *= sc * g4.x; v.y *= sc * g4.y; v.z *= sc * g4.z; v.w *= sc * g4.w;
                    h16x4 hv; hv.x = (h16)v.x; hv.y = (h16)v.y; hv.z = (h16)v.z; hv.w = (h16)v.w;
                    *(h16x4*)((h16*)(p.ws + WS_MK_P) + (size_t)row * 256 + n0j + 4 * cg) = hv;
                }
                float* dst = p.out + (isk ? O_PMK : O_PMV) + (size_t)row * 256 + (isk ? n0j : n0j - 256) + 4 * cg;
                *(float4*)dst = v;
            }
            if (!isk) vt_store(Cs, j, (h16*)(p.ws + WS_MVT_P) + (size_t)(((n0j - 256) >> 6) * 64) * NMEM + m0, NMEM, tid);
        }
    }
};

struct EpiOut {
    __device__ __forceinline__ void operator()(const Params& p, const float* Cs, int m0, int n0, int tid) const {
        const int cg = tid & 15, r0 = tid >> 4;
#pragma unroll 1
        for (int i = 0; i < 8; ++i) {
            const int rl = r0 + 16 * i, row = m0 + rl;
            const float* x = (row < SEQ ? p.in[0] + (size_t)row * D : p.in[1] + (size_t)(row - SEQ) * D) + n0 + 4 * cg;
            float* y = (row < SEQ ? p.out + O_YP + (size_t)row * D : p.out + O_YS + (size_t)(row - SEQ) * D) + n0 + 4 * cg;
#pragma unroll
            for (int j = 0; j < 2; ++j) {
                const float4 v = *(const float4*)&Cs[rl * CS_LD + 64 * j + 4 * cg];
                const float4 xv = *(const float4*)(x + 64 * j);
                *(float4*)(y + 64 * j) = make_float4(xv.x + v.x, xv.y + v.y, xv.z + v.z, xv.w + v.w);
            }
        }
    }
};

__device__ void phase1(const Params& p, unsigned char* smem) {
    const h16* XH = (const h16*)(p.ws + WS_XH);
    const h16* HMH = (const h16*)(p.ws + WS_HMH);
    const h16* WTIN = (const h16*)(p.ws + WS_WTIN);
    const h16* WTMEM = (const h16*)(p.ws + WS_WTMEM);
    const EpiIn ein{}; const EpiMem emem{};
    const int G = gridDim.x;
    if ((G & 7) == 0) {
        const int xcd = blockIdx.x & 7, local = blockIdx.x >> 3, LG = G >> 3;
        for (int lin = local; lin < 6 * 96; lin += LG) {
            const int rgroup = lin / 96, rem = lin % 96, chalf = rem / 48, rem2 = rem % 48, r = rem2 >> 4, c = chalf * 16 + (rem2 & 15);
            if (c >= 31) continue;
            const int rt = xcd + 8 * (rgroup * 3 + r);
            gemm_tile(p, XH, WTIN, rt * 128, c * 128, smem, ein);
        }
        if (blockIdx.x < 8) { const int rt = blockIdx.x / 4, ct = blockIdx.x % 4; gemm_tile(p, HMH, WTMEM, rt * 128, ct * 128, smem, emem); }
    } else {
        constexpr int NCT = NPAD_IN / 128, NRT = MROWS / 128;
        constexpr int N_IN = NCT * NRT, N_MEM = 2 * 4;
        for (int it = blockIdx.x; it < N_IN + N_MEM; it += gridDim.x) {
            if (it < N_IN) { const int rt = it / NCT, ct = it % NCT; gemm_tile(p, XH, WTIN, rt * 128, ct * 128, smem, ein); }
            else { const int im = it - N_IN, rt = im / 4, ct = im % 4; gemm_tile(p, HMH, WTMEM, rt * 128, ct * 128, smem, emem); }
        }
    }
}

struct KeySrc {
    const float* cache; const float* fresh; int past; int ld;
    __device__ __forceinline__ const float* row(int k) const { return k < past ? cache + (size_t)k * ld : fresh + (size_t)(k - past) * ld; }
};

__device__ __forceinline__ unsigned fkey(float f) { const unsigned u = __float_as_uint(f); return (u & 0x80000000u) ? ~u : (u | 0x80000000u); }

struct SmemDsa {
    float sc[16384];
    float iq[256]; float iw[8];
    unsigned hist[256]; unsigned mw[512];
    int wcnt[4]; int wcnt2[4]; int misc[4];
};

__device__ void select_item(const Params& p, unsigned char* smem, int item) {
    SmemDsa& S = *(SmemDsa*)smem;
    int tid = threadIdx.x; asm volatile("" : "+v"(tid));
    const int lane = tid & 63, w = tid >> 6;
    const float* P = (const float*)(p.ws + WS_P);
    int row, N; KeySrc ki; unsigned* mout;
    if (item < SEQ) {
        row = item; N = 64 * (item / 64 + 1);
        ki = KeySrc{nullptr, p.out + O_PAKI, 0, 32};
        mout = (unsigned*)(p.ws + WS_MASK_P) + (size_t)item * 512;
    } else {
        const int bt = item - SEQ, b = bt / DECS;
        row = item; N = PAST + DECS;
        ki = KeySrc{p.in[5] + (size_t)b * PAST * 32, p.out + O_SAKI + (size_t)b * DECS * 32, PAST, 32};
        mout = (unsigned*)(p.ws + WS_MASK_S) + (size_t)bt * 34;
    }
    const int nw = N / 32;
    __syncthreads();
    if (N <= 256) {
        if (tid < nw) mout[tid] = 0xffffffffu;
        return;
    }
    S.iq[tid] = P[(size_t)row * LDP + PC_IQ + tid];
    if (tid < 8) S.iw[tid] = P[(size_t)row * LDP + PC_IW + tid];
    S.mw[tid] = 0u; S.mw[tid + 256] = 0u;
    __syncthreads();
    for (int k = tid; k < N; k += NT) {
        const float4* kr = (const float4*)ki.row(k);
        float kd[32];
#pragma unroll
        for (int i = 0; i < 8; ++i) { const float4 t4 = kr[i]; kd[4 * i] = t4.x; kd[4 * i + 1] = t4.y; kd[4 * i + 2] = t4.z; kd[4 * i + 3] = t4.w; }
        float score = 0.f;
#pragma unroll 1
        for (int h = 0; h < 8; ++h) {
            float d = 0.f;
#pragma unroll
            for (int i = 0; i < 32; ++i) d = fmaf(S.iq[h * 32 + i], kd[i], d);
            score = fmaf(S.iw[h], fmaxf(d, 0.f), score);
        }
        S.sc[k] = score;
    }
    __syncthreads();
    unsigned prefix = 0; int remaining = 256;
    for (int pass = 0; pass < 4; ++pass) {
        const int shift = 24 - 8 * pass;
        S.hist[tid] = 0;
        __syncthreads();
        for (int k = tid; k < N; k += NT) {
            const unsigned key = fkey(S.sc[k]);
            if (pass == 0 || (key >> (shift + 8)) == prefix) atomicAdd(&S.hist[(key >> shift) & 255u], 1u);
        }
        __syncthreads();
        const int hv = (int)S.hist[tid];
        int x = hv;
#pragma unroll
        for (int o = 1; o < 64; o <<= 1) { const int y = __shfl_down(x, o); if (lane + o < 64) x += y; }
        if (lane == 0) S.wcnt[w] = x;
        __syncthreads();
        int above = x - hv;
        for (int w2 = w + 1; w2 < 4; ++w2) above += S.wcnt[w2];
        if (above < remaining && remaining <= above + hv) { S.misc[0] = (int)((prefix << 8) | (unsigned)tid); S.misc[1] = remaining - above; }
        __syncthreads();
        prefix = (unsigned)S.misc[0]; remaining = S.misc[1];
        __syncthreads();
    }
    const unsigned T = prefix; const int r = remaining;
    int base_eq = 0;
    const unsigned long long lt = (lane == 0) ? 0ull : (~0ull >> (64 - lane));
    for (int k0 = 0; k0 < N; k0 += NT) {
        const int k = k0 + tid;
        const unsigned key = (k < N) ? fkey(S.sc[k]) : 0u;
        const bool gt = (k < N) && key > T, eq = (k < N) && key == T;
        const unsigned long long beq = __ballot(eq);
        const int eqpre = __popcll(beq & lt);
        if (lane == 0) S.wcnt[w] = __popcll(beq);
        __syncthreads();
        int eqbase = base_eq, eqtot = 0;
        for (int w2 = 0; w2 < 4; ++w2) { const int c = S.wcnt[w2]; if (w2 < w) eqbase += c; eqtot += c; }
        const bool sel = gt || (eq && (eqbase + eqpre) < r);
        const unsigned long long bs = __ballot(sel);
        if (lane == 0) S.mw[(k0 >> 5) + 2 * w] = (unsigned)bs;
        if (lane == 32) S.mw[(k0 >> 5) + 2 * w + 1] = (unsigned)(bs >> 32);
        base_eq += eqtot;
        __syncthreads();
    }
    for (int i = tid; i < nw; i += NT) mout[i] = S.mw[i];
}

typedef float f32x4m __attribute__((ext_vector_type(4)));
constexpr int CAND_CAP = 120;
struct SelSm {
    unsigned hist[16][1025];
    float cand_s[16][CAND_CAP]; int cand_k[16][CAND_CAP];
    int cnt[16]; int bstar[16]; int nabove[16]; int ovf[16];
};

__device__ __forceinline__ void score_tile(const h16x8& a, const h16x8 (&bq)[8], const float (&wq)[8], float (&sc)[4]) {
    sc[0] = 0.f; sc[1] = 0.f; sc[2] = 0.f; sc[3] = 0.f;
#pragma unroll
    for (int h = 0; h < 8; ++h) {
        f32x4m z = {0.f, 0.f, 0.f, 0.f};
        const f32x4m d = __builtin_amdgcn_mfma_f32_16x16x32_f16(a, bq[h], z, 0, 0, 0);
#pragma unroll
        for (int i = 0; i < 4; ++i) { const int bits = (int)__float_as_uint(d[i]); sc[i] = fmaf(wq[h], __uint_as_float((unsigned)(bits > 0 ? bits : 0)), sc[i]); }
    }
}

__device__ __forceinline__ int bin_of(float sc, float inv, float off) {
    int b = (int)fmaf(sc, inv, off);
    b = b < 0 ? 0 : (b > 1021 ? 1021 : b);
    return b + (sc > 0.f ? 2 : (sc == 0.f ? 1 : 0));
}

__device__ void select_unit(const Params& p, unsigned char* smem, int u) {
    SelSm& S = *(SelSm*)smem;
    int tid = threadIdx.x; asm volatile("" : "+v"(tid));
    const int lane = tid & 63, w = __builtin_amdgcn_readfirstlane(tid >> 6), q = lane & 15, g = lane >> 4;
    int row0, N, ldm, kslot; const h16* IK; unsigned* mask;
    if (u < 1024) {
        const int q0 = 16 * (1023 - u);
        row0 = q0; N = 64 * (q0 / 64 + 1); IK = (const h16*)(p.ws + WS_IK_P); mask = (unsigned*)(p.ws + WS_MASK_P) + (size_t)q0 * 512; ldm = 512; kslot = 0;
    } else {
        const int bu = u - 1024, b = bu >> 2, t0 = 16 * (bu & 3);
        row0 = SEQ + 64 * b + t0; N = PAST + DECS; IK = (const h16*)(p.ws + WS_IK_S) + (size_t)b * (PAST + DECS) * 32;
        mask = (unsigned*)(p.ws + WS_MASK_S) + (size_t)(64 * b + t0) * 34; ldm = 34; kslot = 1 + b;
    }
    const int nw = N / 32;
    __syncthreads();
    if (N <= 256) {
        for (int i = tid; i < 16 * nw; i += NT) mask[(size_t)(i / nw) * ldm + (i % nw)] = 0xffffffffu;
        return;
    }
    for (int i = tid; i < 16 * 1025; i += NT) ((unsigned*)S.hist)[i] = 0u;
    if (tid < 16) { S.cnt[tid] = 0; S.ovf[tid] = 0; S.bstar[tid] = 0; S.nabove[tid] = 0; }
    const int rowq = row0 + q;
    const h16* IQ = (const h16*)(p.ws + WS_IQ16) + (size_t)rowq * 256 + 8 * g;
    const float* Pf = (const float*)(p.ws + WS_P) + (size_t)rowq * LDP + PC_IW;
    h16x8 bq[8]; float wq[8];
    float hi = 0.f, lo = 0.f;
#pragma unroll
    for (int h = 0; h < 8; ++h) {
        bq[h] = *(const h16x8*)(IQ + h * 32);
        wq[h] = Pf[h];
        float n2 = 0.f;
#pragma unroll
        for (int e = 0; e < 8; ++e) { const float x = (float)bq[h][e]; n2 = fmaf(x, x, n2); }
        n2 += __shfl_xor(n2, 16); n2 += __shfl_xor(n2, 32);
        const float t = wq[h] * sqrtf(n2);
        if (t > 0.f) hi += t; else lo += t;
    }
    const float kmax = sqrtf(__uint_as_float(((const unsigned*)(p.ws + WS_CTL))[kslot])) * 1.01f;
    hi = hi * kmax + 1e-6f; lo = lo * kmax - 1e-6f;
    const float inv = 1022.0f / fmaxf(hi - lo, 1e-20f), off = -lo * inv;
    __syncthreads();
    const h16* ikp = IK + (size_t)q * 32 + 8 * g;
    const int ngw = (nw - w + 3) >> 2;
#define SEL_LD(dst0, dst1, it_) do { const int gi_ = w + 4 * ((it_) < ngw ? (it_) : ngw - 1); \
        dst0 = *(const h16x8*)(ikp + (size_t)(32 * gi_) * 32); dst1 = *(const h16x8*)(ikp + (size_t)(32 * gi_ + 16) * 32); } while (0)
    {
        h16x8 a0, a1; SEL_LD(a0, a1, 0);
        for (int it = 0; it < ngw; ++it) {
            h16x8 n0, n1; SEL_LD(n0, n1, it + 1);
#pragma unroll
            for (int t = 0; t < 2; ++t) {
                float sc[4]; score_tile(t == 0 ? a0 : a1, bq, wq, sc);
#pragma unroll
                for (int i = 0; i < 4; ++i) { const int b = bin_of(sc[i], inv, off); atomicAdd(&S.hist[q][b], 1u); }
            }
            a0 = n0; a1 = n1;
        }
    }
    __syncthreads();
    for (int qq = 0; qq < 4; ++qq) {
        const int qi = 4 * w + qq;
        unsigned c = 0;
#pragma unroll
        for (int e = 0; e < 16; ++e) c += S.hist[qi][16 * lane + e];
        int x = (int)c;
#pragma unroll
        for (int o = 1; o < 64; o <<= 1) { const int y = __shfl_down(x, o); if (lane + o < 64) x += y; }
        const int above = x - (int)c;
        if (above < 256 && 256 <= above + (int)c) {
            int acc = above, bs = 16 * lane;
            for (int e = 15; e >= 0; --e) {
                const int v = (int)S.hist[qi][16 * lane + e];
                if (acc + v >= 256) { bs = 16 * lane + e; break; }
                acc += v;
            }
            S.bstar[qi] = bs; S.nabove[qi] = acc;
        }
    }
    __syncthreads();
    const int bst = S.bstar[q];
    unsigned* mrow = (unsigned*)S.hist;
    {
        h16x8 a0, a1; SEL_LD(a0, a1, 0);
        for (int it = 0; it < ngw; ++it) {
            h16x8 n0, n1; SEL_LD(n0, n1, it + 1);
            const int grp = w + 4 * it;
            unsigned word = 0u;
#pragma unroll
            for (int t = 0; t < 2; ++t) {
                const int k0 = 32 * grp + 16 * t;
                float sc[4]; score_tile(t == 0 ? a0 : a1, bq, wq, sc);
                unsigned nib = 0u;
#pragma unroll
                for (int i = 0; i < 4; ++i) {
                    const int b = bin_of(sc[i], inv, off);
                    if (b > bst) nib |= 1u << i;
                    else if (b == bst) {
                        const int pos = atomicAdd(&S.cnt[q], 1);
                        if (pos < CAND_CAP) { S.cand_s[q][pos] = sc[i]; S.cand_k[q][pos] = k0 + 4 * g + i; }
                    }
                }
                unsigned v = nib << (4 * g);
                v |= (unsigned)__shfl_xor((int)v, 16); v |= (unsigned)__shfl_xor((int)v, 32);
                word |= v << (16 * t);
            }
            if (g == 0) mrow[q * 512 + grp] = word;
            a0 = n0; a1 = n1;
        }
    }
#undef SEL_LD
    __syncthreads();
    for (int qq = 0; qq < 4; ++qq) {
        const int qi = 4 * w + qq;
        const int m = S.cnt[qi], r = 256 - S.nabove[qi];
        if (m > CAND_CAP) { if (lane == 0) S.ovf[qi] = 1; continue; }
        const int nparts = m > 64 ? 2 : 1;
        for (int part = 0; part < nparts; ++part) {
            const int me = lane + 64 * part;
            const float s_me = me < m ? S.cand_s[qi][me] : 0.f;
            const int k_me = me < m ? S.cand_k[qi][me] : 0;
            int rank = 0;
#pragma unroll 4
            for (int j = 0; j < m; ++j) { const float sj = S.cand_s[qi][j]; const int kj = S.cand_k[qi][j]; rank += (sj > s_me || (sj == s_me && kj < k_me)) ? 1 : 0; }
            if (me < m && rank < r) atomicOr(&mrow[qi * 512 + (k_me >> 5)], 1u << (k_me & 31));
        }
    }
    __syncthreads();
    for (int i = tid; i < 16 * nw; i += NT) { const int qi = i / nw, wd = i - qi * nw; mask[(size_t)qi * ldm + wd] = mrow[qi * 512 + wd]; }
    __syncthreads();
    if (tid == 0) {
        unsigned* fl = (unsigned*)(p.ws + WS_REDO) + (size_t)blockIdx.x * REDO_LD;
        unsigned n = fl[0];
        for (int qi = 0; qi < 16; ++qi) if (S.ovf[qi] && n + 1 < (unsigned)REDO_LD) { fl[1 + n] = (unsigned)(row0 + qi); ++n; }
        fl[0] = n;
    }
}

constexpr int ATT_TB_OFF = 32768;
constexpr int ATT_LDS = ATT_TB_OFF + 1024 + 16;

__device__ __forceinline__ int pi32(int r) { return (r & 0x13) | ((r & 4) << 1) | ((r & 8) >> 1); }
__device__ __forceinline__ unsigned pkrtz(float a, float b) { return __builtin_bit_cast(unsigned, __builtin_amdgcn_cvt_pkrtz(a, b)); }

struct AttnUnit {
    int row0, nwaves, ntiles, chunk0, chunk_step, qpos0, head;
    const h16* Kh; const h16* VTh; int ldk; int ldv;
    const float* Kc; const float* Vc; const float* Kn; const float* Vn; int ldf; int ntc;
    const unsigned* mask; int ldm;
};

template <int MODE, bool F32SRC>
__device__ __forceinline__ void attn_unit(const Params& p, unsigned char* smem, const AttnUnit& U, float lam) {
    int tid = threadIdx.x; asm volatile("" : "+v"(tid));
    const int lane = tid & 63, w = __builtin_amdgcn_readfirstlane(tid >> 6), l31 = lane & 31, hh = lane >> 5;
    const int qt = (MODE == 1) ? (w & 1) : w, cmap = (MODE == 1) ? (w >> 1) : 0;
    const bool active = qt < U.nwaves;
    const int chunk_w = U.chunk0 + U.chunk_step * (qt >> 1);
    const int rowq = U.row0 + 32 * qt + l31;
    const int qpos = U.qpos0 + 32 * qt + l31;
    float* tb = (float*)(smem + ATT_TB_OFF);
    __syncthreads();
    if (MODE != 2) {
        if (tid < 255) { const int hc = (MODE == 0 ? U.head : 8 + U.head); tb[tid] = (p.in[10][rel_bucket(tid - 191) * 12 + hc] - p.in[10][15 * 12 + hc]) * LOG2E; }
    }
    if (MODE == 0 && tid < 4) ((unsigned*)(smem + ATT_TB_OFF + 1024))[tid] = ((tid & 1) ? 0x0000ffffu : 0u) | ((tid & 2) ? 0xffff0000u : 0u);
    constexpr int NQF = (MODE == 1) ? 2 : 4;
    h16x8 qf[NQF];
    if (active) {
        const h16* Qb = (MODE == 0) ? (const h16*)(p.ws + WS_QA) + (size_t)rowq * 512 + U.head * 64
                      : (MODE == 1) ? (const h16*)(p.ws + WS_QB) + (size_t)rowq * 256 + U.head * 64 + 32 * cmap
                                    : (const h16*)(p.ws + WS_QC) + (size_t)rowq * 256 + U.head * 64;
#pragma unroll
        for (int s = 0; s < NQF; ++s) qf[s] = *(const h16x8*)(Qb + 16 * s + 8 * hh);
    } else {
#pragma unroll
        for (int s = 0; s < NQF; ++s)
#pragma unroll
            for (int e = 0; e < 8; ++e) qf[s][e] = (h16)0.f;
    }
    f32x16 O[2];
    float lsum = 0.f;
    const unsigned* lut = (const unsigned*)(smem + ATT_TB_OFF + 1024);
#pragma unroll
    for (int m = 0; m < 2; ++m)
#pragma unroll
        for (int r = 0; r < 16; ++r) O[m][r] = 0.f;
    int crow[2], cch[2], so[2];
#pragma unroll
    for (int i = 0; i < 2; ++i) { const int c = tid + 256 * i; crow[i] = c >> 3; cch[i] = c & 7; so[i] = crow[i] * 128 + ((cch[i] ^ ((crow[i] >> 1) & 7)) << 4); }
    u32x4 rk[2], rv[2], rk2[2], rv2[2];
    f32x4 fk[2][2], fv[2][2];
#define ATT_LOADR(RK, RV, j) do { \
        _Pragma("unroll") for (int i = 0; i < 2; ++i) { \
            RK[i] = *(const u32x4*)(U.Kh + (size_t)(64 * (j) + crow[i]) * U.ldk + cch[i] * 8); \
            RV[i] = *(const u32x4*)(U.VTh + (size_t)crow[i] * U.ldv + 64 * (j) + cch[i] * 8); } } while (0)
#define ATT_WRITER(RK, RV, b) do { unsigned char* kt_ = smem + (b) * 16384; unsigned char* vt_ = kt_ + 8192; \
        _Pragma("unroll") for (int i = 0; i < 2; ++i) { *(u32x4*)(kt_ + so[i]) = RK[i]; *(u32x4*)(vt_ + so[i]) = RV[i]; } } while (0)
#define ATT_LOAD(j) do { \
        if constexpr (!F32SRC) { ATT_LOADR(rk, rv, j); \
        } else { \
            const float* kb_ = ((j) < U.ntc) ? U.Kc + (size_t)(64 * (j)) * U.ldf : U.Kn + (size_t)(64 * ((j) - U.ntc)) * U.ldf; \
            const float* vb_ = ((j) < U.ntc) ? U.Vc + (size_t)(64 * (j)) * U.ldf : U.Vn + (size_t)(64 * ((j) - U.ntc)) * U.ldf; \
            _Pragma("unroll") for (int i = 0; i < 2; ++i) { \
                const float* ks_ = kb_ + (size_t)crow[i] * U.ldf + cch[i] * 8; const float* vs_ = vb_ + (size_t)crow[i] * U.ldf + cch[i] * 8; \
                fk[i][0] = *(const f32x4*)ks_; fk[i][1] = *(const f32x4*)(ks_ + 4); fv[i][0] = *(const f32x4*)vs_; fv[i][1] = *(const f32x4*)(vs_ + 4); } \
        } } while (0)
#define ATT_WRITE(b) do { \
        unsigned char* kt_ = smem + (b) * 16384; unsigned char* vt_ = kt_ + 8192; \
        if constexpr (!F32SRC) { \
            _Pragma("unroll") for (int i = 0; i < 2; ++i) { *(u32x4*)(kt_ + so[i]) = rk[i]; *(u32x4*)(vt_ + so[i]) = rv[i]; } \
        } else { \
            _Pragma("unroll") for (int i = 0; i < 2; ++i) { \
                h16x8 hk_; _Pragma("unroll") for (int e = 0; e < 4; ++e) { hk_[e] = (h16)fk[i][0][e]; hk_[4 + e] = (h16)fk[i][1][e]; } \
                *(h16x8*)(kt_ + so[i]) = hk_; \
                const int key_ = crow[i]; \
                _Pragma("unroll") for (int e = 0; e < 8; ++e) { const int dv_ = 8 * cch[i] + e; \
                    *(__bf16*)(vt_ + dv_ * 128 + (((key_ >> 3) ^ ((dv_ >> 1) & 7)) << 4) + (key_ & 7) * 2) = (__bf16)(e < 4 ? fv[i][0][e] : fv[i][1][e - 4]); } } \
        } } while (0)

    const unsigned char* kdma[2]; const unsigned char* vdma[2]; int dmo[2];
#pragma unroll
    for (int i = 0; i < 2; ++i) {
        const int row = 16 * w + 8 * i + (lane >> 3), ch = (lane & 7) ^ ((row >> 1) & 7);
        kdma[i] = F32SRC ? nullptr : (const unsigned char*)(U.Kh + (size_t)row * U.ldk + ch * 8);
        vdma[i] = F32SRC ? nullptr : (const unsigned char*)(U.VTh + (size_t)row * U.ldv + ch * 8);
        dmo[i] = (16 * w + 8 * i) * 128;
    }
#define ATT_DMA(b, j) do { _Pragma("unroll") for (int i = 0; i < 2; ++i) { \
        __builtin_amdgcn_global_load_lds((const unsigned*)(kdma[i] + (size_t)(64 * (j)) * U.ldk * 2), (__attribute__((address_space(3))) unsigned*)(smem + (b) * 16384 + dmo[i]), 16, 0, 0); \
        __builtin_amdgcn_global_load_lds((const unsigned*)(vdma[i] + (size_t)(64 * (j)) * 2), (__attribute__((address_space(3))) unsigned*)(smem + (b) * 16384 + 8192 + dmo[i]), 16, 0, 0); } } while (0)
    if constexpr (!F32SRC) { ATT_DMA(0, 0); } else { ATT_LOAD(0); ATT_WRITE(0); }
    const unsigned* mrow = (MODE == 0) ? U.mask + (size_t)(32 * qt + l31) * U.ldm : nullptr;
    unsigned mwn0 = 0xffffffffu, mwn1 = 0xffffffffu;
    if (MODE == 0) { mwn0 = mrow[0]; mwn1 = mrow[1]; }
    __syncthreads();
    const int pil = pi32(l31), ksw = (pil >> 1) & 7, vsw = (l31 >> 1) & 7;
    const int jlast = U.ntiles - 1;
    auto clampj = [&](int x) { return x < jlast ? x : jlast; };
    if constexpr (!F32SRC) {
        for (int j = 0; j < U.ntiles; ++j) {
            const int buf = j & 1;
            const int jn = clampj(j + 1);
            unsigned mw[2] = {mwn0 >> (8 * hh), mwn1 >> (8 * hh)};
            if (MODE == 0) { mwn0 = mrow[2 * jn]; mwn1 = mrow[2 * jn + 1]; }
            ATT_DMA(buf ^ 1, jn);
        if (active && (MODE == 2 || j <= chunk_w)) {
            const unsigned char* Kt = smem + buf * 16384;
            const unsigned char* Vt = Kt + 8192;
            const bool near = (MODE != 2) && (j >= chunk_w - 2);
            bf16x8 pf[4];
#pragma unroll
            for (int u = 0; u < 2; ++u) {
                f32x16 S;
#pragma unroll
                for (int r = 0; r < 16; ++r) S[r] = 0.f;
                const unsigned char* kp = Kt + (32 * u + pil) * 128;
#pragma unroll
                for (int s = 0; s < NQF; ++s) {
                    const int ch = (MODE == 1) ? (4 * cmap + 2 * s + hh) : (2 * s + hh);
                    const h16x8 a = *(const h16x8*)(kp + ((ch ^ ksw) << 4));
                    S = __builtin_amdgcn_mfma_f32_32x32x16_f16(a, qf[s], S, 0, 0, 0);
                }
                if (near) {
                    const int base = 64 * j + 32 * u + 8 * hh - qpos + 191;
#pragma unroll
                    for (int i = 0; i < 16; ++i) S[i] += tb[base + (i & 7) + 16 * (i >> 3)];
                }
#pragma unroll
                for (int i = 0; i < 16; ++i) S[i] = __builtin_amdgcn_exp2f(S[i]);
#pragma unroll
                for (int s2 = 0; s2 < 2; ++s2) {
                    u32x4 pk;
#pragma unroll
                    for (int e = 0; e < 4; ++e) {
                        unsigned v = pkbf(S[8 * s2 + 2 * e], S[8 * s2 + 2 * e + 1]);
                        if (MODE == 0) {
                            const unsigned idx = (mw[u] >> (16 * s2 + 2 * e)) & 3u;
                            v &= lut[idx];
                        }
                        lsum = __builtin_amdgcn_fdot2_f32_bf16(__builtin_bit_cast(bf16x2, v), __builtin_bit_cast(bf16x2, 0x3f803f80u), lsum, false);
                        pk[e] = v;
                    }
                    pf[2 * u + s2] = __builtin_bit_cast(bf16x8, pk);
                }
            }
#pragma unroll
            for (int m = 0; m < 2; ++m)
#pragma unroll
                for (int sp = 0; sp < 4; ++sp) {
                    const bf16x8 vfr = *(const bf16x8*)(Vt + (32 * m + l31) * 128 + (((2 * sp + hh) ^ vsw) << 4));
                    O[m] = __builtin_amdgcn_mfma_f32_32x32x16_bf16(vfr, pf[sp], O[m], 0, 0, 0);
                }
        }
            __syncthreads();
        }
    } else {
    for (int j = 0; j < U.ntiles; ++j) {
        const int buf = j & 1;
        const int jn = j < jlast ? j + 1 : jlast;
        unsigned mw[2] = {mwn0 >> (8 * hh), mwn1 >> (8 * hh)};
        if (MODE == 0) { mwn0 = mrow[2 * jn]; mwn1 = mrow[2 * jn + 1]; }
        if (active && (MODE == 2 || j <= chunk_w)) {
            const unsigned char* Kt = smem + buf * 16384;
            const unsigned char* Vt = Kt + 8192;
            const bool near = (MODE != 2) && (j >= chunk_w - 2);
            bf16x8 pf[4];
#pragma unroll
            for (int u = 0; u < 2; ++u) {
                f32x16 S;
#pragma unroll
                for (int r = 0; r < 16; ++r) S[r] = 0.f;
                const unsigned char* kp = Kt + (32 * u + pil) * 128;
#pragma unroll
                for (int s = 0; s < NQF; ++s) {
                    const int ch = (MODE == 1) ? (4 * cmap + 2 * s + hh) : (2 * s + hh);
                    const h16x8 a = *(const h16x8*)(kp + ((ch ^ ksw) << 4));
                    S = __builtin_amdgcn_mfma_f32_32x32x16_f16(a, qf[s], S, 0, 0, 0);
                }
                if (near) {
                    const int base = 64 * j + 32 * u + 8 * hh - qpos + 191;
#pragma unroll
                    for (int i = 0; i < 16; ++i) S[i] += tb[base + (i & 7) + 16 * (i >> 3)];
                }
#pragma unroll
                for (int i = 0; i < 16; ++i) S[i] = __builtin_amdgcn_exp2f(S[i]);
#pragma unroll
                for (int s2 = 0; s2 < 2; ++s2) {
                    u32x4 pk;
#pragma unroll
                    for (int e = 0; e < 4; ++e) {
                        unsigned v = pkbf(S[8 * s2 + 2 * e], S[8 * s2 + 2 * e + 1]);
                        if (MODE == 0) {
                            const unsigned idx = (mw[u] >> (16 * s2 + 2 * e)) & 3u;
                            v &= lut[idx];
                        }
                        lsum = __builtin_amdgcn_fdot2_f32_bf16(__builtin_bit_cast(bf16x2, v), __builtin_bit_cast(bf16x2, 0x3f803f80u), lsum, false);
                        pk[e] = v;
                    }
                    pf[2 * u + s2] = __builtin_bit_cast(bf16x8, pk);
                }
            }
#pragma unroll
            for (int m = 0; m < 2; ++m)
#pragma unroll
                for (int sp = 0; sp < 4; ++sp) {
                    const bf16x8 vfr = *(const bf16x8*)(Vt + (32 * m + l31) * 128 + (((2 * sp + hh) ^ vsw) << 4));
                    O[m] = __builtin_amdgcn_mfma_f32_32x32x16_bf16(vfr, pf[sp], O[m], 0, 0, 0);
                }
        }
        ATT_LOAD(jn);
        ATT_WRITE(buf ^ 1);
        __syncthreads();
    }
    }
#undef ATT_LOAD
#undef ATT_WRITE
#undef ATT_LOADR
#undef ATT_WRITER
#undef ATT_DMA
    const float l = lsum + __shfl_xor(lsum, 32);
    const float inv = 1.0f / l;
    if (MODE == 1) {
        float* X = (float*)smem;
        if (cmap == 1) {
#pragma unroll
            for (int m = 0; m < 2; ++m)
#pragma unroll
                for (int i = 0; i < 16; ++i) X[(qt * 32 + m * 16 + i) * 64 + lane] = O[m][i] * inv;
        }
        __syncthreads();
        if (cmap == 1) return;
#pragma unroll
        for (int m = 0; m < 2; ++m)
#pragma unroll
            for (int i = 0; i < 16; ++i) O[m][i] = O[m][i] * inv - lam * X[(qt * 32 + m * 16 + i) * 64 + lane];
    } else {
        if (!active) return;
#pragma unroll
        for (int m = 0; m < 2; ++m)
#pragma unroll
            for (int i = 0; i < 16; ++i) O[m][i] *= inv;
    }
    const int colbase = (MODE == 0 ? 0 : (MODE == 1 ? 512 : 768)) + U.head * 64;
    const h16* G = (const h16*)(p.ws + WS_G) + (size_t)rowq * 1024 + colbase;
    h16* Oo = (h16*)(p.ws + WS_O16) + (size_t)rowq * 1024 + colbase;
    float sc = 1.f;
    if (MODE == 1) {
        float ss = 0.f;
#pragma unroll
        for (int m = 0; m < 2; ++m)
#pragma unroll
            for (int i = 0; i < 16; ++i) ss = fmaf(O[m][i], O[m][i], ss);
        ss += __shfl_xor(ss, 32);
        sc = (1.0f / sqrtf(ss * (1.0f / 64.0f) + EPS)) * 0.8f;
    }
#pragma unroll
    for (int m = 0; m < 2; ++m)
#pragma unroll
        for (int g4 = 0; g4 < 4; ++g4) {
            const int dv = 32 * m + 8 * g4 + 4 * hh;
            const h16x4 gv = *(const h16x4*)(G + dv);
            h16x4 o4;
#pragma unroll
            for (int e = 0; e < 4; ++e) {
                float o = O[m][4 * g4 + e];
                if (MODE == 1) o = o * sc * p.in[18][dv + e];
                o4[e] = (h16)(o * silu((float)gv[e]));
            }
            *(h16x4*)(Oo + dv) = o4;
        }
}

__device__ __forceinline__ AttnUnit unit_zero() {
    AttnUnit U; U.row0 = 0; U.nwaves = 0; U.ntiles = 0; U.chunk0 = 0; U.chunk_step = 0; U.qpos0 = 0; U.head = 0; U.Kh = nullptr; U.VTh = nullptr; U.ldk = 0; U.ldv = 0;
    U.Kc = nullptr; U.Vc = nullptr; U.Kn = nullptr; U.Vn = nullptr; U.ldf = 0; U.ntc = 0; U.mask = nullptr; U.ldm = 0; return U;
}

#define ZIGZAG_LOOP(NALL) for (int zk_ = 0, pos_ = 0; zk_ * (int)gridDim.x < (NALL); ++zk_) \
    if ((pos_ = (zk_ & 1) ? (zk_ + 1) * (int)gridDim.x - 1 - (int)blockIdx.x : zk_ * (int)gridDim.x + (int)blockIdx.x) < (NALL))
#define ZIGZAG_LOOP_SWAP(NALL) for (int zi_ = 0, zk_ = 0, pos_ = 0; zi_ * (int)gridDim.x < (NALL); ++zi_) \
    if ((zk_ = (blockIdx.x >= gridDim.x / 2 && zi_ < 4) ? (zi_ ^ 2) : zi_, \
         pos_ = (zk_ & 1) ? (zk_ + 1) * (int)gridDim.x - 1 - (int)blockIdx.x : zk_ * (int)gridDim.x + (int)blockIdx.x) < (NALL))

__device__ void phase2(const Params& p, unsigned char* smem) {
    float s1 = 0.f, s2 = 0.f;
    for (int i = 0; i < 32; ++i) { s1 = fmaf(p.in[19][i], p.in[20][i], s1); s2 = fmaf(p.in[21][i], p.in[22][i], s2); }
    const float lam = expf(s1) - expf(s2) + 0.2f;
    constexpr int N_BP = 1024, N_SP = 1024, N_BS = 128, N_CS = 128, N_SS = 128, N_CP = 512;
    constexpr int N_ALL = N_BP + N_SP + N_BS + N_CS + N_SS + N_CP;
    ZIGZAG_LOOP_SWAP(N_ALL) {
        int it = pos_;
        if (it < N_BP) {
            const int g = 255 - (it >> 2), head = blockIdx.x & 3;
            AttnUnit U = unit_zero();
            U.row0 = 64 * g; U.nwaves = 2; U.ntiles = g + 1; U.chunk0 = g; U.chunk_step = 0; U.qpos0 = 64 * g; U.head = head;
            U.Kh = (const h16*)(p.ws + WS_KB_P) + head * 64; U.ldk = 256;
            U.VTh = (const h16*)(p.ws + WS_VTB_P) + (size_t)(head * 64) * SEQ; U.ldv = SEQ;
            attn_unit<1, false>(p, smem, U, lam);
            continue;
        }
        it -= N_BP;
        if (it < N_SP) { select_unit(p, smem, it); continue; }
        it -= N_SP;
        if (it < N_BS) {
            const int b = it >> 2, head = it & 3;
            AttnUnit U = unit_zero();
            U.row0 = SEQ + 64 * b; U.nwaves = 2; U.ntiles = 17; U.chunk0 = 16; U.chunk_step = 0; U.qpos0 = PAST; U.head = head;
            U.Kc = p.in[6] + (size_t)b * PAST * 256 + head * 64; U.Vc = p.in[7] + (size_t)b * PAST * 256 + head * 64;
            U.Kn = p.out + O_SBK + (size_t)b * DECS * 256 + head * 64; U.Vn = p.out + O_SBV + (size_t)b * DECS * 256 + head * 64;
            U.ldf = 256; U.ntc = 16;
            attn_unit<1, true>(p, smem, U, lam);
            continue;
        }
        it -= N_BS;
        if (it < N_CS) {
            const int b = it >> 2, head = it & 3;
            AttnUnit U = unit_zero();
            U.row0 = SEQ + 64 * b; U.nwaves = 2; U.ntiles = 4; U.head = head;
            U.Kc = p.in[8] + (size_t)b * NMEM * 256 + head * 64; U.Vc = p.in[9] + (size_t)b * NMEM * 256 + head * 64;
            U.Kn = U.Kc; U.Vn = U.Vc; U.ldf = 256; U.ntc = 4;
            attn_unit<2, true>(p, smem, U, lam);
            continue;
        }
        it -= N_CS;
        if (it < N_SS) { select_unit(p, smem, 1024 + it); continue; }
        it -= N_SS;
        {
            const int g = it >> 2, head = it & 3;
            AttnUnit U = unit_zero();
            U.row0 = 128 * g; U.nwaves = 4; U.ntiles = 4; U.head = head;
            U.Kh = (const h16*)(p.ws + WS_MK_P) + head * 64; U.ldk = 256;
            U.VTh = (const h16*)(p.ws + WS_MVT_P) + (size_t)(head * 64) * NMEM; U.ldv = NMEM;
            attn_unit<2, false>(p, smem, U, lam);
        }
    }
    {
        __syncthreads();
        const unsigned* fl = (const unsigned*)(p.ws + WS_REDO) + (size_t)blockIdx.x * REDO_LD;
        const unsigned n = __builtin_amdgcn_readfirstlane((int)__hip_atomic_load(fl, __ATOMIC_RELAXED, __HIP_MEMORY_SCOPE_AGENT));
        for (unsigned i = 0; i < n; ++i) {
            const int row = __builtin_amdgcn_readfirstlane((int)__hip_atomic_load(fl + 1 + i, __ATOMIC_RELAXED, __HIP_MEMORY_SCOPE_AGENT));
            select_item(p, smem, row);
        }
    }
}

__device__ void phase3(const Params& p, unsigned char* smem) {
    constexpr int G_SPLIT = 18, N_HI = (128 - G_SPLIT) * 8, N_AS = 256, N_LO = G_SPLIT * 8;
    ZIGZAG_LOOP(N_HI + N_AS + N_LO) {
        int it = pos_;
        if (it >= N_HI && it < N_HI + N_AS) {
            it -= N_HI;
            const int b = it >> 3, head = blockIdx.x & 7;
            AttnUnit U = unit_zero();
            U.row0 = SEQ + 64 * b; U.nwaves = 2; U.ntiles = 17; U.chunk0 = 16; U.chunk_step = 0; U.qpos0 = PAST; U.head = head;
            U.Kc = p.in[3] + (size_t)b * PAST * 512 + head * 64; U.Vc = p.in[4] + (size_t)b * PAST * 512 + head * 64;
            U.Kn = p.out + O_SAK + (size_t)b * DECS * 512 + head * 64; U.Vn = p.out + O_SAV + (size_t)b * DECS * 512 + head * 64;
            U.ldf = 512; U.ntc = 16;
            U.mask = (const unsigned*)(p.ws + WS_MASK_S) + (size_t)(64 * b) * 34; U.ldm = 34;
            attn_unit<0, true>(p, smem, U, 0.f);
            continue;
        }
        if (it >= N_HI) it -= N_AS;
        {
            const int g = 127 - (it >> 3), head = blockIdx.x & 7;
            AttnUnit U = unit_zero();
            U.row0 = 128 * g; U.nwaves = 4; U.ntiles = 2 * g + 2; U.chunk0 = 2 * g; U.chunk_step = 1; U.qpos0 = 128 * g; U.head = head;
            U.Kh = (const h16*)(p.ws + WS_KA_P) + head * 64; U.ldk = 512;
            U.VTh = (const h16*)(p.ws + WS_VTA_P) + (size_t)(head * 64) * SEQ; U.ldv = SEQ;
            U.mask = (const unsigned*)(p.ws + WS_MASK_P) + (size_t)(128 * g) * 512; U.ldm = 512;
            attn_unit<0, false>(p, smem, U, 0.f);
        }
    }
}

__device__ void phase4(const Params& p, unsigned char* smem) {
    const h16* O16 = (const h16*)(p.ws + WS_O16);
    const h16* WTOUT = (const h16*)(p.ws + WS_WTOUT);
    constexpr int NCT = D / 128, NRT = MROWS / 128;
    const EpiOut eo{};
    const int G = gridDim.x;
    if ((G & 7) == 0) {
        const int xcd = blockIdx.x & 7, local = blockIdx.x >> 3, LG = G >> 3;
        for (int lin = local; lin < (NRT / 8) * NCT; lin += LG) {
            const int rt = xcd + 8 * (lin / NCT), ct = lin % NCT;
            gemm_tile(p, O16, WTOUT, rt * 128, ct * 128, smem, eo);
        }
    } else {
        for (int it = blockIdx.x; it < NCT * NRT; it += gridDim.x) {
            const int rt = it / NCT, ct = it % NCT;
            gemm_tile(p, O16, WTOUT, rt * 128, ct * 128, smem, eo);
        }
    }
}

constexpr int SMEM_BYTES = 80 * 1024;

__device__ __forceinline__ void grid_barrier(unsigned* cnt, unsigned target) {
    asm volatile("s_waitcnt vmcnt(0)" ::: "memory");
    __syncthreads();
    if (threadIdx.x == 0) {
        __builtin_amdgcn_fence(__ATOMIC_RELEASE, "agent");
        asm volatile("s_waitcnt vmcnt(0)" ::: "memory");
        __hip_atomic_fetch_add(cnt, 1u, __ATOMIC_RELAXED, __HIP_MEMORY_SCOPE_AGENT);
        while (__hip_atomic_load(cnt, __ATOMIC_RELAXED, __HIP_MEMORY_SCOPE_AGENT) < target) __builtin_amdgcn_s_sleep(2);
        __builtin_amdgcn_fence(__ATOMIC_ACQUIRE, "agent");
        asm volatile("s_waitcnt vmcnt(0)" ::: "memory");
    }
    __syncthreads();
}

__global__ void __launch_bounds__(NT, 2) fwd_kernel(Params p) {
    __shared__ __attribute__((aligned(16))) unsigned char smem[SMEM_BYTES];
    static_assert(ATT_LDS <= SMEM_BYTES && sizeof(SmemDsa) <= SMEM_BYTES && sizeof(SelSm) <= SMEM_BYTES && CS_LD * 128 * 4 <= SMEM_BYTES, "smem");
    cg::grid_group grid = cg::this_grid();
    unsigned nbar = 0;
    for (int ph = p.ph_lo; ph < p.ph_hi; ++ph) {
#ifndef REP_PHASE
#define REP_PHASE -1
#endif
        const int nrep = (ph == REP_PHASE) ? 2 : 1;
        for (int rep = 0; rep < nrep; ++rep) {
            if (ph == 0) phase0(p, smem);
            else if (ph == 1) phase1(p, smem);
            else if (ph == 2) phase2(p, smem);
            else if (ph == 3) phase3(p, smem);
            else phase4(p, smem);
            if (rep + 1 < nrep) grid.sync();
        }
        if (ph + 1 < p.ph_hi) {
            if (p.ph_lo > 0) grid.sync();
            else grid_barrier((unsigned*)(p.ws + WS_CTL) + 48, ++nbar * gridDim.x);
        }
    }
}

extern "C" void kernel_launch(void* const* d_in, const int* in_sizes, int n_in, void* d_out, int out_size, void* d_ws, size_t ws_size, hipStream_t stream) {
    static int grid_blocks = 0;
    if (!grid_blocks) {
        int dev = 0, cus = 0, per_cu = 0;
        (void)hipGetDevice(&dev);
        (void)hipDeviceGetAttribute(&cus, hipDeviceAttributeMultiprocessorCount, dev);
        (void)hipOccupancyMaxActiveBlocksPerMultiprocessor(&per_cu, fwd_kernel, NT, 0);
        if (per_cu < 1) per_cu = 1;
        if (per_cu > (160 * 1024) / SMEM_BYTES) per_cu = (160 * 1024) / SMEM_BYTES;
        grid_blocks = cus * per_cu;
        if (ws_size < WS_END) fprintf(stderr, "kernel_launch: workspace too small: %zu < %zu\n", ws_size, (size_t)WS_END);
    }
    if (ws_size < WS_END) return;
    (void)hipMemsetAsync((unsigned char*)d_ws + WS_CTL, 0, 256 + (size_t)2048 * REDO_LD * 4, stream);
    Params p{};
    for (int i = 0; i < 27; ++i) p.in[i] = (const float*)d_in[i];
    p.out = (float*)d_out; p.ws = (unsigned char*)d_ws;
#if ONE_LAUNCH
    p.ph_lo = 0; p.ph_hi = 5;
    void* args[] = {&p};
    hipError_t e = hipLaunchCooperativeKernel((void*)fwd_kernel, dim3(grid_blocks), dim3(NT), args, 0, stream);
    if (e != hipSuccess) fprintf(stderr, "cooperative launch failed: %s (grid %d)\n", hipGetErrorString(e), grid_blocks);
#else
    for (int ph = 0; ph < 5; ++ph) {
        p.ph_lo = ph; p.ph_hi = ph + 1;
        hipLaunchKernelGGL(fwd_kernel, dim3(grid_blocks), dim3(NT), 0, stream, p);
    }
#endif
}
```

```cpp
#include <hip/hip_runtime.h>
#include <hip/hip_cooperative_groups.h>
#include <cstdio>
#include <cstdint>
namespace cg = cooperative_groups;

#define NT 256
#define ONE_LAUNCH 1

constexpr int D = 1024, SEQ = 16384, DECB = 32, DECS = 64, PAST = 1024, NMEM = 256;
constexpr int MROWS = SEQ + DECB * DECS;
constexpr int DIN = 3880;
constexpr int LDP = 264;
constexpr int PC_IQ = 0, PC_IW = 256;
constexpr float EPS = 1e-6f;

constexpr size_t O_YP = 0, O_YS = 16777216, O_PAK = 18874368, O_PAV = 27262976, O_PAKI = 35651584, O_PBK = 36175872,
                 O_PBV = 40370176, O_PMK = 44564480, O_PMV = 44630016, O_SAK = 44695552, O_SAV = 45744128,
                 O_SAKI = 46792704, O_SBK = 46858240, O_SBV = 47382528;

typedef _Float16 h16;
typedef h16 h16x2 __attribute__((ext_vector_type(2)));
typedef h16 h16x4 __attribute__((ext_vector_type(4)));
typedef h16 h16x8 __attribute__((ext_vector_type(8)));
typedef float f32x4 __attribute__((ext_vector_type(4)));
typedef unsigned u32x4 __attribute__((ext_vector_type(4)));
typedef __bf16 bf16x8 __attribute__((ext_vector_type(8)));
typedef __bf16 bf16x2 __attribute__((ext_vector_type(2)));
typedef float f32x2 __attribute__((ext_vector_type(2)));
__device__ __forceinline__ unsigned pkbf(float a, float b) { const f32x2 v = {a, b}; return __builtin_bit_cast(unsigned, __builtin_convertvector(v, bf16x2)); }
typedef float f32x16 __attribute__((ext_vector_type(16)));

constexpr int NPAD_IN = 3968;
constexpr float LOG2E = 1.4426950408889634f;
constexpr size_t WS_XH = 0;
constexpr size_t WS_O16 = WS_XH;
constexpr size_t WS_HMH = WS_XH + (size_t)MROWS * D * 2;
constexpr size_t WS_WTIN = WS_HMH + (size_t)NMEM * D * 2;
constexpr size_t WS_WTOUT = WS_WTIN + (size_t)NPAD_IN * D * 2;
constexpr size_t WS_WTMEM = WS_WTOUT + (size_t)D * D * 2;
constexpr size_t WS_QA = WS_WTMEM + (size_t)512 * D * 2;
constexpr size_t WS_QB = WS_QA + (size_t)MROWS * 512 * 2;
constexpr size_t WS_QC = WS_QB + (size_t)MROWS * 256 * 2;
constexpr size_t WS_G = WS_QC + (size_t)MROWS * 256 * 2;
constexpr size_t WS_KB_P = WS_G + (size_t)MROWS * 1024 * 2;
constexpr size_t WS_VTB_P = WS_KB_P + (size_t)SEQ * 256 * 2;
constexpr size_t WS_MK_P = WS_VTB_P + (size_t)SEQ * 256 * 2;
constexpr size_t WS_MVT_P = WS_MK_P + (size_t)NMEM * 256 * 2;
constexpr size_t WS_KA_P = WS_MVT_P + (size_t)NMEM * 256 * 2;
constexpr size_t WS_VTA_P = WS_KA_P + (size_t)SEQ * 512 * 2;
constexpr size_t WS_MASK_P = WS_VTA_P + (size_t)SEQ * 512 * 2;
constexpr size_t WS_MASK_S = WS_MASK_P + (size_t)SEQ * 512 * 4;
constexpr size_t WS_IQ16 = WS_MASK_S + (size_t)DECB * DECS * 34 * 4;
constexpr size_t WS_IK_P = WS_IQ16 + (size_t)MROWS * 256 * 2;
constexpr size_t WS_IK_S = WS_IK_P + (size_t)SEQ * 32 * 2;
constexpr size_t WS_CTL = WS_IK_S + (size_t)DECB * (PAST + DECS) * 32 * 2;
constexpr int REDO_LD = 64;
constexpr size_t WS_REDO = WS_CTL + 256;
constexpr size_t WS_P = WS_REDO + (size_t)2048 * REDO_LD * 4;
constexpr size_t WS_END = WS_P + (size_t)MROWS * LDP * 4;

struct Params {
    const float* in[27];
    float* out;
    unsigned char* ws;
    int ph_lo, ph_hi;
};

__device__ __forceinline__ float wave_sum(float v) {
#pragma unroll
    for (int o = 1; o < 64; o <<= 1) v += __shfl_xor(v, o);
    return v;
}
__device__ __forceinline__ float wave_max(float v) {
#pragma unroll
    for (int o = 1; o < 64; o <<= 1) v = fmaxf(v, __shfl_xor(v, o));
    return v;
}
__device__ __forceinline__ float silu(float x) { return x / (1.0f + expf(-x)); }

__device__ __forceinline__ int rel_bucket(int rel) {
    const int ret = rel > 0 ? 16 : 0;
    const int n = rel < 0 ? -rel : rel;
    int b;
    if (n < 8) b = n;
    else if (n < 12) b = 8;
    else if (n < 16) b = 9;
    else if (n < 23) b = 10;
    else if (n < 32) b = 11;
    else if (n < 46) b = 12;
    else if (n < 64) b = 13;
    else if (n < 91) b = 14;
    else b = 15;
    return ret + b;
}

__device__ __forceinline__ void rms_row_h(const float* x, const float* g, h16* o, int lane) {
    const float4* xr = (const float4*)x;
    const float4* gr = (const float4*)g;
    float4 v[4];
    float s = 0.f;
#pragma unroll
    for (int j = 0; j < 4; ++j) { v[j] = xr[lane + 64 * j]; s += v[j].x * v[j].x + v[j].y * v[j].y + v[j].z * v[j].z + v[j].w * v[j].w; }
    s = wave_sum(s);
    const float r = 1.0f / sqrtf(s * (1.0f / 1024.0f) + EPS);
#pragma unroll
    for (int j = 0; j < 4; ++j) {
        const float4 gg = gr[lane + 64 * j];
        h16x4 o4; o4.x = (h16)(v[j].x * r * gg.x); o4.y = (h16)(v[j].y * r * gg.y); o4.z = (h16)(v[j].z * r * gg.z); o4.w = (h16)(v[j].w * r * gg.w);
        ((h16x4*)o)[lane + 64 * j] = o4;
    }
}

__device__ __forceinline__ void transpose_item(const float* __restrict__ W, int ldw, int c0, int nvalid, int k0, h16* __restrict__ WT, int r0, float* scr, int lane) {
#pragma unroll 8
    for (int i = 0; i < 32; ++i) {
        const int kk = 2 * i + (lane >> 5), n = lane & 31;
        scr[kk * 33 + n] = (n < nvalid) ? W[(size_t)(k0 + kk) * ldw + c0 + n] : 0.f;
    }
    asm volatile("s_waitcnt lgkmcnt(0)" ::: "memory");
    const int c = lane & 7;
#pragma unroll
    for (int j = 0; j < 4; ++j) {
        const int n = (lane >> 3) + 8 * j;
        const float* s = scr + (8 * c) * 33 + n;
        h16x8 o;
#pragma unroll
        for (int e = 0; e < 8; ++e) o[e] = (h16)s[e * 33];
        *(h16x8*)(WT + (size_t)(r0 + n) * 1024 + k0 + 8 * c) = o;
    }
    asm volatile("s_waitcnt lgkmcnt(0)" ::: "memory");
}

__device__ __forceinline__ int inproj_col(int np) { return np < 2304 ? np : (np < 3840 ? np + 40 : np - 3840 + 2304); }

__device__ void phase0(const Params& p, unsigned char* smem) {
    int tid0 = threadIdx.x; asm volatile("" : "+v"(tid0));
    const int lane = tid0 & 63, w = tid0 >> 6;
    const int gw = blockIdx.x * 4 + w, ngw = gridDim.x * 4;
    h16* XH = (h16*)(p.ws + WS_XH);
    h16* HMH = (h16*)(p.ws + WS_HMH);
    h16* WTIN = (h16*)(p.ws + WS_WTIN);
    h16* WTOUT = (h16*)(p.ws + WS_WTOUT);
    h16* WTMEM = (h16*)(p.ws + WS_WTMEM);
    float* scr = (float*)smem + w * (64 * 33);
    constexpr int N_ROWS = MROWS + NMEM;
    constexpr int I_IN = 16 * (NPAD_IN / 32), I_OUT = 16 * 32, I_MEM = 16 * 16, I_KIDX = DECB * (PAST / 64);
    for (int it = gw; it < N_ROWS + I_IN + I_OUT + I_MEM + I_KIDX; it += ngw) {
        if (it < N_ROWS) {
            const int r = it;
            if (r < SEQ) rms_row_h(p.in[0] + (size_t)r * D, p.in[11], XH + (size_t)r * D, lane);
            else if (r < MROWS) rms_row_h(p.in[1] + (size_t)(r - SEQ) * D, p.in[11], XH + (size_t)r * D, lane);
            else rms_row_h(p.in[2] + (size_t)(r - MROWS) * D, p.in[25], HMH + (size_t)(r - MROWS) * D, lane);
        } else if (it < N_ROWS + I_IN) {
            const int r = it - N_ROWS, nb = r % (NPAD_IN / 32), kb = r / (NPAD_IN / 32);
            const int np0 = nb * 32;
            int nvalid = DIN - np0; nvalid = nvalid < 0 ? 0 : (nvalid > 32 ? 32 : nvalid);
            const int c0 = nvalid > 0 ? inproj_col(np0) : 0;
            transpose_item(p.in[12], DIN, c0, nvalid, kb * 64, WTIN, np0, scr, lane);
        } else if (it < N_ROWS + I_IN + I_OUT) {
            const int r = it - N_ROWS - I_IN, nb = r % 32, kb = r / 32;
            transpose_item(p.in[13], D, nb * 32, 32, kb * 64, WTOUT, nb * 32, scr, lane);
        } else if (it < N_ROWS + I_IN + I_OUT + I_MEM) {
            const int r = it - N_ROWS - I_IN - I_OUT, nb = r % 16, kb = r / 16;
            transpose_item(p.in[26], 512, nb * 32, 32, kb * 64, WTMEM, nb * 32, scr, lane);
        } else {
            const int r = it - N_ROWS - I_IN - I_OUT - I_MEM, b = r / (PAST / 64), key = (r % (PAST / 64)) * 64 + lane;
            const f32x4* src = (const f32x4*)(p.in[5] + ((size_t)b * PAST + key) * 32);
            h16* dst = (h16*)(p.ws + WS_IK_S) + ((size_t)b * (PAST + DECS) + key) * 32;
            float ss = 0.f;
#pragma unroll
            for (int c = 0; c < 4; ++c) {
                const f32x4 x0 = src[2 * c], x1 = src[2 * c + 1];
                h16x8 o;
#pragma unroll
                for (int e = 0; e < 4; ++e) { o[e] = (h16)x0[e]; o[4 + e] = (h16)x1[e]; ss = fmaf(x0[e], x0[e], ss); ss = fmaf(x1[e], x1[e], ss); }
                *(h16x8*)(dst + 8 * c) = o;
            }
            ss = wave_max(ss);
            if (lane == 0) atomicMax((unsigned*)(p.ws + WS_CTL) + 1 + b, __float_as_uint(ss));
        }
    }
}

constexpr int CS_LD = 132;
template <class Epi>
__device__ __forceinline__ void gemm_tile(const Params& p, const h16* __restrict__ A, const h16* __restrict__ Bt, int m0, int n0, unsigned char* smem, const Epi& epi) {
    int tid = threadIdx.x; asm volatile("" : "+v"(tid));
    const int lane = tid & 63, wid = tid >> 6, wm = wid >> 1, wn = wid & 1;
    const int l31 = lane & 31, hh = lane >> 5;
    f32x16 acc[2][2];
#pragma unroll
    for (int a = 0; a < 2; ++a)
#pragma unroll
        for (int b = 0; b < 2; ++b)
#pragma unroll
            for (int r = 0; r < 16; ++r) acc[a][b][r] = 0.f;
    const unsigned char* agl[4]; const unsigned char* bgl[4]; int ldo[4];
#pragma unroll
    for (int i = 0; i < 4; ++i) {
        const int row = 32 * wid + 8 * i + (lane >> 3), slot = lane & 7, ch = slot ^ ((row >> 1) & 7);
        agl[i] = (const unsigned char*)(A + (size_t)(m0 + row) * 1024 + ch * 8);
        bgl[i] = (const unsigned char*)(Bt + (size_t)(n0 + row) * 1024 + ch * 8);
        ldo[i] = (32 * wid + 8 * i) * 128;
    }
#define GT_DMA(stage_, kt_) do { const int ko_ = ((kt_) < 15 ? (kt_) : 15) * 128; \
        _Pragma("unroll") for (int i = 0; i < 4; ++i) { \
            __builtin_amdgcn_global_load_lds((const unsigned*)(agl[i] + ko_), (__attribute__((address_space(3))) unsigned*)(smem + (stage_) * 32768 + ldo[i]), 16, 0, 0); \
            __builtin_amdgcn_global_load_lds((const unsigned*)(bgl[i] + ko_), (__attribute__((address_space(3))) unsigned*)(smem + (stage_) * 32768 + 16384 + ldo[i]), 16, 0, 0); } } while (0)
    const int sw = (l31 >> 1) & 7;
    const int arow = (wm * 64 + l31) * 128, brow = (wn * 64 + l31) * 128;
    __syncthreads();
    GT_DMA(0, 0);
    __syncthreads();
    for (int kt = 0; kt < 16; ++kt) {
        const unsigned char* As = smem + (kt & 1) * 32768; const unsigned char* Bs = As + 16384;
        GT_DMA((kt + 1) & 1, kt + 1);
#pragma unroll
        for (int s = 0; s < 4; ++s) {
            const int co = (((2 * s + hh) ^ sw) << 4);
            h16x8 a[2], b[2];
#pragma unroll
            for (int mt = 0; mt < 2; ++mt) a[mt] = *(const h16x8*)(As + arow + mt * 32 * 128 + co);
#pragma unroll
            for (int nt = 0; nt < 2; ++nt) b[nt] = *(const h16x8*)(Bs + brow + nt * 32 * 128 + co);
#pragma unroll
            for (int mt = 0; mt < 2; ++mt)
#pragma unroll
                for (int nt = 0; nt < 2; ++nt) acc[mt][nt] = __builtin_amdgcn_mfma_f32_32x32x16_f16(a[mt], b[nt], acc[mt][nt], 0, 0, 0);
        }
        __syncthreads();
    }
#undef GT_DMA
    float* Cs = (float*)smem;
#pragma unroll
    for (int mt = 0; mt < 2; ++mt)
#pragma unroll
        for (int nt = 0; nt < 2; ++nt)
#pragma unroll
            for (int r = 0; r < 16; ++r) {
                const int row = wm * 64 + mt * 32 + (r & 3) + 8 * (r >> 2) + 4 * hh, col = wn * 64 + nt * 32 + l31;
                Cs[row * CS_LD + col] = acc[mt][nt][r];
            }
    __syncthreads();
    epi(p, Cs, m0, n0, tid);
}

__device__ __forceinline__ float group_sum16(float v) { v += __shfl_xor(v, 1); v += __shfl_xor(v, 2); v += __shfl_xor(v, 4); v += __shfl_xor(v, 8); return v; }
__device__ __forceinline__ float group_sum8(float v) { v += __shfl_xor(v, 1); v += __shfl_xor(v, 2); v += __shfl_xor(v, 4); return v; }

struct Seg {
    float* bp; float* bs; int ld; int col; int norm; const float* gain;
    h16* hp; h16* hs; int hld; int hcol; float hscale;
    int vt; int head;
};

__device__ __forceinline__ Seg seg_of(const Params& p, int n0) {
    float* P = (float*)(p.ws + WS_P);
    float* out = p.out;
    h16* QA = (h16*)(p.ws + WS_QA); h16* QB = (h16*)(p.ws + WS_QB); h16* QC = (h16*)(p.ws + WS_QC); h16* G = (h16*)(p.ws + WS_G);
    Seg s; s.norm = 0; s.gain = nullptr; s.hp = nullptr; s.hs = nullptr; s.hld = 0; s.hcol = 0; s.hscale = 1.f; s.vt = 0; s.head = 0;
    s.bp = nullptr; s.bs = nullptr; s.ld = 0; s.col = 0;
#define SEG_O(op, os, ldv, c) do { s.bp = out + (op); s.bs = out + (os) - (size_t)SEQ * (ldv); s.ld = (ldv); s.col = (c); } while (0)
#define SEG_H(ptr, ldv, c, sc) do { s.hp = (ptr); s.hs = (ptr); s.hld = (ldv); s.hcol = (c); s.hscale = (sc); } while (0)
    if (n0 < 512) { s.norm = 64; s.gain = p.in[14]; SEG_H(QA, 512, n0, 0.125f * LOG2E); }
    else if (n0 < 1024) { SEG_O(O_PAK, O_SAK, 512, n0 - 512); s.norm = 64; s.gain = p.in[15]; s.hp = (h16*)(p.ws + WS_KA_P); s.hs = nullptr; s.hld = 512; s.hcol = n0 - 512; }
    else if (n0 < 1536) { SEG_O(O_PAV, O_SAV, 512, n0 - 1024); s.vt = 1; s.head = (n0 - 1024) >> 6; }
    else if (n0 < 2048) { SEG_H(G, 1024, n0 - 1536, 1.f); }
    else if (n0 < 2304) { s.bp = P; s.bs = P; s.ld = LDP; s.col = PC_IQ + n0 - 2048; SEG_H((h16*)(p.ws + WS_IQ16), 256, n0 - 2048, 1.f); }
    else if (n0 < 2560) { s.norm = 32; s.gain = p.in[16]; SEG_H(QB, 256, n0 - 2304, 0.17677669529663687f * LOG2E); }
    else if (n0 < 2816) { SEG_O(O_PBK, O_SBK, 256, n0 - 2560); s.norm = 32; s.gain = p.in[17]; s.hp = (h16*)(p.ws + WS_KB_P); s.hs = nullptr; s.hld = 256; s.hcol = n0 - 2560; }
    else if (n0 < 3072) { SEG_O(O_PBV, O_SBV, 256, n0 - 2816); s.vt = 2; s.head = (n0 - 2816) >> 6; }
    else if (n0 < 3328) { SEG_H(G, 1024, 512 + n0 - 3072, 1.f); }
    else if (n0 < 3584) { s.norm = 64; s.gain = p.in[23]; SEG_H(QC, 256, n0 - 3328, 0.125f * LOG2E); }
    else { SEG_H(G, 1024, 768 + n0 - 3584, 1.f); }
#undef SEG_O
#undef SEG_H
    return s;
}

__device__ __forceinline__ void vt_store(const float* Cs, int j, h16* dst_base, size_t ldv, int tid) {
    const int dv = tid & 63, rq = tid >> 6;
    h16* dst = dst_base + (size_t)dv * ldv + 32 * rq;
#pragma unroll
    for (int e8 = 0; e8 < 4; ++e8) {
        u32x4 o;
#pragma unroll
        for (int e = 0; e < 4; ++e) o[e] = pkbf(Cs[(32 * rq + 8 * e8 + 2 * e) * CS_LD + 64 * j + dv], Cs[(32 * rq + 8 * e8 + 2 * e + 1) * CS_LD + 64 * j + dv]);
        *(u32x4*)(dst + 8 * e8) = o;
    }
}

struct EpiIn {
    __device__ __forceinline__ void operator()(const Params& p, const float* Cs, int m0, int n0, int tid) const {
        const int cg = tid & 15, r0 = tid >> 4;
#pragma unroll 1
        for (int j = 0; j < 2; ++j) {
            const int n0j = n0 + 64 * j;
            if (n0j >= DIN) continue;
            if (n0j == 3840) {
                float* P = (float*)(p.ws + WS_P);
                float mx0 = 0.f, mx1 = 0.f;
#pragma unroll 1
                for (int i = 0; i < 8; ++i) {
                    const int rl = r0 + 16 * i, row = m0 + rl;
                    const float4 v = *(const float4*)&Cs[rl * CS_LD + 4 * cg];
                    float ss = (cg < 8) ? (v.x * v.x + v.y * v.y + v.z * v.z + v.w * v.w) : 0.f;
                    ss = group_sum8(ss);
                    if (i < 4) mx0 = fmaxf(mx0, ss); else mx1 = fmaxf(mx1, ss);
                    if (cg < 8) {
                        float* dst = (row < SEQ ? p.out + O_PAKI + (size_t)row * 32 : p.out + O_SAKI + (size_t)(row - SEQ) * 32) + 4 * cg; *(float4*)dst = v;
                        h16x4 hv; hv.x = (h16)v.x; hv.y = (h16)v.y; hv.z = (h16)v.z; hv.w = (h16)v.w;
                        h16* hd = row < SEQ ? (h16*)(p.ws + WS_IK_P) + (size_t)row * 32 : (h16*)(p.ws + WS_IK_S) + ((size_t)((row - SEQ) >> 6) * (PAST + DECS) + PAST + ((row - SEQ) & 63)) * 32;
                        *(h16x4*)(hd + 4 * cg) = hv;
                    }
                    else if (cg < 10) { *(float4*)(P + (size_t)row * LDP + PC_IW + 4 * (cg - 8)) = v; }
                }
                if (cg == 0) {
                    unsigned* ctl = (unsigned*)(p.ws + WS_CTL);
                    if (m0 < SEQ) atomicMax(ctl, __float_as_uint(fmaxf(mx0, mx1)));
                    else { const int b0 = (m0 - SEQ) >> 6; atomicMax(ctl + 1 + b0, __float_as_uint(mx0)); atomicMax(ctl + 2 + b0, __float_as_uint(mx1)); }
                }
                continue;
            }
            const Seg s = seg_of(p, n0j);
            float4 g4 = make_float4(1.f, 1.f, 1.f, 1.f);
            if (s.norm == 64) g4 = *(const float4*)(s.gain + 4 * cg);
            else if (s.norm == 32) g4 = *(const float4*)(s.gain + ((4 * cg) & 31));
#pragma unroll 1
            for (int i = 0; i < 8; ++i) {
                const int rl = r0 + 16 * i, row = m0 + rl;
                float4 v = *(const float4*)&Cs[rl * CS_LD + 64 * j + 4 * cg];
                if (s.norm) {
                    float ss = v.x * v.x + v.y * v.y + v.z * v.z + v.w * v.w;
                    float sc;
                    if (s.norm == 64) { ss = group_sum16(ss); sc = 1.0f / sqrtf(ss * (1.0f / 64.0f) + EPS); }
                    else { ss = group_sum8(ss); sc = 1.0f / sqrtf(ss * (1.0f / 32.0f) + EPS); }
                    v.x *= sc * g4.x; v.y *= sc * g4.y; v.z *= sc * g4.z; v.w *= sc * g4.w;
                }
                if (s.bp) *(float4*)((row < SEQ ? s.bp : s.bs) + (size_t)row * s.ld + s.col + 4 * cg) = v;
                h16* hb = row < SEQ ? s.hp : s.hs;
                if (hb) {
                    h16x4 hv; hv.x = (h16)(v.x * s.hscale); hv.y = (h16)(v.y * s.hscale); hv.z = (h16)(v.z * s.hscale); hv.w = (h16)(v.w * s.hscale);
                    *(h16x4*)(hb + (size_t)row * s.hld + s.hcol + 4 * cg) = hv;
                }
            }
            if (s.vt == 2 && m0 < SEQ) vt_store(Cs, j, (h16*)(p.ws + WS_VTB_P) + (size_t)(s.head * 64) * SEQ + m0, SEQ, tid);
            if (s.vt == 1 && m0 < SEQ) vt_store(Cs, j, (h16*)(p.ws + WS_VTA_P) + (size_t)(s.head * 64) * SEQ + m0, SEQ, tid);
        }
    }
};

struct EpiMem {
    __device__ __forceinline__ void operator()(const Params& p, const float* Cs, int m0, int n0, int tid) const {
        const int cg = tid & 15, r0 = tid >> 4;
#pragma unroll 1
        for (int j = 0; j < 2; ++j) {
            const int n0j = n0 + 64 * j;
            const bool isk = n0j < 256;
            const float4 g4 = isk ? *(const float4*)(p.in[24] + 4 * cg) : make_float4(1.f, 1.f, 1.f, 1.f);
#pragma unroll 1
            for (int i = 0; i < 8; ++i) {
                const int rl = r0 + 16 * i, row = m0 + rl;
                float4 v = *(const float4*)&Cs[rl * CS_LD + 64 * j + 4 * cg];
                if (isk) {
                    float ss = group_sum16(v.x * v.x + v.y * v.y + v.z * v.z + v.w * v.w);
                    const float sc = 1.0f / sqrtf(ss * (1.0f / 64.0f) + EPS);
                    v.x *= sc * g4.x; v.y *= sc * g4.y; v.z *= sc * g4.z; v.w *= sc * g4.w;
                    h16x4 hv; hv.x = (h16)v.x; hv.y = (h16)v.y; hv.z = (h16)v.z; hv.w = (h16)v.w;
                    *(h16x4*)((h16*)(p.ws + WS_MK_P) + (size_t)row * 256 + n0j + 4 * cg) = hv;
                }
                float* dst = p.out + (isk ? O_PMK : O_PMV) + (size_t)row * 256 + (isk ? n0j : n0j - 256) + 4 * cg;
                *(float4*)dst = v;
            }
            if (!isk) vt_store(Cs, j, (h16*)(p.ws + WS_MVT_P) + (size_t)(((n0j - 256) >> 6) * 64) * NMEM + m0, NMEM, tid);
        }
    }
};

struct EpiOut {
    __device__ __forceinline__ void operator()(const Params& p, const float* Cs, int m0, int n0, int tid) const {
        const int cg = tid & 15, r0 = tid >> 4;
#pragma unroll 1
        for (int i = 0; i < 8; ++i) {
            const int rl = r0 + 16 * i, row = m0 + rl;
            const float* x = (row < SEQ ? p.in[0] + (size_t)row * D : p.in[1] + (size_t)(row - SEQ) * D) + n0 + 4 * cg;
            float* y = (row < SEQ ? p.out + O_YP + (size_t)row * D : p.out + O_YS + (size_t)(row - SEQ) * D) + n0 + 4 * cg;
#pragma unroll
            for (int j = 0; j < 2; ++j) {
                const float4 v = *(const float4*)&Cs[rl * CS_LD + 64 * j + 4 * cg];
                const float4 xv = *(const float4*)(x + 64 * j);
                *(float4*)(y + 64 * j) = make_float4(xv.x + v.x, xv.y + v.y, xv.z + v.z, xv.w + v.w);
            }
        }
    }
};

__device__ void phase1(const Params& p, unsigned char* smem) {
    const h16* XH = (const h16*)(p.ws + WS_XH);
    const h16* HMH = (const h16*)(p.ws + WS_HMH);
    const h16* WTIN = (const h16*)(p.ws + WS_WTIN);
    const h16* WTMEM = (const h16*)(p.ws + WS_WTMEM);
    const EpiIn ein{}; const EpiMem emem{};
    const int G = gridDim.x;
    if ((G & 7) == 0) {
        const int xcd = blockIdx.x & 7, local = blockIdx.x >> 3, LG = G >> 3;
        for (int lin = local; lin < 6 * 96; lin += LG) {
            const int rgroup = lin / 96, rem = lin % 96, chalf = rem / 48, rem2 = rem % 48, r = rem2 >> 4, c = chalf * 16 + (rem2 & 15);
            if (c >= 31) continue;
            const int rt = xcd + 8 * (rgroup * 3 + r);
            gemm_tile(p, XH, WTIN, rt * 128, c * 128, smem, ein);
        }
        if (blockIdx.x < 8) { const int rt = blockIdx.x / 4, ct = blockIdx.x % 4; gemm_tile(p, HMH, WTMEM, rt * 128, ct * 128, smem, emem); }
    } else {
        constexpr int NCT = NPAD_IN / 128, NRT = MROWS / 128;
        constexpr int N_IN = NCT * NRT, N_MEM = 2 * 4;
        for (int it = blockIdx.x; it < N_IN + N_MEM; it += gridDim.x) {
            if (it < N_IN) { const int rt = it / NCT, ct = it % NCT; gemm_tile(p, XH, WTIN, rt * 128, ct * 128, smem, ein); }
            else { const int im = it - N_IN, rt = im / 4, ct = im % 4; gemm_tile(p, HMH, WTMEM, rt * 128, ct * 128, smem, emem); }
        }
    }
}

struct KeySrc {
    const float* cache; const float* fresh; int past; int ld;
    __device__ __forceinline__ const float* row(int k) const { return k < past ? cache + (size_t)k * ld : fresh + (size_t)(k - past) * ld; }
};

__device__ __forceinline__ unsigned fkey(float f) { const unsigned u = __float_as_uint(f); return (u & 0x80000000u) ? ~u : (u | 0x80000000u); }

struct SmemDsa {
    float sc[16384];
    float iq[256]; float iw[8];
    unsigned hist[256]; unsigned mw[512];
    int wcnt[4]; int wcnt2[4]; int misc[4];
};

__device__ void select_item(const Params& p, unsigned char* smem, int item) {
    SmemDsa& S = *(SmemDsa*)smem;
    int tid = threadIdx.x; asm volatile("" : "+v"(tid));
    const int lane = tid & 63, w = tid >> 6;
    const float* P = (const float*)(p.ws + WS_P);
    int row, N; KeySrc ki; unsigned* mout;
    if (item < SEQ) {
        row = item; N = 64 * (item / 64 + 1);
        ki = KeySrc{nullptr, p.out + O_PAKI, 0, 32};
        mout = (unsigned*)(p.ws + WS_MASK_P) + (size_t)item * 512;
    } else {
        const int bt = item - SEQ, b = bt / DECS;
        row = item; N = PAST + DECS;
        ki = KeySrc{p.in[5] + (size_t)b * PAST * 32, p.out + O_SAKI + (size_t)b * DECS * 32, PAST, 32};
        mout = (unsigned*)(p.ws + WS_MASK_S) + (size_t)bt * 34;
    }
    const int nw = N / 32;
    __syncthreads();
    if (N <= 256) {
        if (tid < nw) mout[tid] = 0xffffffffu;
        return;
    }
    S.iq[tid] = P[(size_t)row * LDP + PC_IQ + tid];
    if (tid < 8) S.iw[tid] = P[(size_t)row * LDP + PC_IW + tid];
    S.mw[tid] = 0u; S.mw[tid + 256] = 0u;
    __syncthreads();
    for (int k = tid; k < N; k += NT) {
        const float4* kr = (const float4*)ki.row(k);
        float kd[32];
#pragma unroll
        for (int i = 0; i < 8; ++i) { const float4 t4 = kr[i]; kd[4 * i] = t4.x; kd[4 * i + 1] = t4.y; kd[4 * i + 2] = t4.z; kd[4 * i + 3] = t4.w; }
        float score = 0.f;
#pragma unroll 1
        for (int h = 0; h < 8; ++h) {
            float d = 0.f;
#pragma unroll
            for (int i = 0; i < 32; ++i) d = fmaf(S.iq[h * 32 + i], kd[i], d);
            score = fmaf(S.iw[h], fmaxf(d, 0.f), score);
        }
        S.sc[k] = score;
    }
    __syncthreads();
    unsigned prefix = 0; int remaining = 256;
    for (int pass = 0; pass < 4; ++pass) {
        const int shift = 24 - 8 * pass;
        S.hist[tid] = 0;
        __syncthreads();
        for (int k = tid; k < N; k += NT) {
            const unsigned key = fkey(S.sc[k]);
            if (pass == 0 || (key >> (shift + 8)) == prefix) atomicAdd(&S.hist[(key >> shift) & 255u], 1u);
        }
        __syncthreads();
        const int hv = (int)S.hist[tid];
        int x = hv;
#pragma unroll
        for (int o = 1; o < 64; o <<= 1) { const int y = __shfl_down(x, o); if (lane + o < 64) x += y; }
        if (lane == 0) S.wcnt[w] = x;
        __syncthreads();
        int above = x - hv;
        for (int w2 = w + 1; w2 < 4; ++w2) above += S.wcnt[w2];
        if (above < remaining && remaining <= above + hv) { S.misc[0] = (int)((prefix << 8) | (unsigned)tid); S.misc[1] = remaining - above; }
        __syncthreads();
        prefix = (unsigned)S.misc[0]; remaining = S.misc[1];
        __syncthreads();
    }
    const unsigned T = prefix; const int r = remaining;
    int base_eq = 0;
    const unsigned long long lt = (lane == 0) ? 0ull : (~0ull >> (64 - lane));
    for (int k0 = 0; k0 < N; k0 += NT) {
        const int k = k0 + tid;
        const unsigned key = (k < N) ? fkey(S.sc[k]) : 0u;
        const bool gt = (k < N) && key > T, eq = (k < N) && key == T;
        const unsigned long long beq = __ballot(eq);
        const int eqpre = __popcll(beq & lt);
        if (lane == 0) S.wcnt[w] = __popcll(beq);
        __syncthreads();
        int eqbase = base_eq, eqtot = 0;
        for (int w2 = 0; w2 < 4; ++w2) { const int c = S.wcnt[w2]; if (w2 < w) eqbase += c; eqtot += c; }
        const bool sel = gt || (eq && (eqbase + eqpre) < r);
        const unsigned long long bs = __ballot(sel);
        if (lane == 0) S.mw[(k0 >> 5) + 2 * w] = (unsigned)bs;
        if (lane == 32) S.mw[(k0 >> 5) + 2 * w + 1] = (unsigned)(bs >> 32);
        base_eq += eqtot;
        __syncthreads();
    }
    for (int i = tid; i < nw; i += NT) mout[i] = S.mw[i];
}

typedef float f32x4m __attribute__((ext_vector_type(4)));
constexpr int CAND_CAP = 120;
struct SelSm {
    unsigned hist[16][1025];
    float cand_s[16][CAND_CAP]; int cand_k[16][CAND_CAP];
    int cnt[16]; int bstar[16]; int nabove[16]; int ovf[16];
};

__device__ __forceinline__ void score_tile(const h16x8& a, const h16x8 (&bq)[8], const float (&wq)[8], float (&sc)[4]) {
    sc[0] = 0.f; sc[1] = 0.f; sc[2] = 0.f; sc[3] = 0.f;
#pragma unroll
    for (int h = 0; h < 8; ++h) {
        f32x4m z = {0.f, 0.f, 0.f, 0.f};
        const f32x4m d = __builtin_amdgcn_mfma_f32_16x16x32_f16(a, bq[h], z, 0, 0, 0);
#pragma unroll
        for (int i = 0; i < 4; ++i) { const int bits = (int)__float_as_uint(d[i]); sc[i] = fmaf(wq[h], __uint_as_float((unsigned)(bits > 0 ? bits : 0)), sc[i]); }
    }
}

__device__ __forceinline__ int bin_of(float sc, float inv, float off) {
    int b = (int)fmaf(sc, inv, off);
    b = b < 0 ? 0 : (b > 1021 ? 1021 : b);
    const int bits = (int)__float_as_uint(sc);
    const int sgn = bits < -1 ? -1 : (bits > 1 ? 1 : bits);
    return b + sgn + 1;
}

__device__ void select_unit(const Params& p, unsigned char* smem, int u) {
    SelSm& S = *(SelSm*)smem;
    int tid = threadIdx.x; asm volatile("" : "+v"(tid));
    const int lane = tid & 63, w = __builtin_amdgcn_readfirstlane(tid >> 6), q = lane & 15, g = lane >> 4;
    int row0, N, ldm, kslot; const h16* IK; unsigned* mask;
    if (u < 1024) {
        const int q0 = 16 * (1023 - u);
        row0 = q0; N = 64 * (q0 / 64 + 1); IK = (const h16*)(p.ws + WS_IK_P); mask = (unsigned*)(p.ws + WS_MASK_P) + (size_t)q0 * 512; ldm = 512; kslot = 0;
    } else {
        const int bu = u - 1024, b = bu >> 2, t0 = 16 * (bu & 3);
        row0 = SEQ + 64 * b + t0; N = PAST + DECS; IK = (const h16*)(p.ws + WS_IK_S) + (size_t)b * (PAST + DECS) * 32;
        mask = (unsigned*)(p.ws + WS_MASK_S) + (size_t)(64 * b + t0) * 34; ldm = 34; kslot = 1 + b;
    }
    const int nw = N / 32;
    __syncthreads();
    if (N <= 256) {
        for (int i = tid; i < 16 * nw; i += NT) mask[(size_t)(i / nw) * ldm + (i % nw)] = 0xffffffffu;
        return;
    }
    for (int i = tid; i < 16 * 1025; i += NT) ((unsigned*)S.hist)[i] = 0u;
    if (tid < 16) { S.cnt[tid] = 0; S.ovf[tid] = 0; S.bstar[tid] = 0; S.nabove[tid] = 0; }
    const int rowq = row0 + q;
    const h16* IQ = (const h16*)(p.ws + WS_IQ16) + (size_t)rowq * 256 + 8 * g;
    const float* Pf = (const float*)(p.ws + WS_P) + (size_t)rowq * LDP + PC_IW;
    h16x8 bq[8]; float wq[8];
    float hi = 0.f, lo = 0.f;
#pragma unroll
    for (int h = 0; h < 8; ++h) {
        bq[h] = *(const h16x8*)(IQ + h * 32);
        wq[h] = Pf[h];
        float n2 = 0.f;
#pragma unroll
        for (int e = 0; e < 8; ++e) { const float x = (float)bq[h][e]; n2 = fmaf(x, x, n2); }
        n2 += __shfl_xor(n2, 16); n2 += __shfl_xor(n2, 32);
        const float t = wq[h] * sqrtf(n2);
        if (t > 0.f) hi += t; else lo += t;
    }
    const float kmax = sqrtf(__uint_as_float(((const unsigned*)(p.ws + WS_CTL))[kslot])) * 1.01f;
    hi = hi * kmax + 1e-6f; lo = lo * kmax - 1e-6f;
    const float inv = 1022.0f / fmaxf(hi - lo, 1e-20f), off = -lo * inv;
    __syncthreads();
    const h16* ikp = IK + (size_t)q * 32 + 8 * g;
    const int ngw = (nw - w + 3) >> 2;
#define SEL_LD(dst0, dst1, it_) do { const int gi_ = w + 4 * ((it_) < ngw ? (it_) : ngw - 1); \
        dst0 = *(const h16x8*)(ikp + (size_t)(32 * gi_) * 32); dst1 = *(const h16x8*)(ikp + (size_t)(32 * gi_ + 16) * 32); } while (0)
    {
        h16x8 a0, a1; SEL_LD(a0, a1, 0);
        for (int it = 0; it < ngw; ++it) {
            h16x8 n0, n1; SEL_LD(n0, n1, it + 1);
#pragma unroll
            for (int t = 0; t < 2; ++t) {
                float sc[4]; score_tile(t == 0 ? a0 : a1, bq, wq, sc);
#pragma unroll
                for (int i = 0; i < 4; ++i) { const int b = bin_of(sc[i], inv, off); atomicAdd(&S.hist[q][b], 1u); }
            }
            a0 = n0; a1 = n1;
        }
    }
    __syncthreads();
    for (int qq = 0; qq < 4; ++qq) {
        const int qi = 4 * w + qq;
        unsigned c = 0;
#pragma unroll
        for (int e = 0; e < 16; ++e) c += S.hist[qi][16 * lane + e];
        int x = (int)c;
#pragma unroll
        for (int o = 1; o < 64; o <<= 1) { const int y = __shfl_down(x, o); if (lane + o < 64) x += y; }
        const int above = x - (int)c;
        if (above < 256 && 256 <= above + (int)c) {
            int acc = above, bs = 16 * lane;
            for (int e = 15; e >= 0; --e) {
                const int v = (int)S.hist[qi][16 * lane + e];
                if (acc + v >= 256) { bs = 16 * lane + e; break; }
                acc += v;
            }
            S.bstar[qi] = bs; S.nabove[qi] = acc;
        }
    }
    __syncthreads();
    const int bst = S.bstar[q];
    unsigned* mrow = (unsigned*)S.hist;
    {
        h16x8 a0, a1; SEL_LD(a0, a1, 0);
        for (int it = 0; it < ngw; ++it) {
            h16x8 n0, n1; SEL_LD(n0, n1, it + 1);
            const int grp = w + 4 * it;
            unsigned word = 0u;
#pragma unroll
            for (int t = 0; t < 2; ++t) {
                const int k0 = 32 * grp + 16 * t;
                float sc[4]; score_tile(t == 0 ? a0 : a1, bq, wq, sc);
                unsigned nib = 0u;
#pragma unroll
                for (int i = 0; i < 4; ++i) {
                    const int b = bin_of(sc[i], inv, off);
                    if (b > bst) nib |= 1u << i;
                    else if (b == bst) {
                        const int pos = atomicAdd(&S.cnt[q], 1);
                        if (pos < CAND_CAP) { S.cand_s[q][pos] = sc[i]; S.cand_k[q][pos] = k0 + 4 * g + i; }
                    }
                }
                unsigned v = nib << (4 * g);
                v |= (unsigned)__shfl_xor((int)v, 16); v |= (unsigned)__shfl_xor((int)v, 32);
                word |= v << (16 * t);
            }
            if (g == 0) mrow[q * 512 + grp] = word;
            a0 = n0; a1 = n1;
        }
    }
#undef SEL_LD
    __syncthreads();
    for (int qq = 0; qq < 4; ++qq) {
        const int qi = 4 * w + qq;
        const int m = S.cnt[qi], r = 256 - S.nabove[qi];
        if (m > CAND_CAP) { if (lane == 0) S.ovf[qi] = 1; continue; }
        const int nparts = m > 64 ? 2 : 1;
        for (int part = 0; part < nparts; ++part) {
            const int me = lane + 64 * part;
            const float s_me = me < m ? S.cand_s[qi][me] : 0.f;
            const int k_me = me < m ? S.cand_k[qi][me] : 0;
            int rank = 0;
#pragma unroll 4
            for (int j = 0; j < m; ++j) { const float sj = S.cand_s[qi][j]; const int kj = S.cand_k[qi][j]; rank += (sj > s_me || (sj == s_me && kj < k_me)) ? 1 : 0; }
            if (me < m && rank < r) atomicOr(&mrow[qi * 512 + (k_me >> 5)], 1u << (k_me & 31));
        }
    }
    __syncthreads();
    for (int i = tid; i < 16 * nw; i += NT) { const int qi = i / nw, wd = i - qi * nw; mask[(size_t)qi * ldm + wd] = mrow[qi * 512 + wd]; }
    __syncthreads();
    if (tid == 0) {
        unsigned* fl = (unsigned*)(p.ws + WS_REDO) + (size_t)blockIdx.x * REDO_LD;
        unsigned n = fl[0];
        for (int qi = 0; qi < 16; ++qi) if (S.ovf[qi] && n + 1 < (unsigned)REDO_LD) { fl[1 + n] = (unsigned)(row0 + qi); ++n; }
        fl[0] = n;
    }
}

constexpr int ATT_TB_OFF = 32768;
constexpr int ATT_LDS = ATT_TB_OFF + 1024 + 16;

__device__ __forceinline__ int pi32(int r) { return (r & 0x13) | ((r & 4) << 1) | ((r & 8) >> 1); }
__device__ __forceinline__ unsigned pkrtz(float a, float b) { return __builtin_bit_cast(unsigned, __builtin_amdgcn_cvt_pkrtz(a, b)); }

struct AttnUnit {
    int row0, nrows, ntiles, qpos0, head;
    const h16* Kh; const h16* VTh; int ldk; int ldv;
    const float* Kc; const float* Vc; const float* Kn; const float* Vn; int ldf; int ntc;
    const unsigned* mask; int ldm;
};

template <int MODE, bool F32SRC, int NQ>
__device__ __forceinline__ void attn_unit(const Params& p, unsigned char* smem, const AttnUnit& U, float lam) {
    int tid = threadIdx.x; asm volatile("" : "+v"(tid));
    const int lane = tid & 63, w = __builtin_amdgcn_readfirstlane(tid >> 6), l31 = lane & 31, hh = lane >> 5;
    const int wq = (MODE == 1) ? (w & 1) : w, cmap = (MODE == 1) ? (w >> 1) : 0;
    const int qb = wq * 32 * NQ;
    const bool active = qb < U.nrows;
    const int chunk_w = (U.qpos0 + qb) >> 6;
    float* tb = (float*)(smem + ATT_TB_OFF);
    __syncthreads();
    if (MODE != 2) {
        if (tid < 255) { const int hc = (MODE == 0 ? U.head : 8 + U.head); tb[tid] = (p.in[10][rel_bucket(tid - 191) * 12 + hc] - p.in[10][15 * 12 + hc]) * LOG2E; }
    }
    if (MODE == 0 && tid < 4) ((unsigned*)(smem + ATT_TB_OFF + 1024))[tid] = ((tid & 1) ? 0x0000ffffu : 0u) | ((tid & 2) ? 0xffff0000u : 0u);
    constexpr int NQF = (MODE == 1) ? 2 : 4;
    h16x8 qf[NQ][NQF];
#pragma unroll
    for (int nq = 0; nq < NQ; ++nq) {
        if (active) {
            const int rowq = U.row0 + qb + 32 * nq + l31;
            const h16* Qb = (MODE == 0) ? (const h16*)(p.ws + WS_QA) + (size_t)rowq * 512 + U.head * 64
                          : (MODE == 1) ? (const h16*)(p.ws + WS_QB) + (size_t)rowq * 256 + U.head * 64 + 32 * cmap
                                        : (const h16*)(p.ws + WS_QC) + (size_t)rowq * 256 + U.head * 64;
#pragma unroll
            for (int s = 0; s < NQF; ++s) qf[nq][s] = *(const h16x8*)(Qb + 16 * s + 8 * hh);
        } else {
#pragma unroll
            for (int s = 0; s < NQF; ++s)
#pragma unroll
                for (int e = 0; e < 8; ++e) qf[nq][s][e] = (h16)0.f;
        }
    }
    f32x16 O[NQ][2];
    float lsum[NQ];
    const unsigned* lut = (const unsigned*)(smem + ATT_TB_OFF + 1024);
#pragma unroll
    for (int nq = 0; nq < NQ; ++nq) {
        lsum[nq] = 0.f;
#pragma unroll
        for (int m = 0; m < 2; ++m)
#pragma unroll
            for (int r = 0; r < 16; ++r) O[nq][m][r] = 0.f;
    }
    int crow[2], cch[2], so[2];
#pragma unroll
    for (int i = 0; i < 2; ++i) { const int c = tid + 256 * i; crow[i] = c >> 3; cch[i] = c & 7; so[i] = crow[i] * 128 + ((cch[i] ^ ((crow[i] >> 1) & 7)) << 4); }
#define ATT_STAGE_F32(b, j) do { \
        unsigned char* kt_ = smem + (b) * 16384; unsigned char* vt_ = kt_ + 8192; \
        const float* kb_ = ((j) < U.ntc) ? U.Kc + (size_t)(64 * (j)) * U.ldf : U.Kn + (size_t)(64 * ((j) - U.ntc)) * U.ldf; \
        const float* vb_ = ((j) < U.ntc) ? U.Vc + (size_t)(64 * (j)) * U.ldf : U.Vn + (size_t)(64 * ((j) - U.ntc)) * U.ldf; \
        { f32x4 f_[2][2]; \
          _Pragma("unroll") for (int i = 0; i < 2; ++i) { const float* ks_ = kb_ + (size_t)crow[i] * U.ldf + cch[i] * 8; f_[i][0] = *(const f32x4*)ks_; f_[i][1] = *(const f32x4*)(ks_ + 4); } \
          _Pragma("unroll") for (int i = 0; i < 2; ++i) { h16x8 hk_; _Pragma("unroll") for (int e = 0; e < 4; ++e) { hk_[e] = (h16)f_[i][0][e]; hk_[4 + e] = (h16)f_[i][1][e]; } \
            *(h16x8*)(kt_ + so[i]) = hk_; } } \
        asm volatile("" ::: "memory"); \
        { f32x4 f_[2][2]; \
          _Pragma("unroll") for (int i = 0; i < 2; ++i) { const float* vs_ = vb_ + (size_t)crow[i] * U.ldf + cch[i] * 8; f_[i][0] = *(const f32x4*)vs_; f_[i][1] = *(const f32x4*)(vs_ + 4); } \
          _Pragma("unroll") for (int i = 0; i < 2; ++i) { const int key_ = crow[i]; \
            _Pragma("unroll") for (int e = 0; e < 8; ++e) { const int dv_ = 8 * cch[i] + e; \
                *(__bf16*)(vt_ + dv_ * 128 + (((key_ >> 3) ^ ((dv_ >> 1) & 7)) << 4) + (key_ & 7) * 2) = (__bf16)(e < 4 ? f_[i][0][e] : f_[i][1][e - 4]); } } } } while (0)
    const int drow0 = 16 * w + (lane >> 3), drow1 = drow0 + 8;
    const int dch0 = (lane & 7) ^ ((drow0 >> 1) & 7), dch1 = (lane & 7) ^ ((drow1 >> 1) & 7);
    const unsigned char* kbase = F32SRC ? nullptr : (const unsigned char*)U.Kh;
    const unsigned char* vbase = F32SRC ? nullptr : (const unsigned char*)U.VTh;
    const unsigned kof0 = (unsigned)(drow0 * U.ldk + dch0 * 8) * 2u, kof1 = (unsigned)(drow1 * U.ldk + dch1 * 8) * 2u;
    const size_t vof0 = ((size_t)drow0 * U.ldv + dch0 * 8) * 2, vof1 = ((size_t)drow1 * U.ldv + dch1 * 8) * 2;
    const int dmo0 = (16 * w) * 128, dmo1 = (16 * w + 8) * 128;
#define ATT_DMA(b, j) do { \
        const unsigned char* kt_ = kbase + (size_t)(64 * (j)) * U.ldk * 2; const unsigned char* vt_ = vbase + (size_t)(64 * (j)) * 2; \
        __builtin_amdgcn_global_load_lds((const unsigned*)(kt_ + kof0), (__attribute__((address_space(3))) unsigned*)(smem + (b) * 16384 + dmo0), 16, 0, 0); \
        __builtin_amdgcn_global_load_lds((const unsigned*)(vt_ + vof0), (__attribute__((address_space(3))) unsigned*)(smem + (b) * 16384 + 8192 + dmo0), 16, 0, 0); \
        __builtin_amdgcn_global_load_lds((const unsigned*)(kt_ + kof1), (__attribute__((address_space(3))) unsigned*)(smem + (b) * 16384 + dmo1), 16, 0, 0); \
        __builtin_amdgcn_global_load_lds((const unsigned*)(vt_ + vof1), (__attribute__((address_space(3))) unsigned*)(smem + (b) * 16384 + 8192 + dmo1), 16, 0, 0); } while (0)
    if constexpr (!F32SRC) { ATT_DMA(0, 0); } else { ATT_STAGE_F32(0, 0); }
    const unsigned* mrow[NQ];
    unsigned mwn[NQ][2];
#pragma unroll
    for (int nq = 0; nq < NQ; ++nq) {
        mrow[nq] = (MODE == 0) ? U.mask + (size_t)(qb + 32 * nq + l31) * U.ldm : nullptr;
        mwn[nq][0] = 0xffffffffu; mwn[nq][1] = 0xffffffffu;
        if (MODE == 0 && NQ == 1) { mwn[nq][0] = mrow[nq][0]; mwn[nq][1] = mrow[nq][1]; }
    }
    __syncthreads();
    const int pil = pi32(l31), ksw = (pil >> 1) & 7, vsw = (l31 >> 1) & 7;
    const int jlast = U.ntiles - 1;
    for (int j = 0; j < U.ntiles; ++j) {
        const int buf = j & 1;
        const int jn = j < jlast ? j + 1 : jlast;
        unsigned mw[NQ][2];
#pragma unroll
        for (int nq = 0; nq < NQ; ++nq) {
            if (NQ == 1) {
                mw[nq][0] = mwn[nq][0] >> (8 * hh); mw[nq][1] = mwn[nq][1] >> (8 * hh);
                if (MODE == 0) { mwn[nq][0] = mrow[nq][2 * jn]; mwn[nq][1] = mrow[nq][2 * jn + 1]; }
            } else {
                mw[nq][0] = 0xffffffffu; mw[nq][1] = 0xffffffffu;
                if (MODE == 0) { mw[nq][0] = mrow[nq][2 * j] >> (8 * hh); mw[nq][1] = mrow[nq][2 * j + 1] >> (8 * hh); }
            }
        }
        if constexpr (!F32SRC) ATT_DMA(buf ^ 1, jn);
        if (active && (MODE == 2 || j <= chunk_w)) {
            const unsigned char* Kt = smem + buf * 16384;
            const unsigned char* Vt = Kt + 8192;
            const bool near = (MODE != 2) && (j >= chunk_w - 2);
#pragma unroll
            for (int u = 0; u < 2; ++u) {
                const unsigned char* kp = Kt + (32 * u + pil) * 128;
                bf16x8 pf[NQ][2];
                h16x8 kf[NQF];
#pragma unroll
                for (int s = 0; s < NQF; ++s) { const int ch = (MODE == 1) ? (4 * cmap + 2 * s + hh) : (2 * s + hh); kf[s] = *(const h16x8*)(kp + ((ch ^ ksw) << 4)); }
#pragma unroll
                for (int nq = 0; nq < NQ; ++nq) {
                    f32x16 S;
#pragma unroll
                    for (int r = 0; r < 16; ++r) S[r] = 0.f;
#pragma unroll
                    for (int s = 0; s < NQF; ++s) S = __builtin_amdgcn_mfma_f32_32x32x16_f16(kf[s], qf[nq][s], S, 0, 0, 0);
                    if (near) {
                        const int base = 64 * j + 32 * u + 8 * hh - (U.qpos0 + qb + 32 * nq + l31) + 191;
#pragma unroll
                        for (int i = 0; i < 16; ++i) S[i] += tb[base + (i & 7) + 16 * (i >> 3)];
                    }
#pragma unroll
                    for (int i = 0; i < 16; ++i) S[i] = __builtin_amdgcn_exp2f(S[i]);
#pragma unroll
                    for (int s2 = 0; s2 < 2; ++s2) {
                        u32x4 pk;
#pragma unroll
                        for (int e = 0; e < 4; ++e) {
                            unsigned v = pkbf(S[8 * s2 + 2 * e], S[8 * s2 + 2 * e + 1]);
                            if (MODE == 0) v &= lut[(mw[nq][u] >> (16 * s2 + 2 * e)) & 3u];
                            lsum[nq] = __builtin_amdgcn_fdot2_f32_bf16(__builtin_bit_cast(bf16x2, v), __builtin_bit_cast(bf16x2, 0x3f803f80u), lsum[nq], false);
                            pk[e] = v;
                        }
                        pf[nq][s2] = __builtin_bit_cast(bf16x8, pk);
                    }
                }
#pragma unroll
                for (int m = 0; m < 2; ++m)
#pragma unroll
                    for (int s2 = 0; s2 < 2; ++s2) {
                        const bf16x8 vfr = *(const bf16x8*)(Vt + (32 * m + l31) * 128 + (((2 * (2 * u + s2) + hh) ^ vsw) << 4));
#pragma unroll
                        for (int nq = 0; nq < NQ; ++nq) O[nq][m] = __builtin_amdgcn_mfma_f32_32x32x16_bf16(vfr, pf[nq][s2], O[nq][m], 0, 0, 0);
                    }
            }
        }
        if constexpr (F32SRC) { ATT_STAGE_F32(buf ^ 1, jn); }
        __syncthreads();
    }
#undef ATT_STAGE_F32
#undef ATT_DMA
    float inv[NQ];
#pragma unroll
    for (int nq = 0; nq < NQ; ++nq) { const float l = lsum[nq] + __shfl_xor(lsum[nq], 32); inv[nq] = 1.0f / l; }
    if (MODE == 1) {
        float* X = (float*)smem;
        if (cmap == 1) {
#pragma unroll
            for (int nq = 0; nq < NQ; ++nq)
#pragma unroll
                for (int m = 0; m < 2; ++m)
#pragma unroll
                    for (int i = 0; i < 16; ++i) X[((wq * NQ + nq) * 32 + m * 16 + i) * 64 + lane] = O[nq][m][i] * inv[nq];
        }
        __syncthreads();
        if (cmap == 1) return;
#pragma unroll
        for (int nq = 0; nq < NQ; ++nq)
#pragma unroll
            for (int m = 0; m < 2; ++m)
#pragma unroll
                for (int i = 0; i < 16; ++i) O[nq][m][i] = O[nq][m][i] * inv[nq] - lam * X[((wq * NQ + nq) * 32 + m * 16 + i) * 64 + lane];
    } else {
        if (!active) return;
#pragma unroll
        for (int nq = 0; nq < NQ; ++nq)
#pragma unroll
            for (int m = 0; m < 2; ++m)
#pragma unroll
                for (int i = 0; i < 16; ++i) O[nq][m][i] *= inv[nq];
    }
    const int colbase = (MODE == 0 ? 0 : (MODE == 1 ? 512 : 768)) + U.head * 64;
#pragma unroll
    for (int nq = 0; nq < NQ; ++nq) {
        const int rowq = U.row0 + qb + 32 * nq + l31;
        const h16* G = (const h16*)(p.ws + WS_G) + (size_t)rowq * 1024 + colbase;
        h16* Oo = (h16*)(p.ws + WS_O16) + (size_t)rowq * 1024 + colbase;
        float sc = 1.f;
        if (MODE == 1) {
            float ss = 0.f;
#pragma unroll
            for (int m = 0; m < 2; ++m)
#pragma unroll
                for (int i = 0; i < 16; ++i) ss = fmaf(O[nq][m][i], O[nq][m][i], ss);
            ss += __shfl_xor(ss, 32);
            sc = (1.0f / sqrtf(ss * (1.0f / 64.0f) + EPS)) * 0.8f;
        }
#pragma unroll
        for (int m = 0; m < 2; ++m)
#pragma unroll
            for (int g4 = 0; g4 < 4; ++g4) {
                const int dv = 32 * m + 8 * g4 + 4 * hh;
                const h16x4 gv = *(const h16x4*)(G + dv);
                h16x4 o4;
#pragma unroll
                for (int e = 0; e < 4; ++e) {
                    float o = O[nq][m][4 * g4 + e];
                    if (MODE == 1) o = o * sc * p.in[18][dv + e];
                    o4[e] = (h16)(o * silu((float)gv[e]));
                }
                *(h16x4*)(Oo + dv) = o4;
            }
    }
}

__device__ __forceinline__ AttnUnit unit_zero() {
    AttnUnit U; U.row0 = 0; U.nrows = 0; U.ntiles = 0; U.qpos0 = 0; U.head = 0; U.Kh = nullptr; U.VTh = nullptr; U.ldk = 0; U.ldv = 0;
    U.Kc = nullptr; U.Vc = nullptr; U.Kn = nullptr; U.Vn = nullptr; U.ldf = 0; U.ntc = 0; U.mask = nullptr; U.ldm = 0; return U;
}
__device__ __forceinline__ void unit_a_prompt(const Params& p, unsigned char* smem, int g, int head) {
    AttnUnit U = unit_zero();
    U.row0 = 256 * g; U.nrows = 256; U.ntiles = 4 * g + 4; U.qpos0 = 256 * g; U.head = head;
    U.Kh = (const h16*)(p.ws + WS_KA_P) + head * 64; U.ldk = 512;
    U.VTh = (const h16*)(p.ws + WS_VTA_P) + (size_t)(head * 64) * SEQ; U.ldv = SEQ;
    U.mask = (const unsigned*)(p.ws + WS_MASK_P) + (size_t)(256 * g) * 512; U.ldm = 512;
    attn_unit<0, false, 2>(p, smem, U, 0.f);
}
__device__ __forceinline__ void unit_b_prompt(const Params& p, unsigned char* smem, int g, int head, float lam) {
    AttnUnit U = unit_zero();
    U.row0 = 128 * g; U.nrows = 128; U.ntiles = 2 * g + 2; U.qpos0 = 128 * g; U.head = head;
    U.Kh = (const h16*)(p.ws + WS_KB_P) + head * 64; U.ldk = 256;
    U.VTh = (const h16*)(p.ws + WS_VTB_P) + (size_t)(head * 64) * SEQ; U.ldv = SEQ;
    attn_unit<1, false, 2>(p, smem, U, lam);
}
__device__ __forceinline__ void unit_a_sample(const Params& p, unsigned char* smem, int b, int head) {
    AttnUnit U = unit_zero();
    U.row0 = SEQ + 64 * b; U.nrows = 64; U.ntiles = 17; U.qpos0 = PAST; U.head = head;
    U.Kc = p.in[3] + (size_t)b * PAST * 512 + head * 64; U.Vc = p.in[4] + (size_t)b * PAST * 512 + head * 64;
    U.Kn = p.out + O_SAK + (size_t)b * DECS * 512 + head * 64; U.Vn = p.out + O_SAV + (size_t)b * DECS * 512 + head * 64;
    U.ldf = 512; U.ntc = 16;
    U.mask = (const unsigned*)(p.ws + WS_MASK_S) + (size_t)(64 * b) * 34; U.ldm = 34;
    attn_unit<0, true, 1>(p, smem, U, 0.f);
}
__device__ __forceinline__ void unit_b_sample(const Params& p, unsigned char* smem, int b, int head, float lam) {
    AttnUnit U = unit_zero();
    U.row0 = SEQ + 64 * b; U.nrows = 64; U.ntiles = 17; U.qpos0 = PAST; U.head = head;
    U.Kc = p.in[6] + (size_t)b * PAST * 256 + head * 64; U.Vc = p.in[7] + (size_t)b * PAST * 256 + head * 64;
    U.Kn = p.out + O_SBK + (size_t)b * DECS * 256 + head * 64; U.Vn = p.out + O_SBV + (size_t)b * DECS * 256 + head * 64;
    U.ldf = 256; U.ntc = 16;
    attn_unit<1, true, 1>(p, smem, U, lam);
}
__device__ __forceinline__ void unit_c_prompt(const Params& p, unsigned char* smem, int g, int head) {
    AttnUnit U = unit_zero();
    U.row0 = 128 * g; U.nrows = 128; U.ntiles = 4; U.head = head;
    U.Kh = (const h16*)(p.ws + WS_MK_P) + head * 64; U.ldk = 256;
    U.VTh = (const h16*)(p.ws + WS_MVT_P) + (size_t)(head * 64) * NMEM; U.ldv = NMEM;
    attn_unit<2, false, 1>(p, smem, U, 0.f);
}
__device__ __forceinline__ void unit_c_sample(const Params& p, unsigned char* smem, int b, int head) {
    AttnUnit U = unit_zero();
    U.row0 = SEQ + 64 * b; U.nrows = 64; U.ntiles = 4; U.head = head;
    U.Kc = p.in[8] + (size_t)b * NMEM * 256 + head * 64; U.Vc = p.in[9] + (size_t)b * NMEM * 256 + head * 64;
    U.Kn = U.Kc; U.Vn = U.Vc; U.ldf = 256; U.ntc = 4;
    attn_unit<2, true, 1>(p, smem, U, 0.f);
}

#define ZIGZAG_LOOP(NALL) for (int zk_ = 0, pos_ = 0; zk_ * (int)gridDim.x < (NALL); ++zk_) \
    if ((pos_ = (zk_ & 1) ? (zk_ + 1) * (int)gridDim.x - 1 - (int)blockIdx.x : zk_ * (int)gridDim.x + (int)blockIdx.x) < (NALL))

__device__ __forceinline__ float diff_lambda_of(const Params& p) {
    float s1 = 0.f, s2 = 0.f;
    for (int i = 0; i < 32; ++i) { s1 = fmaf(p.in[19][i], p.in[20][i], s1); s2 = fmaf(p.in[21][i], p.in[22][i], s2); }
    return expf(s1) - expf(s2) + 0.2f;
}

__device__ void phase2(const Params& p, unsigned char* smem) {
    const float lam = diff_lambda_of(p);
    constexpr int N_SP = 1024, N_BS = 128, N_CS = 128, N_SS = 128, N_CP = 512;
    constexpr int N_ALL = N_SP + N_BS + N_CS + N_SS + N_CP;
    ZIGZAG_LOOP(N_ALL) {
        int it = pos_;
        if (it < N_SP) { select_unit(p, smem, it); continue; }
        it -= N_SP;
        if (it < N_BS) { unit_b_sample(p, smem, it >> 2, it & 3, lam); continue; }
        it -= N_BS;
        if (it < N_CS) { unit_c_sample(p, smem, it >> 2, it & 3); continue; }
        it -= N_CS;
        if (it < N_SS) { select_unit(p, smem, 1024 + it); continue; }
        it -= N_SS;
        unit_c_prompt(p, smem, it >> 2, it & 3);
    }
    {
        __syncthreads();
        const unsigned* fl = (const unsigned*)(p.ws + WS_REDO) + (size_t)blockIdx.x * REDO_LD;
        const unsigned n = __builtin_amdgcn_readfirstlane((int)__hip_atomic_load(fl, __ATOMIC_RELAXED, __HIP_MEMORY_SCOPE_AGENT));
        for (unsigned i = 0; i < n; ++i) {
            const int row = __builtin_amdgcn_readfirstlane((int)__hip_atomic_load(fl + 1 + i, __ATOMIC_RELAXED, __HIP_MEMORY_SCOPE_AGENT));
            select_item(p, smem, row);
        }
    }
}

__device__ void phase3(const Params& p, unsigned char* smem) {
    const float lam = diff_lambda_of(p);
    const int G = gridDim.x;
    for (int i = blockIdx.x; i < 512; i += G) {
        { const int g = 63 - (i >> 3), head = i & 7; unit_a_prompt(p, smem, g, head); }
        { const int r = 511 - i, g = 127 - (r >> 2), head = r & 3; unit_b_prompt(p, smem, g, head, lam); }
        if (i >= 256) { const int s = i - 256; unit_a_sample(p, smem, s >> 3, s & 7); }
    }
}

__device__ void phase4(const Params& p, unsigned char* smem) {
    const h16* O16 = (const h16*)(p.ws + WS_O16);
    const h16* WTOUT = (const h16*)(p.ws + WS_WTOUT);
    constexpr int NCT = D / 128, NRT = MROWS / 128;
    const EpiOut eo{};
    const int G = gridDim.x;
    if ((G & 7) == 0) {
        const int xcd = blockIdx.x & 7, local = blockIdx.x >> 3, LG = G >> 3;
        for (int lin = local; lin < (NRT / 8) * NCT; lin += LG) {
            const int rt = xcd + 8 * (lin / NCT), ct = lin % NCT;
            gemm_tile(p, O16, WTOUT, rt * 128, ct * 128, smem, eo);
        }
    } else {
        for (int it = blockIdx.x; it < NCT * NRT; it += gridDim.x) {
            const int rt = it / NCT, ct = it % NCT;
            gemm_tile(p, O16, WTOUT, rt * 128, ct * 128, smem, eo);
        }
    }
}

constexpr int SMEM_BYTES = 80 * 1024;

__device__ __forceinline__ void grid_barrier(unsigned* cnt, unsigned target) {
    asm volatile("s_waitcnt vmcnt(0)" ::: "memory");
    __syncthreads();
    if (threadIdx.x == 0) {
        __builtin_amdgcn_fence(__ATOMIC_RELEASE, "agent");
        asm volatile("s_waitcnt vmcnt(0)" ::: "memory");
        __hip_atomic_fetch_add(cnt, 1u, __ATOMIC_RELAXED, __HIP_MEMORY_SCOPE_AGENT);
        while (__hip_atomic_load(cnt, __ATOMIC_RELAXED, __HIP_MEMORY_SCOPE_AGENT) < target) __builtin_amdgcn_s_sleep(2);
        __builtin_amdgcn_fence(__ATOMIC_ACQUIRE, "agent");
        asm volatile("s_waitcnt vmcnt(0)" ::: "memory");
    }
    __syncthreads();
}

__global__ void __launch_bounds__(NT, 2) fwd_kernel(Params p) {
    __shared__ __attribute__((aligned(16))) unsigned char smem[SMEM_BYTES];
    static_assert(ATT_LDS <= SMEM_BYTES && sizeof(SmemDsa) <= SMEM_BYTES && sizeof(SelSm) <= SMEM_BYTES && CS_LD * 128 * 4 <= SMEM_BYTES, "smem");
    unsigned nbar = 0;
    for (int ph = p.ph_lo; ph < p.ph_hi; ++ph) {
#ifndef REP_PHASE
#define REP_PHASE -1
#endif
        const int nrep = (ph == REP_PHASE) ? 2 : 1;
        for (int rep = 0; rep < nrep; ++rep) {
            if (ph == 0) phase0(p, smem);
            else if (ph == 1) phase1(p, smem);
            else if (ph == 2) phase2(p, smem);
            else if (ph == 3) phase3(p, smem);
            else phase4(p, smem);
            if (rep + 1 < nrep) cg::this_grid().sync();
        }
        if (ph + 1 < p.ph_hi) {
            if (p.ph_lo > 0) cg::this_grid().sync();
            else grid_barrier((unsigned*)(p.ws + WS_CTL) + 48, ++nbar * gridDim.x);
        }
    }
}

extern "C" void kernel_launch(void* const* d_in, const int* in_sizes, int n_in, void* d_out, int out_size, void* d_ws, size_t ws_size, hipStream_t stream) {
    static int grid_blocks = 0;
    if (!grid_blocks) {
        int dev = 0, cus = 0, per_cu = 0;
        (void)hipGetDevice(&dev);
        (void)hipDeviceGetAttribute(&cus, hipDeviceAttributeMultiprocessorCount, dev);
        (void)hipOccupancyMaxActiveBlocksPerMultiprocessor(&per_cu, fwd_kernel, NT, 0);
        if (per_cu < 1) per_cu = 1;
        if (per_cu > (160 * 1024) / SMEM_BYTES) per_cu = (160 * 1024) / SMEM_BYTES;
        grid_blocks = cus * per_cu;
        if (ws_size < WS_END) fprintf(stderr, "kernel_launch: workspace too small: %zu < %zu\n", ws_size, (size_t)WS_END);
    }
    if (ws_size < WS_END) return;
    (void)hipMemsetAsync((unsigned char*)d_ws + WS_CTL, 0, 256 + (size_t)2048 * REDO_LD * 4, stream);
    Params p{};
    for (int i = 0; i < 27; ++i) p.in[i] = (const float*)d_in[i];
    p.out = (float*)d_out; p.ws = (unsigned char*)d_ws;
#if ONE_LAUNCH
    p.ph_lo = 0; p.ph_hi = 5;
    void* args[] = {&p};
    hipError_t e = hipLaunchCooperativeKernel((void*)fwd_kernel, dim3(grid_blocks), dim3(NT), args, 0, stream);
    if (e != hipSuccess) fprintf(stderr, "cooperative launch failed: %s (grid %d)\n", hipGetErrorString(e), grid_blocks);
#else
    for (int ph = 0; ph < 5; ++ph) {
        p.ph_lo = ph; p.ph_hi = ph + 1;
        hipLaunchKernelGGL(fwd_kernel, dim3(grid_blocks), dim3(NT), 0, stream, p);
    }
#endif
}
```

```cpp
#include <hip/hip_runtime.h>
#include <hip/hip_cooperative_groups.h>
#include <cstdio>
#include <cstdint>
namespace cg = cooperative_groups;

#define NT 256

constexpr int D = 1024, SEQ = 16384, DECB = 32, DECS = 64, PAST = 1024, NMEM = 256;
constexpr int MROWS = SEQ + DECB * DECS;
constexpr int DIN = 3880;
constexpr int LDP = 264;
constexpr int PC_IQ = 0, PC_IW = 256;
constexpr float EPS = 1e-6f;

constexpr size_t O_YP = 0, O_YS = 16777216, O_PAK = 18874368, O_PAV = 27262976, O_PAKI = 35651584, O_PBK = 36175872,
                 O_PBV = 40370176, O_PMK = 44564480, O_PMV = 44630016, O_SAK = 44695552, O_SAV = 45744128,
                 O_SAKI = 46792704, O_SBK = 46858240, O_SBV = 47382528;

typedef _Float16 h16;
typedef h16 h16x2 __attribute__((ext_vector_type(2)));
typedef h16 h16x4 __attribute__((ext_vector_type(4)));
typedef h16 h16x8 __attribute__((ext_vector_type(8)));
typedef float f32x4 __attribute__((ext_vector_type(4)));
typedef unsigned u32x4 __attribute__((ext_vector_type(4)));
typedef __bf16 bf16x8 __attribute__((ext_vector_type(8)));
typedef __bf16 bf16x2 __attribute__((ext_vector_type(2)));
typedef float f32x2 __attribute__((ext_vector_type(2)));
__device__ __forceinline__ unsigned pkbf(float a, float b) { const f32x2 v = {a, b}; return __builtin_bit_cast(unsigned, __builtin_convertvector(v, bf16x2)); }
typedef float f32x16 __attribute__((ext_vector_type(16)));

constexpr int NPAD_IN = 3968;
constexpr float LOG2E = 1.4426950408889634f;
constexpr size_t WS_XH = 0;
constexpr size_t WS_O16 = WS_XH;
constexpr size_t WS_HMH = WS_XH + (size_t)MROWS * D * 2;
constexpr size_t WS_WTIN = WS_HMH + (size_t)NMEM * D * 2;
constexpr size_t WS_WTOUT = WS_WTIN + (size_t)NPAD_IN * D * 2;
constexpr size_t WS_WTMEM = WS_WTOUT + (size_t)D * D * 2;
constexpr size_t WS_QA = WS_WTMEM + (size_t)512 * D * 2;
constexpr size_t WS_QB = WS_QA + (size_t)MROWS * 512 * 2;
constexpr size_t WS_QC = WS_QB + (size_t)MROWS * 256 * 2;
constexpr size_t WS_G = WS_QC + (size_t)MROWS * 256 * 2;
constexpr size_t WS_KB_P = WS_G + (size_t)MROWS * 1024 * 2;
constexpr size_t WS_VTB_P = WS_KB_P + (size_t)SEQ * 256 * 2;
constexpr size_t WS_MK_P = WS_VTB_P + (size_t)SEQ * 256 * 2;
constexpr size_t WS_MVT_P = WS_MK_P + (size_t)NMEM * 256 * 2;
constexpr size_t WS_KA_P = WS_MVT_P + (size_t)NMEM * 256 * 2;
constexpr size_t WS_VTA_P = WS_KA_P + (size_t)SEQ * 512 * 2;
constexpr size_t WS_MASK_P = WS_VTA_P + (size_t)SEQ * 512 * 2;
constexpr size_t WS_MASK_S = WS_MASK_P + (size_t)SEQ * 512 * 4;
constexpr size_t WS_IQ16 = WS_MASK_S + (size_t)DECB * DECS * 34 * 4;
constexpr size_t WS_IK_P = WS_IQ16 + (size_t)MROWS * 256 * 2;
constexpr size_t WS_IK_S = WS_IK_P + (size_t)SEQ * 32 * 2;
constexpr size_t WS_CTL = WS_IK_S + (size_t)DECB * (PAST + DECS) * 32 * 2;
constexpr int REDO_LD = 64;
constexpr size_t WS_REDO = WS_CTL + 256;
constexpr size_t WS_P = WS_REDO + (size_t)2048 * REDO_LD * 4;
constexpr size_t WS_END = WS_P + (size_t)MROWS * LDP * 4;

struct Params {
    const float* in[27];
    float* out;
    unsigned char* ws;
    int ph_lo, ph_hi;
};

__device__ __forceinline__ float wave_sum(float v) {
#pragma unroll
    for (int o = 1; o < 64; o <<= 1) v += __shfl_xor(v, o);
    return v;
}
__device__ __forceinline__ float wave_max(float v) {
#pragma unroll
    for (int o = 1; o < 64; o <<= 1) v = fmaxf(v, __shfl_xor(v, o));
    return v;
}
__device__ __forceinline__ float silu(float x) { return x / (1.0f + expf(-x)); }

__device__ __forceinline__ int rel_bucket(int rel) {
    const int ret = rel > 0 ? 16 : 0;
    const int n = rel < 0 ? -rel : rel;
    int b;
    if (n < 8) b = n;
    else if (n < 12) b = 8;
    else if (n < 16) b = 9;
    else if (n < 23) b = 10;
    else if (n < 32) b = 11;
    else if (n < 46) b = 12;
    else if (n < 64) b = 13;
    else if (n < 91) b = 14;
    else b = 15;
    return ret + b;
}

__device__ __forceinline__ void rms_row_h(const float* x, const float* g, h16* o, int lane) {
    const float4* xr = (const float4*)x;
    const float4* gr = (const float4*)g;
    float4 v[4];
    float s = 0.f;
#pragma unroll
    for (int j = 0; j < 4; ++j) { v[j] = xr[lane + 64 * j]; s += v[j].x * v[j].x + v[j].y * v[j].y + v[j].z * v[j].z + v[j].w * v[j].w; }
    s = wave_sum(s);
    const float r = 1.0f / sqrtf(s * (1.0f / 1024.0f) + EPS);
#pragma unroll
    for (int j = 0; j < 4; ++j) {
        const float4 gg = gr[lane + 64 * j];
        h16x4 o4; o4.x = (h16)(v[j].x * r * gg.x); o4.y = (h16)(v[j].y * r * gg.y); o4.z = (h16)(v[j].z * r * gg.z); o4.w = (h16)(v[j].w * r * gg.w);
        ((h16x4*)o)[lane + 64 * j] = o4;
    }
}

__device__ __forceinline__ void transpose_item(const float* __restrict__ W, int ldw, int c0, int nvalid, int k0, h16* __restrict__ WT, int r0, float* scr, int lane) {
#pragma unroll 8
    for (int i = 0; i < 32; ++i) {
        const int kk = 2 * i + (lane >> 5), n = lane & 31;
        scr[kk * 33 + n] = (n < nvalid) ? W[(size_t)(k0 + kk) * ldw + c0 + n] : 0.f;
    }
    asm volatile("s_waitcnt lgkmcnt(0)" ::: "memory");
    const int c = lane & 7;
#pragma unroll
    for (int j = 0; j < 4; ++j) {
        const int n = (lane >> 3) + 8 * j;
        const float* s = scr + (8 * c) * 33 + n;
        h16x8 o;
#pragma unroll
        for (int e = 0; e < 8; ++e) o[e] = (h16)s[e * 33];
        *(h16x8*)(WT + (size_t)(r0 + n) * 1024 + k0 + 8 * c) = o;
    }
    asm volatile("s_waitcnt lgkmcnt(0)" ::: "memory");
}

__device__ __forceinline__ int inproj_col(int np) { return np < 2304 ? np : (np < 3840 ? np + 40 : np - 3840 + 2304); }

__device__ void phase0(const Params& p, unsigned char* smem) {
    int tid0 = threadIdx.x; asm volatile("" : "+v"(tid0));
    const int lane = tid0 & 63, w = tid0 >> 6;
    const int gw = blockIdx.x * 4 + w, ngw = gridDim.x * 4;
    h16* XH = (h16*)(p.ws + WS_XH);
    h16* HMH = (h16*)(p.ws + WS_HMH);
    h16* WTIN = (h16*)(p.ws + WS_WTIN);
    h16* WTOUT = (h16*)(p.ws + WS_WTOUT);
    h16* WTMEM = (h16*)(p.ws + WS_WTMEM);
    float* scr = (float*)smem + w * (64 * 33);
    constexpr int N_ROWS = MROWS + NMEM;
    constexpr int I_IN = 16 * (NPAD_IN / 32), I_OUT = 16 * 32, I_MEM = 16 * 16, I_KIDX = DECB * (PAST / 64);
    for (int it = gw; it < N_ROWS + I_IN + I_OUT + I_MEM + I_KIDX; it += ngw) {
        if (it < N_ROWS) {
            const int r = it;
            if (r < SEQ) rms_row_h(p.in[0] + (size_t)r * D, p.in[11], XH + (size_t)r * D, lane);
            else if (r < MROWS) rms_row_h(p.in[1] + (size_t)(r - SEQ) * D, p.in[11], XH + (size_t)r * D, lane);
            else rms_row_h(p.in[2] + (size_t)(r - MROWS) * D, p.in[25], HMH + (size_t)(r - MROWS) * D, lane);
        } else if (it < N_ROWS + I_IN) {
            const int r = it - N_ROWS, nb = r % (NPAD_IN / 32), kb = r / (NPAD_IN / 32);
            const int np0 = nb * 32;
            int nvalid = DIN - np0; nvalid = nvalid < 0 ? 0 : (nvalid > 32 ? 32 : nvalid);
            const int c0 = nvalid > 0 ? inproj_col(np0) : 0;
            transpose_item(p.in[12], DIN, c0, nvalid, kb * 64, WTIN, np0, scr, lane);
        } else if (it < N_ROWS + I_IN + I_OUT) {
            const int r = it - N_ROWS - I_IN, nb = r % 32, kb = r / 32;
            transpose_item(p.in[13], D, nb * 32, 32, kb * 64, WTOUT, nb * 32, scr, lane);
        } else if (it < N_ROWS + I_IN + I_OUT + I_MEM) {
            const int r = it - N_ROWS - I_IN - I_OUT, nb = r % 16, kb = r / 16;
            transpose_item(p.in[26], 512, nb * 32, 32, kb * 64, WTMEM, nb * 32, scr, lane);
        } else {
            const int r = it - N_ROWS - I_IN - I_OUT - I_MEM, b = r / (PAST / 64), key = (r % (PAST / 64)) * 64 + lane;
            const f32x4* src = (const f32x4*)(p.in[5] + ((size_t)b * PAST + key) * 32);
            h16* dst = (h16*)(p.ws + WS_IK_S) + ((size_t)b * (PAST + DECS) + key) * 32;
            float ss = 0.f;
#pragma unroll
            for (int c = 0; c < 4; ++c) {
                const f32x4 x0 = src[2 * c], x1 = src[2 * c + 1];
                h16x8 o;
#pragma unroll
                for (int e = 0; e < 4; ++e) { o[e] = (h16)x0[e]; o[4 + e] = (h16)x1[e]; ss = fmaf(x0[e], x0[e], ss); ss = fmaf(x1[e], x1[e], ss); }
                *(h16x8*)(dst + 8 * c) = o;
            }
            ss = wave_max(ss);
            if (lane == 0) atomicMax((unsigned*)(p.ws + WS_CTL) + 1 + b, __float_as_uint(ss));
        }
    }
}

constexpr int CS_LD = 132;
template <class Epi>
__device__ __forceinline__ void gemm_tile(const Params& p, const h16* __restrict__ A, const h16* __restrict__ Bt, int m0, int n0, unsigned char* smem, const Epi& epi) {
    int tid = threadIdx.x; asm volatile("" : "+v"(tid));
    const int lane = tid & 63, wid = tid >> 6, wm = wid >> 1, wn = wid & 1;
    const int l31 = lane & 31, hh = lane >> 5;
    f32x16 acc[2][2];
#pragma unroll
    for (int a = 0; a < 2; ++a)
#pragma unroll
        for (int b = 0; b < 2; ++b)
#pragma unroll
            for (int r = 0; r < 16; ++r) acc[a][b][r] = 0.f;
    const unsigned char* agl[4]; const unsigned char* bgl[4]; int ldo[4];
#pragma unroll
    for (int i = 0; i < 4; ++i) {
        const int row = 32 * wid + 8 * i + (lane >> 3), slot = lane & 7, ch = slot ^ ((row >> 1) & 7);
        agl[i] = (const unsigned char*)(A + (size_t)(m0 + row) * 1024 + ch * 8);
        bgl[i] = (const unsigned char*)(Bt + (size_t)(n0 + row) * 1024 + ch * 8);
        ldo[i] = (32 * wid + 8 * i) * 128;
    }
#define GT_DMA(stage_, kt_) do { const int ko_ = ((kt_) < 15 ? (kt_) : 15) * 128; \
        _Pragma("unroll") for (int i = 0; i < 4; ++i) { \
            __builtin_amdgcn_global_load_lds((const unsigned*)(agl[i] + ko_), (__attribute__((address_space(3))) unsigned*)(smem + (stage_) * 32768 + ldo[i]), 16, 0, 0); \
            __builtin_amdgcn_global_load_lds((const unsigned*)(bgl[i] + ko_), (__attribute__((address_space(3))) unsigned*)(smem + (stage_) * 32768 + 16384 + ldo[i]), 16, 0, 0); } } while (0)
    const int sw = (l31 >> 1) & 7;
    const int arow = (wm * 64 + l31) * 128, brow = (wn * 64 + l31) * 128;
    __syncthreads();
    GT_DMA(0, 0);
    __syncthreads();
    for (int kt = 0; kt < 16; ++kt) {
        const unsigned char* As = smem + (kt & 1) * 32768; const unsigned char* Bs = As + 16384;
        GT_DMA((kt + 1) & 1, kt + 1);
#pragma unroll
        for (int s = 0; s < 4; ++s) {
            const int co = (((2 * s + hh) ^ sw) << 4);
            h16x8 a[2], b[2];
#pragma unroll
            for (int mt = 0; mt < 2; ++mt) a[mt] = *(const h16x8*)(As + arow + mt * 32 * 128 + co);
#pragma unroll
            for (int nt = 0; nt < 2; ++nt) b[nt] = *(const h16x8*)(Bs + brow + nt * 32 * 128 + co);
#pragma unroll
            for (int mt = 0; mt < 2; ++mt)
#pragma unroll
                for (int nt = 0; nt < 2; ++nt) acc[mt][nt] = __builtin_amdgcn_mfma_f32_32x32x16_f16(a[mt], b[nt], acc[mt][nt], 0, 0, 0);
        }
        __syncthreads();
    }
#undef GT_DMA
    float* Cs = (float*)smem;
#pragma unroll
    for (int mt = 0; mt < 2; ++mt)
#pragma unroll
        for (int nt = 0; nt < 2; ++nt)
#pragma unroll
            for (int r = 0; r < 16; ++r) {
                const int row = wm * 64 + mt * 32 + (r & 3) + 8 * (r >> 2) + 4 * hh, col = wn * 64 + nt * 32 + l31;
                Cs[row * CS_LD + col] = acc[mt][nt][r];
            }
    __syncthreads();
    epi(p, Cs, m0, n0, tid);
}

__device__ __forceinline__ float group_sum16(float v) { v += __shfl_xor(v, 1); v += __shfl_xor(v, 2); v += __shfl_xor(v, 4); v += __shfl_xor(v, 8); return v; }
__device__ __forceinline__ float group_sum8(float v) { v += __shfl_xor(v, 1); v += __shfl_xor(v, 2); v += __shfl_xor(v, 4); return v; }

struct Seg {
    float* bp; float* bs; int ld; int col; int norm; const float* gain;
    h16* hp; h16* hs; int hld; int hcol; float hscale;
    int vt; int head;
};

__device__ __forceinline__ Seg seg_of(const Params& p, int n0) {
    float* P = (float*)(p.ws + WS_P);
    float* out = p.out;
    h16* QA = (h16*)(p.ws + WS_QA); h16* QB = (h16*)(p.ws + WS_QB); h16* QC = (h16*)(p.ws + WS_QC); h16* G = (h16*)(p.ws + WS_G);
    Seg s; s.norm = 0; s.gain = nullptr; s.hp = nullptr; s.hs = nullptr; s.hld = 0; s.hcol = 0; s.hscale = 1.f; s.vt = 0; s.head = 0;
    s.bp = nullptr; s.bs = nullptr; s.ld = 0; s.col = 0;
#define SEG_O(op, os, ldv, c) do { s.bp = out + (op); s.bs = out + (os) - (size_t)SEQ * (ldv); s.ld = (ldv); s.col = (c); } while (0)
#define SEG_H(ptr, ldv, c, sc) do { s.hp = (ptr); s.hs = (ptr); s.hld = (ldv); s.hcol = (c); s.hscale = (sc); } while (0)
    if (n0 < 512) { s.norm = 64; s.gain = p.in[14]; SEG_H(QA, 512, n0, 0.125f * LOG2E); }
    else if (n0 < 1024) { SEG_O(O_PAK, O_SAK, 512, n0 - 512); s.norm = 64; s.gain = p.in[15]; s.hp = (h16*)(p.ws + WS_KA_P); s.hs = nullptr; s.hld = 512; s.hcol = n0 - 512; }
    else if (n0 < 1536) { SEG_O(O_PAV, O_SAV, 512, n0 - 1024); s.vt = 1; s.head = (n0 - 1024) >> 6; }
    else if (n0 < 2048) { SEG_H(G, 1024, n0 - 1536, 1.f); }
    else if (n0 < 2304) { s.bp = P; s.bs = P; s.ld = LDP; s.col = PC_IQ + n0 - 2048; SEG_H((h16*)(p.ws + WS_IQ16), 256, n0 - 2048, 1.f); }
    else if (n0 < 2560) { s.norm = 32; s.gain = p.in[16]; SEG_H(QB, 256, n0 - 2304, 0.17677669529663687f * LOG2E); }
    else if (n0 < 2816) { SEG_O(O_PBK, O_SBK, 256, n0 - 2560); s.norm = 32; s.gain = p.in[17]; s.hp = (h16*)(p.ws + WS_KB_P); s.hs = nullptr; s.hld = 256; s.hcol = n0 - 2560; }
    else if (n0 < 3072) { SEG_O(O_PBV, O_SBV, 256, n0 - 2816); s.vt = 2; s.head = (n0 - 2816) >> 6; }
    else if (n0 < 3328) { SEG_H(G, 1024, 512 + n0 - 3072, 1.f); }
    else if (n0 < 3584) { s.norm = 64; s.gain = p.in[23]; SEG_H(QC, 256, n0 - 3328, 0.125f * LOG2E); }
    else { SEG_H(G, 1024, 768 + n0 - 3584, 1.f); }
#undef SEG_O
#undef SEG_H
    return s;
}

__device__ __forceinline__ void vt_store(const float* Cs, int j, h16* dst_base, size_t ldv, int tid) {
    const int dv = tid & 63, rq = tid >> 6;
    h16* dst = dst_base + (size_t)dv * ldv + 32 * rq;
#pragma unroll
    for (int e8 = 0; e8 < 4; ++e8) {
        u32x4 o;
#pragma unroll
        for (int e = 0; e < 4; ++e) o[e] = pkbf(Cs[(32 * rq + 8 * e8 + 2 * e) * CS_LD + 64 * j + dv], Cs[(32 * rq + 8 * e8 + 2 * e + 1) * CS_LD + 64 * j + dv]);
        *(u32x4*)(dst + 8 * e8) = o;
    }
}

struct EpiIn {
    __device__ __forceinline__ void operator()(const Params& p, const float* Cs, int m0, int n0, int tid) const {
        const int cg = tid & 15, r0 = tid >> 4;
#pragma unroll 1
        for (int j = 0; j < 2; ++j) {
            const int n0j = n0 + 64 * j;
            if (n0j >= DIN) continue;
            if (n0j == 3840) {
                float* P = (float*)(p.ws + WS_P);
                float mx0 = 0.f, mx1 = 0.f;
#pragma unroll 1
                for (int i = 0; i < 8; ++i) {
                    const int rl = r0 + 16 * i, row = m0 + rl;
                    const float4 v = *(const float4*)&Cs[rl * CS_LD + 4 * cg];
                    float ss = (cg < 8) ? (v.x * v.x + v.y * v.y + v.z * v.z + v.w * v.w) : 0.f;
                    ss = group_sum8(ss);
                    if (i < 4) mx0 = fmaxf(mx0, ss); else mx1 = fmaxf(mx1, ss);
                    if (cg < 8) {
                        float* dst = (row < SEQ ? p.out + O_PAKI + (size_t)row * 32 : p.out + O_SAKI + (size_t)(row - SEQ) * 32) + 4 * cg; *(float4*)dst = v;
                        h16x4 hv; hv.x = (h16)v.x; hv.y = (h16)v.y; hv.z = (h16)v.z; hv.w = (h16)v.w;
                        h16* hd = row < SEQ ? (h16*)(p.ws + WS_IK_P) + (size_t)row * 32 : (h16*)(p.ws + WS_IK_S) + ((size_t)((row - SEQ) >> 6) * (PAST + DECS) + PAST + ((row - SEQ) & 63)) * 32;
                        *(h16x4*)(hd + 4 * cg) = hv;
                    }
                    else if (cg < 10) { *(float4*)(P + (size_t)row * LDP + PC_IW + 4 * (cg - 8)) = v; }
                }
                if (cg == 0) {
                    unsigned* ctl = (unsigned*)(p.ws + WS_CTL);
                    if (m0 < SEQ) atomicMax(ctl, __float_as_uint(fmaxf(mx0, mx1)));
                    else { const int b0 = (m0 - SEQ) >> 6; atomicMax(ctl + 1 + b0, __float_as_uint(mx0)); atomicMax(ctl + 2 + b0, __float_as_uint(mx1)); }
                }
                continue;
            }
            const Seg s = seg_of(p, n0j);
            float4 g4 = make_float4(1.f, 1.f, 1.f, 1.f);
            if (s.norm == 64) g4 = *(const float4*)(s.gain + 4 * cg);
            else if (s.norm == 32) g4 = *(const float4*)(s.gain + ((4 * cg) & 31));
#pragma unroll 1
            for (int i = 0; i < 8; ++i) {
                const int rl = r0 + 16 * i, row = m0 + rl;
                float4 v = *(const float4*)&Cs[rl * CS_LD + 64 * j + 4 * cg];
                if (s.norm) {
                    float ss = v.x * v.x + v.y * v.y + v.z * v.z + v.w * v.w;
                    float sc;
                    if (s.norm == 64) { ss = group_sum16(ss); sc = 1.0f / sqrtf(ss * (1.0f / 64.0f) + EPS); }
                    else { ss = group_sum8(ss); sc = 1.0f / sqrtf(ss * (1.0f / 32.0f) + EPS); }
                    v.x *= sc * g4.x; v.y *= sc * g4.y; v.z *= sc * g4.z; v.w *= sc * g4.w;
                }
                if (s.bp) *(float4*)((row < SEQ ? s.bp : s.bs) + (size_t)row * s.ld + s.col + 4 * cg) = v;
                h16* hb = row < SEQ ? s.hp : s.hs;
                if (hb) {
                    h16x4 hv; hv.x = (h16)(v.x * s.hscale); hv.y = (h16)(v.y * s.hscale); hv.z = (h16)(v.z * s.hscale); hv.w = (h16)(v.w * s.hscale);
                    *(h16x4*)(hb + (size_t)row * s.hld + s.hcol + 4 * cg) = hv;
                }
            }
            if (s.vt == 2 && m0 < SEQ) vt_store(Cs, j, (h16*)(p.ws + WS_VTB_P) + (size_t)(s.head * 64) * SEQ + m0, SEQ, tid);
            if (s.vt == 1 && m0 < SEQ) vt_store(Cs, j, (h16*)(p.ws + WS_VTA_P) + (size_t)(s.head * 64) * SEQ + m0, SEQ, tid);
        }
    }
};

struct EpiMem {
    __device__ __forceinline__ void operator()(const Params& p, const float* Cs, int m0, int n0, int tid) const {
        const int cg = tid & 15, r0 = tid >> 4;
#pragma unroll 1
        for (int j = 0; j < 2; ++j) {
            const int n0j = n0 + 64 * j;
            const bool isk = n0j < 256;
            const float4 g4 = isk ? *(const float4*)(p.in[24] + 4 * cg) : make_float4(1.f, 1.f, 1.f, 1.f);
#pragma unroll 1
            for (int i = 0; i < 8; ++i) {
                const int rl = r0 + 16 * i, row = m0 + rl;
                float4 v = *(const float4*)&Cs[rl * CS_LD + 64 * j + 4 * cg];
                if (isk) {
                    float ss = group_sum16(v.x * v.x + v.y * v.y + v.z * v.z + v.w * v.w);
                    const float sc = 1.0f / sqrtf(ss * (1.0f / 64.0f) + EPS);
                    v.x *= sc * g4.x; v.y *= sc * g4.y; v.z *= sc * g4.z; v.w *= sc * g4.w;
                    h16x4 hv; hv.x = (h16)v.x; hv.y = (h16)v.y; hv.z = (h16)v.z; hv.w = (h16)v.w;
                    *(h16x4*)((h16*)(p.ws + WS_MK_P) + (size_t)row * 256 + n0j + 4 * cg) = hv;
                }
                float* dst = p.out + (isk ? O_PMK : O_PMV) + (size_t)row * 256 + (isk ? n0j : n0j - 256) + 4 * cg;
                *(float4*)dst = v;
            }
            if (!isk) vt_store(Cs, j, (h16*)(p.ws + WS_MVT_P) + (size_t)(((n0j - 256) >> 6) * 64) * NMEM + m0, NMEM, tid);
        }
    }
};

struct EpiOut {
    __device__ __forceinline__ void operator()(const Params& p, const float* Cs, int m0, int n0, int tid) const {
        const int cg = tid & 15, r0 = tid >> 4;
#pragma unroll 1
        for (int i = 0; i < 8; ++i) {
            const int rl = r0 + 16 * i, row = m0 + rl;
            const float* x = (row < SEQ ? p.in[0] + (size_t)row * D : p.in[1] + (size_t)(row - SEQ) * D) + n0 + 4 * cg;
            float* y = (row < SEQ ? p.out + O_YP + (size_t)row * D : p.out + O_YS + (size_t)(row - SEQ) * D) + n0 + 4 * cg;
#pragma unroll
            for (int j = 0; j < 2; ++j) {
                const float4 v = *(const float4*)&Cs[rl * CS_LD + 64 * j + 4 * cg];
                const float4 xv = *(const float4*)(x + 64 * j);
                *(float4*)(y + 64 * j) = make_float4(xv.x + v.x, xv.y + v.y, xv.z + v.z, xv.w + v.w);
            }
        }
    }
};

__device__ void phase1(const Params& p, unsigned char* smem) {
    const h16* XH = (const h16*)(p.ws + WS_XH);
    const h16* HMH = (const h16*)(p.ws + WS_HMH);
    const h16* WTIN = (const h16*)(p.ws + WS_WTIN);
    const h16* WTMEM = (const h16*)(p.ws + WS_WTMEM);
    const EpiIn ein{}; const EpiMem emem{};
    const int G = gridDim.x;
    if ((G & 7) == 0) {
        const int xcd = blockIdx.x & 7, local = blockIdx.x >> 3, LG = G >> 3;
        for (int lin = local; lin < 6 * 96; lin += LG) {
            const int rgroup = lin / 96, rem = lin % 96, chalf = rem / 48, rem2 = rem % 48, r = rem2 >> 4, c = chalf * 16 + (rem2 & 15);
            if (c >= 31) continue;
            const int rt = xcd + 8 * (rgroup * 3 + r);
            gemm_tile(p, XH, WTIN, rt * 128, c * 128, smem, ein);
        }
        if (blockIdx.x < 8) { const int rt = blockIdx.x / 4, ct = blockIdx.x % 4; gemm_tile(p, HMH, WTMEM, rt * 128, ct * 128, smem, emem); }
    } else {
        constexpr int NCT = NPAD_IN / 128, NRT = MROWS / 128;
        constexpr int N_IN = NCT * NRT, N_MEM = 2 * 4;
        for (int it = blockIdx.x; it < N_IN + N_MEM; it += gridDim.x) {
            if (it < N_IN) { const int rt = it / NCT, ct = it % NCT; gemm_tile(p, XH, WTIN, rt * 128, ct * 128, smem, ein); }
            else { const int im = it - N_IN, rt = im / 4, ct = im % 4; gemm_tile(p, HMH, WTMEM, rt * 128, ct * 128, smem, emem); }
        }
    }
}

struct KeySrc {
    const float* cache; const float* fresh; int past; int ld;
    __device__ __forceinline__ const float* row(int k) const { return k < past ? cache + (size_t)k * ld : fresh + (size_t)(k - past) * ld; }
};

__device__ __forceinline__ unsigned fkey(float f) { const unsigned u = __float_as_uint(f); return (u & 0x80000000u) ? ~u : (u | 0x80000000u); }

struct SmemDsa {
    float sc[16384];
    float iq[256]; float iw[8];
    unsigned hist[256]; unsigned mw[512];
    int wcnt[4]; int wcnt2[4]; int misc[4];
};

__device__ void select_item(const Params& p, unsigned char* smem, int item) {
    SmemDsa& S = *(SmemDsa*)smem;
    int tid = threadIdx.x; asm volatile("" : "+v"(tid));
    const int lane = tid & 63, w = tid >> 6;
    const float* P = (const float*)(p.ws + WS_P);
    int row, N, mst; KeySrc ki; unsigned* mout;
    if (item < SEQ) {
        row = item; N = 64 * (item / 64 + 1);
        ki = KeySrc{nullptr, p.out + O_PAKI, 0, 32};
        mout = (unsigned*)(p.ws + WS_MASK_P) + item; mst = SEQ;
    } else {
        const int bt = item - SEQ, b = bt / DECS;
        row = item; N = PAST + DECS;
        ki = KeySrc{p.in[5] + (size_t)b * PAST * 32, p.out + O_SAKI + (size_t)b * DECS * 32, PAST, 32};
        mout = (unsigned*)(p.ws + WS_MASK_S) + (size_t)bt * 34; mst = 1;
    }
    const int nw = N / 32;
    __syncthreads();
    if (N <= 256) {
        if (tid < nw) mout[(size_t)tid * mst] = 0xffffffffu;
        return;
    }
    S.iq[tid] = P[(size_t)row * LDP + PC_IQ + tid];
    if (tid < 8) S.iw[tid] = P[(size_t)row * LDP + PC_IW + tid];
    S.mw[tid] = 0u; S.mw[tid + 256] = 0u;
    __syncthreads();
    for (int k = tid; k < N; k += NT) {
        const float4* kr = (const float4*)ki.row(k);
        float kd[32];
#pragma unroll
        for (int i = 0; i < 8; ++i) { const float4 t4 = kr[i]; kd[4 * i] = t4.x; kd[4 * i + 1] = t4.y; kd[4 * i + 2] = t4.z; kd[4 * i + 3] = t4.w; }
        float score = 0.f;
#pragma unroll 1
        for (int h = 0; h < 8; ++h) {
            float d = 0.f;
#pragma unroll
            for (int i = 0; i < 32; ++i) d = fmaf(S.iq[h * 32 + i], kd[i], d);
            score = fmaf(S.iw[h], fmaxf(d, 0.f), score);
        }
        S.sc[k] = score;
    }
    __syncthreads();
    unsigned prefix = 0; int remaining = 256;
    for (int pass = 0; pass < 4; ++pass) {
        const int shift = 24 - 8 * pass;
        S.hist[tid] = 0;
        __syncthreads();
        for (int k = tid; k < N; k += NT) {
            const unsigned key = fkey(S.sc[k]);
            if (pass == 0 || (key >> (shift + 8)) == prefix) atomicAdd(&S.hist[(key >> shift) & 255u], 1u);
        }
        __syncthreads();
        const int hv = (int)S.hist[tid];
        int x = hv;
#pragma unroll
        for (int o = 1; o < 64; o <<= 1) { const int y = __shfl_down(x, o); if (lane + o < 64) x += y; }
        if (lane == 0) S.wcnt[w] = x;
        __syncthreads();
        int above = x - hv;
        for (int w2 = w + 1; w2 < 4; ++w2) above += S.wcnt[w2];
        if (above < remaining && remaining <= above + hv) { S.misc[0] = (int)((prefix << 8) | (unsigned)tid); S.misc[1] = remaining - above; }
        __syncthreads();
        prefix = (unsigned)S.misc[0]; remaining = S.misc[1];
        __syncthreads();
    }
    const unsigned T = prefix; const int r = remaining;
    int base_eq = 0;
    const unsigned long long lt = (lane == 0) ? 0ull : (~0ull >> (64 - lane));
    for (int k0 = 0; k0 < N; k0 += NT) {
        const int k = k0 + tid;
        const unsigned key = (k < N) ? fkey(S.sc[k]) : 0u;
        const bool gt = (k < N) && key > T, eq = (k < N) && key == T;
        const unsigned long long beq = __ballot(eq);
        const int eqpre = __popcll(beq & lt);
        if (lane == 0) S.wcnt[w] = __popcll(beq);
        __syncthreads();
        int eqbase = base_eq, eqtot = 0;
        for (int w2 = 0; w2 < 4; ++w2) { const int c = S.wcnt[w2]; if (w2 < w) eqbase += c; eqtot += c; }
        const bool sel = gt || (eq && (eqbase + eqpre) < r);
        const unsigned long long bs = __ballot(sel);
        if (lane == 0) S.mw[(k0 >> 5) + 2 * w] = (unsigned)bs;
        if (lane == 32) S.mw[(k0 >> 5) + 2 * w + 1] = (unsigned)(bs >> 32);
        base_eq += eqtot;
        __syncthreads();
    }
    for (int i = tid; i < nw; i += NT) mout[(size_t)i * mst] = S.mw[i];
}

typedef float f32x4m __attribute__((ext_vector_type(4)));
constexpr int CAND_CAP = 120;
struct SelSm {
    unsigned hist[16][1025];
    float cand_s[16][CAND_CAP]; int cand_k[16][CAND_CAP];
    int cnt[16]; int bstar[16]; int nabove[16]; int ovf[16];
};

__device__ __forceinline__ void score_tile(const h16x8& a, const h16x8 (&bq)[8], const float (&wq)[8], float (&sc)[4]) {
    sc[0] = 0.f; sc[1] = 0.f; sc[2] = 0.f; sc[3] = 0.f;
#pragma unroll
    for (int h = 0; h < 8; ++h) {
        f32x4m z = {0.f, 0.f, 0.f, 0.f};
        const f32x4m d = __builtin_amdgcn_mfma_f32_16x16x32_f16(a, bq[h], z, 0, 0, 0);
#pragma unroll
        for (int i = 0; i < 4; ++i) { const int bits = (int)__float_as_uint(d[i]); sc[i] = fmaf(wq[h], __uint_as_float((unsigned)(bits > 0 ? bits : 0)), sc[i]); }
    }
}

__device__ __forceinline__ int bin_of(float sc, float inv, float off) {
    const int b = min(max((int)fmaf(sc, inv, off), 0), 1021);
    int sgn;
    asm("v_med3_i32 %0, %1, -1, 1" : "=v"(sgn) : "v"(sc));
    return b + sgn + 1;
}

__device__ __forceinline__ void select_unit(const Params& p, unsigned char* smem, int u) {
    SelSm& S = *(SelSm*)smem;
    int tid = threadIdx.x; asm volatile("" : "+v"(tid));
    const int lane = tid & 63, w = __builtin_amdgcn_readfirstlane(tid >> 6), q = lane & 15, g = lane >> 4;
    int row0, N, ldm, ldw, kslot; const h16* IK; unsigned* mask;
    if (u < 1024) {
        const int q0 = 16 * (1023 - u);
        row0 = q0; N = 64 * (q0 / 64 + 1); IK = (const h16*)(p.ws + WS_IK_P); mask = (unsigned*)(p.ws + WS_MASK_P) + q0; ldm = 1; ldw = SEQ; kslot = 0;
    } else {
        const int bu = u - 1024, b = bu >> 2, t0 = 16 * (bu & 3);
        row0 = SEQ + 64 * b + t0; N = PAST + DECS; IK = (const h16*)(p.ws + WS_IK_S) + (size_t)b * (PAST + DECS) * 32;
        mask = (unsigned*)(p.ws + WS_MASK_S) + (size_t)(64 * b + t0) * 34; ldm = 34; ldw = 1; kslot = 1 + b;
    }
    const int nw = N / 32;
    __syncthreads();
    if (N <= 256) {
        for (int i = tid; i < 16 * nw; i += NT) mask[(size_t)(i & 15) * ldm + (size_t)(i >> 4) * ldw] = 0xffffffffu;
        return;
    }
    for (int i = tid; i < 16 * 1025; i += NT) ((unsigned*)S.hist)[i] = 0u;
    if (tid < 16) { S.cnt[tid] = 0; S.ovf[tid] = 0; S.bstar[tid] = 0; S.nabove[tid] = 0; }
    const int rowq = row0 + q;
    const h16* IQ = (const h16*)(p.ws + WS_IQ16) + (size_t)rowq * 256 + 8 * g;
    const float* Pf = (const float*)(p.ws + WS_P) + (size_t)rowq * LDP + PC_IW;
    h16x8 bq[8]; float wq[8];
    float hi = 0.f, lo = 0.f;
#pragma unroll
    for (int h = 0; h < 8; ++h) {
        bq[h] = *(const h16x8*)(IQ + h * 32);
        wq[h] = Pf[h];
        float n2 = 0.f;
#pragma unroll
        for (int e = 0; e < 8; ++e) { const float x = (float)bq[h][e]; n2 = fmaf(x, x, n2); }
        n2 += __shfl_xor(n2, 16); n2 += __shfl_xor(n2, 32);
        const float t = wq[h] * sqrtf(n2);
        if (t > 0.f) hi += t; else lo += t;
    }
    const float kmax = sqrtf(__uint_as_float(((const unsigned*)(p.ws + WS_CTL))[kslot])) * 1.01f;
    hi = hi * kmax + 1e-6f; lo = lo * kmax - 1e-6f;
    const float inv = 1022.0f / fmaxf(hi - lo, 1e-20f), off = -lo * inv;
    __syncthreads();
    const h16* ikp = IK + (size_t)q * 32 + 8 * g;
    const int ngw = (nw - w + 3) >> 2;
#define SEL_LD(dst0, dst1, it_) do { const int gi_ = w + 4 * ((it_) < ngw ? (it_) : ngw - 1); \
        dst0 = *(const h16x8*)(ikp + (size_t)(32 * gi_) * 32); dst1 = *(const h16x8*)(ikp + (size_t)(32 * gi_ + 16) * 32); } while (0)
#define SEL_GROUP_A(x0, x1) do { _Pragma("unroll") for (int t = 0; t < 2; ++t) { \
            float sc[4]; score_tile(t == 0 ? x0 : x1, bq, wq, sc); \
            _Pragma("unroll") for (int i = 0; i < 4; ++i) { const int b = bin_of(sc[i], inv, off); atomicAdd(&S.hist[q][b], 1u); } } } while (0)
    {
        h16x8 a0, a1, b0, b1, c0, c1;
        SEL_LD(a0, a1, 0); SEL_LD(b0, b1, 1); SEL_LD(c0, c1, 2);
        asm volatile("" ::: "memory");
        for (int it = 0; it < ngw; it += 3) {
            SEL_GROUP_A(a0, a1);
            asm volatile("" ::: "memory"); SEL_LD(a0, a1, it + 3); asm volatile("" ::: "memory");
            if (it + 1 < ngw) SEL_GROUP_A(b0, b1);
            asm volatile("" ::: "memory"); SEL_LD(b0, b1, it + 4); asm volatile("" ::: "memory");
            if (it + 2 < ngw) SEL_GROUP_A(c0, c1);
            asm volatile("" ::: "memory"); SEL_LD(c0, c1, it + 5); asm volatile("" ::: "memory");
        }
    }
#undef SEL_GROUP_A
    __syncthreads();
    for (int qq = 0; qq < 4; ++qq) {
        const int qi = 4 * w + qq;
        unsigned c = 0;
#pragma unroll
        for (int e = 0; e < 16; ++e) c += S.hist[qi][16 * lane + e];
        int x = (int)c;
#pragma unroll
        for (int o = 1; o < 64; o <<= 1) { const int y = __shfl_down(x, o); if (lane + o < 64) x += y; }
        const int above = x - (int)c;
        if (above < 256 && 256 <= above + (int)c) {
            int acc = above, bs = 16 * lane;
            for (int e = 15; e >= 0; --e) {
                const int v = (int)S.hist[qi][16 * lane + e];
                if (acc + v >= 256) { bs = 16 * lane + e; break; }
                acc += v;
            }
            S.bstar[qi] = bs; S.nabove[qi] = acc;
        }
    }
    __syncthreads();
    const int bst = S.bstar[q];
    unsigned* mrow = (unsigned*)S.hist;
    {
        h16x8 a0, a1, b0, b1, c0, c1;
        SEL_LD(a0, a1, 0); SEL_LD(b0, b1, 1); SEL_LD(c0, c1, 2);
        asm volatile("" ::: "memory");
        for (int it = 0; it < ngw; it += 3) {
#pragma unroll
          for (int gg = 0; gg < 3; ++gg) {
           if (gg == 0 || it + gg < ngw) {
            const int grp = w + 4 * (it + gg);
            unsigned word = 0u;
#pragma unroll
            for (int t = 0; t < 2; ++t) {
                const int k0 = 32 * grp + 16 * t;
                float sc[4]; score_tile(gg == 0 ? (t == 0 ? a0 : a1) : gg == 1 ? (t == 0 ? b0 : b1) : (t == 0 ? c0 : c1), bq, wq, sc);
                unsigned nib = 0u;
#pragma unroll
                for (int i = 0; i < 4; ++i) {
                    const int b = bin_of(sc[i], inv, off);
                    if (b > bst) nib |= 1u << i;
                    else if (b == bst) {
                        const int pos = atomicAdd(&S.cnt[q], 1);
                        if (pos < CAND_CAP) { S.cand_s[q][pos] = sc[i]; S.cand_k[q][pos] = k0 + 4 * g + i; }
                    }
                }
                unsigned v = nib << (4 * g);
                v |= (unsigned)__shfl_xor((int)v, 16); v |= (unsigned)__shfl_xor((int)v, 32);
                word |= v << (16 * t);
            }
            if (g == 0) mrow[q * 512 + grp] = word;
           }
            asm volatile("" ::: "memory");
            if (gg == 0) SEL_LD(a0, a1, it + 3); else if (gg == 1) SEL_LD(b0, b1, it + 4); else SEL_LD(c0, c1, it + 5);
            asm volatile("" ::: "memory");
          }
        }
    }
#undef SEL_LD
    __syncthreads();
    for (int qq = 0; qq < 4; ++qq) {
        const int qi = 4 * w + qq;
        const int m = S.cnt[qi], r = 256 - S.nabove[qi];
        if (m > CAND_CAP) { if (lane == 0) S.ovf[qi] = 1; continue; }
        const int nparts = m > 64 ? 2 : 1;
        for (int part = 0; part < nparts; ++part) {
            const int me = lane + 64 * part;
            const float s_me = me < m ? S.cand_s[qi][me] : 0.f;
            const int k_me = me < m ? S.cand_k[qi][me] : 0;
            int rank = 0;
#pragma unroll 4
            for (int j = 0; j < m; ++j) { const float sj = S.cand_s[qi][j]; const int kj = S.cand_k[qi][j]; rank += (sj > s_me || (sj == s_me && kj < k_me)) ? 1 : 0; }
            if (me < m && rank < r) atomicOr(&mrow[qi * 512 + (k_me >> 5)], 1u << (k_me & 31));
        }
    }
    __syncthreads();
    for (int i = tid; i < 16 * nw; i += NT) { const int qi = i & 15, wd = i >> 4; mask[(size_t)qi * ldm + (size_t)wd * ldw] = mrow[qi * 512 + wd]; }
    __syncthreads();
    if (tid == 0) {
        unsigned* fl = (unsigned*)(p.ws + WS_REDO) + (size_t)blockIdx.x * REDO_LD;
        unsigned n = fl[0];
        for (int qi = 0; qi < 16; ++qi) if (S.ovf[qi] && n + 1 < (unsigned)REDO_LD) { fl[1 + n] = (unsigned)(row0 + qi); ++n; }
        fl[0] = n;
    }
}

constexpr int ATT_TB_OFF = 32768;
constexpr int ATT_MASK_OFF = ATT_TB_OFF + 1024 + 16;
constexpr int ATT_LDS = ATT_MASK_OFF + 4096;

__device__ __forceinline__ int pi32(int r) { return (r & 0x13) | ((r & 4) << 1) | ((r & 8) >> 1); }
__device__ __forceinline__ unsigned pkrtz(float a, float b) { return __builtin_bit_cast(unsigned, __builtin_amdgcn_cvt_pkrtz(a, b)); }

struct AttnUnit {
    int row0, nrows, ntiles, qpos0, head;
    const h16* Kh; const h16* VTh; int ldk; int ldv;
    const float* Kc; const float* Vc; const float* Kn; const float* Vn; int ldf; int ntc;
    const unsigned* mask; int ldm;
};

template <int MODE, bool F32SRC, int NQ>
__device__ __forceinline__ void attn_unit(const Params& p, unsigned char* smem, const AttnUnit& U, float lam) {
    int tid = threadIdx.x; asm volatile("" : "+v"(tid));
    const int lane = tid & 63, w = __builtin_amdgcn_readfirstlane(tid >> 6), l31 = lane & 31, hh = lane >> 5;
    const int wq = (MODE == 1) ? (w & 1) : w, cmap = (MODE == 1) ? (w >> 1) : 0;
    const int qb = wq * 32 * NQ;
    const bool active = qb < U.nrows;
    const int chunk_w = (U.qpos0 + qb) >> 6;
    float* tb = (float*)(smem + ATT_TB_OFF);
    __syncthreads();
    if (MODE != 2) {
        if (tid < 255) { const int hc = (MODE == 0 ? U.head : 8 + U.head); tb[tid] = (p.in[10][rel_bucket(tid - 191) * 12 + hc] - p.in[10][15 * 12 + hc]) * LOG2E; }
    }
    if (MODE == 0 && tid < 4) ((unsigned*)(smem + ATT_TB_OFF + 1024))[tid] = ((tid & 1) ? 0x0000ffffu : 0u) | ((tid & 2) ? 0xffff0000u : 0u);
    constexpr int NQF = (MODE == 1) ? 2 : 4;
    h16x8 qf[NQ][NQF];
#pragma unroll
    for (int nq = 0; nq < NQ; ++nq) {
        if (active) {
            const int rowq = U.row0 + qb + 32 * nq + l31;
            const h16* Qb = (MODE == 0) ? (const h16*)(p.ws + WS_QA) + (size_t)rowq * 512 + U.head * 64
                          : (MODE == 1) ? (const h16*)(p.ws + WS_QB) + (size_t)rowq * 256 + U.head * 64 + 32 * cmap
                                        : (const h16*)(p.ws + WS_QC) + (size_t)rowq * 256 + U.head * 64;
#pragma unroll
            for (int s = 0; s < NQF; ++s) qf[nq][s] = *(const h16x8*)(Qb + 16 * s + 8 * hh);
        } else {
#pragma unroll
            for (int s = 0; s < NQF; ++s)
#pragma unroll
                for (int e = 0; e < 8; ++e) qf[nq][s][e] = (h16)0.f;
        }
    }
    f32x16 O[NQ][2];
    float lsum[NQ];
    const unsigned* lut = (const unsigned*)(smem + ATT_TB_OFF + 1024);
#pragma unroll
    for (int nq = 0; nq < NQ; ++nq) {
        lsum[nq] = 0.f;
#pragma unroll
        for (int m = 0; m < 2; ++m)
#pragma unroll
            for (int r = 0; r < 16; ++r) O[nq][m][r] = 0.f;
    }
    int crow[2], cch[2], so[2];
#pragma unroll
    for (int i = 0; i < 2; ++i) { const int c = tid + 256 * i; crow[i] = c >> 3; cch[i] = c & 7; so[i] = crow[i] * 128 + ((cch[i] ^ ((crow[i] >> 1) & 7)) << 4); }
#define ATT_STAGE_F32(b, j) do { \
        unsigned char* kt_ = smem + (b) * 16384; unsigned char* vt_ = kt_ + 8192; \
        const float* kb_ = ((j) < U.ntc) ? U.Kc + (size_t)(64 * (j)) * U.ldf : U.Kn + (size_t)(64 * ((j) - U.ntc)) * U.ldf; \
        const float* vb_ = ((j) < U.ntc) ? U.Vc + (size_t)(64 * (j)) * U.ldf : U.Vn + (size_t)(64 * ((j) - U.ntc)) * U.ldf; \
        { f32x4 f_[2][2]; \
          _Pragma("unroll") for (int i = 0; i < 2; ++i) { const float* ks_ = kb_ + (size_t)crow[i] * U.ldf + cch[i] * 8; f_[i][0] = *(const f32x4*)ks_; f_[i][1] = *(const f32x4*)(ks_ + 4); } \
          _Pragma("unroll") for (int i = 0; i < 2; ++i) { h16x8 hk_; _Pragma("unroll") for (int e = 0; e < 4; ++e) { hk_[e] = (h16)f_[i][0][e]; hk_[4 + e] = (h16)f_[i][1][e]; } \
            *(h16x8*)(kt_ + so[i]) = hk_; } } \
        asm volatile("" ::: "memory"); \
        { f32x4 f_[2][2]; \
          _Pragma("unroll") for (int i = 0; i < 2; ++i) { const float* vs_ = vb_ + (size_t)crow[i] * U.ldf + cch[i] * 8; f_[i][0] = *(const f32x4*)vs_; f_[i][1] = *(const f32x4*)(vs_ + 4); } \
          _Pragma("unroll") for (int i = 0; i < 2; ++i) { const int key_ = crow[i]; \
            _Pragma("unroll") for (int e = 0; e < 8; ++e) { const int dv_ = 8 * cch[i] + e; \
                *(__bf16*)(vt_ + dv_ * 128 + (((key_ >> 3) ^ ((dv_ >> 1) & 7)) << 4) + (key_ & 7) * 2) = (__bf16)(e < 4 ? f_[i][0][e] : f_[i][1][e - 4]); } } } } while (0)
    const int drow0 = 16 * w + (lane >> 3), drow1 = drow0 + 8;
    const int dch0 = (lane & 7) ^ ((drow0 >> 1) & 7), dch1 = (lane & 7) ^ ((drow1 >> 1) & 7);
    const unsigned char* kbase = F32SRC ? nullptr : (const unsigned char*)U.Kh;
    const unsigned char* vbase = F32SRC ? nullptr : (const unsigned char*)U.VTh;
    const unsigned kof0 = (unsigned)(drow0 * U.ldk + dch0 * 8) * 2u, kof1 = (unsigned)(drow1 * U.ldk + dch1 * 8) * 2u;
    const size_t vof0 = ((size_t)drow0 * U.ldv + dch0 * 8) * 2, vof1 = ((size_t)drow1 * U.ldv + dch1 * 8) * 2;
    const int dmo0 = (16 * w) * 128, dmo1 = (16 * w + 8) * 128;
#define ATT_DMA(b, j) do { \
        const unsigned char* kt_ = kbase + (size_t)(64 * (j)) * U.ldk * 2; const unsigned char* vt_ = vbase + (size_t)(64 * (j)) * 2; \
        __builtin_amdgcn_global_load_lds((const unsigned*)(kt_ + kof0), (__attribute__((address_space(3))) unsigned*)(smem + (b) * 16384 + dmo0), 16, 0, 0); \
        __builtin_amdgcn_global_load_lds((const unsigned*)(vt_ + vof0), (__attribute__((address_space(3))) unsigned*)(smem + (b) * 16384 + 8192 + dmo0), 16, 0, 0); \
        __builtin_amdgcn_global_load_lds((const unsigned*)(kt_ + kof1), (__attribute__((address_space(3))) unsigned*)(smem + (b) * 16384 + dmo1), 16, 0, 0); \
        __builtin_amdgcn_global_load_lds((const unsigned*)(vt_ + vof1), (__attribute__((address_space(3))) unsigned*)(smem + (b) * 16384 + 8192 + dmo1), 16, 0, 0); } while (0)
    const unsigned* mq = (MODE == 0 && NQ == 2) ? U.mask + qb + lane : nullptr;
#define ATT_MASK_DMA(b, j) do { \
        __builtin_amdgcn_global_load_lds(mq + (size_t)(2 * (j)) * SEQ, (__attribute__((address_space(3))) unsigned*)(smem + ATT_MASK_OFF + (((b) * 4 + w) * 2) * 256), 4, 0, 0); \
        __builtin_amdgcn_global_load_lds(mq + (size_t)(2 * (j) + 1) * SEQ, (__attribute__((address_space(3))) unsigned*)(smem + ATT_MASK_OFF + (((b) * 4 + w) * 2 + 1) * 256), 4, 0, 0); } while (0)
    if constexpr (MODE == 0 && NQ == 2) { ATT_MASK_DMA(0, 0); }
    if constexpr (!F32SRC) { ATT_DMA(0, 0); } else { ATT_STAGE_F32(0, 0); }
    const unsigned* mrow[NQ];
    unsigned mwn[NQ][2];
#pragma unroll
    for (int nq = 0; nq < NQ; ++nq) {
        mrow[nq] = (MODE == 0 && NQ == 1) ? U.mask + (size_t)(qb + 32 * nq + l31) * U.ldm : nullptr;
        mwn[nq][0] = 0xffffffffu; mwn[nq][1] = 0xffffffffu;
        if (MODE == 0 && NQ == 1) { mwn[nq][0] = mrow[nq][0]; mwn[nq][1] = mrow[nq][1]; }
    }
    __syncthreads();
    const int pil = pi32(l31), ksw = (pil >> 1) & 7, vsw = (l31 >> 1) & 7;
    const int jlast = U.ntiles - 1;
    for (int j = 0; j < U.ntiles; ++j) {
        const int buf = j & 1;
        const int jn = j < jlast ? j + 1 : jlast;
        unsigned mw[NQ][2];
#pragma unroll
        for (int nq = 0; nq < NQ; ++nq) {
            if (NQ == 1) {
                mw[nq][0] = mwn[nq][0] >> (8 * hh); mw[nq][1] = mwn[nq][1] >> (8 * hh);
                if (MODE == 0) { mwn[nq][0] = mrow[nq][2 * jn]; mwn[nq][1] = mrow[nq][2 * jn + 1]; }
            } else {
                mw[nq][0] = 0xffffffffu; mw[nq][1] = 0xffffffffu;
                if (MODE == 0) {
                    const unsigned* ml = (const unsigned*)(smem + ATT_MASK_OFF + ((buf * 4 + w) * 2) * 256) + 32 * nq + l31;
                    mw[nq][0] = ml[0] >> (8 * hh); mw[nq][1] = ml[64] >> (8 * hh);
                }
            }
        }
        if constexpr (MODE == 0 && NQ == 2) { ATT_MASK_DMA(buf ^ 1, jn); }
        if constexpr (!F32SRC) ATT_DMA(buf ^ 1, jn);
        if (active && (MODE == 2 || j <= chunk_w)) {
            const unsigned char* Kt = smem + buf * 16384;
            const unsigned char* Vt = Kt + 8192;
            const bool near = (MODE != 2) && (j >= chunk_w - 2);
#pragma unroll
            for (int u = 0; u < 2; ++u) {
                const unsigned char* kp = Kt + (32 * u + pil) * 128;
                bf16x8 pf[NQ][2];
                h16x8 kf[NQF];
#pragma unroll
                for (int s = 0; s < NQF; ++s) { const int ch = (MODE == 1) ? (4 * cmap + 2 * s + hh) : (2 * s + hh); kf[s] = *(const h16x8*)(kp + ((ch ^ ksw) << 4)); }
#pragma unroll
                for (int nq = 0; nq < NQ; ++nq) {
                    f32x16 S;
#pragma unroll
                    for (int r = 0; r < 16; ++r) S[r] = 0.f;
#pragma unroll
                    for (int s = 0; s < NQF; ++s) S = __builtin_amdgcn_mfma_f32_32x32x16_f16(kf[s], qf[nq][s], S, 0, 0, 0);
                    if (near) {
                        const int base = 64 * j + 32 * u + 8 * hh - (U.qpos0 + qb + 32 * nq + l31) + 191;
#pragma unroll
                        for (int i = 0; i < 16; ++i) S[i] += tb[base + (i & 7) + 16 * (i >> 3)];
                    }
#pragma unroll
                    for (int i = 0; i < 16; ++i) S[i] = __builtin_amdgcn_exp2f(S[i]);
#pragma unroll
                    for (int s2 = 0; s2 < 2; ++s2) {
                        u32x4 pk;
#pragma unroll
                        for (int e = 0; e < 4; ++e) {
                            unsigned v = pkbf(S[8 * s2 + 2 * e], S[8 * s2 + 2 * e + 1]);
                            if (MODE == 0) v &= lut[(mw[nq][u] >> (16 * s2 + 2 * e)) & 3u];
                            lsum[nq] = __builtin_amdgcn_fdot2_f32_bf16(__builtin_bit_cast(bf16x2, v), __builtin_bit_cast(bf16x2, 0x3f803f80u), lsum[nq], false);
                            pk[e] = v;
                        }
                        pf[nq][s2] = __builtin_bit_cast(bf16x8, pk);
                    }
                }
#pragma unroll
                for (int m = 0; m < 2; ++m)
#pragma unroll
                    for (int s2 = 0; s2 < 2; ++s2) {
                        const bf16x8 vfr = *(const bf16x8*)(Vt + (32 * m + l31) * 128 + (((2 * (2 * u + s2) + hh) ^ vsw) << 4));
#pragma unroll
                        for (int nq = 0; nq < NQ; ++nq) O[nq][m] = __builtin_amdgcn_mfma_f32_32x32x16_bf16(vfr, pf[nq][s2], O[nq][m], 0, 0, 0);
                    }
            }
        }
        if constexpr (F32SRC) { ATT_STAGE_F32(buf ^ 1, jn); }
        __syncthreads();
    }
#undef ATT_STAGE_F32
#undef ATT_DMA
#undef ATT_MASK_DMA
    float inv[NQ];
#pragma unroll
    for (int nq = 0; nq < NQ; ++nq) { const float l = lsum[nq] + __shfl_xor(lsum[nq], 32); inv[nq] = 1.0f / l; }
    if (MODE == 1) {
        float* X = (float*)smem;
        if (cmap == 1) {
#pragma unroll
            for (int nq = 0; nq < NQ; ++nq)
#pragma unroll
                for (int m = 0; m < 2; ++m)
#pragma unroll
                    for (int i = 0; i < 16; ++i) X[((wq * NQ + nq) * 32 + m * 16 + i) * 64 + lane] = O[nq][m][i] * inv[nq];
        }
        __syncthreads();
        if (cmap == 1) return;
#pragma unroll
        for (int nq = 0; nq < NQ; ++nq)
#pragma unroll
            for (int m = 0; m < 2; ++m)
#pragma unroll
                for (int i = 0; i < 16; ++i) O[nq][m][i] = O[nq][m][i] * inv[nq] - lam * X[((wq * NQ + nq) * 32 + m * 16 + i) * 64 + lane];
    } else {
        if (!active) return;
#pragma unroll
        for (int nq = 0; nq < NQ; ++nq)
#pragma unroll
            for (int m = 0; m < 2; ++m)
#pragma unroll
                for (int i = 0; i < 16; ++i) O[nq][m][i] *= inv[nq];
    }
    const int colbase = (MODE == 0 ? 0 : (MODE == 1 ? 512 : 768)) + U.head * 64;
#pragma unroll
    for (int nq = 0; nq < NQ; ++nq) {
        const int rowq = U.row0 + qb + 32 * nq + l31;
        const h16* G = (const h16*)(p.ws + WS_G) + (size_t)rowq * 1024 + colbase;
        h16* Oo = (h16*)(p.ws + WS_O16) + (size_t)rowq * 1024 + colbase;
        float sc = 1.f;
        if (MODE == 1) {
            float ss = 0.f;
#pragma unroll
            for (int m = 0; m < 2; ++m)
#pragma unroll
                for (int i = 0; i < 16; ++i) ss = fmaf(O[nq][m][i], O[nq][m][i], ss);
            ss += __shfl_xor(ss, 32);
            sc = (1.0f / sqrtf(ss * (1.0f / 64.0f) + EPS)) * 0.8f;
        }
#pragma unroll
        for (int m = 0; m < 2; ++m)
#pragma unroll
            for (int g4 = 0; g4 < 4; ++g4) {
                const int dv = 32 * m + 8 * g4 + 4 * hh;
                const h16x4 gv = *(const h16x4*)(G + dv);
                h16x4 o4;
#pragma unroll
                for (int e = 0; e < 4; ++e) {
                    float o = O[nq][m][4 * g4 + e];
                    if (MODE == 1) o = o * sc * p.in[18][dv + e];
                    o4[e] = (h16)(o * silu((float)gv[e]));
                }
                *(h16x4*)(Oo + dv) = o4;
            }
    }
}

__device__ __forceinline__ AttnUnit unit_zero() {
    AttnUnit U; U.row0 = 0; U.nrows = 0; U.ntiles = 0; U.qpos0 = 0; U.head = 0; U.Kh = nullptr; U.VTh = nullptr; U.ldk = 0; U.ldv = 0;
    U.Kc = nullptr; U.Vc = nullptr; U.Kn = nullptr; U.Vn = nullptr; U.ldf = 0; U.ntc = 0; U.mask = nullptr; U.ldm = 0; return U;
}
__device__ __forceinline__ void unit_a_prompt(const Params& p, unsigned char* smem, int g, int head) {
    AttnUnit U = unit_zero();
    U.row0 = 256 * g; U.nrows = 256; U.ntiles = 4 * g + 4; U.qpos0 = 256 * g; U.head = head;
    U.Kh = (const h16*)(p.ws + WS_KA_P) + head * 64; U.ldk = 512;
    U.VTh = (const h16*)(p.ws + WS_VTA_P) + (size_t)(head * 64) * SEQ; U.ldv = SEQ;
    U.mask = (const unsigned*)(p.ws + WS_MASK_P) + 256 * g; U.ldm = 0;
    attn_unit<0, false, 2>(p, smem, U, 0.f);
}
__device__ __forceinline__ void unit_b_prompt(const Params& p, unsigned char* smem, int g, int head, float lam) {
    AttnUnit U = unit_zero();
    U.row0 = 128 * g; U.nrows = 128; U.ntiles = 2 * g + 2; U.qpos0 = 128 * g; U.head = head;
    U.Kh = (const h16*)(p.ws + WS_KB_P) + head * 64; U.ldk = 256;
    U.VTh = (const h16*)(p.ws + WS_VTB_P) + (size_t)(head * 64) * SEQ; U.ldv = SEQ;
    attn_unit<1, false, 2>(p, smem, U, lam);
}
__device__ __forceinline__ void unit_a_sample(const Params& p, unsigned char* smem, int b, int head) {
    AttnUnit U = unit_zero();
    U.row0 = SEQ + 64 * b; U.nrows = 64; U.ntiles = 17; U.qpos0 = PAST; U.head = head;
    U.Kc = p.in[3] + (size_t)b * PAST * 512 + head * 64; U.Vc = p.in[4] + (size_t)b * PAST * 512 + head * 64;
    U.Kn = p.out + O_SAK + (size_t)b * DECS * 512 + head * 64; U.Vn = p.out + O_SAV + (size_t)b * DECS * 512 + head * 64;
    U.ldf = 512; U.ntc = 16;
    U.mask = (const unsigned*)(p.ws + WS_MASK_S) + (size_t)(64 * b) * 34; U.ldm = 34;
    attn_unit<0, true, 1>(p, smem, U, 0.f);
}
__device__ __forceinline__ void unit_b_sample(const Params& p, unsigned char* smem, int b, int head, float lam) {
    AttnUnit U = unit_zero();
    U.row0 = SEQ + 64 * b; U.nrows = 64; U.ntiles = 17; U.qpos0 = PAST; U.head = head;
    U.Kc = p.in[6] + (size_t)b * PAST * 256 + head * 64; U.Vc = p.in[7] + (size_t)b * PAST * 256 + head * 64;
    U.Kn = p.out + O_SBK + (size_t)b * DECS * 256 + head * 64; U.Vn = p.out + O_SBV + (size_t)b * DECS * 256 + head * 64;
    U.ldf = 256; U.ntc = 16;
    attn_unit<1, true, 1>(p, smem, U, lam);
}
__device__ __forceinline__ void unit_c_prompt(const Params& p, unsigned char* smem, int g, int head) {
    AttnUnit U = unit_zero();
    U.row0 = 128 * g; U.nrows = 128; U.ntiles = 4; U.head = head;
    U.Kh = (const h16*)(p.ws + WS_MK_P) + head * 64; U.ldk = 256;
    U.VTh = (const h16*)(p.ws + WS_MVT_P) + (size_t)(head * 64) * NMEM; U.ldv = NMEM;
    attn_unit<2, false, 1>(p, smem, U, 0.f);
}
__device__ __forceinline__ void unit_c_sample(const Params& p, unsigned char* smem, int b, int head) {
    AttnUnit U = unit_zero();
    U.row0 = SEQ + 64 * b; U.nrows = 64; U.ntiles = 4; U.head = head;
    U.Kc = p.in[8] + (size_t)b * NMEM * 256 + head * 64; U.Vc = p.in[9] + (size_t)b * NMEM * 256 + head * 64;
    U.Kn = U.Kc; U.Vn = U.Vc; U.ldf = 256; U.ntc = 4;
    attn_unit<2, true, 1>(p, smem, U, 0.f);
}

#define ZIGZAG_LOOP(NALL) for (int zk_ = 0, pos_ = 0; zk_ * (int)gridDim.x < (NALL); ++zk_) \
    if ((pos_ = (zk_ & 1) ? (zk_ + 1) * (int)gridDim.x - 1 - (int)blockIdx.x : zk_ * (int)gridDim.x + (int)blockIdx.x) < (NALL))

__device__ __forceinline__ float diff_lambda_of(const Params& p) {
    float s1 = 0.f, s2 = 0.f;
    for (int i = 0; i < 32; ++i) { s1 = fmaf(p.in[19][i], p.in[20][i], s1); s2 = fmaf(p.in[21][i], p.in[22][i], s2); }
    return expf(s1) - expf(s2) + 0.2f;
}

__device__ void phase2(const Params& p, unsigned char* smem) {
    const float lam = diff_lambda_of(p);
    constexpr int N_SP = 1024, N_BS = 128, N_CS = 128, N_SS = 128, N_CP = 512;
    constexpr int N_ALL = N_SP + N_BS + N_CS + N_SS + N_CP;
    ZIGZAG_LOOP(N_ALL) {
        int it = pos_;
        {
            const int ss = it - (N_SP + N_BS + N_CS);
            const int su = it < N_SP ? it : ((ss >= 0 && ss < N_SS) ? 1024 + ss : -1);
            if (su >= 0) { select_unit(p, smem, su); continue; }
        }
        it -= N_SP;
        if (it < N_BS) { unit_b_sample(p, smem, it >> 2, it & 3, lam); continue; }
        it -= N_BS;
        if (it < N_CS) { unit_c_sample(p, smem, it >> 2, it & 3); continue; }
        it -= N_CS + N_SS;
        unit_c_prompt(p, smem, it >> 2, it & 3);
    }
    {
        __syncthreads();
        const unsigned* fl = (const unsigned*)(p.ws + WS_REDO) + (size_t)blockIdx.x * REDO_LD;
        const unsigned n = __builtin_amdgcn_readfirstlane((int)__hip_atomic_load(fl, __ATOMIC_RELAXED, __HIP_MEMORY_SCOPE_AGENT));
        for (unsigned i = 0; i < n; ++i) {
            const int row = __builtin_amdgcn_readfirstlane((int)__hip_atomic_load(fl + 1 + i, __ATOMIC_RELAXED, __HIP_MEMORY_SCOPE_AGENT));
            select_item(p, smem, row);
        }
    }
}

__device__ void phase3(const Params& p, unsigned char* smem) {
    const float lam = diff_lambda_of(p);
    const int G = gridDim.x;
    for (int i = blockIdx.x; i < 512; i += G) {
        { const int g = 63 - (i >> 3), head = i & 7; unit_a_prompt(p, smem, g, head); }
        { const int r = 511 - i, g = 127 - (r >> 2), head = r & 3; unit_b_prompt(p, smem, g, head, lam); }
        if (i >= 256) { const int s = i - 256; unit_a_sample(p, smem, s >> 3, s & 7); }
    }
}

__device__ void phase4(const Params& p, unsigned char* smem) {
    const h16* O16 = (const h16*)(p.ws + WS_O16);
    const h16* WTOUT = (const h16*)(p.ws + WS_WTOUT);
    constexpr int NCT = D / 128, NRT = MROWS / 128;
    const EpiOut eo{};
    const int G = gridDim.x;
    if ((G & 7) == 0) {
        const int xcd = blockIdx.x & 7, local = blockIdx.x >> 3, LG = G >> 3;
        for (int lin = local; lin < (NRT / 8) * NCT; lin += LG) {
            const int rt = xcd + 8 * (lin / NCT), ct = lin % NCT;
            gemm_tile(p, O16, WTOUT, rt * 128, ct * 128, smem, eo);
        }
    } else {
        for (int it = blockIdx.x; it < NCT * NRT; it += gridDim.x) {
            const int rt = it / NCT, ct = it % NCT;
            gemm_tile(p, O16, WTOUT, rt * 128, ct * 128, smem, eo);
        }
    }
}

constexpr int SMEM_BYTES = 80 * 1024;

__device__ __forceinline__ void grid_barrier(unsigned* cnt, unsigned target) {
    asm volatile("s_waitcnt vmcnt(0)" ::: "memory");
    __syncthreads();
    if (threadIdx.x == 0) {
        __builtin_amdgcn_fence(__ATOMIC_RELEASE, "agent");
        asm volatile("s_waitcnt vmcnt(0)" ::: "memory");
        __hip_atomic_fetch_add(cnt, 1u, __ATOMIC_RELAXED, __HIP_MEMORY_SCOPE_AGENT);
        while (__hip_atomic_load(cnt, __ATOMIC_RELAXED, __HIP_MEMORY_SCOPE_AGENT) < target) __builtin_amdgcn_s_sleep(2);
        __builtin_amdgcn_fence(__ATOMIC_ACQUIRE, "agent");
        asm volatile("s_waitcnt vmcnt(0)" ::: "memory");
    }
    __syncthreads();
}

__global__ void __launch_bounds__(NT, 2) fwd_kernel(Params p) {
    __shared__ __attribute__((aligned(16))) unsigned char smem[SMEM_BYTES];
    static_assert(ATT_LDS <= SMEM_BYTES && sizeof(SmemDsa) <= SMEM_BYTES && sizeof(SelSm) <= SMEM_BYTES && CS_LD * 128 * 4 <= SMEM_BYTES, "smem");
    unsigned nbar = 0;
#define SEAM() grid_barrier((unsigned*)(p.ws + WS_CTL) + 48, ++nbar * gridDim.x)
    phase0(p, smem);
    if (p.ph_lo > 0) cg::this_grid().sync(); else SEAM();
    phase1(p, smem); SEAM();
    phase2(p, smem); SEAM();
    phase3(p, smem); SEAM();
    phase4(p, smem);
#undef SEAM
}

extern "C" void kernel_launch(void* const* d_in, const int* in_sizes, int n_in, void* d_out, int out_size, void* d_ws, size_t ws_size, hipStream_t stream) {
    static int grid_blocks = 0;
    if (!grid_blocks) {
        int dev = 0, cus = 0, per_cu = 0;
        (void)hipGetDevice(&dev);
        (void)hipDeviceGetAttribute(&cus, hipDeviceAttributeMultiprocessorCount, dev);
        (void)hipOccupancyMaxActiveBlocksPerMultiprocessor(&per_cu, fwd_kernel, NT, 0);
        if (per_cu < 1) per_cu = 1;
        if (per_cu > (160 * 1024) / SMEM_BYTES) per_cu = (160 * 1024) / SMEM_BYTES;
        grid_blocks = cus * per_cu;
        if (ws_size < WS_END) fprintf(stderr, "kernel_launch: workspace too small: %zu < %zu\n", ws_size, (size_t)WS_END);
    }
    if (ws_size < WS_END) return;
    (void)hipMemsetAsync((unsigned char*)d_ws + WS_CTL, 0, 256 + (size_t)2048 * REDO_LD * 4, stream);
    Params p{};
    for (int i = 0; i < 27; ++i) p.in[i] = (const float*)d_in[i];
    p.out = (float*)d_out; p.ws = (unsigned char*)d_ws;
    p.ph_lo = 0; p.ph_hi = 5;
    void* args[] = {&p};
    hipError_t e = hipLaunchCooperativeKernel((void*)fwd_kernel, dim3(grid_blocks), dim3(NT), args, 0, stream);
    if (e != hipSuccess) fprintf(stderr, "cooperative launch failed: %s (grid %d)\n", hipGetErrorString(e), grid_blocks);
}
```

```cpp
#include <hip/hip_runtime.h>
#include <hip/hip_cooperative_groups.h>
#include <cstdio>
#include <cstdint>
namespace cg = cooperative_groups;

#define NT 256

constexpr int D = 1024, SEQ = 16384, DECB = 32, DECS = 64, PAST = 1024, NMEM = 256;
constexpr int MROWS = SEQ + DECB * DECS;
constexpr int DIN = 3880;
constexpr int LDP = 264;
constexpr int PC_IQ = 0, PC_IW = 256;
constexpr float EPS = 1e-6f;

constexpr size_t O_YP = 0, O_YS = 16777216, O_PAK = 18874368, O_PAV = 27262976, O_PAKI = 35651584, O_PBK = 36175872,
                 O_PBV = 40370176, O_PMK = 44564480, O_PMV = 44630016, O_SAK = 44695552, O_SAV = 45744128,
                 O_SAKI = 46792704, O_SBK = 46858240, O_SBV = 47382528;

typedef _Float16 h16;
typedef h16 h16x2 __attribute__((ext_vector_type(2)));
typedef h16 h16x4 __attribute__((ext_vector_type(4)));
typedef h16 h16x8 __attribute__((ext_vector_type(8)));
typedef float f32x4 __attribute__((ext_vector_type(4)));
typedef unsigned u32x4 __attribute__((ext_vector_type(4)));
typedef __bf16 bf16x8 __attribute__((ext_vector_type(8)));
typedef __bf16 bf16x2 __attribute__((ext_vector_type(2)));
typedef float f32x2 __attribute__((ext_vector_type(2)));
__device__ __forceinline__ unsigned pkbf(float a, float b) { const f32x2 v = {a, b}; return __builtin_bit_cast(unsigned, __builtin_convertvector(v, bf16x2)); }
typedef float f32x16 __attribute__((ext_vector_type(16)));

constexpr int NPAD_IN = 3968;
constexpr float LOG2E = 1.4426950408889634f;
constexpr size_t WS_XH = 0;
constexpr size_t WS_O16 = WS_XH;
constexpr size_t WS_HMH = WS_XH + (size_t)MROWS * D * 2;
constexpr size_t WS_WTIN = WS_HMH + (size_t)NMEM * D * 2;
constexpr size_t WS_WTOUT = WS_WTIN + (size_t)NPAD_IN * D * 2;
constexpr size_t WS_WTMEM = WS_WTOUT + (size_t)D * D * 2;
constexpr size_t WS_QA = WS_WTMEM + (size_t)512 * D * 2;
constexpr size_t WS_QB = WS_QA + (size_t)MROWS * 512 * 2;
constexpr size_t WS_QC = WS_QB + (size_t)MROWS * 256 * 2;
constexpr size_t WS_G = WS_QC + (size_t)MROWS * 256 * 2;
constexpr size_t WS_KB_P = WS_G + (size_t)MROWS * 1024 * 2;
constexpr size_t WS_VTB_P = WS_KB_P + (size_t)SEQ * 256 * 2;
constexpr size_t WS_MK_P = WS_VTB_P + (size_t)SEQ * 256 * 2;
constexpr size_t WS_MVT_P = WS_MK_P + (size_t)NMEM * 256 * 2;
constexpr size_t WS_KA_P = WS_MVT_P + (size_t)NMEM * 256 * 2;
constexpr size_t WS_VTA_P = WS_KA_P + (size_t)SEQ * 512 * 2;
constexpr size_t WS_MASK_P = WS_VTA_P + (size_t)SEQ * 512 * 2;
constexpr size_t WS_MASK_S = WS_MASK_P + (size_t)SEQ * 512 * 4;
constexpr size_t WS_IQ16 = WS_MASK_S + (size_t)DECB * DECS * 34 * 4;
constexpr size_t WS_IK_P = WS_IQ16 + (size_t)MROWS * 256 * 2;
constexpr size_t WS_IK_S = WS_IK_P + (size_t)SEQ * 32 * 2;
constexpr size_t WS_CTL = WS_IK_S + (size_t)DECB * (PAST + DECS) * 32 * 2;
constexpr int REDO_LD = 64;
constexpr size_t WS_REDO = WS_CTL + 256;
constexpr size_t WS_P = WS_REDO + (size_t)2048 * REDO_LD * 4;
constexpr size_t WS_END = WS_P + (size_t)MROWS * LDP * 4;

struct Params {
    const float* in[27];
    float* out;
    unsigned char* ws;
    int ph_lo, ph_hi;
};

__device__ __forceinline__ float wave_sum(float v) {
#pragma unroll
    for (int o = 1; o < 64; o <<= 1) v += __shfl_xor(v, o);
    return v;
}
__device__ __forceinline__ float wave_max(float v) {
#pragma unroll
    for (int o = 1; o < 64; o <<= 1) v = fmaxf(v, __shfl_xor(v, o));
    return v;
}
__device__ __forceinline__ float silu(float x) { return x / (1.0f + expf(-x)); }

__device__ __forceinline__ int rel_bucket(int rel) {
    const int ret = rel > 0 ? 16 : 0;
    const int n = rel < 0 ? -rel : rel;
    int b;
    if (n < 8) b = n;
    else if (n < 12) b = 8;
    else if (n < 16) b = 9;
    else if (n < 23) b = 10;
    else if (n < 32) b = 11;
    else if (n < 46) b = 12;
    else if (n < 64) b = 13;
    else if (n < 91) b = 14;
    else b = 15;
    return ret + b;
}

__device__ __forceinline__ void rms_row_h(const float* x, const float* g, h16* o, int lane) {
    const float4* xr = (const float4*)x;
    const float4* gr = (const float4*)g;
    float4 v[4];
    float s = 0.f;
#pragma unroll
    for (int j = 0; j < 4; ++j) { v[j] = xr[lane + 64 * j]; s += v[j].x * v[j].x + v[j].y * v[j].y + v[j].z * v[j].z + v[j].w * v[j].w; }
    s = wave_sum(s);
    const float r = 1.0f / sqrtf(s * (1.0f / 1024.0f) + EPS);
#pragma unroll
    for (int j = 0; j < 4; ++j) {
        const float4 gg = gr[lane + 64 * j];
        h16x4 o4; o4.x = (h16)(v[j].x * r * gg.x); o4.y = (h16)(v[j].y * r * gg.y); o4.z = (h16)(v[j].z * r * gg.z); o4.w = (h16)(v[j].w * r * gg.w);
        ((h16x4*)o)[lane + 64 * j] = o4;
    }
}

__device__ __forceinline__ void transpose_item(const float* __restrict__ W, int ldw, int c0, int nvalid, int k0, h16* __restrict__ WT, int r0, float* scr, int lane) {
#pragma unroll 8
    for (int i = 0; i < 32; ++i) {
        const int kk = 2 * i + (lane >> 5), n = lane & 31;
        scr[kk * 33 + n] = (n < nvalid) ? W[(size_t)(k0 + kk) * ldw + c0 + n] : 0.f;
    }
    asm volatile("s_waitcnt lgkmcnt(0)" ::: "memory");
    const int c = lane & 7;
#pragma unroll
    for (int j = 0; j < 4; ++j) {
        const int n = (lane >> 3) + 8 * j;
        const float* s = scr + (8 * c) * 33 + n;
        h16x8 o;
#pragma unroll
        for (int e = 0; e < 8; ++e) o[e] = (h16)s[e * 33];
        *(h16x8*)(WT + (size_t)(r0 + n) * 1024 + k0 + 8 * c) = o;
    }
    asm volatile("s_waitcnt lgkmcnt(0)" ::: "memory");
}

__device__ __forceinline__ int inproj_col(int np) { return np < 2304 ? np : (np < 3840 ? np + 40 : np - 3840 + 2304); }

__device__ void phase0(const Params& p, unsigned char* smem) {
    int tid0 = threadIdx.x; asm volatile("" : "+v"(tid0));
    const int lane = tid0 & 63, w = tid0 >> 6;
    const int gw = blockIdx.x * 4 + w, ngw = gridDim.x * 4;
    h16* XH = (h16*)(p.ws + WS_XH);
    h16* HMH = (h16*)(p.ws + WS_HMH);
    h16* WTIN = (h16*)(p.ws + WS_WTIN);
    h16* WTOUT = (h16*)(p.ws + WS_WTOUT);
    h16* WTMEM = (h16*)(p.ws + WS_WTMEM);
    float* scr = (float*)smem + w * (64 * 33);
    constexpr int N_ROWS = MROWS + NMEM;
    constexpr int I_IN = 16 * (NPAD_IN / 32), I_OUT = 16 * 32, I_MEM = 16 * 16, I_KIDX = DECB * (PAST / 64);
    for (int it = gw; it < N_ROWS + I_IN + I_OUT + I_MEM + I_KIDX; it += ngw) {
        if (it < N_ROWS) {
            const int r = it;
            if (r < SEQ) rms_row_h(p.in[0] + (size_t)r * D, p.in[11], XH + (size_t)r * D, lane);
            else if (r < MROWS) rms_row_h(p.in[1] + (size_t)(r - SEQ) * D, p.in[11], XH + (size_t)r * D, lane);
            else rms_row_h(p.in[2] + (size_t)(r - MROWS) * D, p.in[25], HMH + (size_t)(r - MROWS) * D, lane);
        } else if (it < N_ROWS + I_IN) {
            const int r = it - N_ROWS, nb = r % (NPAD_IN / 32), kb = r / (NPAD_IN / 32);
            const int np0 = nb * 32;
            int nvalid = DIN - np0; nvalid = nvalid < 0 ? 0 : (nvalid > 32 ? 32 : nvalid);
            const int c0 = nvalid > 0 ? inproj_col(np0) : 0;
            transpose_item(p.in[12], DIN, c0, nvalid, kb * 64, WTIN, np0, scr, lane);
        } else if (it < N_ROWS + I_IN + I_OUT) {
            const int r = it - N_ROWS - I_IN, nb = r % 32, kb = r / 32;
            transpose_item(p.in[13], D, nb * 32, 32, kb * 64, WTOUT, nb * 32, scr, lane);
        } else if (it < N_ROWS + I_IN + I_OUT + I_MEM) {
            const int r = it - N_ROWS - I_IN - I_OUT, nb = r % 16, kb = r / 16;
            transpose_item(p.in[26], 512, nb * 32, 32, kb * 64, WTMEM, nb * 32, scr, lane);
        } else {
            const int r = it - N_ROWS - I_IN - I_OUT - I_MEM, b = r / (PAST / 64), key = (r % (PAST / 64)) * 64 + lane;
            const f32x4* src = (const f32x4*)(p.in[5] + ((size_t)b * PAST + key) * 32);
            h16* dst = (h16*)(p.ws + WS_IK_S) + ((size_t)b * (PAST + DECS) + key) * 32;
            float ss = 0.f;
#pragma unroll
            for (int c = 0; c < 4; ++c) {
                const f32x4 x0 = src[2 * c], x1 = src[2 * c + 1];
                h16x8 o;
#pragma unroll
                for (int e = 0; e < 4; ++e) { o[e] = (h16)x0[e]; o[4 + e] = (h16)x1[e]; ss = fmaf(x0[e], x0[e], ss); ss = fmaf(x1[e], x1[e], ss); }
                *(h16x8*)(dst + 8 * c) = o;
            }
            ss = wave_max(ss);
            if (lane == 0) atomicMax((unsigned*)(p.ws + WS_CTL) + 1 + b, __float_as_uint(ss));
        }
    }
}

constexpr int CS_LD = 132;
template <class Epi>
__device__ __forceinline__ void gemm_tile(const Params& p, const h16* __restrict__ A, const h16* __restrict__ Bt, int m0, int n0, unsigned char* smem, const Epi& epi) {
    int tid = threadIdx.x; asm volatile("" : "+v"(tid));
    const int lane = tid & 63, wid = tid >> 6, wm = wid >> 1, wn = wid & 1;
    const int l31 = lane & 31, hh = lane >> 5;
    f32x16 acc[2][2];
#pragma unroll
    for (int a = 0; a < 2; ++a)
#pragma unroll
        for (int b = 0; b < 2; ++b)
#pragma unroll
            for (int r = 0; r < 16; ++r) acc[a][b][r] = 0.f;
    const unsigned char* agl[4]; const unsigned char* bgl[4]; int ldo[4];
#pragma unroll
    for (int i = 0; i < 4; ++i) {
        const int row = 32 * wid + 8 * i + (lane >> 3), slot = lane & 7, ch = slot ^ ((row >> 1) & 7);
        agl[i] = (const unsigned char*)(A + (size_t)(m0 + row) * 1024 + ch * 8);
        bgl[i] = (const unsigned char*)(Bt + (size_t)(n0 + row) * 1024 + ch * 8);
        ldo[i] = (32 * wid + 8 * i) * 128;
    }
#define GT_DMA(stage_, kt_) do { const int ko_ = ((kt_) < 15 ? (kt_) : 15) * 128; \
        _Pragma("unroll") for (int i = 0; i < 4; ++i) { \
            __builtin_amdgcn_global_load_lds((const unsigned*)(agl[i] + ko_), (__attribute__((address_space(3))) unsigned*)(smem + (stage_) * 32768 + ldo[i]), 16, 0, 0); \
            __builtin_amdgcn_global_load_lds((const unsigned*)(bgl[i] + ko_), (__attribute__((address_space(3))) unsigned*)(smem + (stage_) * 32768 + 16384 + ldo[i]), 16, 0, 0); } } while (0)
    const int sw = (l31 >> 1) & 7;
    const int arow = (wm * 64 + l31) * 128, brow = (wn * 64 + l31) * 128;
    __syncthreads();
    GT_DMA(0, 0);
    __syncthreads();
    for (int kt = 0; kt < 16; ++kt) {
        const unsigned char* As = smem + (kt & 1) * 32768; const unsigned char* Bs = As + 16384;
        GT_DMA((kt + 1) & 1, kt + 1);
#pragma unroll
        for (int s = 0; s < 4; ++s) {
            const int co = (((2 * s + hh) ^ sw) << 4);
            h16x8 a[2], b[2];
#pragma unroll
            for (int mt = 0; mt < 2; ++mt) a[mt] = *(const h16x8*)(As + arow + mt * 32 * 128 + co);
#pragma unroll
            for (int nt = 0; nt < 2; ++nt) b[nt] = *(const h16x8*)(Bs + brow + nt * 32 * 128 + co);
#pragma unroll
            for (int mt = 0; mt < 2; ++mt)
#pragma unroll
                for (int nt = 0; nt < 2; ++nt) acc[mt][nt] = __builtin_amdgcn_mfma_f32_32x32x16_f16(a[mt], b[nt], acc[mt][nt], 0, 0, 0);
        }
        __syncthreads();
    }
#undef GT_DMA
    float* Cs = (float*)smem;
#pragma unroll
    for (int mt = 0; mt < 2; ++mt)
#pragma unroll
        for (int nt = 0; nt < 2; ++nt)
#pragma unroll
            for (int r = 0; r < 16; ++r) {
                const int row = wm * 64 + mt * 32 + (r & 3) + 8 * (r >> 2) + 4 * hh, col = wn * 64 + nt * 32 + l31;
                Cs[row * CS_LD + col] = acc[mt][nt][r];
            }
    __syncthreads();
    epi(p, Cs, m0, n0, tid);
}

__device__ __forceinline__ float group_sum16(float v) { v += __shfl_xor(v, 1); v += __shfl_xor(v, 2); v += __shfl_xor(v, 4); v += __shfl_xor(v, 8); return v; }
__device__ __forceinline__ float group_sum8(float v) { v += __shfl_xor(v, 1); v += __shfl_xor(v, 2); v += __shfl_xor(v, 4); return v; }

struct Seg {
    float* bp; float* bs; int ld; int col; int norm; const float* gain;
    h16* hp; h16* hs; int hld; int hcol; float hscale;
    int vt; int head;
};

__device__ __forceinline__ Seg seg_of(const Params& p, int n0) {
    float* P = (float*)(p.ws + WS_P);
    float* out = p.out;
    h16* QA = (h16*)(p.ws + WS_QA); h16* QB = (h16*)(p.ws + WS_QB); h16* QC = (h16*)(p.ws + WS_QC); h16* G = (h16*)(p.ws + WS_G);
    Seg s; s.norm = 0; s.gain = nullptr; s.hp = nullptr; s.hs = nullptr; s.hld = 0; s.hcol = 0; s.hscale = 1.f; s.vt = 0; s.head = 0;
    s.bp = nullptr; s.bs = nullptr; s.ld = 0; s.col = 0;
#define SEG_O(op, os, ldv, c) do { s.bp = out + (op); s.bs = out + (os) - (size_t)SEQ * (ldv); s.ld = (ldv); s.col = (c); } while (0)
#define SEG_H(ptr, ldv, c, sc) do { s.hp = (ptr); s.hs = (ptr); s.hld = (ldv); s.hcol = (c); s.hscale = (sc); } while (0)
    if (n0 < 512) { s.norm = 64; s.gain = p.in[14]; SEG_H(QA, 512, n0, 0.125f * LOG2E); }
    else if (n0 < 1024) { SEG_O(O_PAK, O_SAK, 512, n0 - 512); s.norm = 64; s.gain = p.in[15]; s.hp = (h16*)(p.ws + WS_KA_P); s.hs = nullptr; s.hld = 512; s.hcol = n0 - 512; }
    else if (n0 < 1536) { SEG_O(O_PAV, O_SAV, 512, n0 - 1024); s.vt = 1; s.head = (n0 - 1024) >> 6; }
    else if (n0 < 2048) { SEG_H(G, 1024, n0 - 1536, 1.f); }
    else if (n0 < 2304) { s.bp = P; s.bs = P; s.ld = LDP; s.col = PC_IQ + n0 - 2048; SEG_H((h16*)(p.ws + WS_IQ16), 256, n0 - 2048, 1.f); }
    else if (n0 < 2560) { s.norm = 32; s.gain = p.in[16]; SEG_H(QB, 256, n0 - 2304, 0.17677669529663687f * LOG2E); }
    else if (n0 < 2816) { SEG_O(O_PBK, O_SBK, 256, n0 - 2560); s.norm = 32; s.gain = p.in[17]; s.hp = (h16*)(p.ws + WS_KB_P); s.hs = nullptr; s.hld = 256; s.hcol = n0 - 2560; }
    else if (n0 < 3072) { SEG_O(O_PBV, O_SBV, 256, n0 - 2816); s.vt = 2; s.head = (n0 - 2816) >> 6; }
    else if (n0 < 3328) { SEG_H(G, 1024, 512 + n0 - 3072, 1.f); }
    else if (n0 < 3584) { s.norm = 64; s.gain = p.in[23]; SEG_H(QC, 256, n0 - 3328, 0.125f * LOG2E); }
    else { SEG_H(G, 1024, 768 + n0 - 3584, 1.f); }
#undef SEG_O
#undef SEG_H
    return s;
}

__device__ __forceinline__ void vt_store(const float* Cs, int j, h16* dst_base, size_t ldv, int tid) {
    const int dv = tid & 63, rq = tid >> 6;
    h16* dst = dst_base + (size_t)dv * ldv + 32 * rq;
#pragma unroll
    for (int e8 = 0; e8 < 4; ++e8) {
        u32x4 o;
#pragma unroll
        for (int e = 0; e < 4; ++e) o[e] = pkbf(Cs[(32 * rq + 8 * e8 + 2 * e) * CS_LD + 64 * j + dv], Cs[(32 * rq + 8 * e8 + 2 * e + 1) * CS_LD + 64 * j + dv]);
        *(u32x4*)(dst + 8 * e8) = o;
    }
}

struct EpiIn {
    __device__ __forceinline__ void operator()(const Params& p, const float* Cs, int m0, int n0, int tid) const {
        const int cg = tid & 15, r0 = tid >> 4;
#pragma unroll 1
        for (int j = 0; j < 2; ++j) {
            const int n0j = n0 + 64 * j;
            if (n0j >= DIN) continue;
            if (n0j == 3840) {
                float* P = (float*)(p.ws + WS_P);
                float mx0 = 0.f, mx1 = 0.f;
#pragma unroll 1
                for (int i = 0; i < 8; ++i) {
                    const int rl = r0 + 16 * i, row = m0 + rl;
                    const float4 v = *(const float4*)&Cs[rl * CS_LD + 4 * cg];
                    float ss = (cg < 8) ? (v.x * v.x + v.y * v.y + v.z * v.z + v.w * v.w) : 0.f;
                    ss = group_sum8(ss);
                    if (i < 4) mx0 = fmaxf(mx0, ss); else mx1 = fmaxf(mx1, ss);
                    if (cg < 8) {
                        float* dst = (row < SEQ ? p.out + O_PAKI + (size_t)row * 32 : p.out + O_SAKI + (size_t)(row - SEQ) * 32) + 4 * cg; *(float4*)dst = v;
                        h16x4 hv; hv.x = (h16)v.x; hv.y = (h16)v.y; hv.z = (h16)v.z; hv.w = (h16)v.w;
                        h16* hd = row < SEQ ? (h16*)(p.ws + WS_IK_P) + (size_t)row * 32 : (h16*)(p.ws + WS_IK_S) + ((size_t)((row - SEQ) >> 6) * (PAST + DECS) + PAST + ((row - SEQ) & 63)) * 32;
                        *(h16x4*)(hd + 4 * cg) = hv;
                    }
                    else if (cg < 10) { *(float4*)(P + (size_t)row * LDP + PC_IW + 4 * (cg - 8)) = v; }
                }
                if (cg == 0) {
                    unsigned* ctl = (unsigned*)(p.ws + WS_CTL);
                    if (m0 < SEQ) atomicMax(ctl, __float_as_uint(fmaxf(mx0, mx1)));
                    else { const int b0 = (m0 - SEQ) >> 6; atomicMax(ctl + 1 + b0, __float_as_uint(mx0)); atomicMax(ctl + 2 + b0, __float_as_uint(mx1)); }
                }
                continue;
            }
            const Seg s = seg_of(p, n0j);
            float4 g4 = make_float4(1.f, 1.f, 1.f, 1.f);
            if (s.norm == 64) g4 = *(const float4*)(s.gain + 4 * cg);
            else if (s.norm == 32) g4 = *(const float4*)(s.gain + ((4 * cg) & 31));
#pragma unroll 1
            for (int i = 0; i < 8; ++i) {
                const int rl = r0 + 16 * i, row = m0 + rl;
                float4 v = *(const float4*)&Cs[rl * CS_LD + 64 * j + 4 * cg];
                if (s.norm) {
                    float ss = v.x * v.x + v.y * v.y + v.z * v.z + v.w * v.w;
                    float sc;
                    if (s.norm == 64) { ss = group_sum16(ss); sc = 1.0f / sqrtf(ss * (1.0f / 64.0f) + EPS); }
                    else { ss = group_sum8(ss); sc = 1.0f / sqrtf(ss * (1.0f / 32.0f) + EPS); }
                    v.x *= sc * g4.x; v.y *= sc * g4.y; v.z *= sc * g4.z; v.w *= sc * g4.w;
                }
                if (s.bp) *(float4*)((row < SEQ ? s.bp : s.bs) + (size_t)row * s.ld + s.col + 4 * cg) = v;
                h16* hb = row < SEQ ? s.hp : s.hs;
                if (hb) {
                    h16x4 hv; hv.x = (h16)(v.x * s.hscale); hv.y = (h16)(v.y * s.hscale); hv.z = (h16)(v.z * s.hscale); hv.w = (h16)(v.w * s.hscale);
                    *(h16x4*)(hb + (size_t)row * s.hld + s.hcol + 4 * cg) = hv;
                }
            }
            if (s.vt == 2 && m0 < SEQ) vt_store(Cs, j, (h16*)(p.ws + WS_VTB_P) + (size_t)(s.head * 64) * SEQ + m0, SEQ, tid);
            if (s.vt == 1 && m0 < SEQ) vt_store(Cs, j, (h16*)(p.ws + WS_VTA_P) + (size_t)(s.head * 64) * SEQ + m0, SEQ, tid);
        }
    }
};

struct EpiMem {
    __device__ __forceinline__ void operator()(const Params& p, const float* Cs, int m0, int n0, int tid) const {
        const int cg = tid & 15, r0 = tid >> 4;
#pragma unroll 1
        for (int j = 0; j < 2; ++j) {
            const int n0j = n0 + 64 * j;
            const bool isk = n0j < 256;
            const float4 g4 = isk ? *(const float4*)(p.in[24] + 4 * cg) : make_float4(1.f, 1.f, 1.f, 1.f);
#pragma unroll 1
            for (int i = 0; i < 8; ++i) {
                const int rl = r0 + 16 * i, row = m0 + rl;
                float4 v = *(const float4*)&Cs[rl * CS_LD + 64 * j + 4 * cg];
                if (isk) {
                    float ss = group_sum16(v.x * v.x + v.y * v.y + v.z * v.z + v.w * v.w);
                    const float sc = 1.0f / sqrtf(ss * (1.0f / 64.0f) + EPS);
                    v.x *= sc * g4.x; v.y *= sc * g4.y; v.z *= sc * g4.z; v.w *= sc * g4.w;
                    h16x4 hv; hv.x = (h16)v.x; hv.y = (h16)v.y; hv.z = (h16)v.z; hv.w = (h16)v.w;
                    *(h16x4*)((h16*)(p.ws + WS_MK_P) + (size_t)row * 256 + n0j + 4 * cg) = hv;
                }
                float* dst = p.out + (isk ? O_PMK : O_PMV) + (size_t)row * 256 + (isk ? n0j : n0j - 256) + 4 * cg;
                *(float4*)dst = v;
            }
            if (!isk) vt_store(Cs, j, (h16*)(p.ws + WS_MVT_P) + (size_t)(((n0j - 256) >> 6) * 64) * NMEM + m0, NMEM, tid);
        }
    }
};

struct EpiOut {
    __device__ __forceinline__ void operator()(const Params& p, const float* Cs, int m0, int n0, int tid) const {
        const int cg = tid & 15, r0 = tid >> 4;
#pragma unroll 1
        for (int i = 0; i < 8; ++i) {
            const int rl = r0 + 16 * i, row = m0 + rl;
            const float* x = (row < SEQ ? p.in[0] + (size_t)row * D : p.in[1] + (size_t)(row - SEQ) * D) + n0 + 4 * cg;
            float* y = (row < SEQ ? p.out + O_YP + (size_t)row * D : p.out + O_YS + (size_t)(row - SEQ) * D) + n0 + 4 * cg;
#pragma unroll
            for (int j = 0; j < 2; ++j) {
                const float4 v = *(const float4*)&Cs[rl * CS_LD + 64 * j + 4 * cg];
                const float4 xv = *(const float4*)(x + 64 * j);
                *(float4*)(y + 64 * j) = make_float4(xv.x + v.x, xv.y + v.y, xv.z + v.z, xv.w + v.w);
            }
        }
    }
};

__device__ void phase1(const Params& p, unsigned char* smem) {
    const h16* XH = (const h16*)(p.ws + WS_XH);
    const h16* HMH = (const h16*)(p.ws + WS_HMH);
    const h16* WTIN = (const h16*)(p.ws + WS_WTIN);
    const h16* WTMEM = (const h16*)(p.ws + WS_WTMEM);
    const EpiIn ein{}; const EpiMem emem{};
    const int G = gridDim.x;
    if ((G & 7) == 0) {
        const int xcd = blockIdx.x & 7, local = blockIdx.x >> 3, LG = G >> 3;
        for (int lin = local; lin < 6 * 96; lin += LG) {
            const int rgroup = lin / 96, rem = lin % 96, chalf = rem / 48, rem2 = rem % 48, r = rem2 >> 4, c = chalf * 16 + (rem2 & 15);
            if (c >= 31) continue;
            const int rt = xcd + 8 * (rgroup * 3 + r);
            gemm_tile(p, XH, WTIN, rt * 128, c * 128, smem, ein);
        }
        if (blockIdx.x < 8) { const int rt = blockIdx.x / 4, ct = blockIdx.x % 4; gemm_tile(p, HMH, WTMEM, rt * 128, ct * 128, smem, emem); }
    } else {
        constexpr int NCT = NPAD_IN / 128, NRT = MROWS / 128;
        constexpr int N_IN = NCT * NRT, N_MEM = 2 * 4;
        for (int it = blockIdx.x; it < N_IN + N_MEM; it += gridDim.x) {
            if (it < N_IN) { const int rt = it / NCT, ct = it % NCT; gemm_tile(p, XH, WTIN, rt * 128, ct * 128, smem, ein); }
            else { const int im = it - N_IN, rt = im / 4, ct = im % 4; gemm_tile(p, HMH, WTMEM, rt * 128, ct * 128, smem, emem); }
        }
    }
}

struct KeySrc {
    const float* cache; const float* fresh; int past; int ld;
    __device__ __forceinline__ const float* row(int k) const { return k < past ? cache + (size_t)k * ld : fresh + (size_t)(k - past) * ld; }
};

__device__ __forceinline__ unsigned fkey(float f) { const unsigned u = __float_as_uint(f); return (u & 0x80000000u) ? ~u : (u | 0x80000000u); }

struct SmemDsa {
    float sc[16384];
    float iq[256]; float iw[8];
    unsigned hist[256]; unsigned mw[512];
    int wcnt[4]; int wcnt2[4]; int misc[4];
};

__device__ void select_item(const Params& p, unsigned char* smem, int item) {
    SmemDsa& S = *(SmemDsa*)smem;
    int tid = threadIdx.x; asm volatile("" : "+v"(tid));
    const int lane = tid & 63, w = tid >> 6;
    const float* P = (const float*)(p.ws + WS_P);
    int row, N, mst; KeySrc ki; unsigned* mout;
    if (item < SEQ) {
        row = item; N = 64 * (item / 64 + 1);
        ki = KeySrc{nullptr, p.out + O_PAKI, 0, 32};
        mout = (unsigned*)(p.ws + WS_MASK_P) + item; mst = SEQ;
    } else {
        const int bt = item - SEQ, b = bt / DECS;
        row = item; N = PAST + DECS;
        ki = KeySrc{p.in[5] + (size_t)b * PAST * 32, p.out + O_SAKI + (size_t)b * DECS * 32, PAST, 32};
        mout = (unsigned*)(p.ws + WS_MASK_S) + (size_t)bt * 34; mst = 1;
    }
    const int nw = N / 32;
    __syncthreads();
    if (N <= 256) {
        if (tid < nw) mout[(size_t)tid * mst] = 0xffffffffu;
        return;
    }
    S.iq[tid] = P[(size_t)row * LDP + PC_IQ + tid];
    if (tid < 8) S.iw[tid] = P[(size_t)row * LDP + PC_IW + tid];
    S.mw[tid] = 0u; S.mw[tid + 256] = 0u;
    __syncthreads();
    for (int k = tid; k < N; k += NT) {
        const float4* kr = (const float4*)ki.row(k);
        float kd[32];
#pragma unroll
        for (int i = 0; i < 8; ++i) { const float4 t4 = kr[i]; kd[4 * i] = t4.x; kd[4 * i + 1] = t4.y; kd[4 * i + 2] = t4.z; kd[4 * i + 3] = t4.w; }
        float score = 0.f;
#pragma unroll 1
        for (int h = 0; h < 8; ++h) {
            float d = 0.f;
#pragma unroll
            for (int i = 0; i < 32; ++i) d = fmaf(S.iq[h * 32 + i], kd[i], d);
            score = fmaf(S.iw[h], fmaxf(d, 0.f), score);
        }
        S.sc[k] = score;
    }
    __syncthreads();
    unsigned prefix = 0; int remaining = 256;
    for (int pass = 0; pass < 4; ++pass) {
        const int shift = 24 - 8 * pass;
        S.hist[tid] = 0;
        __syncthreads();
        for (int k = tid; k < N; k += NT) {
            const unsigned key = fkey(S.sc[k]);
            if (pass == 0 || (key >> (shift + 8)) == prefix) atomicAdd(&S.hist[(key >> shift) & 255u], 1u);
        }
        __syncthreads();
        const int hv = (int)S.hist[tid];
        int x = hv;
#pragma unroll
        for (int o = 1; o < 64; o <<= 1) { const int y = __shfl_down(x, o); if (lane + o < 64) x += y; }
        if (lane == 0) S.wcnt[w] = x;
        __syncthreads();
        int above = x - hv;
        for (int w2 = w + 1; w2 < 4; ++w2) above += S.wcnt[w2];
        if (above < remaining && remaining <= above + hv) { S.misc[0] = (int)((prefix << 8) | (unsigned)tid); S.misc[1] = remaining - above; }
        __syncthreads();
        prefix = (unsigned)S.misc[0]; remaining = S.misc[1];
        __syncthreads();
    }
    const unsigned T = prefix; const int r = remaining;
    int base_eq = 0;
    const unsigned long long lt = (lane == 0) ? 0ull : (~0ull >> (64 - lane));
    for (int k0 = 0; k0 < N; k0 += NT) {
        const int k = k0 + tid;
        const unsigned key = (k < N) ? fkey(S.sc[k]) : 0u;
        const bool gt = (k < N) && key > T, eq = (k < N) && key == T;
        const unsigned long long beq = __ballot(eq);
        const int eqpre = __popcll(beq & lt);
        if (lane == 0) S.wcnt[w] = __popcll(beq);
        __syncthreads();
        int eqbase = base_eq, eqtot = 0;
        for (int w2 = 0; w2 < 4; ++w2) { const int c = S.wcnt[w2]; if (w2 < w) eqbase += c; eqtot += c; }
        const bool sel = gt || (eq && (eqbase + eqpre) < r);
        const unsigned long long bs = __ballot(sel);
        if (lane == 0) S.mw[(k0 >> 5) + 2 * w] = (unsigned)bs;
        if (lane == 32) S.mw[(k0 >> 5) + 2 * w + 1] = (unsigned)(bs >> 32);
        base_eq += eqtot;
        __syncthreads();
    }
    for (int i = tid; i < nw; i += NT) mout[(size_t)i * mst] = S.mw[i];
}

typedef float f32x4m __attribute__((ext_vector_type(4)));
constexpr int CAND_CAP = 120;
struct SelSm {
    unsigned hist[16][1025];
    float cand_s[16][CAND_CAP]; int cand_k[16][CAND_CAP];
    int cnt[16]; int bstar[16]; int nabove[16]; int ovf[16];
};

__device__ __forceinline__ void score_tile(const h16x8& a, const h16x8 (&bq)[8], const float (&wq)[8], float (&sc)[4]) {
    sc[0] = 0.f; sc[1] = 0.f; sc[2] = 0.f; sc[3] = 0.f;
#pragma unroll
    for (int h = 0; h < 8; ++h) {
        f32x4m z = {0.f, 0.f, 0.f, 0.f};
        const f32x4m d = __builtin_amdgcn_mfma_f32_16x16x32_f16(a, bq[h], z, 0, 0, 0);
#pragma unroll
        for (int i = 0; i < 4; ++i) { const int bits = (int)__float_as_uint(d[i]); sc[i] = fmaf(wq[h], __uint_as_float((unsigned)(bits > 0 ? bits : 0)), sc[i]); }
    }
}

__device__ __forceinline__ int bin_of(float sc, float inv, float off) {
    const int b = min(max((int)fmaf(sc, inv, off), 0), 1021);
    int sgn;
    asm("v_med3_i32 %0, %1, -1, 1" : "=v"(sgn) : "v"(sc));
    return b + sgn + 1;
}

__device__ __forceinline__ void select_unit(const Params& p, unsigned char* smem, int u) {
    SelSm& S = *(SelSm*)smem;
    int tid = threadIdx.x; asm volatile("" : "+v"(tid));
    const int lane = tid & 63, w = __builtin_amdgcn_readfirstlane(tid >> 6), q = lane & 15, g = lane >> 4;
    int row0, N, ldm, ldw, kslot; const h16* IK; unsigned* mask;
    if (u < 1024) {
        const int q0 = 16 * (1023 - u);
        row0 = q0; N = 64 * (q0 / 64 + 1); IK = (const h16*)(p.ws + WS_IK_P); mask = (unsigned*)(p.ws + WS_MASK_P) + q0; ldm = 1; ldw = SEQ; kslot = 0;
    } else {
        const int bu = u - 1024, b = bu >> 2, t0 = 16 * (bu & 3);
        row0 = SEQ + 64 * b + t0; N = PAST + DECS; IK = (const h16*)(p.ws + WS_IK_S) + (size_t)b * (PAST + DECS) * 32;
        mask = (unsigned*)(p.ws + WS_MASK_S) + (size_t)(64 * b + t0) * 34; ldm = 34; ldw = 1; kslot = 1 + b;
    }
    const int nw = N / 32;
    __syncthreads();
    if (N <= 256) {
        for (int i = tid; i < 16 * nw; i += NT) mask[(size_t)(i & 15) * ldm + (size_t)(i >> 4) * ldw] = 0xffffffffu;
        return;
    }
    for (int i = tid; i < 16 * 1025; i += NT) ((unsigned*)S.hist)[i] = 0u;
    if (tid < 16) { S.cnt[tid] = 0; S.ovf[tid] = 0; S.bstar[tid] = 0; S.nabove[tid] = 0; }
    const int rowq = row0 + q;
    const h16* IQ = (const h16*)(p.ws + WS_IQ16) + (size_t)rowq * 256 + 8 * g;
    const float* Pf = (const float*)(p.ws + WS_P) + (size_t)rowq * LDP + PC_IW;
    h16x8 bq[8]; float wq[8];
    float hi = 0.f, lo = 0.f;
#pragma unroll
    for (int h = 0; h < 8; ++h) {
        bq[h] = *(const h16x8*)(IQ + h * 32);
        wq[h] = Pf[h];
        float n2 = 0.f;
#pragma unroll
        for (int e = 0; e < 8; ++e) { const float x = (float)bq[h][e]; n2 = fmaf(x, x, n2); }
        n2 += __shfl_xor(n2, 16); n2 += __shfl_xor(n2, 32);
        const float t = wq[h] * sqrtf(n2);
        if (t > 0.f) hi += t; else lo += t;
    }
    const float kmax = sqrtf(__uint_as_float(((const unsigned*)(p.ws + WS_CTL))[kslot])) * 1.01f;
    hi = hi * kmax + 1e-6f; lo = lo * kmax - 1e-6f;
    const float inv = 1022.0f / fmaxf(hi - lo, 1e-20f), off = -lo * inv;
    __syncthreads();
    const h16* ikp = IK + (size_t)q * 32 + 8 * g;
    const int ngw = (nw - w + 3) >> 2;
#define SEL_LD(dst0, dst1, it_) do { const int gi_ = w + 4 * ((it_) < ngw ? (it_) : ngw - 1); \
        dst0 = *(const h16x8*)(ikp + (size_t)(32 * gi_) * 32); dst1 = *(const h16x8*)(ikp + (size_t)(32 * gi_ + 16) * 32); } while (0)
#define SEL_GROUP_A(x0, x1) do { _Pragma("unroll") for (int t = 0; t < 2; ++t) { \
            float sc[4]; score_tile(t == 0 ? x0 : x1, bq, wq, sc); \
            _Pragma("unroll") for (int i = 0; i < 4; ++i) { const int b = bin_of(sc[i], inv, off); atomicAdd(&S.hist[q][b], 1u); } } } while (0)
    {
        h16x8 a0, a1, b0, b1, c0, c1;
        SEL_LD(a0, a1, 0); SEL_LD(b0, b1, 1); SEL_LD(c0, c1, 2);
        asm volatile("" ::: "memory");
        for (int it = 0; it < ngw; it += 3) {
            SEL_GROUP_A(a0, a1);
            asm volatile("" ::: "memory"); SEL_LD(a0, a1, it + 3); asm volatile("" ::: "memory");
            if (it + 1 < ngw) SEL_GROUP_A(b0, b1);
            asm volatile("" ::: "memory"); SEL_LD(b0, b1, it + 4); asm volatile("" ::: "memory");
            if (it + 2 < ngw) SEL_GROUP_A(c0, c1);
            asm volatile("" ::: "memory"); SEL_LD(c0, c1, it + 5); asm volatile("" ::: "memory");
        }
    }
#undef SEL_GROUP_A
    __syncthreads();
    for (int qq = 0; qq < 4; ++qq) {
        const int qi = 4 * w + qq;
        unsigned c = 0;
#pragma unroll
        for (int e = 0; e < 16; ++e) c += S.hist[qi][16 * lane + e];
        int x = (int)c;
#pragma unroll
        for (int o = 1; o < 64; o <<= 1) { const int y = __shfl_down(x, o); if (lane + o < 64) x += y; }
        const int above = x - (int)c;
        if (above < 256 && 256 <= above + (int)c) {
            int acc = above, bs = 16 * lane;
            for (int e = 15; e >= 0; --e) {
                const int v = (int)S.hist[qi][16 * lane + e];
                if (acc + v >= 256) { bs = 16 * lane + e; break; }
                acc += v;
            }
            S.bstar[qi] = bs; S.nabove[qi] = acc;
        }
    }
    __syncthreads();
    const int bst = S.bstar[q];
    unsigned* mrow = (unsigned*)S.hist;
    {
        h16x8 a0, a1, b0, b1, c0, c1;
        SEL_LD(a0, a1, 0); SEL_LD(b0, b1, 1); SEL_LD(c0, c1, 2);
        asm volatile("" ::: "memory");
        for (int it = 0; it < ngw; it += 3) {
#pragma unroll
          for (int gg = 0; gg < 3; ++gg) {
           if (gg == 0 || it + gg < ngw) {
            const int grp = w + 4 * (it + gg);
            unsigned word = 0u;
#pragma unroll
            for (int t = 0; t < 2; ++t) {
                const int k0 = 32 * grp + 16 * t;
                float sc[4]; score_tile(gg == 0 ? (t == 0 ? a0 : a1) : gg == 1 ? (t == 0 ? b0 : b1) : (t == 0 ? c0 : c1), bq, wq, sc);
                unsigned nib = 0u;
#pragma unroll
                for (int i = 0; i < 4; ++i) {
                    const int b = bin_of(sc[i], inv, off);
                    if (b > bst) nib |= 1u << i;
                    else if (b == bst) {
                        const int pos = atomicAdd(&S.cnt[q], 1);
                        if (pos < CAND_CAP) { S.cand_s[q][pos] = sc[i]; S.cand_k[q][pos] = k0 + 4 * g + i; }
                    }
                }
                unsigned v = nib << (4 * g);
                v |= (unsigned)__shfl_xor((int)v, 16); v |= (unsigned)__shfl_xor((int)v, 32);
                word |= v << (16 * t);
            }
            if (g == 0) mrow[q * 512 + grp] = word;
           }
            asm volatile("" ::: "memory");
            if (gg == 0) SEL_LD(a0, a1, it + 3); else if (gg == 1) SEL_LD(b0, b1, it + 4); else SEL_LD(c0, c1, it + 5);
            asm volatile("" ::: "memory");
          }
        }
    }
#undef SEL_LD
    __syncthreads();
    for (int qq = 0; qq < 4; ++qq) {
        const int qi = 4 * w + qq;
        const int m = S.cnt[qi], r = 256 - S.nabove[qi];
        if (m > CAND_CAP) { if (lane == 0) S.ovf[qi] = 1; continue; }
        const int nparts = m > 64 ? 2 : 1;
        for (int part = 0; part < nparts; ++part) {
            const int me = lane + 64 * part;
            const float s_me = me < m ? S.cand_s[qi][me] : 0.f;
            const int k_me = me < m ? S.cand_k[qi][me] : 0;
            int rank = 0;
#pragma unroll 4
            for (int j = 0; j < m; ++j) { const float sj = S.cand_s[qi][j]; const int kj = S.cand_k[qi][j]; rank += (sj > s_me || (sj == s_me && kj < k_me)) ? 1 : 0; }
            if (me < m && rank < r) atomicOr(&mrow[qi * 512 + (k_me >> 5)], 1u << (k_me & 31));
        }
    }
    __syncthreads();
    for (int i = tid; i < 16 * nw; i += NT) { const int qi = i & 15, wd = i >> 4; mask[(size_t)qi * ldm + (size_t)wd * ldw] = mrow[qi * 512 + wd]; }
    __syncthreads();
    if (tid == 0) {
        unsigned* fl = (unsigned*)(p.ws + WS_REDO) + (size_t)blockIdx.x * REDO_LD;
        unsigned n = fl[0];
        for (int qi = 0; qi < 16; ++qi) if (S.ovf[qi] && n + 1 < (unsigned)REDO_LD) { fl[1 + n] = (unsigned)(row0 + qi); ++n; }
        fl[0] = n;
    }
}

constexpr int ATT_TB_OFF = 32768;
constexpr int ATT_MASK_OFF = ATT_TB_OFF + 1024 + 16;
constexpr int ATT_LUT_OFF = ATT_MASK_OFF + 4096;
constexpr int ATT_LDS = ATT_LUT_OFF + 4096;

__device__ __forceinline__ int pi32(int r) { return (r & 0x13) | ((r & 4) << 1) | ((r & 8) >> 1); }
__device__ __forceinline__ unsigned pkrtz(float a, float b) { return __builtin_bit_cast(unsigned, __builtin_amdgcn_cvt_pkrtz(a, b)); }

struct AttnUnit {
    int row0, nrows, ntiles, qpos0, head;
    const h16* Kh; const h16* VTh; int ldk; int ldv;
    const float* Kc; const float* Vc; const float* Kn; const float* Vn; int ldf; int ntc;
    const unsigned* mask; int ldm;
};

template <int MODE, bool F32SRC, int NQ>
__device__ __forceinline__ void attn_unit(const Params& p, unsigned char* smem, const AttnUnit& U, float lam) {
    int tid = threadIdx.x; asm volatile("" : "+v"(tid));
    const int lane = tid & 63, w = __builtin_amdgcn_readfirstlane(tid >> 6), l31 = lane & 31, hh = lane >> 5;
    const int wq = (MODE == 1) ? (w & 1) : w, cmap = (MODE == 1) ? (w >> 1) : 0;
    const int qb = wq * 32 * NQ;
    const bool active = qb < U.nrows;
    const int chunk_w = (U.qpos0 + qb) >> 6;
    float* tb = (float*)(smem + ATT_TB_OFF);
    __syncthreads();
    if (MODE != 2) {
        if (tid < 255) { const int hc = (MODE == 0 ? U.head : 8 + U.head); tb[tid] = (p.in[10][rel_bucket(tid - 191) * 12 + hc] - p.in[10][15 * 12 + hc]) * LOG2E; }
    }
    if (MODE == 0) {
        u32x4 e4;
#pragma unroll
        for (int e = 0; e < 4; ++e) { const int t2 = (tid >> (2 * e)) & 3; e4[e] = ((t2 & 1) ? 0x0000ffffu : 0u) | ((t2 & 2) ? 0xffff0000u : 0u); }
        ((u32x4*)(smem + ATT_LUT_OFF))[tid] = e4;
    }
    constexpr int NQF = (MODE == 1) ? 2 : 4;
    h16x8 qf[NQ][NQF];
#pragma unroll
    for (int nq = 0; nq < NQ; ++nq) {
        if (active) {
            const int rowq = U.row0 + qb + 32 * nq + l31;
            const h16* Qb = (MODE == 0) ? (const h16*)(p.ws + WS_QA) + (size_t)rowq * 512 + U.head * 64
                          : (MODE == 1) ? (const h16*)(p.ws + WS_QB) + (size_t)rowq * 256 + U.head * 64 + 32 * cmap
                                        : (const h16*)(p.ws + WS_QC) + (size_t)rowq * 256 + U.head * 64;
#pragma unroll
            for (int s = 0; s < NQF; ++s) qf[nq][s] = *(const h16x8*)(Qb + 16 * s + 8 * hh);
        } else {
#pragma unroll
            for (int s = 0; s < NQF; ++s)
#pragma unroll
                for (int e = 0; e < 8; ++e) qf[nq][s][e] = (h16)0.f;
        }
    }
    f32x16 O[NQ][2];
    float lsum[NQ];
    const u32x4* lut = (const u32x4*)(smem + ATT_LUT_OFF);
#pragma unroll
    for (int nq = 0; nq < NQ; ++nq) {
        lsum[nq] = 0.f;
#pragma unroll
        for (int m = 0; m < 2; ++m)
#pragma unroll
            for (int r = 0; r < 16; ++r) O[nq][m][r] = 0.f;
    }
    int crow[2], cch[2], so[2];
#pragma unroll
    for (int i = 0; i < 2; ++i) { const int c = tid + 256 * i; crow[i] = c >> 3; cch[i] = c & 7; so[i] = crow[i] * 128 + ((cch[i] ^ ((crow[i] >> 1) & 7)) << 4); }
#define ATT_STAGE_F32(b, j) do { \
        unsigned char* kt_ = smem + (b) * 16384; unsigned char* vt_ = kt_ + 8192; \
        const float* kb_ = ((j) < U.ntc) ? U.Kc + (size_t)(64 * (j)) * U.ldf : U.Kn + (size_t)(64 * ((j) - U.ntc)) * U.ldf; \
        const float* vb_ = ((j) < U.ntc) ? U.Vc + (size_t)(64 * (j)) * U.ldf : U.Vn + (size_t)(64 * ((j) - U.ntc)) * U.ldf; \
        { f32x4 f_[2][2]; \
          _Pragma("unroll") for (int i = 0; i < 2; ++i) { const float* ks_ = kb_ + (size_t)crow[i] * U.ldf + cch[i] * 8; f_[i][0] = *(const f32x4*)ks_; f_[i][1] = *(const f32x4*)(ks_ + 4); } \
          _Pragma("unroll") for (int i = 0; i < 2; ++i) { h16x8 hk_; _Pragma("unroll") for (int e = 0; e < 4; ++e) { hk_[e] = (h16)f_[i][0][e]; hk_[4 + e] = (h16)f_[i][1][e]; } \
            *(h16x8*)(kt_ + so[i]) = hk_; } } \
        asm volatile("" ::: "memory"); \
        { f32x4 f_[2][2]; \
          _Pragma("unroll") for (int i = 0; i < 2; ++i) { const float* vs_ = vb_ + (size_t)crow[i] * U.ldf + cch[i] * 8; f_[i][0] = *(const f32x4*)vs_; f_[i][1] = *(const f32x4*)(vs_ + 4); } \
          _Pragma("unroll") for (int i = 0; i < 2; ++i) { const int key_ = crow[i]; \
            _Pragma("unroll") for (int e = 0; e < 8; ++e) { const int dv_ = 8 * cch[i] + e; \
                *(__bf16*)(vt_ + dv_ * 128 + (((key_ >> 3) ^ ((dv_ >> 1) & 7)) << 4) + (key_ & 7) * 2) = (__bf16)(e < 4 ? f_[i][0][e] : f_[i][1][e - 4]); } } } } while (0)
    const int drow0 = 16 * w + (lane >> 3), drow1 = drow0 + 8;
    const int dch0 = (lane & 7) ^ ((drow0 >> 1) & 7), dch1 = (lane & 7) ^ ((drow1 >> 1) & 7);
    const unsigned char* kbase = F32SRC ? nullptr : (const unsigned char*)U.Kh;
    const unsigned char* vbase = F32SRC ? nullptr : (const unsigned char*)U.VTh;
    const unsigned kof0 = (unsigned)(drow0 * U.ldk + dch0 * 8) * 2u, kof1 = (unsigned)(drow1 * U.ldk + dch1 * 8) * 2u;
    const size_t vof0 = ((size_t)drow0 * U.ldv + dch0 * 8) * 2, vof1 = ((size_t)drow1 * U.ldv + dch1 * 8) * 2;
    const int dmo0 = (16 * w) * 128, dmo1 = (16 * w + 8) * 128;
#define ATT_DMA(b, j) do { \
        const unsigned char* kt_ = kbase + (size_t)(64 * (j)) * U.ldk * 2; const unsigned char* vt_ = vbase + (size_t)(64 * (j)) * 2; \
        __builtin_amdgcn_global_load_lds((const unsigned*)(kt_ + kof0), (__attribute__((address_space(3))) unsigned*)(smem + (b) * 16384 + dmo0), 16, 0, 0); \
        __builtin_amdgcn_global_load_lds((const unsigned*)(vt_ + vof0), (__attribute__((address_space(3))) unsigned*)(smem + (b) * 16384 + 8192 + dmo0), 16, 0, 0); \
        __builtin_amdgcn_global_load_lds((const unsigned*)(kt_ + kof1), (__attribute__((address_space(3))) unsigned*)(smem + (b) * 16384 + dmo1), 16, 0, 0); \
        __builtin_amdgcn_global_load_lds((const unsigned*)(vt_ + vof1), (__attribute__((address_space(3))) unsigned*)(smem + (b) * 16384 + 8192 + dmo1), 16, 0, 0); } while (0)
    const unsigned* mq = (MODE == 0 && NQ == 2) ? U.mask + qb + lane : nullptr;
#define ATT_MASK_DMA(b, j) do { \
        __builtin_amdgcn_global_load_lds(mq + (size_t)(2 * (j)) * SEQ, (__attribute__((address_space(3))) unsigned*)(smem + ATT_MASK_OFF + (((b) * 4 + w) * 2) * 256), 4, 0, 0); \
        __builtin_amdgcn_global_load_lds(mq + (size_t)(2 * (j) + 1) * SEQ, (__attribute__((address_space(3))) unsigned*)(smem + ATT_MASK_OFF + (((b) * 4 + w) * 2 + 1) * 256), 4, 0, 0); } while (0)
    if constexpr (MODE == 0 && NQ == 2) { ATT_MASK_DMA(0, 0); }
    if constexpr (!F32SRC) { ATT_DMA(0, 0); } else { ATT_STAGE_F32(0, 0); }
    const unsigned* mrow[NQ];
    unsigned mwn[NQ][2];
#pragma unroll
    for (int nq = 0; nq < NQ; ++nq) {
        mrow[nq] = (MODE == 0 && NQ == 1) ? U.mask + (size_t)(qb + 32 * nq + l31) * U.ldm : nullptr;
        mwn[nq][0] = 0xffffffffu; mwn[nq][1] = 0xffffffffu;
        if (MODE == 0 && NQ == 1) { mwn[nq][0] = mrow[nq][0]; mwn[nq][1] = mrow[nq][1]; }
    }
    __syncthreads();
    const int pil = pi32(l31), ksw = (pil >> 1) & 7, vsw = (l31 >> 1) & 7;
    const int jlast = U.ntiles - 1;
    for (int j = 0; j < U.ntiles; ++j) {
        const int buf = j & 1;
        const int jn = j < jlast ? j + 1 : jlast;
        unsigned mw[NQ][2];
#pragma unroll
        for (int nq = 0; nq < NQ; ++nq) {
            if (NQ == 1) {
                mw[nq][0] = mwn[nq][0] >> (8 * hh); mw[nq][1] = mwn[nq][1] >> (8 * hh);
                if (MODE == 0) { mwn[nq][0] = mrow[nq][2 * jn]; mwn[nq][1] = mrow[nq][2 * jn + 1]; }
            } else {
                mw[nq][0] = 0xffffffffu; mw[nq][1] = 0xffffffffu;
                if (MODE == 0) {
                    const unsigned* ml = (const unsigned*)(smem + ATT_MASK_OFF + ((buf * 4 + w) * 2) * 256) + 32 * nq + l31;
                    mw[nq][0] = ml[0] >> (8 * hh); mw[nq][1] = ml[64] >> (8 * hh);
                }
            }
        }
        if constexpr (MODE == 0 && NQ == 2) { ATT_MASK_DMA(buf ^ 1, jn); }
        if constexpr (!F32SRC) ATT_DMA(buf ^ 1, jn);
        if (active && (MODE == 2 || j <= chunk_w)) {
            const unsigned char* Kt = smem + buf * 16384;
            const unsigned char* Vt = Kt + 8192;
            const bool near = (MODE != 2) && (j >= chunk_w - 2);
#pragma unroll
            for (int u = 0; u < 2; ++u) {
                const unsigned char* kp = Kt + (32 * u + pil) * 128;
                bf16x8 pf[NQ][2];
                h16x8 kf[NQF];
#pragma unroll
                for (int s = 0; s < NQF; ++s) { const int ch = (MODE == 1) ? (4 * cmap + 2 * s + hh) : (2 * s + hh); kf[s] = *(const h16x8*)(kp + ((ch ^ ksw) << 4)); }
#pragma unroll
                for (int nq = 0; nq < NQ; ++nq) {
                    f32x16 S;
#pragma unroll
                    for (int r = 0; r < 16; ++r) S[r] = 0.f;
#pragma unroll
                    for (int s = 0; s < NQF; ++s) S = __builtin_amdgcn_mfma_f32_32x32x16_f16(kf[s], qf[nq][s], S, 0, 0, 0);
                    if (near) {
                        const int base = 64 * j + 32 * u + 8 * hh - (U.qpos0 + qb + 32 * nq + l31) + 191;
#pragma unroll
                        for (int i = 0; i < 16; ++i) S[i] += tb[base + (i & 7) + 16 * (i >> 3)];
                    }
#pragma unroll
                    for (int i = 0; i < 16; ++i) S[i] = __builtin_amdgcn_exp2f(S[i]);
#pragma unroll
                    for (int s2 = 0; s2 < 2; ++s2) {
                        u32x4 pk;
                        u32x4 mk4 = {0xffffffffu, 0xffffffffu, 0xffffffffu, 0xffffffffu};
                        if (MODE == 0) mk4 = lut[(mw[nq][u] >> (16 * s2)) & 0xffu];
#pragma unroll
                        for (int e = 0; e < 4; ++e) {
                            unsigned v = pkbf(S[8 * s2 + 2 * e], S[8 * s2 + 2 * e + 1]);
                            if (MODE == 0) v &= mk4[e];
                            lsum[nq] = __builtin_amdgcn_fdot2_f32_bf16(__builtin_bit_cast(bf16x2, v), __builtin_bit_cast(bf16x2, 0x3f803f80u), lsum[nq], false);
                            pk[e] = v;
                        }
                        pf[nq][s2] = __builtin_bit_cast(bf16x8, pk);
                    }
                }
#pragma unroll
                for (int m = 0; m < 2; ++m)
#pragma unroll
                    for (int s2 = 0; s2 < 2; ++s2) {
                        const bf16x8 vfr = *(const bf16x8*)(Vt + (32 * m + l31) * 128 + (((2 * (2 * u + s2) + hh) ^ vsw) << 4));
#pragma unroll
                        for (int nq = 0; nq < NQ; ++nq) O[nq][m] = __builtin_amdgcn_mfma_f32_32x32x16_bf16(vfr, pf[nq][s2], O[nq][m], 0, 0, 0);
                    }
            }
        }
        if constexpr (F32SRC) { ATT_STAGE_F32(buf ^ 1, jn); }
        __syncthreads();
    }
#undef ATT_STAGE_F32
#undef ATT_DMA
#undef ATT_MASK_DMA
    float inv[NQ];
#pragma unroll
    for (int nq = 0; nq < NQ; ++nq) { const float l = lsum[nq] + __shfl_xor(lsum[nq], 32); inv[nq] = 1.0f / l; }
    if (MODE == 1) {
        float* X = (float*)smem;
        if (cmap == 1) {
#pragma unroll
            for (int nq = 0; nq < NQ; ++nq)
#pragma unroll
                for (int m = 0; m < 2; ++m)
#pragma unroll
                    for (int i = 0; i < 16; ++i) X[((wq * NQ + nq) * 32 + m * 16 + i) * 64 + lane] = O[nq][m][i] * inv[nq];
        }
        __syncthreads();
        if (cmap == 1) return;
#pragma unroll
        for (int nq = 0; nq < NQ; ++nq)
#pragma unroll
            for (int m = 0; m < 2; ++m)
#pragma unroll
                for (int i = 0; i < 16; ++i) O[nq][m][i] = O[nq][m][i] * inv[nq] - lam * X[((wq * NQ + nq) * 32 + m * 16 + i) * 64 + lane];
    } else {
        if (!active) return;
#pragma unroll
        for (int nq = 0; nq < NQ; ++nq)
#pragma unroll
            for (int m = 0; m < 2; ++m)
#pragma unroll
                for (int i = 0; i < 16; ++i) O[nq][m][i] *= inv[nq];
    }
    const int colbase = (MODE == 0 ? 0 : (MODE == 1 ? 512 : 768)) + U.head * 64;
#pragma unroll
    for (int nq = 0; nq < NQ; ++nq) {
        const int rowq = U.row0 + qb + 32 * nq + l31;
        const h16* G = (const h16*)(p.ws + WS_G) + (size_t)rowq * 1024 + colbase;
        h16* Oo = (h16*)(p.ws + WS_O16) + (size_t)rowq * 1024 + colbase;
        float sc = 1.f;
        if (MODE == 1) {
            float ss = 0.f;
#pragma unroll
            for (int m = 0; m < 2; ++m)
#pragma unroll
                for (int i = 0; i < 16; ++i) ss = fmaf(O[nq][m][i], O[nq][m][i], ss);
            ss += __shfl_xor(ss, 32);
            sc = (1.0f / sqrtf(ss * (1.0f / 64.0f) + EPS)) * 0.8f;
        }
#pragma unroll
        for (int m = 0; m < 2; ++m)
#pragma unroll
            for (int g4 = 0; g4 < 4; ++g4) {
                const int dv = 32 * m + 8 * g4 + 4 * hh;
                const h16x4 gv = *(const h16x4*)(G + dv);
                h16x4 o4;
#pragma unroll
                for (int e = 0; e < 4; ++e) {
                    float o = O[nq][m][4 * g4 + e];
                    if (MODE == 1) o = o * sc * p.in[18][dv + e];
                    o4[e] = (h16)(o * silu((float)gv[e]));
                }
                *(h16x4*)(Oo + dv) = o4;
            }
    }
}

__device__ __forceinline__ AttnUnit unit_zero() {
    AttnUnit U; U.row0 = 0; U.nrows = 0; U.ntiles = 0; U.qpos0 = 0; U.head = 0; U.Kh = nullptr; U.VTh = nullptr; U.ldk = 0; U.ldv = 0;
    U.Kc = nullptr; U.Vc = nullptr; U.Kn = nullptr; U.Vn = nullptr; U.ldf = 0; U.ntc = 0; U.mask = nullptr; U.ldm = 0; return U;
}
__device__ __forceinline__ void unit_a_prompt(const Params& p, unsigned char* smem, int g, int head) {
    AttnUnit U = unit_zero();
    U.row0 = 256 * g; U.nrows = 256; U.ntiles = 4 * g + 4; U.qpos0 = 256 * g; U.head = head;
    U.Kh = (const h16*)(p.ws + WS_KA_P) + head * 64; U.ldk = 512;
    U.VTh = (const h16*)(p.ws + WS_VTA_P) + (size_t)(head * 64) * SEQ; U.ldv = SEQ;
    U.mask = (const unsigned*)(p.ws + WS_MASK_P) + 256 * g; U.ldm = 0;
    attn_unit<0, false, 2>(p, smem, U, 0.f);
}
__device__ __forceinline__ void unit_b_prompt(const Params& p, unsigned char* smem, int g, int head, float lam) {
    AttnUnit U = unit_zero();
    U.row0 = 128 * g; U.nrows = 128; U.ntiles = 2 * g + 2; U.qpos0 = 128 * g; U.head = head;
    U.Kh = (const h16*)(p.ws + WS_KB_P) + head * 64; U.ldk = 256;
    U.VTh = (const h16*)(p.ws + WS_VTB_P) + (size_t)(head * 64) * SEQ; U.ldv = SEQ;
    attn_unit<1, false, 2>(p, smem, U, lam);
}
__device__ __forceinline__ void unit_a_sample(const Params& p, unsigned char* smem, int b, int head) {
    AttnUnit U = unit_zero();
    U.row0 = SEQ + 64 * b; U.nrows = 64; U.ntiles = 17; U.qpos0 = PAST; U.head = head;
    U.Kc = p.in[3] + (size_t)b * PAST * 512 + head * 64; U.Vc = p.in[4] + (size_t)b * PAST * 512 + head * 64;
    U.Kn = p.out + O_SAK + (size_t)b * DECS * 512 + head * 64; U.Vn = p.out + O_SAV + (size_t)b * DECS * 512 + head * 64;
    U.ldf = 512; U.ntc = 16;
    U.mask = (const unsigned*)(p.ws + WS_MASK_S) + (size_t)(64 * b) * 34; U.ldm = 34;
    attn_unit<0, true, 1>(p, smem, U, 0.f);
}
__device__ __forceinline__ void unit_b_sample(const Params& p, unsigned char* smem, int b, int head, float lam) {
    AttnUnit U = unit_zero();
    U.row0 = SEQ + 64 * b; U.nrows = 64; U.ntiles = 17; U.qpos0 = PAST; U.head = head;
    U.Kc = p.in[6] + (size_t)b * PAST * 256 + head * 64; U.Vc = p.in[7] + (size_t)b * PAST * 256 + head * 64;
    U.Kn = p.out + O_SBK + (size_t)b * DECS * 256 + head * 64; U.Vn = p.out + O_SBV + (size_t)b * DECS * 256 + head * 64;
    U.ldf = 256; U.ntc = 16;
    attn_unit<1, true, 1>(p, smem, U, lam);
}
__device__ __forceinline__ void unit_c_prompt(const Params& p, unsigned char* smem, int g, int head) {
    AttnUnit U = unit_zero();
    U.row0 = 128 * g; U.nrows = 128; U.ntiles = 4; U.head = head;
    U.Kh = (const h16*)(p.ws + WS_MK_P) + head * 64; U.ldk = 256;
    U.VTh = (const h16*)(p.ws + WS_MVT_P) + (size_t)(head * 64) * NMEM; U.ldv = NMEM;
    attn_unit<2, false, 1>(p, smem, U, 0.f);
}
__device__ __forceinline__ void unit_c_sample(const Params& p, unsigned char* smem, int b, int head) {
    AttnUnit U = unit_zero();
    U.row0 = SEQ + 64 * b; U.nrows = 64; U.ntiles = 4; U.head = head;
    U.Kc = p.in[8] + (size_t)b * NMEM * 256 + head * 64; U.Vc = p.in[9] + (size_t)b * NMEM * 256 + head * 64;
    U.Kn = U.Kc; U.Vn = U.Vc; U.ldf = 256; U.ntc = 4;
    attn_unit<2, true, 1>(p, smem, U, 0.f);
}

#define ZIGZAG_LOOP(NALL) for (int zk_ = 0, pos_ = 0; zk_ * (int)gridDim.x < (NALL); ++zk_) \
    if ((pos_ = (zk_ & 1) ? (zk_ + 1) * (int)gridDim.x - 1 - (int)blockIdx.x : zk_ * (int)gridDim.x + (int)blockIdx.x) < (NALL))

__device__ __forceinline__ float diff_lambda_of(const Params& p) {
    float s1 = 0.f, s2 = 0.f;
    for (int i = 0; i < 32; ++i) { s1 = fmaf(p.in[19][i], p.in[20][i], s1); s2 = fmaf(p.in[21][i], p.in[22][i], s2); }
    return expf(s1) - expf(s2) + 0.2f;
}

__device__ void phase2(const Params& p, unsigned char* smem) {
    const float lam = diff_lambda_of(p);
    constexpr int N_SP = 1024, N_BS = 128, N_CS = 128, N_SS = 128, N_CP = 512;
    constexpr int N_ALL = N_SP + N_BS + N_CS + N_SS + N_CP;
    ZIGZAG_LOOP(N_ALL) {
        int it = pos_;
        {
            const int ss = it - (N_SP + N_BS + N_CS);
            const int su = it < N_SP ? it : ((ss >= 0 && ss < N_SS) ? 1024 + ss : -1);
            if (su >= 0) { select_unit(p, smem, su); continue; }
        }
        it -= N_SP;
        if (it < N_BS) { unit_b_sample(p, smem, it >> 2, it & 3, lam); continue; }
        it -= N_BS;
        if (it < N_CS) { unit_c_sample(p, smem, it >> 2, it & 3); continue; }
        it -= N_CS + N_SS;
        unit_c_prompt(p, smem, it >> 2, it & 3);
    }
    {
        __syncthreads();
        const unsigned* fl = (const unsigned*)(p.ws + WS_REDO) + (size_t)blockIdx.x * REDO_LD;
        const unsigned n = __builtin_amdgcn_readfirstlane((int)__hip_atomic_load(fl, __ATOMIC_RELAXED, __HIP_MEMORY_SCOPE_AGENT));
        for (unsigned i = 0; i < n; ++i) {
            const int row = __builtin_amdgcn_readfirstlane((int)__hip_atomic_load(fl + 1 + i, __ATOMIC_RELAXED, __HIP_MEMORY_SCOPE_AGENT));
            select_item(p, smem, row);
        }
    }
}

__device__ void phase3(const Params& p, unsigned char* smem) {
    const float lam = diff_lambda_of(p);
    const int G = gridDim.x;
    for (int i = blockIdx.x; i < 512; i += G) {
        { const int g = 63 - (i >> 3), head = i & 7; unit_a_prompt(p, smem, g, head); }
        { const int r = 511 - i, g = 127 - (r >> 2), head = r & 3; unit_b_prompt(p, smem, g, head, lam); }
        if (i >= 256) { const int s = i - 256; unit_a_sample(p, smem, s >> 3, s & 7); }
    }
}

__device__ void phase4(const Params& p, unsigned char* smem) {
    const h16* O16 = (const h16*)(p.ws + WS_O16);
    const h16* WTOUT = (const h16*)(p.ws + WS_WTOUT);
    constexpr int NCT = D / 128, NRT = MROWS / 128;
    const EpiOut eo{};
    const int G = gridDim.x;
    if ((G & 7) == 0) {
        const int xcd = blockIdx.x & 7, local = blockIdx.x >> 3, LG = G >> 3;
        for (int lin = local; lin < (NRT / 8) * NCT; lin += LG) {
            const int rt = xcd + 8 * (lin / NCT), ct = lin % NCT;
            gemm_tile(p, O16, WTOUT, rt * 128, ct * 128, smem, eo);
        }
    } else {
        for (int it = blockIdx.x; it < NCT * NRT; it += gridDim.x) {
            const int rt = it / NCT, ct = it % NCT;
            gemm_tile(p, O16, WTOUT, rt * 128, ct * 128, smem, eo);
        }
    }
}

constexpr int SMEM_BYTES = 80 * 1024;

__device__ __forceinline__ void grid_barrier(unsigned* cnt, unsigned target) {
    asm volatile("s_waitcnt vmcnt(0)" ::: "memory");
    __syncthreads();
    if (threadIdx.x == 0) {
        __builtin_amdgcn_fence(__ATOMIC_RELEASE, "agent");
        asm volatile("s_waitcnt vmcnt(0)" ::: "memory");
        __hip_atomic_fetch_add(cnt, 1u, __ATOMIC_RELAXED, __HIP_MEMORY_SCOPE_AGENT);
        while (__hip_atomic_load(cnt, __ATOMIC_RELAXED, __HIP_MEMORY_SCOPE_AGENT) < target) __builtin_amdgcn_s_sleep(2);
        __builtin_amdgcn_fence(__ATOMIC_ACQUIRE, "agent");
        asm volatile("s_waitcnt vmcnt(0)" ::: "memory");
    }
    __syncthreads();
}

__global__ void __launch_bounds__(NT, 2) fwd_kernel(Params p) {
    __shared__ __attribute__((aligned(16))) unsigned char smem[SMEM_BYTES];
    static_assert(ATT_LDS <= SMEM_BYTES && sizeof(SmemDsa) <= SMEM_BYTES && sizeof(SelSm) <= SMEM_BYTES && CS_LD * 128 * 4 <= SMEM_BYTES, "smem");
    unsigned nbar = 0;
#define SEAM() grid_barrier((unsigned*)(p.ws + WS_CTL) + 48, ++nbar * gridDim.x)
    phase0(p, smem);
    if (p.ph_lo > 0) cg::this_grid().sync(); else SEAM();
    phase1(p, smem); SEAM();
    phase2(p, smem); SEAM();
    phase3(p, smem); SEAM();
    phase4(p, smem);
#undef SEAM
}

extern "C" void kernel_launch(void* const* d_in, const int* in_sizes, int n_in, void* d_out, int out_size, void* d_ws, size_t ws_size, hipStream_t stream) {
    static int grid_blocks = 0;
    if (!grid_blocks) {
        int dev = 0, cus = 0, per_cu = 0;
        (void)hipGetDevice(&dev);
        (void)hipDeviceGetAttribute(&cus, hipDeviceAttributeMultiprocessorCount, dev);
        (void)hipOccupancyMaxActiveBlocksPerMultiprocessor(&per_cu, fwd_kernel, NT, 0);
        if (per_cu < 1) per_cu = 1;
        if (per_cu > (160 * 1024) / SMEM_BYTES) per_cu = (160 * 1024) / SMEM_BYTES;
        grid_blocks = cus * per_cu;
        if (ws_size < WS_END) fprintf(stderr, "kernel_launch: workspace too small: %zu < %zu\n", ws_size, (size_t)WS_END);
    }
    if (ws_size < WS_END) return;
    (void)hipMemsetAsync((unsigned char*)d_ws + WS_CTL, 0, 256 + (size_t)2048 * REDO_LD * 4, stream);
    Params p{};
    for (int i = 0; i < 27; ++i) p.in[i] = (const float*)d_in[i];
    p.out = (float*)d_out; p.ws = (unsigned char*)d_ws;
    p.ph_lo = 0; p.ph_hi = 5;
    void* args[] = {&p};
    hipError_t e = hipLaunchCooperativeKernel((void*)fwd_kernel, dim3(grid_blocks), dim3(NT), args, 0, stream);
    if (e != hipSuccess) fprintf(stderr, "cooperative launch failed: %s (grid %d)\n", hipGetErrorString(e), grid_blocks);
}
```

```cpp
#include <hip/hip_runtime.h>
#include <hip/hip_cooperative_groups.h>
#include <cstdio>
#include <cstdint>
namespace cg = cooperative_groups;

#define NT 256

constexpr int D = 1024, SEQ = 16384, DECB = 32, DECS = 64, PAST = 1024, NMEM = 256;
constexpr int MROWS = SEQ + DECB * DECS;
constexpr int DIN = 3880;
constexpr int LDP = 264;
constexpr int PC_IQ = 0, PC_IW = 256;
constexpr float EPS = 1e-6f;

constexpr size_t O_YP = 0, O_YS = 16777216, O_PAK = 18874368, O_PAV = 27262976, O_PAKI = 35651584, O_PBK = 36175872,
                 O_PBV = 40370176, O_PMK = 44564480, O_PMV = 44630016, O_SAK = 44695552, O_SAV = 45744128,
                 O_SAKI = 46792704, O_SBK = 46858240, O_SBV = 47382528;

typedef _Float16 h16;
typedef h16 h16x2 __attribute__((ext_vector_type(2)));
typedef h16 h16x4 __attribute__((ext_vector_type(4)));
typedef h16 h16x8 __attribute__((ext_vector_type(8)));
typedef float f32x4 __attribute__((ext_vector_type(4)));
typedef unsigned u32x4 __attribute__((ext_vector_type(4)));
typedef __bf16 bf16x8 __attribute__((ext_vector_type(8)));
typedef __bf16 bf16x2 __attribute__((ext_vector_type(2)));
typedef float f32x2 __attribute__((ext_vector_type(2)));
__device__ __forceinline__ unsigned pkbf(float a, float b) { const f32x2 v = {a, b}; return __builtin_bit_cast(unsigned, __builtin_convertvector(v, bf16x2)); }
typedef float f32x16 __attribute__((ext_vector_type(16)));

constexpr int NPAD_IN = 3968;
constexpr float LOG2E = 1.4426950408889634f;
constexpr size_t WS_XH = 0;
constexpr size_t WS_O16 = WS_XH;
constexpr size_t WS_HMH = WS_XH + (size_t)MROWS * D * 2;
constexpr size_t WS_WTIN = WS_HMH + (size_t)NMEM * D * 2;
constexpr size_t WS_WTOUT = WS_WTIN + (size_t)NPAD_IN * D * 2;
constexpr size_t WS_WTMEM = WS_WTOUT + (size_t)D * D * 2;
constexpr size_t WS_QA = WS_WTMEM + (size_t)512 * D * 2;
constexpr size_t WS_QB = WS_QA + (size_t)MROWS * 512 * 2;
constexpr size_t WS_QC = WS_QB + (size_t)MROWS * 256 * 2;
constexpr size_t WS_G = WS_QC + (size_t)MROWS * 256 * 2;
constexpr size_t WS_KB_P = WS_G + (size_t)MROWS * 1024 * 2;
constexpr size_t WS_VTB_P = WS_KB_P + (size_t)SEQ * 256 * 2;
constexpr size_t WS_MK_P = WS_VTB_P + (size_t)SEQ * 256 * 2;
constexpr size_t WS_MVT_P = WS_MK_P + (size_t)NMEM * 256 * 2;
constexpr size_t WS_KA_P = WS_MVT_P + (size_t)NMEM * 256 * 2;
constexpr size_t WS_VTA_P = WS_KA_P + (size_t)SEQ * 512 * 2;
constexpr size_t WS_MASK_P = WS_VTA_P + (size_t)SEQ * 512 * 2;
constexpr size_t WS_MASK_S = WS_MASK_P + (size_t)SEQ * 512 * 4;
constexpr size_t WS_IQ16 = WS_MASK_S + (size_t)DECB * DECS * 34 * 4;
constexpr size_t WS_IK_P = WS_IQ16 + (size_t)MROWS * 256 * 2;
constexpr size_t WS_IK_S = WS_IK_P + (size_t)SEQ * 32 * 2;
constexpr size_t WS_CTL = WS_IK_S + (size_t)DECB * (PAST + DECS) * 32 * 2;
constexpr int REDO_LD = 64;
constexpr size_t WS_REDO = WS_CTL + 256;
constexpr size_t WS_P = WS_REDO + (size_t)2048 * REDO_LD * 4;
constexpr size_t WS_END = WS_P + (size_t)MROWS * LDP * 4;

struct Params {
    const float* in[27];
    float* out;
    unsigned char* ws;
    int ph_lo, ph_hi;
};

__device__ __forceinline__ float wave_sum(float v) {
#pragma unroll
    for (int o = 1; o < 64; o <<= 1) v += __shfl_xor(v, o);
    return v;
}
__device__ __forceinline__ float wave_max(float v) {
#pragma unroll
    for (int o = 1; o < 64; o <<= 1) v = fmaxf(v, __shfl_xor(v, o));
    return v;
}
__device__ __forceinline__ float silu(float x) { return x / (1.0f + expf(-x)); }

__device__ __forceinline__ int rel_bucket(int rel) {
    const int ret = rel > 0 ? 16 : 0;
    const int n = rel < 0 ? -rel : rel;
    int b;
    if (n < 8) b = n;
    else if (n < 12) b = 8;
    else if (n < 16) b = 9;
    else if (n < 23) b = 10;
    else if (n < 32) b = 11;
    else if (n < 46) b = 12;
    else if (n < 64) b = 13;
    else if (n < 91) b = 14;
    else b = 15;
    return ret + b;
}

__device__ __forceinline__ void rms_row_h(const float* x, const float* g, h16* o, int lane) {
    const float4* xr = (const float4*)x;
    const float4* gr = (const float4*)g;
    float4 v[4];
    float s = 0.f;
#pragma unroll
    for (int j = 0; j < 4; ++j) { v[j] = xr[lane + 64 * j]; s += v[j].x * v[j].x + v[j].y * v[j].y + v[j].z * v[j].z + v[j].w * v[j].w; }
    s = wave_sum(s);
    const float r = 1.0f / sqrtf(s * (1.0f / 1024.0f) + EPS);
#pragma unroll
    for (int j = 0; j < 4; ++j) {
        const float4 gg = gr[lane + 64 * j];
        h16x4 o4; o4.x = (h16)(v[j].x * r * gg.x); o4.y = (h16)(v[j].y * r * gg.y); o4.z = (h16)(v[j].z * r * gg.z); o4.w = (h16)(v[j].w * r * gg.w);
        ((h16x4*)o)[lane + 64 * j] = o4;
    }
}

__device__ __forceinline__ void transpose_item(const float* __restrict__ W, int ldw, int c0, int nvalid, int k0, h16* __restrict__ WT, int r0, float* scr, int lane) {
#pragma unroll 8
    for (int i = 0; i < 32; ++i) {
        const int kk = 2 * i + (lane >> 5), n = lane & 31;
        scr[kk * 33 + n] = (n < nvalid) ? W[(size_t)(k0 + kk) * ldw + c0 + n] : 0.f;
    }
    asm volatile("s_waitcnt lgkmcnt(0)" ::: "memory");
    const int c = lane & 7;
#pragma unroll
    for (int j = 0; j < 4; ++j) {
        const int n = (lane >> 3) + 8 * j;
        const float* s = scr + (8 * c) * 33 + n;
        h16x8 o;
#pragma unroll
        for (int e = 0; e < 8; ++e) o[e] = (h16)s[e * 33];
        *(h16x8*)(WT + (size_t)(r0 + n) * 1024 + k0 + 8 * c) = o;
    }
    asm volatile("s_waitcnt lgkmcnt(0)" ::: "memory");
}

__device__ __forceinline__ int inproj_col(int np) { return np < 2304 ? np : (np < 3840 ? np + 40 : np - 3840 + 2304); }

__device__ void phase0(const Params& p, unsigned char* smem) {
    int tid0 = threadIdx.x; asm volatile("" : "+v"(tid0));
    const int lane = tid0 & 63, w = tid0 >> 6;
    const int gw = blockIdx.x * 4 + w, ngw = gridDim.x * 4;
    h16* XH = (h16*)(p.ws + WS_XH);
    h16* HMH = (h16*)(p.ws + WS_HMH);
    h16* WTIN = (h16*)(p.ws + WS_WTIN);
    h16* WTOUT = (h16*)(p.ws + WS_WTOUT);
    h16* WTMEM = (h16*)(p.ws + WS_WTMEM);
    float* scr = (float*)smem + w * (64 * 33);
    constexpr int N_ROWS = MROWS + NMEM;
    constexpr int I_IN = 16 * (NPAD_IN / 32), I_OUT = 16 * 32, I_MEM = 16 * 16, I_KIDX = DECB * (PAST / 64);
    for (int it = gw; it < N_ROWS + I_IN + I_OUT + I_MEM + I_KIDX; it += ngw) {
        if (it < N_ROWS) {
            const int r = it;
            if (r < SEQ) rms_row_h(p.in[0] + (size_t)r * D, p.in[11], XH + (size_t)r * D, lane);
            else if (r < MROWS) rms_row_h(p.in[1] + (size_t)(r - SEQ) * D, p.in[11], XH + (size_t)r * D, lane);
            else rms_row_h(p.in[2] + (size_t)(r - MROWS) * D, p.in[25], HMH + (size_t)(r - MROWS) * D, lane);
        } else if (it < N_ROWS + I_IN) {
            const int r = it - N_ROWS, nb = r % (NPAD_IN / 32), kb = r / (NPAD_IN / 32);
            const int np0 = nb * 32;
            int nvalid = DIN - np0; nvalid = nvalid < 0 ? 0 : (nvalid > 32 ? 32 : nvalid);
            const int c0 = nvalid > 0 ? inproj_col(np0) : 0;
            transpose_item(p.in[12], DIN, c0, nvalid, kb * 64, WTIN, np0, scr, lane);
        } else if (it < N_ROWS + I_IN + I_OUT) {
            const int r = it - N_ROWS - I_IN, nb = r % 32, kb = r / 32;
            transpose_item(p.in[13], D, nb * 32, 32, kb * 64, WTOUT, nb * 32, scr, lane);
        } else if (it < N_ROWS + I_IN + I_OUT + I_MEM) {
            const int r = it - N_ROWS - I_IN - I_OUT, nb = r % 16, kb = r / 16;
            transpose_item(p.in[26], 512, nb * 32, 32, kb * 64, WTMEM, nb * 32, scr, lane);
        } else {
            const int r = it - N_ROWS - I_IN - I_OUT - I_MEM, b = r / (PAST / 64), key = (r % (PAST / 64)) * 64 + lane;
            const f32x4* src = (const f32x4*)(p.in[5] + ((size_t)b * PAST + key) * 32);
            h16* dst = (h16*)(p.ws + WS_IK_S) + ((size_t)b * (PAST + DECS) + key) * 32;
            float ss = 0.f;
#pragma unroll
            for (int c = 0; c < 4; ++c) {
                const f32x4 x0 = src[2 * c], x1 = src[2 * c + 1];
                h16x8 o;
#pragma unroll
                for (int e = 0; e < 4; ++e) { o[e] = (h16)x0[e]; o[4 + e] = (h16)x1[e]; ss = fmaf(x0[e], x0[e], ss); ss = fmaf(x1[e], x1[e], ss); }
                *(h16x8*)(dst + 8 * c) = o;
            }
            ss = wave_max(ss);
            if (lane == 0) atomicMax((unsigned*)(p.ws + WS_CTL) + 1 + b, __float_as_uint(ss));
        }
    }
}

constexpr int CS_LD = 132;
template <class Epi>
__device__ __forceinline__ void gemm_tile(const Params& p, const h16* __restrict__ A, const h16* __restrict__ Bt, int m0, int n0, unsigned char* smem, const Epi& epi) {
    int tid = threadIdx.x; asm volatile("" : "+v"(tid));
    const int lane = tid & 63, wid = tid >> 6, wm = wid >> 1, wn = wid & 1;
    const int l31 = lane & 31, hh = lane >> 5;
    f32x16 acc[2][2];
#pragma unroll
    for (int a = 0; a < 2; ++a)
#pragma unroll
        for (int b = 0; b < 2; ++b)
#pragma unroll
            for (int r = 0; r < 16; ++r) acc[a][b][r] = 0.f;
    const unsigned char* agl[4]; const unsigned char* bgl[4]; int ldo[4];
#pragma unroll
    for (int i = 0; i < 4; ++i) {
        const int row = 32 * wid + 8 * i + (lane >> 3), slot = lane & 7, ch = slot ^ ((row >> 1) & 7);
        agl[i] = (const unsigned char*)(A + (size_t)(m0 + row) * 1024 + ch * 8);
        bgl[i] = (const unsigned char*)(Bt + (size_t)(n0 + row) * 1024 + ch * 8);
        ldo[i] = (32 * wid + 8 * i) * 128;
    }
#define GT_DMA(stage_, kt_) do { const int ko_ = ((kt_) < 15 ? (kt_) : 15) * 128; \
        _Pragma("unroll") for (int i = 0; i < 4; ++i) { \
            __builtin_amdgcn_global_load_lds((const unsigned*)(agl[i] + ko_), (__attribute__((address_space(3))) unsigned*)(smem + (stage_) * 32768 + ldo[i]), 16, 0, 0); \
            __builtin_amdgcn_global_load_lds((const unsigned*)(bgl[i] + ko_), (__attribute__((address_space(3))) unsigned*)(smem + (stage_) * 32768 + 16384 + ldo[i]), 16, 0, 0); } } while (0)
    const int sw = (l31 >> 1) & 7;
    const int arow = (wm * 64 + l31) * 128, brow = (wn * 64 + l31) * 128;
    __syncthreads();
    GT_DMA(0, 0);
    __syncthreads();
    for (int kt = 0; kt < 16; ++kt) {
        const unsigned char* As = smem + (kt & 1) * 32768; const unsigned char* Bs = As + 16384;
        GT_DMA((kt + 1) & 1, kt + 1);
#pragma unroll
        for (int s = 0; s < 4; ++s) {
            const int co = (((2 * s + hh) ^ sw) << 4);
            h16x8 a[2], b[2];
#pragma unroll
            for (int mt = 0; mt < 2; ++mt) a[mt] = *(const h16x8*)(As + arow + mt * 32 * 128 + co);
#pragma unroll
            for (int nt = 0; nt < 2; ++nt) b[nt] = *(const h16x8*)(Bs + brow + nt * 32 * 128 + co);
#pragma unroll
            for (int mt = 0; mt < 2; ++mt)
#pragma unroll
                for (int nt = 0; nt < 2; ++nt) acc[mt][nt] = __builtin_amdgcn_mfma_f32_32x32x16_f16(a[mt], b[nt], acc[mt][nt], 0, 0, 0);
        }
        __syncthreads();
    }
#undef GT_DMA
    float* Cs = (float*)smem;
#pragma unroll
    for (int mt = 0; mt < 2; ++mt)
#pragma unroll
        for (int nt = 0; nt < 2; ++nt)
#pragma unroll
            for (int r = 0; r < 16; ++r) {
                const int row = wm * 64 + mt * 32 + (r & 3) + 8 * (r >> 2) + 4 * hh, col = wn * 64 + nt * 32 + l31;
                Cs[row * CS_LD + col] = acc[mt][nt][r];
            }
    __syncthreads();
    epi(p, Cs, m0, n0, tid);
}

__device__ __forceinline__ float group_sum16(float v) { v += __shfl_xor(v, 1); v += __shfl_xor(v, 2); v += __shfl_xor(v, 4); v += __shfl_xor(v, 8); return v; }
__device__ __forceinline__ float group_sum8(float v) { v += __shfl_xor(v, 1); v += __shfl_xor(v, 2); v += __shfl_xor(v, 4); return v; }

struct Seg {
    float* bp; float* bs; int ld; int col; int norm; const float* gain;
    h16* hp; h16* hs; int hld; int hcol; float hscale;
    int vt; int head;
};

__device__ __forceinline__ Seg seg_of(const Params& p, int n0) {
    float* P = (float*)(p.ws + WS_P);
    float* out = p.out;
    h16* QA = (h16*)(p.ws + WS_QA); h16* QB = (h16*)(p.ws + WS_QB); h16* QC = (h16*)(p.ws + WS_QC); h16* G = (h16*)(p.ws + WS_G);
    Seg s; s.norm = 0; s.gain = nullptr; s.hp = nullptr; s.hs = nullptr; s.hld = 0; s.hcol = 0; s.hscale = 1.f; s.vt = 0; s.head = 0;
    s.bp = nullptr; s.bs = nullptr; s.ld = 0; s.col = 0;
#define SEG_O(op, os, ldv, c) do { s.bp = out + (op); s.bs = out + (os) - (size_t)SEQ * (ldv); s.ld = (ldv); s.col = (c); } while (0)
#define SEG_H(ptr, ldv, c, sc) do { s.hp = (ptr); s.hs = (ptr); s.hld = (ldv); s.hcol = (c); s.hscale = (sc); } while (0)
    if (n0 < 512) { s.norm = 64; s.gain = p.in[14]; SEG_H(QA, 512, n0, 0.125f * LOG2E); }
    else if (n0 < 1024) { SEG_O(O_PAK, O_SAK, 512, n0 - 512); s.norm = 64; s.gain = p.in[15]; s.hp = (h16*)(p.ws + WS_KA_P); s.hs = nullptr; s.hld = 512; s.hcol = n0 - 512; }
    else if (n0 < 1536) { SEG_O(O_PAV, O_SAV, 512, n0 - 1024); s.vt = 1; s.head = (n0 - 1024) >> 6; }
    else if (n0 < 2048) { SEG_H(G, 1024, n0 - 1536, 1.f); }
    else if (n0 < 2304) { s.bp = P; s.bs = P; s.ld = LDP; s.col = PC_IQ + n0 - 2048; SEG_H((h16*)(p.ws + WS_IQ16), 256, n0 - 2048, 1.f); }
    else if (n0 < 2560) { s.norm = 32; s.gain = p.in[16]; SEG_H(QB, 256, n0 - 2304, 0.17677669529663687f * LOG2E); }
    else if (n0 < 2816) { SEG_O(O_PBK, O_SBK, 256, n0 - 2560); s.norm = 32; s.gain = p.in[17]; s.hp = (h16*)(p.ws + WS_KB_P); s.hs = nullptr; s.hld = 256; s.hcol = n0 - 2560; }
    else if (n0 < 3072) { SEG_O(O_PBV, O_SBV, 256, n0 - 2816); s.vt = 2; s.head = (n0 - 2816) >> 6; }
    else if (n0 < 3328) { SEG_H(G, 1024, 512 + n0 - 3072, 1.f); }
    else if (n0 < 3584) { s.norm = 64; s.gain = p.in[23]; SEG_H(QC, 256, n0 - 3328, 0.125f * LOG2E); }
    else { SEG_H(G, 1024, 768 + n0 - 3584, 1.f); }
#undef SEG_O
#undef SEG_H
    return s;
}

__device__ __forceinline__ void vt_store(const float* Cs, int j, h16* dst_base, size_t ldv, int tid) {
    const int dv = tid & 63, rq = tid >> 6;
    h16* dst = dst_base + (size_t)dv * ldv + 32 * rq;
#pragma unroll
    for (int e8 = 0; e8 < 4; ++e8) {
        u32x4 o;
#pragma unroll
        for (int e = 0; e < 4; ++e) o[e] = pkbf(Cs[(32 * rq + 8 * e8 + 2 * e) * CS_LD + 64 * j + dv], Cs[(32 * rq + 8 * e8 + 2 * e + 1) * CS_LD + 64 * j + dv]);
        *(u32x4*)(dst + 8 * e8) = o;
    }
}

struct EpiIn {
    __device__ __forceinline__ void operator()(const Params& p, const float* Cs, int m0, int n0, int tid) const {
        const int cg = tid & 15, r0 = tid >> 4;
#pragma unroll 1
        for (int j = 0; j < 2; ++j) {
            const int n0j = n0 + 64 * j;
            if (n0j >= DIN) continue;
            if (n0j == 3840) {
                float* P = (float*)(p.ws + WS_P);
                float mx0 = 0.f, mx1 = 0.f;
#pragma unroll 1
                for (int i = 0; i < 8; ++i) {
                    const int rl = r0 + 16 * i, row = m0 + rl;
                    const float4 v = *(const float4*)&Cs[rl * CS_LD + 4 * cg];
                    float ss = (cg < 8) ? (v.x * v.x + v.y * v.y + v.z * v.z + v.w * v.w) : 0.f;
                    ss = group_sum8(ss);
                    if (i < 4) mx0 = fmaxf(mx0, ss); else mx1 = fmaxf(mx1, ss);
                    if (cg < 8) {
                        float* dst = (row < SEQ ? p.out + O_PAKI + (size_t)row * 32 : p.out + O_SAKI + (size_t)(row - SEQ) * 32) + 4 * cg; *(float4*)dst = v;
                        h16x4 hv; hv.x = (h16)v.x; hv.y = (h16)v.y; hv.z = (h16)v.z; hv.w = (h16)v.w;
                        h16* hd = row < SEQ ? (h16*)(p.ws + WS_IK_P) + (size_t)row * 32 : (h16*)(p.ws + WS_IK_S) + ((size_t)((row - SEQ) >> 6) * (PAST + DECS) + PAST + ((row - SEQ) & 63)) * 32;
                        *(h16x4*)(hd + 4 * cg) = hv;
                    }
                    else if (cg < 10) { *(float4*)(P + (size_t)row * LDP + PC_IW + 4 * (cg - 8)) = v; }
                }
                if (cg == 0) {
                    unsigned* ctl = (unsigned*)(p.ws + WS_CTL);
                    if (m0 < SEQ) atomicMax(ctl, __float_as_uint(fmaxf(mx0, mx1)));
                    else { const int b0 = (m0 - SEQ) >> 6; atomicMax(ctl + 1 + b0, __float_as_uint(mx0)); atomicMax(ctl + 2 + b0, __float_as_uint(mx1)); }
                }
                continue;
            }
            const Seg s = seg_of(p, n0j);
            float4 g4 = make_float4(1.f, 1.f, 1.f, 1.f);
            if (s.norm == 64) g4 = *(const float4*)(s.gain + 4 * cg);
            else if (s.norm == 32) g4 = *(const float4*)(s.gain + ((4 * cg) & 31));
#pragma unroll 1
            for (int i = 0; i < 8; ++i) {
                const int rl = r0 + 16 * i, row = m0 + rl;
                float4 v = *(const float4*)&Cs[rl * CS_LD + 64 * j + 4 * cg];
                if (s.norm) {
                    float ss = v.x * v.x + v.y * v.y + v.z * v.z + v.w * v.w;
                    float sc;
                    if (s.norm == 64) { ss = group_sum16(ss); sc = 1.0f / sqrtf(ss * (1.0f / 64.0f) + EPS); }
                    else { ss = group_sum8(ss); sc = 1.0f / sqrtf(ss * (1.0f / 32.0f) + EPS); }
                    v.x *= sc * g4.x; v.y *= sc * g4.y; v.z *= sc * g4.z; v.w *= sc * g4.w;
                }
                if (s.bp) *(float4*)((row < SEQ ? s.bp : s.bs) + (size_t)row * s.ld + s.col + 4 * cg) = v;
                h16* hb = row < SEQ ? s.hp : s.hs;
                if (hb) {
                    h16x4 hv; hv.x = (h16)(v.x * s.hscale); hv.y = (h16)(v.y * s.hscale); hv.z = (h16)(v.z * s.hscale); hv.w = (h16)(v.w * s.hscale);
                    *(h16x4*)(hb + (size_t)row * s.hld + s.hcol + 4 * cg) = hv;
                }
            }
            if (s.vt == 2 && m0 < SEQ) vt_store(Cs, j, (h16*)(p.ws + WS_VTB_P) + (size_t)(s.head * 64) * SEQ + m0, SEQ, tid);
            if (s.vt == 1 && m0 < SEQ) vt_store(Cs, j, (h16*)(p.ws + WS_VTA_P) + (size_t)(s.head * 64) * SEQ + m0, SEQ, tid);
        }
    }
};

struct EpiMem {
    __device__ __forceinline__ void operator()(const Params& p, const float* Cs, int m0, int n0, int tid) const {
        const int cg = tid & 15, r0 = tid >> 4;
#pragma unroll 1
        for (int j = 0; j < 2; ++j) {
            const int n0j = n0 + 64 * j;
            const bool isk = n0j < 256;
            const float4 g4 = isk ? *(const float4*)(p.in[24] + 4 * cg) : make_float4(1.f, 1.f, 1.f, 1.f);
#pragma unroll 1
            for (int i = 0; i < 8; ++i) {
                const int rl = r0 + 16 * i, row = m0 + rl;
                float4 v = *(const float4*)&Cs[rl * CS_LD + 64 * j + 4 * cg];
                if (isk) {
                    float ss = group_sum16(v.x * v.x + v.y * v.y + v.z * v.z + v.w * v.w);
                    const float sc = 1.0f / sqrtf(ss * (1.0f / 64.0f) + EPS);
                    v.x *= sc * g4.x; v.y *= sc * g4.y; v.z *= sc * g4.z; v.w *= sc * g4.w;
                    h16x4 hv; hv.x = (h16)v.x; hv.y = (h16)v.y; hv.z = (h16)v.z; hv.w = (h16)v.w;
                    *(h16x4*)((h16*)(p.ws + WS_MK_P) + (size_t)row * 256 + n0j + 4 * cg) = hv;
                }
                float* dst = p.out + (isk ? O_PMK : O_PMV) + (size_t)row * 256 + (isk ? n0j : n0j - 256) + 4 * cg;
                *(float4*)dst = v;
            }
            if (!isk) vt_store(Cs, j, (h16*)(p.ws + WS_MVT_P) + (size_t)(((n0j - 256) >> 6) * 64) * NMEM + m0, NMEM, tid);
        }
    }
};

struct EpiOut {
    __device__ __forceinline__ void operator()(const Params& p, const float* Cs, int m0, int n0, int tid) const {
        const int cg = tid & 15, r0 = tid >> 4;
#pragma unroll 1
        for (int i = 0; i < 8; ++i) {
            const int rl = r0 + 16 * i, row = m0 + rl;
            const float* x = (row < SEQ ? p.in[0] + (size_t)row * D : p.in[1] + (size_t)(row - SEQ) * D) + n0 + 4 * cg;
            float* y = (row < SEQ ? p.out + O_YP + (size_t)row * D : p.out + O_YS + (size_t)(row - SEQ) * D) + n0 + 4 * cg;
#pragma unroll
            for (int j = 0; j < 2; ++j) {
                const float4 v = *(const float4*)&Cs[rl * CS_LD + 64 * j + 4 * cg];
                const float4 xv = *(const float4*)(x + 64 * j);
                *(float4*)(y + 64 * j) = make_float4(xv.x + v.x, xv.y + v.y, xv.z + v.z, xv.w + v.w);
            }
        }
    }
};

__device__ void phase1(const Params& p, unsigned char* smem) {
    const h16* XH = (const h16*)(p.ws + WS_XH);
    const h16* HMH = (const h16*)(p.ws + WS_HMH);
    const h16* WTIN = (const h16*)(p.ws + WS_WTIN);
    const h16* WTMEM = (const h16*)(p.ws + WS_WTMEM);
    const EpiIn ein{}; const EpiMem emem{};
    const int G = gridDim.x;
    if ((G & 7) == 0) {
        const int xcd = blockIdx.x & 7, local = blockIdx.x >> 3, LG = G >> 3;
        for (int lin = local; lin < 6 * 96; lin += LG) {
            const int rgroup = lin / 96, rem = lin % 96, chalf = rem / 48, rem2 = rem % 48, r = rem2 >> 4, c = chalf * 16 + (rem2 & 15);
            if (c >= 31) continue;
            const int rt = xcd + 8 * (rgroup * 3 + r);
            gemm_tile(p, XH, WTIN, rt * 128, c * 128, smem, ein);
        }
        if (blockIdx.x < 8) { const int rt = blockIdx.x / 4, ct = blockIdx.x % 4; gemm_tile(p, HMH, WTMEM, rt * 128, ct * 128, smem, emem); }
    } else {
        constexpr int NCT = NPAD_IN / 128, NRT = MROWS / 128;
        constexpr int N_IN = NCT * NRT, N_MEM = 2 * 4;
        for (int it = blockIdx.x; it < N_IN + N_MEM; it += gridDim.x) {
            if (it < N_IN) { const int rt = it / NCT, ct = it % NCT; gemm_tile(p, XH, WTIN, rt * 128, ct * 128, smem, ein); }
            else { const int im = it - N_IN, rt = im / 4, ct = im % 4; gemm_tile(p, HMH, WTMEM, rt * 128, ct * 128, smem, emem); }
        }
    }
}

struct KeySrc {
    const float* cache; const float* fresh; int past; int ld;
    __device__ __forceinline__ const float* row(int k) const { return k < past ? cache + (size_t)k * ld : fresh + (size_t)(k - past) * ld; }
};

__device__ __forceinline__ unsigned fkey(float f) { const unsigned u = __float_as_uint(f); return (u & 0x80000000u) ? ~u : (u | 0x80000000u); }

struct SmemDsa {
    float sc[16384];
    float iq[256]; float iw[8];
    unsigned hist[256]; unsigned mw[512];
    int wcnt[4]; int wcnt2[4]; int misc[4];
};

__device__ void select_item(const Params& p, unsigned char* smem, int item) {
    SmemDsa& S = *(SmemDsa*)smem;
    int tid = threadIdx.x; asm volatile("" : "+v"(tid));
    const int lane = tid & 63, w = tid >> 6;
    const float* P = (const float*)(p.ws + WS_P);
    int row, N, mst; KeySrc ki; unsigned* mout;
    if (item < SEQ) {
        row = item; N = 64 * (item / 64 + 1);
        ki = KeySrc{nullptr, p.out + O_PAKI, 0, 32};
        mout = (unsigned*)(p.ws + WS_MASK_P) + item; mst = SEQ;
    } else {
        const int bt = item - SEQ, b = bt / DECS;
        row = item; N = PAST + DECS;
        ki = KeySrc{p.in[5] + (size_t)b * PAST * 32, p.out + O_SAKI + (size_t)b * DECS * 32, PAST, 32};
        mout = (unsigned*)(p.ws + WS_MASK_S) + (size_t)bt * 34; mst = 1;
    }
    const int nw = N / 32;
    __syncthreads();
    if (N <= 256) {
        if (tid < nw) mout[(size_t)tid * mst] = 0xffffffffu;
        return;
    }
    S.iq[tid] = P[(size_t)row * LDP + PC_IQ + tid];
    if (tid < 8) S.iw[tid] = P[(size_t)row * LDP + PC_IW + tid];
    S.mw[tid] = 0u; S.mw[tid + 256] = 0u;
    __syncthreads();
    for (int k = tid; k < N; k += NT) {
        const float4* kr = (const float4*)ki.row(k);
        float kd[32];
#pragma unroll
        for (int i = 0; i < 8; ++i) { const float4 t4 = kr[i]; kd[4 * i] = t4.x; kd[4 * i + 1] = t4.y; kd[4 * i + 2] = t4.z; kd[4 * i + 3] = t4.w; }
        float score = 0.f;
#pragma unroll 1
        for (int h = 0; h < 8; ++h) {
            float d = 0.f;
#pragma unroll
            for (int i = 0; i < 32; ++i) d = fmaf(S.iq[h * 32 + i], kd[i], d);
            score = fmaf(S.iw[h], fmaxf(d, 0.f), score);
        }
        S.sc[k] = score;
    }
    __syncthreads();
    unsigned prefix = 0; int remaining = 256;
    for (int pass = 0; pass < 4; ++pass) {
        const int shift = 24 - 8 * pass;
        S.hist[tid] = 0;
        __syncthreads();
        for (int k = tid; k < N; k += NT) {
            const unsigned key = fkey(S.sc[k]);
            if (pass == 0 || (key >> (shift + 8)) == prefix) atomicAdd(&S.hist[(key >> shift) & 255u], 1u);
        }
        __syncthreads();
        const int hv = (int)S.hist[tid];
        int x = hv;
#pragma unroll
        for (int o = 1; o < 64; o <<= 1) { const int y = __shfl_down(x, o); if (lane + o < 64) x += y; }
        if (lane == 0) S.wcnt[w] = x;
        __syncthreads();
        int above = x - hv;
        for (int w2 = w + 1; w2 < 4; ++w2) above += S.wcnt[w2];
        if (above < remaining && remaining <= above + hv) { S.misc[0] = (int)((prefix << 8) | (unsigned)tid); S.misc[1] = remaining - above; }
        __syncthreads();
        prefix = (unsigned)S.misc[0]; remaining = S.misc[1];
        __syncthreads();
    }
    const unsigned T = prefix; const int r = remaining;
    int base_eq = 0;
    const unsigned long long lt = (lane == 0) ? 0ull : (~0ull >> (64 - lane));
    for (int k0 = 0; k0 < N; k0 += NT) {
        const int k = k0 + tid;
        const unsigned key = (k < N) ? fkey(S.sc[k]) : 0u;
        const bool gt = (k < N) && key > T, eq = (k < N) && key == T;
        const unsigned long long beq = __ballot(eq);
        const int eqpre = __popcll(beq & lt);
        if (lane == 0) S.wcnt[w] = __popcll(beq);
        __syncthreads();
        int eqbase = base_eq, eqtot = 0;
        for (int w2 = 0; w2 < 4; ++w2) { const int c = S.wcnt[w2]; if (w2 < w) eqbase += c; eqtot += c; }
        const bool sel = gt || (eq && (eqbase + eqpre) < r);
        const unsigned long long bs = __ballot(sel);
        if (lane == 0) S.mw[(k0 >> 5) + 2 * w] = (unsigned)bs;
        if (lane == 32) S.mw[(k0 >> 5) + 2 * w + 1] = (unsigned)(bs >> 32);
        base_eq += eqtot;
        __syncthreads();
    }
    for (int i = tid; i < nw; i += NT) mout[(size_t)i * mst] = S.mw[i];
}

typedef float f32x4m __attribute__((ext_vector_type(4)));
constexpr int CAND_CAP = 120;
struct SelSm {
    unsigned hist[16][1025];
    float cand_s[16][CAND_CAP]; int cand_k[16][CAND_CAP];
    int cnt[16]; int bstar[16]; int nabove[16]; int ovf[16];
};

__device__ __forceinline__ void score_tile(const h16x8& a, const h16x8 (&bq)[8], const float (&wq)[8], float (&sc)[4]) {
    sc[0] = 0.f; sc[1] = 0.f; sc[2] = 0.f; sc[3] = 0.f;
#pragma unroll
    for (int h = 0; h < 8; ++h) {
        f32x4m z = {0.f, 0.f, 0.f, 0.f};
        const f32x4m d = __builtin_amdgcn_mfma_f32_16x16x32_f16(a, bq[h], z, 0, 0, 0);
#pragma unroll
        for (int i = 0; i < 4; ++i) { const int bits = (int)__float_as_uint(d[i]); sc[i] = fmaf(wq[h], __uint_as_float((unsigned)(bits > 0 ? bits : 0)), sc[i]); }
    }
}

__device__ __forceinline__ int bin_of(float sc, float inv, float off) {
    const int b = min(max((int)fmaf(sc, inv, off), 0), 1021);
    int sgn;
    asm("v_med3_i32 %0, %1, -1, 1" : "=v"(sgn) : "v"(sc));
    return b + sgn + 1;
}

__device__ __forceinline__ void select_unit(const Params& p, unsigned char* smem, int u) {
    SelSm& S = *(SelSm*)smem;
    int tid = threadIdx.x; asm volatile("" : "+v"(tid));
    const int lane = tid & 63, w = __builtin_amdgcn_readfirstlane(tid >> 6), q = lane & 15, g = lane >> 4;
    int row0, N, ldm, ldw, kslot; const h16* IK; unsigned* mask;
    if (u < 1024) {
        const int q0 = 16 * (1023 - u);
        row0 = q0; N = 64 * (q0 / 64 + 1); IK = (const h16*)(p.ws + WS_IK_P); mask = (unsigned*)(p.ws + WS_MASK_P) + q0; ldm = 1; ldw = SEQ; kslot = 0;
    } else {
        const int bu = u - 1024, b = bu >> 2, t0 = 16 * (bu & 3);
        row0 = SEQ + 64 * b + t0; N = PAST + DECS; IK = (const h16*)(p.ws + WS_IK_S) + (size_t)b * (PAST + DECS) * 32;
        mask = (unsigned*)(p.ws + WS_MASK_S) + (size_t)(64 * b + t0) * 34; ldm = 34; ldw = 1; kslot = 1 + b;
    }
    const int nw = N / 32;
    __syncthreads();
    if (N <= 256) {
        for (int i = tid; i < 16 * nw; i += NT) mask[(size_t)(i & 15) * ldm + (size_t)(i >> 4) * ldw] = 0xffffffffu;
        return;
    }
    for (int i = tid; i < 16 * 1025; i += NT) ((unsigned*)S.hist)[i] = 0u;
    if (tid < 16) { S.cnt[tid] = 0; S.ovf[tid] = 0; S.bstar[tid] = 0; S.nabove[tid] = 0; }
    const int rowq = row0 + q;
    const h16* IQ = (const h16*)(p.ws + WS_IQ16) + (size_t)rowq * 256 + 8 * g;
    const float* Pf = (const float*)(p.ws + WS_P) + (size_t)rowq * LDP + PC_IW;
    h16x8 bq[8]; float wq[8];
    float hi = 0.f, lo = 0.f;
#pragma unroll
    for (int h = 0; h < 8; ++h) {
        bq[h] = *(const h16x8*)(IQ + h * 32);
        wq[h] = Pf[h];
        float n2 = 0.f;
#pragma unroll
        for (int e = 0; e < 8; ++e) { const float x = (float)bq[h][e]; n2 = fmaf(x, x, n2); }
        n2 += __shfl_xor(n2, 16); n2 += __shfl_xor(n2, 32);
        const float t = wq[h] * sqrtf(n2);
        if (t > 0.f) hi += t; else lo += t;
    }
    const float kmax = sqrtf(__uint_as_float(((const unsigned*)(p.ws + WS_CTL))[kslot])) * 1.01f;
    hi = hi * kmax + 1e-6f; lo = lo * kmax - 1e-6f;
    const float inv = 1022.0f / fmaxf(hi - lo, 1e-20f), off = -lo * inv;
    __syncthreads();
    const h16* ikp = IK + (size_t)q * 32 + 8 * g;
    const int ngw = (nw - w + 3) >> 2;
#define SEL_LD(dst0, dst1, it_) do { const int gi_ = w + 4 * ((it_) < ngw ? (it_) : ngw - 1); \
        dst0 = *(const h16x8*)(ikp + (size_t)(32 * gi_) * 32); dst1 = *(const h16x8*)(ikp + (size_t)(32 * gi_ + 16) * 32); } while (0)
#define SEL_GROUP_A(x0, x1) do { _Pragma("unroll") for (int t = 0; t < 2; ++t) { \
            float sc[4]; score_tile(t == 0 ? x0 : x1, bq, wq, sc); \
            _Pragma("unroll") for (int i = 0; i < 4; ++i) { const int b = bin_of(sc[i], inv, off); atomicAdd(&S.hist[q][b], 1u); } } } while (0)
    {
        h16x8 a0, a1, b0, b1, c0, c1;
        SEL_LD(a0, a1, 0); SEL_LD(b0, b1, 1); SEL_LD(c0, c1, 2);
        asm volatile("" ::: "memory");
        for (int it = 0; it < ngw; it += 3) {
            SEL_GROUP_A(a0, a1);
            asm volatile("" ::: "memory"); SEL_LD(a0, a1, it + 3); asm volatile("" ::: "memory");
            if (it + 1 < ngw) SEL_GROUP_A(b0, b1);
            asm volatile("" ::: "memory"); SEL_LD(b0, b1, it + 4); asm volatile("" ::: "memory");
            if (it + 2 < ngw) SEL_GROUP_A(c0, c1);
            asm volatile("" ::: "memory"); SEL_LD(c0, c1, it + 5); asm volatile("" ::: "memory");
        }
    }
#undef SEL_GROUP_A
    __syncthreads();
    for (int qq = 0; qq < 4; ++qq) {
        const int qi = 4 * w + qq;
        unsigned c = 0;
#pragma unroll
        for (int e = 0; e < 16; ++e) c += S.hist[qi][16 * lane + e];
        int x = (int)c;
#pragma unroll
        for (int o = 1; o < 64; o <<= 1) { const int y = __shfl_down(x, o); if (lane + o < 64) x += y; }
        const int above = x - (int)c;
        if (above < 256 && 256 <= above + (int)c) {
            int acc = above, bs = 16 * lane;
            for (int e = 15; e >= 0; --e) {
                const int v = (int)S.hist[qi][16 * lane + e];
                if (acc + v >= 256) { bs = 16 * lane + e; break; }
                acc += v;
            }
            S.bstar[qi] = bs; S.nabove[qi] = acc;
        }
    }
    __syncthreads();
    const int bst = S.bstar[q];
    unsigned* mrow = (unsigned*)S.hist;
    {
        h16x8 a0, a1, b0, b1, c0, c1;
        SEL_LD(a0, a1, 0); SEL_LD(b0, b1, 1); SEL_LD(c0, c1, 2);
        asm volatile("" ::: "memory");
        for (int it = 0; it < ngw; it += 3) {
#pragma unroll
          for (int gg = 0; gg < 3; ++gg) {
           if (gg == 0 || it + gg < ngw) {
            const int grp = w + 4 * (it + gg);
            unsigned word = 0u;
#pragma unroll
            for (int t = 0; t < 2; ++t) {
                const int k0 = 32 * grp + 16 * t;
                float sc[4]; score_tile(gg == 0 ? (t == 0 ? a0 : a1) : gg == 1 ? (t == 0 ? b0 : b1) : (t == 0 ? c0 : c1), bq, wq, sc);
                unsigned nib = 0u;
#pragma unroll
                for (int i = 0; i < 4; ++i) {
                    const int b = bin_of(sc[i], inv, off);
                    if (b > bst) nib |= 1u << i;
                    else if (b == bst) {
                        const int pos = atomicAdd(&S.cnt[q], 1);
                        if (pos < CAND_CAP) { S.cand_s[q][pos] = sc[i]; S.cand_k[q][pos] = k0 + 4 * g + i; }
                    }
                }
                unsigned v = nib << (4 * g);
                v |= (unsigned)__shfl_xor((int)v, 16); v |= (unsigned)__shfl_xor((int)v, 32);
                word |= v << (16 * t);
            }
            if (g == 0) mrow[q * 512 + grp] = word;
           }
            asm volatile("" ::: "memory");
            if (gg == 0) SEL_LD(a0, a1, it + 3); else if (gg == 1) SEL_LD(b0, b1, it + 4); else SEL_LD(c0, c1, it + 5);
            asm volatile("" ::: "memory");
          }
        }
    }
#undef SEL_LD
    __syncthreads();
    for (int qq = 0; qq < 4; ++qq) {
        const int qi = 4 * w + qq;
        const int m = S.cnt[qi], r = 256 - S.nabove[qi];
        if (m > CAND_CAP) { if (lane == 0) S.ovf[qi] = 1; continue; }
        const int nparts = m > 64 ? 2 : 1;
        for (int part = 0; part < nparts; ++part) {
            const int me = lane + 64 * part;
            const float s_me = me < m ? S.cand_s[qi][me] : 0.f;
            const int k_me = me < m ? S.cand_k[qi][me] : 0;
            int rank = 0;
#pragma unroll 4
            for (int j = 0; j < m; ++j) { const float sj = S.cand_s[qi][j]; const int kj = S.cand_k[qi][j]; rank += (sj > s_me || (sj == s_me && kj < k_me)) ? 1 : 0; }
            if (me < m && rank < r) atomicOr(&mrow[qi * 512 + (k_me >> 5)], 1u << (k_me & 31));
        }
    }
    __syncthreads();
    for (int i = tid; i < 16 * nw; i += NT) { const int qi = i & 15, wd = i >> 4; mask[(size_t)qi * ldm + (size_t)wd * ldw] = mrow[qi * 512 + wd]; }
    __syncthreads();
    if (tid == 0) {
        unsigned* fl = (unsigned*)(p.ws + WS_REDO) + (size_t)blockIdx.x * REDO_LD;
        unsigned n = fl[0];
        for (int qi = 0; qi < 16; ++qi) if (S.ovf[qi] && n + 1 < (unsigned)REDO_LD) { fl[1 + n] = (unsigned)(row0 + qi); ++n; }
        fl[0] = n;
    }
}

constexpr int ATT_TB_OFF = 32768;
constexpr int ATT_MASK_OFF = ATT_TB_OFF + 1024 + 16;
constexpr int ATT_LUT_OFF = ATT_MASK_OFF + 4096;
constexpr int ATT_LDS = ATT_LUT_OFF + 4096;

__device__ __forceinline__ int pi32(int r) { return (r & 0x13) | ((r & 4) << 1) | ((r & 8) >> 1); }
__device__ __forceinline__ unsigned pkrtz(float a, float b) { return __builtin_bit_cast(unsigned, __builtin_amdgcn_cvt_pkrtz(a, b)); }

struct AttnUnit {
    int row0, nrows, ntiles, qpos0, head;
    const h16* Kh; const h16* VTh; int ldk; int ldv;
    const float* Kc; const float* Vc; const float* Kn; const float* Vn; int ldf; int ntc;
    const unsigned* mask; int ldm;
};

template <int MODE, bool F32SRC, int NQ>
__device__ __forceinline__ void attn_unit(const Params& p, unsigned char* smem, const AttnUnit& U, float lam) {
    int tid = threadIdx.x; asm volatile("" : "+v"(tid));
    const int lane = tid & 63, w = __builtin_amdgcn_readfirstlane(tid >> 6), l31 = lane & 31, hh = lane >> 5;
    const int wq = (MODE == 1) ? (w & 1) : w, cmap = (MODE == 1) ? (w >> 1) : 0;
    const int qb = wq * 32 * NQ;
    const bool active = qb < U.nrows;
    const int chunk_w = (U.qpos0 + qb) >> 6;
    float* tb = (float*)(smem + ATT_TB_OFF);
    __syncthreads();
    if (MODE != 2) {
        if (tid < 255) { const int hc = (MODE == 0 ? U.head : 8 + U.head); tb[tid] = (p.in[10][rel_bucket(tid - 191) * 12 + hc] - p.in[10][15 * 12 + hc]) * LOG2E; }
    }
    if (MODE == 0) {
        u32x4 e4;
#pragma unroll
        for (int e = 0; e < 4; ++e) { const int t2 = (tid >> (2 * e)) & 3; e4[e] = ((t2 & 1) ? 0x0000ffffu : 0u) | ((t2 & 2) ? 0xffff0000u : 0u); }
        ((u32x4*)(smem + ATT_LUT_OFF))[tid] = e4;
    }
    constexpr int NQF = (MODE == 1) ? 2 : 4;
    h16x8 qf[NQ][NQF];
#pragma unroll
    for (int nq = 0; nq < NQ; ++nq) {
        if (active) {
            const int rowq = U.row0 + qb + 32 * nq + l31;
            const h16* Qb = (MODE == 0) ? (const h16*)(p.ws + WS_QA) + (size_t)rowq * 512 + U.head * 64
                          : (MODE == 1) ? (const h16*)(p.ws + WS_QB) + (size_t)rowq * 256 + U.head * 64 + 32 * cmap
                                        : (const h16*)(p.ws + WS_QC) + (size_t)rowq * 256 + U.head * 64;
#pragma unroll
            for (int s = 0; s < NQF; ++s) qf[nq][s] = *(const h16x8*)(Qb + 16 * s + 8 * hh);
        } else {
#pragma unroll
            for (int s = 0; s < NQF; ++s)
#pragma unroll
                for (int e = 0; e < 8; ++e) qf[nq][s][e] = (h16)0.f;
        }
    }
    f32x16 O[NQ][2];
    float lsum[NQ];
    const u32x4* lut = (const u32x4*)(smem + ATT_LUT_OFF);
#pragma unroll
    for (int nq = 0; nq < NQ; ++nq) {
        lsum[nq] = 0.f;
#pragma unroll
        for (int m = 0; m < 2; ++m)
#pragma unroll
            for (int r = 0; r < 16; ++r) O[nq][m][r] = 0.f;
    }
    int crow[2], cch[2], so[2];
#pragma unroll
    for (int i = 0; i < 2; ++i) { const int c = tid + 256 * i; crow[i] = c >> 3; cch[i] = c & 7; so[i] = crow[i] * 128 + ((cch[i] ^ ((crow[i] >> 1) & 7)) << 4); }
#define ATT_STAGE_F32(b, j) do { \
        unsigned char* kt_ = smem + (b) * 16384; unsigned char* vt_ = kt_ + 8192; \
        const float* kb_ = ((j) < U.ntc) ? U.Kc + (size_t)(64 * (j)) * U.ldf : U.Kn + (size_t)(64 * ((j) - U.ntc)) * U.ldf; \
        const float* vb_ = ((j) < U.ntc) ? U.Vc + (size_t)(64 * (j)) * U.ldf : U.Vn + (size_t)(64 * ((j) - U.ntc)) * U.ldf; \
        { f32x4 f_[2][2]; \
          _Pragma("unroll") for (int i = 0; i < 2; ++i) { const float* ks_ = kb_ + (size_t)crow[i] * U.ldf + cch[i] * 8; f_[i][0] = *(const f32x4*)ks_; f_[i][1] = *(const f32x4*)(ks_ + 4); } \
          _Pragma("unroll") for (int i = 0; i < 2; ++i) { h16x8 hk_; _Pragma("unroll") for (int e = 0; e < 4; ++e) { hk_[e] = (h16)f_[i][0][e]; hk_[4 + e] = (h16)f_[i][1][e]; } \
            *(h16x8*)(kt_ + so[i]) = hk_; } } \
        asm volatile("" ::: "memory"); \
        { f32x4 f_[2][2]; \
          _Pragma("unroll") for (int i = 0; i < 2; ++i) { const float* vs_ = vb_ + (size_t)crow[i] * U.ldf + cch[i] * 8; f_[i][0] = *(const f32x4*)vs_; f_[i][1] = *(const f32x4*)(vs_ + 4); } \
          _Pragma("unroll") for (int i = 0; i < 2; ++i) { const int key_ = crow[i]; \
            _Pragma("unroll") for (int e = 0; e < 8; ++e) { const int dv_ = 8 * cch[i] + e; \
                *(__bf16*)(vt_ + dv_ * 128 + (((key_ >> 3) ^ ((dv_ >> 1) & 7)) << 4) + (key_ & 7) * 2) = (__bf16)(e < 4 ? f_[i][0][e] : f_[i][1][e - 4]); } } } } while (0)
    const int drow0 = 16 * w + (lane >> 3), drow1 = drow0 + 8;
    const int dch0 = (lane & 7) ^ ((drow0 >> 1) & 7), dch1 = (lane & 7) ^ ((drow1 >> 1) & 7);
    const unsigned char* kbase = F32SRC ? nullptr : (const unsigned char*)U.Kh;
    const unsigned char* vbase = F32SRC ? nullptr : (const unsigned char*)U.VTh;
    const unsigned kof0 = (unsigned)(drow0 * U.ldk + dch0 * 8) * 2u, kof1 = (unsigned)(drow1 * U.ldk + dch1 * 8) * 2u;
    const size_t vof0 = ((size_t)drow0 * U.ldv + dch0 * 8) * 2, vof1 = ((size_t)drow1 * U.ldv + dch1 * 8) * 2;
    const int dmo0 = (16 * w) * 128, dmo1 = (16 * w + 8) * 128;
#define ATT_DMA(b, j) do { \
        const unsigned char* kt_ = kbase + (size_t)(64 * (j)) * U.ldk * 2; const unsigned char* vt_ = vbase + (size_t)(64 * (j)) * 2; \
        __builtin_amdgcn_global_load_lds((const unsigned*)(kt_ + kof0), (__attribute__((address_space(3))) unsigned*)(smem + (b) * 16384 + dmo0), 16, 0, 0); \
        __builtin_amdgcn_global_load_lds((const unsigned*)(vt_ + vof0), (__attribute__((address_space(3))) unsigned*)(smem + (b) * 16384 + 8192 + dmo0), 16, 0, 0); \
        __builtin_amdgcn_global_load_lds((const unsigned*)(kt_ + kof1), (__attribute__((address_space(3))) unsigned*)(smem + (b) * 16384 + dmo1), 16, 0, 0); \
        __builtin_amdgcn_global_load_lds((const unsigned*)(vt_ + vof1), (__attribute__((address_space(3))) unsigned*)(smem + (b) * 16384 + 8192 + dmo1), 16, 0, 0); } while (0)
    const unsigned* mq = (MODE == 0 && NQ == 2) ? U.mask + qb + lane : nullptr;
#define ATT_MASK_DMA(b, j) do { \
        __builtin_amdgcn_global_load_lds(mq + (size_t)(2 * (j)) * SEQ, (__attribute__((address_space(3))) unsigned*)(smem + ATT_MASK_OFF + (((b) * 4 + w) * 2) * 256), 4, 0, 0); \
        __builtin_amdgcn_global_load_lds(mq + (size_t)(2 * (j) + 1) * SEQ, (__attribute__((address_space(3))) unsigned*)(smem + ATT_MASK_OFF + (((b) * 4 + w) * 2 + 1) * 256), 4, 0, 0); } while (0)
    if constexpr (MODE == 0 && NQ == 2) { ATT_MASK_DMA(0, 0); }
    if constexpr (!F32SRC) { ATT_DMA(0, 0); } else { ATT_STAGE_F32(0, 0); }
    const unsigned* mrow[NQ];
    unsigned mwn[NQ][2];
#pragma unroll
    for (int nq = 0; nq < NQ; ++nq) {
        mrow[nq] = (MODE == 0 && NQ == 1) ? U.mask + (size_t)(qb + 32 * nq + l31) * U.ldm : nullptr;
        mwn[nq][0] = 0xffffffffu; mwn[nq][1] = 0xffffffffu;
        if (MODE == 0 && NQ == 1) { mwn[nq][0] = mrow[nq][0]; mwn[nq][1] = mrow[nq][1]; }
    }
    __syncthreads();
    const int pil = pi32(l31), ksw = (pil >> 1) & 7, vsw = (l31 >> 1) & 7;
    const int jlast = U.ntiles - 1;
    for (int j = 0; j < U.ntiles; ++j) {
        const int buf = j & 1;
        const int jn = j < jlast ? j + 1 : jlast;
        unsigned mw[NQ][2];
#pragma unroll
        for (int nq = 0; nq < NQ; ++nq) {
            if (NQ == 1) {
                mw[nq][0] = mwn[nq][0] >> (8 * hh); mw[nq][1] = mwn[nq][1] >> (8 * hh);
                if (MODE == 0) { mwn[nq][0] = mrow[nq][2 * jn]; mwn[nq][1] = mrow[nq][2 * jn + 1]; }
            } else {
                mw[nq][0] = 0xffffffffu; mw[nq][1] = 0xffffffffu;
                if (MODE == 0) {
                    const unsigned* ml = (const unsigned*)(smem + ATT_MASK_OFF + ((buf * 4 + w) * 2) * 256) + 32 * nq + l31;
                    mw[nq][0] = ml[0] >> (8 * hh); mw[nq][1] = ml[64] >> (8 * hh);
                }
            }
        }
        if constexpr (MODE == 0 && NQ == 2) { ATT_MASK_DMA(buf ^ 1, jn); }
        if constexpr (!F32SRC) ATT_DMA(buf ^ 1, jn);
        if (active && (MODE == 2 || j <= chunk_w)) {
            const unsigned char* Kt = smem + buf * 16384;
            const unsigned char* Vt = Kt + 8192;
            const bool near = (MODE != 2) && (j >= chunk_w - 2);
#pragma unroll
            for (int u = 0; u < 2; ++u) {
                const unsigned char* kp = Kt + (32 * u + pil) * 128;
                bf16x8 pf[NQ][2];
                h16x8 kf[NQF];
#pragma unroll
                for (int s = 0; s < NQF; ++s) { const int ch = (MODE == 1) ? (4 * cmap + 2 * s + hh) : (2 * s + hh); kf[s] = *(const h16x8*)(kp + ((ch ^ ksw) << 4)); }
#pragma unroll
                for (int nq = 0; nq < NQ; ++nq) {
                    f32x16 S;
#pragma unroll
                    for (int r = 0; r < 16; ++r) S[r] = 0.f;
#pragma unroll
                    for (int s = 0; s < NQF; ++s) S = __builtin_amdgcn_mfma_f32_32x32x16_f16(kf[s], qf[nq][s], S, 0, 0, 0);
                    if (near) {
                        const int base = 64 * j + 32 * u + 8 * hh - (U.qpos0 + qb + 32 * nq + l31) + 191;
#pragma unroll
                        for (int i = 0; i < 16; ++i) S[i] += tb[base + (i & 7) + 16 * (i >> 3)];
                    }
#pragma unroll
                    for (int i = 0; i < 16; ++i) S[i] = __builtin_amdgcn_exp2f(S[i]);
#pragma unroll
                    for (int s2 = 0; s2 < 2; ++s2) {
                        u32x4 pk;
                        u32x4 mk4 = {0xffffffffu, 0xffffffffu, 0xffffffffu, 0xffffffffu};
                        if (MODE == 0) mk4 = lut[(mw[nq][u] >> (16 * s2)) & 0xffu];
#pragma unroll
                        for (int e = 0; e < 4; ++e) {
                            unsigned v = pkbf(S[8 * s2 + 2 * e], S[8 * s2 + 2 * e + 1]);
                            if (MODE == 0) v &= mk4[e];
                            lsum[nq] = __builtin_amdgcn_fdot2_f32_bf16(__builtin_bit_cast(bf16x2, v), __builtin_bit_cast(bf16x2, 0x3f803f80u), lsum[nq], false);
                            pk[e] = v;
                        }
                        pf[nq][s2] = __builtin_bit_cast(bf16x8, pk);
                    }
                }
#pragma unroll
                for (int m = 0; m < 2; ++m)
#pragma unroll
                    for (int s2 = 0; s2 < 2; ++s2) {
                        const bf16x8 vfr = *(const bf16x8*)(Vt + (32 * m + l31) * 128 + (((2 * (2 * u + s2) + hh) ^ vsw) << 4));
#pragma unroll
                        for (int nq = 0; nq < NQ; ++nq) O[nq][m] = __builtin_amdgcn_mfma_f32_32x32x16_bf16(vfr, pf[nq][s2], O[nq][m], 0, 0, 0);
                    }
            }
        }
        if constexpr (F32SRC) { ATT_STAGE_F32(buf ^ 1, jn); }
        __syncthreads();
    }
#undef ATT_STAGE_F32
#undef ATT_DMA
#undef ATT_MASK_DMA
    float inv[NQ];
#pragma unroll
    for (int nq = 0; nq < NQ; ++nq) { const float l = lsum[nq] + __shfl_xor(lsum[nq], 32); inv[nq] = 1.0f / l; }
    if (MODE == 1) {
        float* X = (float*)smem;
        if (cmap == 1) {
#pragma unroll
            for (int nq = 0; nq < NQ; ++nq)
#pragma unroll
                for (int m = 0; m < 2; ++m)
#pragma unroll
                    for (int i = 0; i < 16; ++i) X[((wq * NQ + nq) * 32 + m * 16 + i) * 64 + lane] = O[nq][m][i] * inv[nq];
        }
        __syncthreads();
        if (cmap == 1) return;
#pragma unroll
        for (int nq = 0; nq < NQ; ++nq)
#pragma unroll
            for (int m = 0; m < 2; ++m)
#pragma unroll
                for (int i = 0; i < 16; ++i) O[nq][m][i] = O[nq][m][i] * inv[nq] - lam * X[((wq * NQ + nq) * 32 + m * 16 + i) * 64 + lane];
    } else {
        if (!active) return;
#pragma unroll
        for (int nq = 0; nq < NQ; ++nq)
#pragma unroll
            for (int m = 0; m < 2; ++m)
#pragma unroll
                for (int i = 0; i < 16; ++i) O[nq][m][i] *= inv[nq];
    }
    const int colbase = (MODE == 0 ? 0 : (MODE == 1 ? 512 : 768)) + U.head * 64;
#pragma unroll
    for (int nq = 0; nq < NQ; ++nq) {
        const int rowq = U.row0 + qb + 32 * nq + l31;
        const h16* G = (const h16*)(p.ws + WS_G) + (size_t)rowq * 1024 + colbase;
        h16* Oo = (h16*)(p.ws + WS_O16) + (size_t)rowq * 1024 + colbase;
        float sc = 1.f;
        if (MODE == 1) {
            float ss = 0.f;
#pragma unroll
            for (int m = 0; m < 2; ++m)
#pragma unroll
                for (int i = 0; i < 16; ++i) ss = fmaf(O[nq][m][i], O[nq][m][i], ss);
            ss += __shfl_xor(ss, 32);
            sc = (1.0f / sqrtf(ss * (1.0f / 64.0f) + EPS)) * 0.8f;
        }
#pragma unroll
        for (int m = 0; m < 2; ++m)
#pragma unroll
            for (int g4 = 0; g4 < 4; ++g4) {
                const int dv = 32 * m + 8 * g4 + 4 * hh;
                const h16x4 gv = *(const h16x4*)(G + dv);
                h16x4 o4;
#pragma unroll
                for (int e = 0; e < 4; ++e) {
                    float o = O[nq][m][4 * g4 + e];
                    if (MODE == 1) o = o * sc * p.in[18][dv + e];
                    o4[e] = (h16)(o * silu((float)gv[e]));
                }
                *(h16x4*)(Oo + dv) = o4;
            }
    }
}

__device__ __forceinline__ AttnUnit unit_zero() {
    AttnUnit U; U.row0 = 0; U.nrows = 0; U.ntiles = 0; U.qpos0 = 0; U.head = 0; U.Kh = nullptr; U.VTh = nullptr; U.ldk = 0; U.ldv = 0;
    U.Kc = nullptr; U.Vc = nullptr; U.Kn = nullptr; U.Vn = nullptr; U.ldf = 0; U.ntc = 0; U.mask = nullptr; U.ldm = 0; return U;
}
__device__ __forceinline__ void unit_a_prompt(const Params& p, unsigned char* smem, int g, int head) {
    AttnUnit U = unit_zero();
    U.row0 = 256 * g; U.nrows = 256; U.ntiles = 4 * g + 4; U.qpos0 = 256 * g; U.head = head;
    U.Kh = (const h16*)(p.ws + WS_KA_P) + head * 64; U.ldk = 512;
    U.VTh = (const h16*)(p.ws + WS_VTA_P) + (size_t)(head * 64) * SEQ; U.ldv = SEQ;
    U.mask = (const unsigned*)(p.ws + WS_MASK_P) + 256 * g; U.ldm = 0;
    attn_unit<0, false, 2>(p, smem, U, 0.f);
}
__device__ __forceinline__ void unit_b_prompt(const Params& p, unsigned char* smem, int g, int head, float lam) {
    AttnUnit U = unit_zero();
    U.row0 = 128 * g; U.nrows = 128; U.ntiles = 2 * g + 2; U.qpos0 = 128 * g; U.head = head;
    U.Kh = (const h16*)(p.ws + WS_KB_P) + head * 64; U.ldk = 256;
    U.VTh = (const h16*)(p.ws + WS_VTB_P) + (size_t)(head * 64) * SEQ; U.ldv = SEQ;
    attn_unit<1, false, 2>(p, smem, U, lam);
}
__device__ __forceinline__ void unit_a_sample(const Params& p, unsigned char* smem, int b, int head) {
    AttnUnit U = unit_zero();
    U.row0 = SEQ + 64 * b; U.nrows = 64; U.ntiles = 17; U.qpos0 = PAST; U.head = head;
    U.Kc = p.in[3] + (size_t)b * PAST * 512 + head * 64; U.Vc = p.in[4] + (size_t)b * PAST * 512 + head * 64;
    U.Kn = p.out + O_SAK + (size_t)b * DECS * 512 + head * 64; U.Vn = p.out + O_SAV + (size_t)b * DECS * 512 + head * 64;
    U.ldf = 512; U.ntc = 16;
    U.mask = (const unsigned*)(p.ws + WS_MASK_S) + (size_t)(64 * b) * 34; U.ldm = 34;
    attn_unit<0, true, 1>(p, smem, U, 0.f);
}
__device__ __forceinline__ void unit_b_sample(const Params& p, unsigned char* smem, int b, int head, float lam) {
    AttnUnit U = unit_zero();
    U.row0 = SEQ + 64 * b; U.nrows = 64; U.ntiles = 17; U.qpos0 = PAST; U.head = head;
    U.Kc = p.in[6] + (size_t)b * PAST * 256 + head * 64; U.Vc = p.in[7] + (size_t)b * PAST * 256 + head * 64;
    U.Kn = p.out + O_SBK + (size_t)b * DECS * 256 + head * 64; U.Vn = p.out + O_SBV + (size_t)b * DECS * 256 + head * 64;
    U.ldf = 256; U.ntc = 16;
    attn_unit<1, true, 1>(p, smem, U, lam);
}
__device__ __forceinline__ void unit_c_prompt(const Params& p, unsigned char* smem, int g, int head) {
    AttnUnit U = unit_zero();
    U.row0 = 128 * g; U.nrows = 128; U.ntiles = 4; U.head = head;
    U.Kh = (const h16*)(p.ws + WS_MK_P) + head * 64; U.ldk = 256;
    U.VTh = (const h16*)(p.ws + WS_MVT_P) + (size_t)(head * 64) * NMEM; U.ldv = NMEM;
    attn_unit<2, false, 1>(p, smem, U, 0.f);
}
__device__ __forceinline__ void unit_c_sample(const Params& p, unsigned char* smem, int b, int head) {
    AttnUnit U = unit_zero();
    U.row0 = SEQ + 64 * b; U.nrows = 64; U.ntiles = 4; U.head = head;
    U.Kc = p.in[8] + (size_t)b * NMEM * 256 + head * 64; U.Vc = p.in[9] + (size_t)b * NMEM * 256 + head * 64;
    U.Kn = U.Kc; U.Vn = U.Vc; U.ldf = 256; U.ntc = 4;
    attn_unit<2, true, 1>(p, smem, U, 0.f);
}

#define ZIGZAG_LOOP(NALL) for (int zk_ = 0, pos_ = 0; zk_ * (int)gridDim.x < (NALL); ++zk_) \
    if ((pos_ = (zk_ & 1) ? (zk_ + 1) * (int)gridDim.x - 1 - (int)blockIdx.x : zk_ * (int)gridDim.x + (int)blockIdx.x) < (NALL))

__device__ __forceinline__ float diff_lambda_of(const Params& p) {
    float s1 = 0.f, s2 = 0.f;
    for (int i = 0; i < 32; ++i) { s1 = fmaf(p.in[19][i], p.in[20][i], s1); s2 = fmaf(p.in[21][i], p.in[22][i], s2); }
    return expf(s1) - expf(s2) + 0.2f;
}

__device__ void phase2(const Params& p, unsigned char* smem) {
    const float lam = diff_lambda_of(p);
    constexpr int N_SP = 1024, N_BS = 128, N_CS = 128, N_SS = 128, N_CP = 512;
    constexpr int N_ALL = N_SP + N_BS + N_CS + N_SS + N_CP;
    ZIGZAG_LOOP(N_ALL) {
        int it = pos_;
        {
            const int ss = it - (N_SP + N_BS + N_CS);
            const int su = it < N_SP ? it : ((ss >= 0 && ss < N_SS) ? 1024 + ss : -1);
            if (su >= 0) { select_unit(p, smem, su); continue; }
        }
        it -= N_SP;
        if (it < N_BS) { unit_b_sample(p, smem, it >> 2, it & 3, lam); continue; }
        it -= N_BS;
        if (it < N_CS) { unit_c_sample(p, smem, it >> 2, it & 3); continue; }
        it -= N_CS + N_SS;
        unit_c_prompt(p, smem, it >> 2, it & 3);
    }
    {
        __syncthreads();
        const unsigned* fl = (const unsigned*)(p.ws + WS_REDO) + (size_t)blockIdx.x * REDO_LD;
        const unsigned n = __builtin_amdgcn_readfirstlane((int)__hip_atomic_load(fl, __ATOMIC_RELAXED, __HIP_MEMORY_SCOPE_AGENT));
        for (unsigned i = 0; i < n; ++i) {
            const int row = __builtin_amdgcn_readfirstlane((int)__hip_atomic_load(fl + 1 + i, __ATOMIC_RELAXED, __HIP_MEMORY_SCOPE_AGENT));
            select_item(p, smem, row);
        }
    }
}

__device__ void phase3(const Params& p, unsigned char* smem) {
    const float lam = diff_lambda_of(p);
    const int G = gridDim.x;
    for (int i0 = blockIdx.x; i0 < 512; i0 += G) {
        const int i = (G == 512 && i0 >= 256) ? 8 * (95 - (i0 >> 3)) + (i0 & 7) : i0;
        { const int g = 63 - (i >> 3), head = i & 7; unit_a_prompt(p, smem, g, head); }
        { const int r = 511 - i, g = 127 - (r >> 2), head = r & 3; unit_b_prompt(p, smem, g, head, lam); }
        if (i >= 256) { const int s = i - 256; unit_a_sample(p, smem, s >> 3, s & 7); }
    }
}

__device__ void phase4(const Params& p, unsigned char* smem) {
    const h16* O16 = (const h16*)(p.ws + WS_O16);
    const h16* WTOUT = (const h16*)(p.ws + WS_WTOUT);
    constexpr int NCT = D / 128, NRT = MROWS / 128;
    const EpiOut eo{};
    const int G = gridDim.x;
    if ((G & 7) == 0) {
        const int xcd = blockIdx.x & 7, local = blockIdx.x >> 3, LG = G >> 3;
        for (int lin = local; lin < (NRT / 8) * NCT; lin += LG) {
            const int rt = xcd + 8 * (lin / NCT), ct = lin % NCT;
            gemm_tile(p, O16, WTOUT, rt * 128, ct * 128, smem, eo);
        }
    } else {
        for (int it = blockIdx.x; it < NCT * NRT; it += gridDim.x) {
            const int rt = it / NCT, ct = it % NCT;
            gemm_tile(p, O16, WTOUT, rt * 128, ct * 128, smem, eo);
        }
    }
}

constexpr int SMEM_BYTES = 80 * 1024;

__device__ __forceinline__ void grid_barrier(unsigned* cnt, unsigned target) {
    asm volatile("s_waitcnt vmcnt(0)" ::: "memory");
    __syncthreads();
    if (threadIdx.x == 0) {
        __builtin_amdgcn_fence(__ATOMIC_RELEASE, "agent");
        asm volatile("s_waitcnt vmcnt(0)" ::: "memory");
        __hip_atomic_fetch_add(cnt, 1u, __ATOMIC_RELAXED, __HIP_MEMORY_SCOPE_AGENT);
        while (__hip_atomic_load(cnt, __ATOMIC_RELAXED, __HIP_MEMORY_SCOPE_AGENT) < target) __builtin_amdgcn_s_sleep(2);
        __builtin_amdgcn_fence(__ATOMIC_ACQUIRE, "agent");
        asm volatile("s_waitcnt vmcnt(0)" ::: "memory");
    }
    __syncthreads();
}

__global__ void __launch_bounds__(NT, 2) fwd_kernel(Params p) {
    __shared__ __attribute__((aligned(16))) unsigned char smem[SMEM_BYTES];
    static_assert(ATT_LDS <= SMEM_BYTES && sizeof(SmemDsa) <= SMEM_BYTES && sizeof(SelSm) <= SMEM_BYTES && CS_LD * 128 * 4 <= SMEM_BYTES, "smem");
    unsigned nbar = 0;
#define SEAM() grid_barrier((unsigned*)(p.ws + WS_CTL) + 48, ++nbar * gridDim.x)
    phase0(p, smem);
    if (p.ph_lo > 0) cg::this_grid().sync(); else SEAM();
    phase1(p, smem); SEAM();
    phase2(p, smem); SEAM();
    phase3(p, smem); SEAM();
    phase4(p, smem);
#undef SEAM
}

extern "C" void kernel_launch(void* const* d_in, const int* in_sizes, int n_in, void* d_out, int out_size, void* d_ws, size_t ws_size, hipStream_t stream) {
    static int grid_blocks = 0;
    if (!grid_blocks) {
        int dev = 0, cus = 0, per_cu = 0;
        (void)hipGetDevice(&dev);
        (void)hipDeviceGetAttribute(&cus, hipDeviceAttributeMultiprocessorCount, dev);
        (void)hipOccupancyMaxActiveBlocksPerMultiprocessor(&per_cu, fwd_kernel, NT, 0);
        if (per_cu < 1) per_cu = 1;
        if (per_cu > (160 * 1024) / SMEM_BYTES) per_cu = (160 * 1024) / SMEM_BYTES;
        grid_blocks = cus * per_cu;
        if (ws_size < WS_END) fprintf(stderr, "kernel_launch: workspace too small: %zu < %zu\n", ws_size, (size_t)WS_END);
    }
    if (ws_size < WS_END) return;
    (void)hipMemsetAsync((unsigned char*)d_ws + WS_CTL, 0, 256 + (size_t)2048 * REDO_LD * 4, stream);
    Params p{};
    for (int i = 0; i < 27; ++i) p.in[i] = (const float*)d_in[i];
    p.out = (float*)d_out; p.ws = (unsigned char*)d_ws;
    p.ph_lo = 0; p.ph_hi = 5;
    void* args[] = {&p};
    hipError_t e = hipLaunchCooperativeKernel((void*)fwd_kernel, dim3(grid_blocks), dim3(NT), args, 0, stream);
    if (e != hipSuccess) fprintf(stderr, "cooperative launch failed: %s (grid %d)\n", hipGetErrorString(e), grid_blocks);
}
```

```cpp
#include <hip/hip_runtime.h>
#include <hip/hip_cooperative_groups.h>
#include <cstdio>
#include <cstdint>
namespace cg = cooperative_groups;

#define NT 256

constexpr int D = 1024, SEQ = 16384, DECB = 32, DECS = 64, PAST = 1024, NMEM = 256;
constexpr int MROWS = SEQ + DECB * DECS;
constexpr int DIN = 3880;
constexpr int LDP = 264;
constexpr int PC_IQ = 0, PC_IW = 256;
constexpr float EPS = 1e-6f;

constexpr size_t O_YP = 0, O_YS = 16777216, O_PAK = 18874368, O_PAV = 27262976, O_PAKI = 35651584, O_PBK = 36175872,
                 O_PBV = 40370176, O_PMK = 44564480, O_PMV = 44630016, O_SAK = 44695552, O_SAV = 45744128,
                 O_SAKI = 46792704, O_SBK = 46858240, O_SBV = 47382528;

typedef _Float16 h16;
typedef h16 h16x2 __attribute__((ext_vector_type(2)));
typedef h16 h16x4 __attribute__((ext_vector_type(4)));
typedef h16 h16x8 __attribute__((ext_vector_type(8)));
typedef float f32x4 __attribute__((ext_vector_type(4)));
typedef unsigned u32x4 __attribute__((ext_vector_type(4)));
typedef __bf16 bf16x8 __attribute__((ext_vector_type(8)));
typedef __bf16 bf16x2 __attribute__((ext_vector_type(2)));
typedef float f32x2 __attribute__((ext_vector_type(2)));
__device__ __forceinline__ unsigned pkbf(float a, float b) { const f32x2 v = {a, b}; return __builtin_bit_cast(unsigned, __builtin_convertvector(v, bf16x2)); }
typedef float f32x16 __attribute__((ext_vector_type(16)));

constexpr int NPAD_IN = 3968;
constexpr float LOG2E = 1.4426950408889634f;
constexpr size_t WS_XH = 0;
constexpr size_t WS_O16 = WS_XH;
constexpr size_t WS_HMH = WS_XH + (size_t)MROWS * D * 2;
constexpr size_t WS_WTIN = WS_HMH + (size_t)NMEM * D * 2;
constexpr size_t WS_WTOUT = WS_WTIN + (size_t)NPAD_IN * D * 2;
constexpr size_t WS_WTMEM = WS_WTOUT + (size_t)D * D * 2;
constexpr size_t WS_QA = WS_WTMEM + (size_t)512 * D * 2;
constexpr size_t WS_QB = WS_QA + (size_t)MROWS * 512 * 2;
constexpr size_t WS_QC = WS_QB + (size_t)MROWS * 256 * 2;
constexpr size_t WS_G = WS_QC + (size_t)MROWS * 256 * 2;
constexpr size_t WS_KB_P = WS_G + (size_t)MROWS * 1024 * 2;
constexpr size_t WS_VTB_P = WS_KB_P + (size_t)SEQ * 256 * 2;
constexpr size_t WS_MK_P = WS_VTB_P + (size_t)SEQ * 256 * 2;
constexpr size_t WS_MVT_P = WS_MK_P + (size_t)NMEM * 256 * 2;
constexpr size_t WS_KA_P = WS_MVT_P + (size_t)NMEM * 256 * 2;
constexpr size_t WS_VTA_P = WS_KA_P + (size_t)SEQ * 512 * 2;
constexpr size_t WS_MASK_P = WS_VTA_P + (size_t)SEQ * 512 * 2;
constexpr size_t WS_MASK_S = WS_MASK_P + (size_t)SEQ * 512 * 4;
constexpr size_t WS_IQ16 = WS_MASK_S + (size_t)DECB * DECS * 34 * 4;
constexpr size_t WS_IK_P = WS_IQ16 + (size_t)MROWS * 256 * 2;
constexpr size_t WS_IK_S = WS_IK_P + (size_t)SEQ * 32 * 2;
constexpr size_t WS_CTL = WS_IK_S + (size_t)DECB * (PAST + DECS) * 32 * 2;
constexpr int REDO_LD = 64;
constexpr size_t WS_REDO = WS_CTL + 256;
constexpr size_t WS_P = WS_REDO + (size_t)2048 * REDO_LD * 4;
constexpr size_t WS_END = WS_P + (size_t)MROWS * LDP * 4;

struct Params {
    const float* in[27];
    float* out;
    unsigned char* ws;
    int ph_lo, ph_hi;
};

__device__ __forceinline__ float wave_sum(float v) {
#pragma unroll
    for (int o = 1; o < 64; o <<= 1) v += __shfl_xor(v, o);
    return v;
}
__device__ __forceinline__ float wave_max(float v) {
#pragma unroll
    for (int o = 1; o < 64; o <<= 1) v = fmaxf(v, __shfl_xor(v, o));
    return v;
}
__device__ __forceinline__ float silu(float x) { return x / (1.0f + expf(-x)); }

__device__ __forceinline__ int rel_bucket(int rel) {
    const int ret = rel > 0 ? 16 : 0;
    const int n = rel < 0 ? -rel : rel;
    int b;
    if (n < 8) b = n;
    else if (n < 12) b = 8;
    else if (n < 16) b = 9;
    else if (n < 23) b = 10;
    else if (n < 32) b = 11;
    else if (n < 46) b = 12;
    else if (n < 64) b = 13;
    else if (n < 91) b = 14;
    else b = 15;
    return ret + b;
}

__device__ __forceinline__ void rms_row_h(const float* x, const float* g, h16* o, int lane) {
    const float4* xr = (const float4*)x;
    const float4* gr = (const float4*)g;
    float4 v[4];
    float s = 0.f;
#pragma unroll
    for (int j = 0; j < 4; ++j) { v[j] = xr[lane + 64 * j]; s += v[j].x * v[j].x + v[j].y * v[j].y + v[j].z * v[j].z + v[j].w * v[j].w; }
    s = wave_sum(s);
    const float r = 1.0f / sqrtf(s * (1.0f / 1024.0f) + EPS);
#pragma unroll
    for (int j = 0; j < 4; ++j) {
        const float4 gg = gr[lane + 64 * j];
        h16x4 o4; o4.x = (h16)(v[j].x * r * gg.x); o4.y = (h16)(v[j].y * r * gg.y); o4.z = (h16)(v[j].z * r * gg.z); o4.w = (h16)(v[j].w * r * gg.w);
        ((h16x4*)o)[lane + 64 * j] = o4;
    }
}

__device__ __forceinline__ void transpose_item(const float* __restrict__ W, int ldw, int c0, int nvalid, int k0, h16* __restrict__ WT, int r0, float* scr, int lane) {
#pragma unroll 8
    for (int i = 0; i < 32; ++i) {
        const int kk = 2 * i + (lane >> 5), n = lane & 31;
        scr[kk * 33 + n] = (n < nvalid) ? W[(size_t)(k0 + kk) * ldw + c0 + n] : 0.f;
    }
    asm volatile("s_waitcnt lgkmcnt(0)" ::: "memory");
    const int c = lane & 7;
#pragma unroll
    for (int j = 0; j < 4; ++j) {
        const int n = (lane >> 3) + 8 * j;
        const float* s = scr + (8 * c) * 33 + n;
        h16x8 o;
#pragma unroll
        for (int e = 0; e < 8; ++e) o[e] = (h16)s[e * 33];
        *(h16x8*)(WT + (size_t)(r0 + n) * 1024 + k0 + 8 * c) = o;
    }
    asm volatile("s_waitcnt lgkmcnt(0)" ::: "memory");
}

__device__ __forceinline__ int inproj_col(int np) { return np < 2304 ? np : (np < 3840 ? np + 40 : np - 3840 + 2304); }

__device__ void phase0(const Params& p, unsigned char* smem) {
    int tid0 = threadIdx.x; asm volatile("" : "+v"(tid0));
    const int lane = tid0 & 63, w = tid0 >> 6;
    const int gw = blockIdx.x * 4 + w, ngw = gridDim.x * 4;
    h16* XH = (h16*)(p.ws + WS_XH);
    h16* HMH = (h16*)(p.ws + WS_HMH);
    h16* WTIN = (h16*)(p.ws + WS_WTIN);
    h16* WTOUT = (h16*)(p.ws + WS_WTOUT);
    h16* WTMEM = (h16*)(p.ws + WS_WTMEM);
    float* scr = (float*)smem + w * (64 * 33);
    constexpr int N_ROWS = MROWS + NMEM;
    constexpr int I_IN = 16 * (NPAD_IN / 32), I_OUT = 16 * 32, I_MEM = 16 * 16, I_KIDX = DECB * (PAST / 64);
    for (int it = gw; it < N_ROWS + I_IN + I_OUT + I_MEM + I_KIDX; it += ngw) {
        if (it < N_ROWS) {
            const int r = it;
            if (r < SEQ) rms_row_h(p.in[0] + (size_t)r * D, p.in[11], XH + (size_t)r * D, lane);
            else if (r < MROWS) rms_row_h(p.in[1] + (size_t)(r - SEQ) * D, p.in[11], XH + (size_t)r * D, lane);
            else rms_row_h(p.in[2] + (size_t)(r - MROWS) * D, p.in[25], HMH + (size_t)(r - MROWS) * D, lane);
        } else if (it < N_ROWS + I_IN) {
            const int r = it - N_ROWS, nb = r % (NPAD_IN / 32), kb = r / (NPAD_IN / 32);
            const int np0 = nb * 32;
            int nvalid = DIN - np0; nvalid = nvalid < 0 ? 0 : (nvalid > 32 ? 32 : nvalid);
            const int c0 = nvalid > 0 ? inproj_col(np0) : 0;
            transpose_item(p.in[12], DIN, c0, nvalid, kb * 64, WTIN, np0, scr, lane);
        } else if (it < N_ROWS + I_IN + I_OUT) {
            const int r = it - N_ROWS - I_IN, nb = r % 32, kb = r / 32;
            transpose_item(p.in[13], D, nb * 32, 32, kb * 64, WTOUT, nb * 32, scr, lane);
        } else if (it < N_ROWS + I_IN + I_OUT + I_MEM) {
            const int r = it - N_ROWS - I_IN - I_OUT, nb = r % 16, kb = r / 16;
            transpose_item(p.in[26], 512, nb * 32, 32, kb * 64, WTMEM, nb * 32, scr, lane);
        } else {
            const int r = it - N_ROWS - I_IN - I_OUT - I_MEM, b = r / (PAST / 64), key = (r % (PAST / 64)) * 64 + lane;
            const f32x4* src = (const f32x4*)(p.in[5] + ((size_t)b * PAST + key) * 32);
            h16* dst = (h16*)(p.ws + WS_IK_S) + ((size_t)b * (PAST + DECS) + key) * 32;
            float ss = 0.f;
#pragma unroll
            for (int c = 0; c < 4; ++c) {
                const f32x4 x0 = src[2 * c], x1 = src[2 * c + 1];
                h16x8 o;
#pragma unroll
                for (int e = 0; e < 4; ++e) { o[e] = (h16)x0[e]; o[4 + e] = (h16)x1[e]; ss = fmaf(x0[e], x0[e], ss); ss = fmaf(x1[e], x1[e], ss); }
                *(h16x8*)(dst + 8 * c) = o;
            }
            ss = wave_max(ss);
            if (lane == 0) atomicMax((unsigned*)(p.ws + WS_CTL) + 1 + b, __float_as_uint(ss));
        }
    }
}

constexpr int CS_LD = 132;
template <class Epi>
__device__ __forceinline__ void gemm_tile(const Params& p, const h16* __restrict__ A, const h16* __restrict__ Bt, int m0, int n0, unsigned char* smem, const Epi& epi) {
    int tid = threadIdx.x; asm volatile("" : "+v"(tid));
    const int lane = tid & 63, wid = tid >> 6, wm = wid >> 1, wn = wid & 1;
    const int l31 = lane & 31, hh = lane >> 5;
    f32x16 acc[2][2];
#pragma unroll
    for (int a = 0; a < 2; ++a)
#pragma unroll
        for (int b = 0; b < 2; ++b)
#pragma unroll
            for (int r = 0; r < 16; ++r) acc[a][b][r] = 0.f;
    const unsigned char* agl[4]; const unsigned char* bgl[4]; int ldo[4];
#pragma unroll
    for (int i = 0; i < 4; ++i) {
        const int row = 32 * wid + 8 * i + (lane >> 3), slot = lane & 7, ch = slot ^ ((row >> 1) & 7);
        agl[i] = (const unsigned char*)(A + (size_t)(m0 + row) * 1024 + ch * 8);
        bgl[i] = (const unsigned char*)(Bt + (size_t)(n0 + row) * 1024 + ch * 8);
        ldo[i] = (32 * wid + 8 * i) * 128;
    }
#define GT_DMA(stage_, kt_) do { const int ko_ = ((kt_) < 15 ? (kt_) : 15) * 128; \
        _Pragma("unroll") for (int i = 0; i < 4; ++i) { \
            __builtin_amdgcn_global_load_lds((const unsigned*)(agl[i] + ko_), (__attribute__((address_space(3))) unsigned*)(smem + (stage_) * 32768 + ldo[i]), 16, 0, 0); \
            __builtin_amdgcn_global_load_lds((const unsigned*)(bgl[i] + ko_), (__attribute__((address_space(3))) unsigned*)(smem + (stage_) * 32768 + 16384 + ldo[i]), 16, 0, 0); } } while (0)
    const int sw = (l31 >> 1) & 7;
    const int arow = (wm * 64 + l31) * 128, brow = (wn * 64 + l31) * 128;
    __syncthreads();
    GT_DMA(0, 0);
    __syncthreads();
    for (int kt = 0; kt < 16; ++kt) {
        const unsigned char* As = smem + (kt & 1) * 32768; const unsigned char* Bs = As + 16384;
        GT_DMA((kt + 1) & 1, kt + 1);
#pragma unroll
        for (int s = 0; s < 4; ++s) {
            const int co = (((2 * s + hh) ^ sw) << 4);
            h16x8 a[2], b[2];
#pragma unroll
            for (int mt = 0; mt < 2; ++mt) a[mt] = *(const h16x8*)(As + arow + mt * 32 * 128 + co);
#pragma unroll
            for (int nt = 0; nt < 2; ++nt) b[nt] = *(const h16x8*)(Bs + brow + nt * 32 * 128 + co);
#pragma unroll
            for (int mt = 0; mt < 2; ++mt)
#pragma unroll
                for (int nt = 0; nt < 2; ++nt) acc[mt][nt] = __builtin_amdgcn_mfma_f32_32x32x16_f16(a[mt], b[nt], acc[mt][nt], 0, 0, 0);
        }
        __syncthreads();
    }
#undef GT_DMA
    float* Cs = (float*)smem;
#pragma unroll
    for (int mt = 0; mt < 2; ++mt)
#pragma unroll
        for (int nt = 0; nt < 2; ++nt)
#pragma unroll
            for (int r = 0; r < 16; ++r) {
                const int row = wm * 64 + mt * 32 + (r & 3) + 8 * (r >> 2) + 4 * hh, col = wn * 64 + nt * 32 + l31;
                Cs[row * CS_LD + col] = acc[mt][nt][r];
            }
    __syncthreads();
    epi(p, Cs, m0, n0, tid);
}

__device__ __forceinline__ float group_sum16(float v) { v += __shfl_xor(v, 1); v += __shfl_xor(v, 2); v += __shfl_xor(v, 4); v += __shfl_xor(v, 8); return v; }
__device__ __forceinline__ float group_sum8(float v) { v += __shfl_xor(v, 1); v += __shfl_xor(v, 2); v += __shfl_xor(v, 4); return v; }

struct Seg {
    float* bp; float* bs; int ld; int col; int norm; const float* gain;
    h16* hp; h16* hs; int hld; int hcol; float hscale;
    int vt; int head;
};

__device__ __forceinline__ Seg seg_of(const Params& p, int n0) {
    float* P = (float*)(p.ws + WS_P);
    float* out = p.out;
    h16* QA = (h16*)(p.ws + WS_QA); h16* QB = (h16*)(p.ws + WS_QB); h16* QC = (h16*)(p.ws + WS_QC); h16* G = (h16*)(p.ws + WS_G);
    Seg s; s.norm = 0; s.gain = nullptr; s.hp = nullptr; s.hs = nullptr; s.hld = 0; s.hcol = 0; s.hscale = 1.f; s.vt = 0; s.head = 0;
    s.bp = nullptr; s.bs = nullptr; s.ld = 0; s.col = 0;
#define SEG_O(op, os, ldv, c) do { s.bp = out + (op); s.bs = out + (os) - (size_t)SEQ * (ldv); s.ld = (ldv); s.col = (c); } while (0)
#define SEG_H(ptr, ldv, c, sc) do { s.hp = (ptr); s.hs = (ptr); s.hld = (ldv); s.hcol = (c); s.hscale = (sc); } while (0)
    if (n0 < 512) { s.norm = 64; s.gain = p.in[14]; SEG_H(QA, 512, n0, 0.125f * LOG2E); }
    else if (n0 < 1024) { SEG_O(O_PAK, O_SAK, 512, n0 - 512); s.norm = 64; s.gain = p.in[15]; s.hp = (h16*)(p.ws + WS_KA_P); s.hs = nullptr; s.hld = 512; s.hcol = n0 - 512; }
    else if (n0 < 1536) { SEG_O(O_PAV, O_SAV, 512, n0 - 1024); s.vt = 1; s.head = (n0 - 1024) >> 6; }
    else if (n0 < 2048) { SEG_H(G, 1024, n0 - 1536, 1.f); }
    else if (n0 < 2304) { s.bp = P; s.bs = P; s.ld = LDP; s.col = PC_IQ + n0 - 2048; SEG_H((h16*)(p.ws + WS_IQ16), 256, n0 - 2048, 1.f); }
    else if (n0 < 2560) { s.norm = 32; s.gain = p.in[16]; SEG_H(QB, 256, n0 - 2304, 0.17677669529663687f * LOG2E); }
    else if (n0 < 2816) { SEG_O(O_PBK, O_SBK, 256, n0 - 2560); s.norm = 32; s.gain = p.in[17]; s.hp = (h16*)(p.ws + WS_KB_P); s.hs = nullptr; s.hld = 256; s.hcol = n0 - 2560; }
    else if (n0 < 3072) { SEG_O(O_PBV, O_SBV, 256, n0 - 2816); s.vt = 2; s.head = (n0 - 2816) >> 6; }
    else if (n0 < 3328) { SEG_H(G, 1024, 512 + n0 - 3072, 1.f); }
    else if (n0 < 3584) { s.norm = 64; s.gain = p.in[23]; SEG_H(QC, 256, n0 - 3328, 0.125f * LOG2E); }
    else { SEG_H(G, 1024, 768 + n0 - 3584, 1.f); }
#undef SEG_O
#undef SEG_H
    return s;
}

__device__ __forceinline__ void vt_store(const float* Cs, int j, h16* dst_base, size_t ldv, int tid) {
    const int dv = tid & 63, rq = tid >> 6;
    h16* dst = dst_base + (size_t)dv * ldv + 32 * rq;
#pragma unroll
    for (int e8 = 0; e8 < 4; ++e8) {
        u32x4 o;
#pragma unroll
        for (int e = 0; e < 4; ++e) o[e] = pkbf(Cs[(32 * rq + 8 * e8 + 2 * e) * CS_LD + 64 * j + dv], Cs[(32 * rq + 8 * e8 + 2 * e + 1) * CS_LD + 64 * j + dv]);
        *(u32x4*)(dst + 8 * e8) = o;
    }
}

struct EpiIn {
    __device__ __forceinline__ void operator()(const Params& p, const float* Cs, int m0, int n0, int tid) const {
        const int cg = tid & 15, r0 = tid >> 4;
#pragma unroll 1
        for (int j = 0; j < 2; ++j) {
            const int n0j = n0 + 64 * j;
            if (n0j >= DIN) continue;
            if (n0j == 3840) {
                float* P = (float*)(p.ws + WS_P);
                float mx0 = 0.f, mx1 = 0.f;
#pragma unroll 1
                for (int i = 0; i < 8; ++i) {
                    const int rl = r0 + 16 * i, row = m0 + rl;
                    const float4 v = *(const float4*)&Cs[rl * CS_LD + 4 * cg];
                    float ss = (cg < 8) ? (v.x * v.x + v.y * v.y + v.z * v.z + v.w * v.w) : 0.f;
                    ss = group_sum8(ss);
                    if (i < 4) mx0 = fmaxf(mx0, ss); else mx1 = fmaxf(mx1, ss);
                    if (cg < 8) {
                        float* dst = (row < SEQ ? p.out + O_PAKI + (size_t)row * 32 : p.out + O_SAKI + (size_t)(row - SEQ) * 32) + 4 * cg; *(float4*)dst = v;
                        h16x4 hv; hv.x = (h16)v.x; hv.y = (h16)v.y; hv.z = (h16)v.z; hv.w = (h16)v.w;
                        h16* hd = row < SEQ ? (h16*)(p.ws + WS_IK_P) + (size_t)row * 32 : (h16*)(p.ws + WS_IK_S) + ((size_t)((row - SEQ) >> 6) * (PAST + DECS) + PAST + ((row - SEQ) & 63)) * 32;
                        *(h16x4*)(hd + 4 * cg) = hv;
                    }
                    else if (cg < 10) { *(float4*)(P + (size_t)row * LDP + PC_IW + 4 * (cg - 8)) = v; }
                }
                if (cg == 0) {
                    unsigned* ctl = (unsigned*)(p.ws + WS_CTL);
                    if (m0 < SEQ) atomicMax(ctl, __float_as_uint(fmaxf(mx0, mx1)));
                    else { const int b0 = (m0 - SEQ) >> 6; atomicMax(ctl + 1 + b0, __float_as_uint(mx0)); atomicMax(ctl + 2 + b0, __float_as_uint(mx1)); }
                }
                continue;
            }
            const Seg s = seg_of(p, n0j);
            float4 g4 = make_float4(1.f, 1.f, 1.f, 1.f);
            if (s.norm == 64) g4 = *(const float4*)(s.gain + 4 * cg);
            else if (s.norm == 32) g4 = *(const float4*)(s.gain + ((4 * cg) & 31));
#pragma unroll 1
            for (int i = 0; i < 8; ++i) {
                const int rl = r0 + 16 * i, row = m0 + rl;
                float4 v = *(const float4*)&Cs[rl * CS_LD + 64 * j + 4 * cg];
                if (s.norm) {
                    float ss = v.x * v.x + v.y * v.y + v.z * v.z + v.w * v.w;
                    float sc;
                    if (s.norm == 64) { ss = group_sum16(ss); sc = 1.0f / sqrtf(ss * (1.0f / 64.0f) + EPS); }
                    else { ss = group_sum8(ss); sc = 1.0f / sqrtf(ss * (1.0f / 32.0f) + EPS); }
                    v.x *= sc * g4.x; v.y *= sc * g4.y; v.z *= sc * g4.z; v.w *= sc * g4.w;
                }
                if (s.bp) *(float4*)((row < SEQ ? s.bp : s.bs) + (size_t)row * s.ld + s.col + 4 * cg) = v;
                h16* hb = row < SEQ ? s.hp : s.hs;
                if (hb) {
                    h16x4 hv; hv.x = (h16)(v.x * s.hscale); hv.y = (h16)(v.y * s.hscale); hv.z = (h16)(v.z * s.hscale); hv.w = (h16)(v.w * s.hscale);
                    *(h16x4*)(hb + (size_t)row * s.hld + s.hcol + 4 * cg) = hv;
                }
            }
            if (s.vt == 2 && m0 < SEQ) vt_store(Cs, j, (h16*)(p.ws + WS_VTB_P) + (size_t)(s.head * 64) * SEQ + m0, SEQ, tid);
            if (s.vt == 1 && m0 < SEQ) vt_store(Cs, j, (h16*)(p.ws + WS_VTA_P) + (size_t)(s.head * 64) * SEQ + m0, SEQ, tid);
        }
    }
};

struct EpiMem {
    __device__ __forceinline__ void operator()(const Params& p, const float* Cs, int m0, int n0, int tid) const {
        const int cg = tid & 15, r0 = tid >> 4;
#pragma unroll 1
        for (int j = 0; j < 2; ++j) {
            const int n0j = n0 + 64 * j;
            const bool isk = n0j < 256;
            const float4 g4 = isk ? *(const float4*)(p.in[24] + 4 * cg) : make_float4(1.f, 1.f, 1.f, 1.f);
#pragma unroll 1
            for (int i = 0; i < 8; ++i) {
                const int rl = r0 + 16 * i, row = m0 + rl;
                float4 v = *(const float4*)&Cs[rl * CS_LD + 64 * j + 4 * cg];
                if (isk) {
                    float ss = group_sum16(v.x * v.x + v.y * v.y + v.z * v.z + v.w * v.w);
                    const float sc = 1.0f / sqrtf(ss * (1.0f / 64.0f) + EPS);
                    v.x *= sc * g4.x; v.y *= sc * g4.y; v.z *= sc * g4.z; v.w *= sc * g4.w;
                    h16x4 hv; hv.x = (h16)v.x; hv.y = (h16)v.y; hv.z = (h16)v.z; hv.w = (h16)v.w;
                    *(h16x4*)((h16*)(p.ws + WS_MK_P) + (size_t)row * 256 + n0j + 4 * cg) = hv;
                }
                float* dst = p.out + (isk ? O_PMK : O_PMV) + (size_t)row * 256 + (isk ? n0j : n0j - 256) + 4 * cg;
                *(float4*)dst = v;
            }
            if (!isk) vt_store(Cs, j, (h16*)(p.ws + WS_MVT_P) + (size_t)(((n0j - 256) >> 6) * 64) * NMEM + m0, NMEM, tid);
        }
    }
};

struct EpiOut {
    __device__ __forceinline__ void operator()(const Params& p, const float* Cs, int m0, int n0, int tid) const {
        const int cg = tid & 15, r0 = tid >> 4;
#pragma unroll 1
        for (int i = 0; i < 8; ++i) {
            const int rl = r0 + 16 * i, row = m0 + rl;
            const float* x = (row < SEQ ? p.in[0] + (size_t)row * D : p.in[1] + (size_t)(row - SEQ) * D) + n0 + 4 * cg;
            float* y = (row < SEQ ? p.out + O_YP + (size_t)row * D : p.out + O_YS + (size_t)(row - SEQ) * D) + n0 + 4 * cg;
#pragma unroll
            for (int j = 0; j < 2; ++j) {
                const float4 v = *(const float4*)&Cs[rl * CS_LD + 64 * j + 4 * cg];
                const float4 xv = *(const float4*)(x + 64 * j);
                *(float4*)(y + 64 * j) = make_float4(xv.x + v.x, xv.y + v.y, xv.z + v.z, xv.w + v.w);
            }
        }
    }
};

__device__ void phase1(const Params& p, unsigned char* smem) {
    const h16* XH = (const h16*)(p.ws + WS_XH);
    const h16* HMH = (const h16*)(p.ws + WS_HMH);
    const h16* WTIN = (const h16*)(p.ws + WS_WTIN);
    const h16* WTMEM = (const h16*)(p.ws + WS_WTMEM);
    const EpiIn ein{}; const EpiMem emem{};
    const int G = gridDim.x;
    if ((G & 7) == 0) {
        const int xcd = blockIdx.x & 7, local = blockIdx.x >> 3, LG = G >> 3;
        for (int lin = local; lin < 6 * 96; lin += LG) {
            const int rgroup = lin / 96, rem = lin % 96, chalf = rem / 48, rem2 = rem % 48, r = rem2 >> 4, c = chalf * 16 + (rem2 & 15);
            if (c >= 31) continue;
            const int rt = xcd + 8 * (rgroup * 3 + r);
            gemm_tile(p, XH, WTIN, rt * 128, c * 128, smem, ein);
        }
        if (blockIdx.x < 8) { const int rt = blockIdx.x / 4, ct = blockIdx.x % 4; gemm_tile(p, HMH, WTMEM, rt * 128, ct * 128, smem, emem); }
    } else {
        constexpr int NCT = NPAD_IN / 128, NRT = MROWS / 128;
        constexpr int N_IN = NCT * NRT, N_MEM = 2 * 4;
        for (int it = blockIdx.x; it < N_IN + N_MEM; it += gridDim.x) {
            if (it < N_IN) { const int rt = it / NCT, ct = it % NCT; gemm_tile(p, XH, WTIN, rt * 128, ct * 128, smem, ein); }
            else { const int im = it - N_IN, rt = im / 4, ct = im % 4; gemm_tile(p, HMH, WTMEM, rt * 128, ct * 128, smem, emem); }
        }
    }
}

struct KeySrc {
    const float* cache; const float* fresh; int past; int ld;
    __device__ __forceinline__ const float* row(int k) const { return k < past ? cache + (size_t)k * ld : fresh + (size_t)(k - past) * ld; }
};

__device__ __forceinline__ unsigned fkey(float f) { const unsigned u = __float_as_uint(f); return (u & 0x80000000u) ? ~u : (u | 0x80000000u); }

struct SmemDsa {
    float sc[16384];
    float iq[256]; float iw[8];
    unsigned hist[256]; unsigned mw[512];
    int wcnt[4]; int wcnt2[4]; int misc[4];
};

__device__ void select_item(const Params& p, unsigned char* smem, int item) {
    SmemDsa& S = *(SmemDsa*)smem;
    int tid = threadIdx.x; asm volatile("" : "+v"(tid));
    const int lane = tid & 63, w = tid >> 6;
    const float* P = (const float*)(p.ws + WS_P);
    int row, N, mst; KeySrc ki; unsigned* mout;
    if (item < SEQ) {
        row = item; N = 64 * (item / 64 + 1);
        ki = KeySrc{nullptr, p.out + O_PAKI, 0, 32};
        mout = (unsigned*)(p.ws + WS_MASK_P) + item; mst = SEQ;
    } else {
        const int bt = item - SEQ, b = bt / DECS;
        row = item; N = PAST + DECS;
        ki = KeySrc{p.in[5] + (size_t)b * PAST * 32, p.out + O_SAKI + (size_t)b * DECS * 32, PAST, 32};
        mout = (unsigned*)(p.ws + WS_MASK_S) + (size_t)bt * 34; mst = 1;
    }
    const int nw = N / 32;
    __syncthreads();
    if (N <= 256) {
        if (tid < nw) mout[(size_t)tid * mst] = 0xffffffffu;
        return;
    }
    S.iq[tid] = P[(size_t)row * LDP + PC_IQ + tid];
    if (tid < 8) S.iw[tid] = P[(size_t)row * LDP + PC_IW + tid];
    S.mw[tid] = 0u; S.mw[tid + 256] = 0u;
    __syncthreads();
    for (int k = tid; k < N; k += NT) {
        const float4* kr = (const float4*)ki.row(k);
        float kd[32];
#pragma unroll
        for (int i = 0; i < 8; ++i) { const float4 t4 = kr[i]; kd[4 * i] = t4.x; kd[4 * i + 1] = t4.y; kd[4 * i + 2] = t4.z; kd[4 * i + 3] = t4.w; }
        float score = 0.f;
#pragma unroll 1
        for (int h = 0; h < 8; ++h) {
            float d = 0.f;
#pragma unroll
            for (int i = 0; i < 32; ++i) d = fmaf(S.iq[h * 32 + i], kd[i], d);
            score = fmaf(S.iw[h], fmaxf(d, 0.f), score);
        }
        S.sc[k] = score;
    }
    __syncthreads();
    unsigned prefix = 0; int remaining = 256;
    for (int pass = 0; pass < 4; ++pass) {
        const int shift = 24 - 8 * pass;
        S.hist[tid] = 0;
        __syncthreads();
        for (int k = tid; k < N; k += NT) {
            const unsigned key = fkey(S.sc[k]);
            if (pass == 0 || (key >> (shift + 8)) == prefix) atomicAdd(&S.hist[(key >> shift) & 255u], 1u);
        }
        __syncthreads();
        const int hv = (int)S.hist[tid];
        int x = hv;
#pragma unroll
        for (int o = 1; o < 64; o <<= 1) { const int y = __shfl_down(x, o); if (lane + o < 64) x += y; }
        if (lane == 0) S.wcnt[w] = x;
        __syncthreads();
        int above = x - hv;
        for (int w2 = w + 1; w2 < 4; ++w2) above += S.wcnt[w2];
        if (above < remaining && remaining <= above + hv) { S.misc[0] = (int)((prefix << 8) | (unsigned)tid); S.misc[1] = remaining - above; }
        __syncthreads();
        prefix = (unsigned)S.misc[0]; remaining = S.misc[1];
        __syncthreads();
    }
    const unsigned T = prefix; const int r = remaining;
    int base_eq = 0;
    const unsigned long long lt = (lane == 0) ? 0ull : (~0ull >> (64 - lane));
    for (int k0 = 0; k0 < N; k0 += NT) {
        const int k = k0 + tid;
        const unsigned key = (k < N) ? fkey(S.sc[k]) : 0u;
        const bool gt = (k < N) && key > T, eq = (k < N) && key == T;
        const unsigned long long beq = __ballot(eq);
        const int eqpre = __popcll(beq & lt);
        if (lane == 0) S.wcnt[w] = __popcll(beq);
        __syncthreads();
        int eqbase = base_eq, eqtot = 0;
        for (int w2 = 0; w2 < 4; ++w2) { const int c = S.wcnt[w2]; if (w2 < w) eqbase += c; eqtot += c; }
        const bool sel = gt || (eq && (eqbase + eqpre) < r);
        const unsigned long long bs = __ballot(sel);
        if (lane == 0) S.mw[(k0 >> 5) + 2 * w] = (unsigned)bs;
        if (lane == 32) S.mw[(k0 >> 5) + 2 * w + 1] = (unsigned)(bs >> 32);
        base_eq += eqtot;
        __syncthreads();
    }
    for (int i = tid; i < nw; i += NT) mout[(size_t)i * mst] = S.mw[i];
}

typedef float f32x4m __attribute__((ext_vector_type(4)));
constexpr int CAND_CAP = 120;
struct SelSm {
    unsigned hist[16][1025];
    float cand_s[16][CAND_CAP]; int cand_k[16][CAND_CAP];
    int cnt[16]; int bstar[16]; int nabove[16]; int ovf[16];
};

__device__ __forceinline__ void score_tile(const h16x8& a, const h16x8 (&bq)[8], const float (&wq)[8], float (&sc)[4]) {
    sc[0] = 0.f; sc[1] = 0.f; sc[2] = 0.f; sc[3] = 0.f;
#pragma unroll
    for (int h = 0; h < 8; ++h) {
        f32x4m z = {0.f, 0.f, 0.f, 0.f};
        const f32x4m d = __builtin_amdgcn_mfma_f32_16x16x32_f16(a, bq[h], z, 0, 0, 0);
#pragma unroll
        for (int i = 0; i < 4; ++i) { const int bits = (int)__float_as_uint(d[i]); sc[i] = fmaf(wq[h], __uint_as_float((unsigned)(bits > 0 ? bits : 0)), sc[i]); }
    }
}

__device__ __forceinline__ int bin_of(float sc, float inv, float off) {
    const int b = min(max((int)fmaf(sc, inv, off), 0), 1021);
    int sgn;
    asm("v_med3_i32 %0, %1, -1, 1" : "=v"(sgn) : "v"(sc));
    return b + sgn + 1;
}

__device__ __forceinline__ void select_unit(const Params& p, unsigned char* smem, int u) {
    SelSm& S = *(SelSm*)smem;
    int tid = threadIdx.x; asm volatile("" : "+v"(tid));
    const int lane = tid & 63, w = __builtin_amdgcn_readfirstlane(tid >> 6), q = lane & 15, g = lane >> 4;
    int row0, N, ldm, ldw, kslot; const h16* IK; unsigned* mask;
    if (u < 1024) {
        const int q0 = 16 * (1023 - u);
        row0 = q0; N = 64 * (q0 / 64 + 1); IK = (const h16*)(p.ws + WS_IK_P); mask = (unsigned*)(p.ws + WS_MASK_P) + q0; ldm = 1; ldw = SEQ; kslot = 0;
    } else {
        const int bu = u - 1024, b = bu >> 2, t0 = 16 * (bu & 3);
        row0 = SEQ + 64 * b + t0; N = PAST + DECS; IK = (const h16*)(p.ws + WS_IK_S) + (size_t)b * (PAST + DECS) * 32;
        mask = (unsigned*)(p.ws + WS_MASK_S) + (size_t)(64 * b + t0) * 34; ldm = 34; ldw = 1; kslot = 1 + b;
    }
    const int nw = N / 32;
    __syncthreads();
    if (N <= 256) {
        for (int i = tid; i < 16 * nw; i += NT) mask[(size_t)(i & 15) * ldm + (size_t)(i >> 4) * ldw] = 0xffffffffu;
        return;
    }
    for (int i = tid; i < 16 * 1025; i += NT) ((unsigned*)S.hist)[i] = 0u;
    if (tid < 16) { S.cnt[tid] = 0; S.ovf[tid] = 0; S.bstar[tid] = 0; S.nabove[tid] = 0; }
    const int rowq = row0 + q;
    const h16* IQ = (const h16*)(p.ws + WS_IQ16) + (size_t)rowq * 256 + 8 * g;
    const float* Pf = (const float*)(p.ws + WS_P) + (size_t)rowq * LDP + PC_IW;
    h16x8 bq[8]; float wq[8];
    float hi = 0.f, lo = 0.f;
#pragma unroll
    for (int h = 0; h < 8; ++h) {
        bq[h] = *(const h16x8*)(IQ + h * 32);
        wq[h] = Pf[h];
        float n2 = 0.f;
#pragma unroll
        for (int e = 0; e < 8; ++e) { const float x = (float)bq[h][e]; n2 = fmaf(x, x, n2); }
        n2 += __shfl_xor(n2, 16); n2 += __shfl_xor(n2, 32);
        const float t = wq[h] * sqrtf(n2);
        if (t > 0.f) hi += t; else lo += t;
    }
    const float kmax = sqrtf(__uint_as_float(((const unsigned*)(p.ws + WS_CTL))[kslot])) * 1.01f;
    hi = hi * kmax + 1e-6f; lo = lo * kmax - 1e-6f;
    const float inv = 1022.0f / fmaxf(hi - lo, 1e-20f), off = -lo * inv;
    __syncthreads();
    const h16* ikp = IK + (size_t)q * 32 + 8 * g;
    const int ngw = (nw - w + 3) >> 2;
#define SEL_LD(dst0, dst1, it_) do { const int gi_ = w + 4 * ((it_) < ngw ? (it_) : ngw - 1); \
        dst0 = *(const h16x8*)(ikp + (size_t)(32 * gi_) * 32); dst1 = *(const h16x8*)(ikp + (size_t)(32 * gi_ + 16) * 32); } while (0)
#define SEL_GROUP_A(x0, x1) do { _Pragma("unroll") for (int t = 0; t < 2; ++t) { \
            float sc[4]; score_tile(t == 0 ? x0 : x1, bq, wq, sc); \
            _Pragma("unroll") for (int i = 0; i < 4; ++i) { const int b = bin_of(sc[i], inv, off); atomicAdd(&S.hist[q][b], 1u); } } } while (0)
    {
        h16x8 a0, a1, b0, b1, c0, c1;
        SEL_LD(a0, a1, 0); SEL_LD(b0, b1, 1); SEL_LD(c0, c1, 2);
        asm volatile("" ::: "memory");
        for (int it = 0; it < ngw; it += 3) {
            SEL_GROUP_A(a0, a1);
            asm volatile("" ::: "memory"); SEL_LD(a0, a1, it + 3); asm volatile("" ::: "memory");
            if (it + 1 < ngw) SEL_GROUP_A(b0, b1);
            asm volatile("" ::: "memory"); SEL_LD(b0, b1, it + 4); asm volatile("" ::: "memory");
            if (it + 2 < ngw) SEL_GROUP_A(c0, c1);
            asm volatile("" ::: "memory"); SEL_LD(c0, c1, it + 5); asm volatile("" ::: "memory");
        }
    }
#undef SEL_GROUP_A
    __syncthreads();
    for (int qq = 0; qq < 4; ++qq) {
        const int qi = 4 * w + qq;
        unsigned c = 0;
#pragma unroll
        for (int e = 0; e < 16; ++e) c += S.hist[qi][16 * lane + e];
        int x = (int)c;
#pragma unroll
        for (int o = 1; o < 64; o <<= 1) { const int y = __shfl_down(x, o); if (lane + o < 64) x += y; }
        const int above = x - (int)c;
        if (above < 256 && 256 <= above + (int)c) {
            int acc = above, bs = 16 * lane;
            for (int e = 15; e >= 0; --e) {
                const int v = (int)S.hist[qi][16 * lane + e];
                if (acc + v >= 256) { bs = 16 * lane + e; break; }
                acc += v;
            }
            S.bstar[qi] = bs; S.nabove[qi] = acc;
        }
    }
    __syncthreads();
    const int bst = S.bstar[q];
    unsigned* mrow = (unsigned*)S.hist;
    {
        h16x8 a0, a1, b0, b1, c0, c1;
        SEL_LD(a0, a1, 0); SEL_LD(b0, b1, 1); SEL_LD(c0, c1, 2);
        asm volatile("" ::: "memory");
        for (int it = 0; it < ngw; it += 3) {
#pragma unroll
          for (int gg = 0; gg < 3; ++gg) {
           if (gg == 0 || it + gg < ngw) {
            const int grp = w + 4 * (it + gg);
            unsigned word = 0u;
#pragma unroll
            for (int t = 0; t < 2; ++t) {
                const int k0 = 32 * grp + 16 * t;
                float sc[4]; score_tile(gg == 0 ? (t == 0 ? a0 : a1) : gg == 1 ? (t == 0 ? b0 : b1) : (t == 0 ? c0 : c1), bq, wq, sc);
                unsigned nib = 0u;
#pragma unroll
                for (int i = 0; i < 4; ++i) {
                    const int b = bin_of(sc[i], inv, off);
                    if (b > bst) nib |= 1u << i;
                    else if (b == bst) {
                        const int pos = atomicAdd(&S.cnt[q], 1);
                        if (pos < CAND_CAP) { S.cand_s[q][pos] = sc[i]; S.cand_k[q][pos] = k0 + 4 * g + i; }
                    }
                }
                unsigned v = nib << (4 * g);
                v |= (unsigned)__shfl_xor((int)v, 16); v |= (unsigned)__shfl_xor((int)v, 32);
                word |= v << (16 * t);
            }
            if (g == 0) mrow[q * 512 + grp] = word;
           }
            asm volatile("" ::: "memory");
            if (gg == 0) SEL_LD(a0, a1, it + 3); else if (gg == 1) SEL_LD(b0, b1, it + 4); else SEL_LD(c0, c1, it + 5);
            asm volatile("" ::: "memory");
          }
        }
    }
#undef SEL_LD
    __syncthreads();
    for (int qq = 0; qq < 4; ++qq) {
        const int qi = 4 * w + qq;
        const int m = S.cnt[qi], r = 256 - S.nabove[qi];
        if (m > CAND_CAP) { if (lane == 0) S.ovf[qi] = 1; continue; }
        const int nparts = m > 64 ? 2 : 1;
        for (int part = 0; part < nparts; ++part) {
            const int me = lane + 64 * part;
            const float s_me = me < m ? S.cand_s[qi][me] : 0.f;
            const int k_me = me < m ? S.cand_k[qi][me] : 0;
            int rank = 0;
#pragma unroll 4
            for (int j = 0; j < m; ++j) { const float sj = S.cand_s[qi][j]; const int kj = S.cand_k[qi][j]; rank += (sj > s_me || (sj == s_me && kj < k_me)) ? 1 : 0; }
            if (me < m && rank < r) atomicOr(&mrow[qi * 512 + (k_me >> 5)], 1u << (k_me & 31));
        }
    }
    __syncthreads();
    for (int i = tid; i < 16 * nw; i += NT) { const int qi = i & 15, wd = i >> 4; mask[(size_t)qi * ldm + (size_t)wd * ldw] = mrow[qi * 512 + wd]; }
    __syncthreads();
    if (tid == 0) {
        unsigned* fl = (unsigned*)(p.ws + WS_REDO) + (size_t)blockIdx.x * REDO_LD;
        unsigned n = fl[0];
        for (int qi = 0; qi < 16; ++qi) if (S.ovf[qi] && n + 1 < (unsigned)REDO_LD) { fl[1 + n] = (unsigned)(row0 + qi); ++n; }
        fl[0] = n;
    }
}

constexpr int ATT_TB_OFF = 32768;
constexpr int ATT_MASK_OFF = ATT_TB_OFF + 1024 + 16;
constexpr int ATT_LUT_OFF = ATT_MASK_OFF + 4096;
constexpr int ATT_LDS = ATT_LUT_OFF + 4096;

__device__ __forceinline__ int pi32(int r) { return (r & 0x13) | ((r & 4) << 1) | ((r & 8) >> 1); }
__device__ __forceinline__ unsigned pkrtz(float a, float b) { return __builtin_bit_cast(unsigned, __builtin_amdgcn_cvt_pkrtz(a, b)); }

struct AttnUnit {
    int row0, nrows, ntiles, qpos0, head;
    const h16* Kh; const h16* VTh; int ldk; int ldv;
    const float* Kc; const float* Vc; const float* Kn; const float* Vn; int ldf; int ntc;
    const unsigned* mask; int ldm;
};

template <int MODE, bool F32SRC, int NQ>
__device__ __forceinline__ void attn_unit(const Params& p, unsigned char* smem, const AttnUnit& U, float lam) {
    int tid = threadIdx.x; asm volatile("" : "+v"(tid));
    const int lane = tid & 63, w = __builtin_amdgcn_readfirstlane(tid >> 6), l31 = lane & 31, hh = lane >> 5;
    const int wq = (MODE == 1) ? (w & 1) : w, cmap = (MODE == 1) ? (w >> 1) : 0;
    const int qb = wq * 32 * NQ;
    const bool active = qb < U.nrows;
    const int chunk_w = (U.qpos0 + qb) >> 6;
    float* tb = (float*)(smem + ATT_TB_OFF);
    __syncthreads();
    if (MODE != 2) {
        if (tid < 255) { const int hc = (MODE == 0 ? U.head : 8 + U.head); tb[tid] = (p.in[10][rel_bucket(tid - 191) * 12 + hc] - p.in[10][15 * 12 + hc]) * LOG2E; }
    }
    if (MODE == 0) {
        u32x4 e4;
#pragma unroll
        for (int e = 0; e < 4; ++e) { const int t2 = (tid >> (2 * e)) & 3; e4[e] = ((t2 & 1) ? 0x0000ffffu : 0u) | ((t2 & 2) ? 0xffff0000u : 0u); }
        ((u32x4*)(smem + ATT_LUT_OFF))[tid] = e4;
    }
    constexpr int NQF = (MODE == 1) ? 2 : 4;
    h16x8 qf[NQ][NQF];
#pragma unroll
    for (int nq = 0; nq < NQ; ++nq) {
        if (active) {
            const int rowq = U.row0 + qb + 32 * nq + l31;
            const h16* Qb = (MODE == 0) ? (const h16*)(p.ws + WS_QA) + (size_t)rowq * 512 + U.head * 64
                          : (MODE == 1) ? (const h16*)(p.ws + WS_QB) + (size_t)rowq * 256 + U.head * 64 + 32 * cmap
                                        : (const h16*)(p.ws + WS_QC) + (size_t)rowq * 256 + U.head * 64;
#pragma unroll
            for (int s = 0; s < NQF; ++s) qf[nq][s] = *(const h16x8*)(Qb + 16 * s + 8 * hh);
        } else {
#pragma unroll
            for (int s = 0; s < NQF; ++s)
#pragma unroll
                for (int e = 0; e < 8; ++e) qf[nq][s][e] = (h16)0.f;
        }
    }
    f32x16 O[NQ][2];
    float lsum[NQ];
    const u32x4* lut = (const u32x4*)(smem + ATT_LUT_OFF);
#pragma unroll
    for (int nq = 0; nq < NQ; ++nq) {
        lsum[nq] = 0.f;
#pragma unroll
        for (int m = 0; m < 2; ++m)
#pragma unroll
            for (int r = 0; r < 16; ++r) O[nq][m][r] = 0.f;
    }
    int crow[2], cch[2], so[2];
#pragma unroll
    for (int i = 0; i < 2; ++i) { const int c = tid + 256 * i; crow[i] = c >> 3; cch[i] = c & 7; so[i] = crow[i] * 128 + ((cch[i] ^ ((crow[i] >> 1) & 7)) << 4); }
#define ATT_STAGE_F32(b, j) do { \
        unsigned char* kt_ = smem + (b) * 16384; unsigned char* vt_ = kt_ + 8192; \
        const float* kb_ = ((j) < U.ntc) ? U.Kc + (size_t)(64 * (j)) * U.ldf : U.Kn + (size_t)(64 * ((j) - U.ntc)) * U.ldf; \
        const float* vb_ = ((j) < U.ntc) ? U.Vc + (size_t)(64 * (j)) * U.ldf : U.Vn + (size_t)(64 * ((j) - U.ntc)) * U.ldf; \
        { f32x4 f_[2][2]; \
          _Pragma("unroll") for (int i = 0; i < 2; ++i) { const float* ks_ = kb_ + (size_t)crow[i] * U.ldf + cch[i] * 8; f_[i][0] = *(const f32x4*)ks_; f_[i][1] = *(const f32x4*)(ks_ + 4); } \
          _Pragma("unroll") for (int i = 0; i < 2; ++i) { h16x8 hk_; _Pragma("unroll") for (int e = 0; e < 4; ++e) { hk_[e] = (h16)f_[i][0][e]; hk_[4 + e] = (h16)f_[i][1][e]; } \
            *(h16x8*)(kt_ + so[i]) = hk_; } } \
        asm volatile("" ::: "memory"); \
        { f32x4 f_[2][2]; \
          _Pragma("unroll") for (int i = 0; i < 2; ++i) { const float* vs_ = vb_ + (size_t)crow[i] * U.ldf + cch[i] * 8; f_[i][0] = *(const f32x4*)vs_; f_[i][1] = *(const f32x4*)(vs_ + 4); } \
          _Pragma("unroll") for (int i = 0; i < 2; ++i) { const int key_ = crow[i]; \
            _Pragma("unroll") for (int e = 0; e < 8; ++e) { const int dv_ = 8 * cch[i] + e; \
                *(__bf16*)(vt_ + dv_ * 128 + (((key_ >> 3) ^ ((dv_ >> 1) & 7)) << 4) + (key_ & 7) * 2) = (__bf16)(e < 4 ? f_[i][0][e] : f_[i][1][e - 4]); } } } } while (0)
    f32x4 fk_[2][2], fv_[2][2];
#define ATT_LD_F32(j) do { \
        const float* kb_ = ((j) < U.ntc) ? U.Kc + (size_t)(64 * (j)) * U.ldf : U.Kn + (size_t)(64 * ((j) - U.ntc)) * U.ldf; \
        const float* vb_ = ((j) < U.ntc) ? U.Vc + (size_t)(64 * (j)) * U.ldf : U.Vn + (size_t)(64 * ((j) - U.ntc)) * U.ldf; \
        _Pragma("unroll") for (int i = 0; i < 2; ++i) { const float* ks_ = kb_ + (size_t)crow[i] * U.ldf + cch[i] * 8; fk_[i][0] = *(const f32x4*)ks_; fk_[i][1] = *(const f32x4*)(ks_ + 4); \
                                                        const float* vs_ = vb_ + (size_t)crow[i] * U.ldf + cch[i] * 8; fv_[i][0] = *(const f32x4*)vs_; fv_[i][1] = *(const f32x4*)(vs_ + 4); } } while (0)
#define ATT_ST_F32(b) do { \
        unsigned char* kt_ = smem + (b) * 16384; unsigned char* vt_ = kt_ + 8192; \
        _Pragma("unroll") for (int i = 0; i < 2; ++i) { h16x8 hk_; _Pragma("unroll") for (int e = 0; e < 4; ++e) { hk_[e] = (h16)fk_[i][0][e]; hk_[4 + e] = (h16)fk_[i][1][e]; } \
            *(h16x8*)(kt_ + so[i]) = hk_; } \
        _Pragma("unroll") for (int i = 0; i < 2; ++i) { const int key_ = crow[i]; \
            _Pragma("unroll") for (int e = 0; e < 8; ++e) { const int dv_ = 8 * cch[i] + e; \
                *(__bf16*)(vt_ + dv_ * 128 + (((key_ >> 3) ^ ((dv_ >> 1) & 7)) << 4) + (key_ & 7) * 2) = (__bf16)(e < 4 ? fv_[i][0][e] : fv_[i][1][e - 4]); } } } while (0)
    const int drow0 = 16 * w + (lane >> 3), drow1 = drow0 + 8;
    const int dch0 = (lane & 7) ^ ((drow0 >> 1) & 7), dch1 = (lane & 7) ^ ((drow1 >> 1) & 7);
    const unsigned char* kbase = F32SRC ? nullptr : (const unsigned char*)U.Kh;
    const unsigned char* vbase = F32SRC ? nullptr : (const unsigned char*)U.VTh;
    const unsigned kof0 = (unsigned)(drow0 * U.ldk + dch0 * 8) * 2u, kof1 = (unsigned)(drow1 * U.ldk + dch1 * 8) * 2u;
    const size_t vof0 = ((size_t)drow0 * U.ldv + dch0 * 8) * 2, vof1 = ((size_t)drow1 * U.ldv + dch1 * 8) * 2;
    const int dmo0 = (16 * w) * 128, dmo1 = (16 * w + 8) * 128;
#define ATT_DMA(b, j) do { \
        const unsigned char* kt_ = kbase + (size_t)(64 * (j)) * U.ldk * 2; const unsigned char* vt_ = vbase + (size_t)(64 * (j)) * 2; \
        __builtin_amdgcn_global_load_lds((const unsigned*)(kt_ + kof0), (__attribute__((address_space(3))) unsigned*)(smem + (b) * 16384 + dmo0), 16, 0, 0); \
        __builtin_amdgcn_global_load_lds((const unsigned*)(vt_ + vof0), (__attribute__((address_space(3))) unsigned*)(smem + (b) * 16384 + 8192 + dmo0), 16, 0, 0); \
        __builtin_amdgcn_global_load_lds((const unsigned*)(kt_ + kof1), (__attribute__((address_space(3))) unsigned*)(smem + (b) * 16384 + dmo1), 16, 0, 0); \
        __builtin_amdgcn_global_load_lds((const unsigned*)(vt_ + vof1), (__attribute__((address_space(3))) unsigned*)(smem + (b) * 16384 + 8192 + dmo1), 16, 0, 0); } while (0)
    const unsigned* mq = (MODE == 0 && NQ == 2) ? U.mask + qb + lane : nullptr;
#define ATT_MASK_DMA(b, j) do { \
        __builtin_amdgcn_global_load_lds(mq + (size_t)(2 * (j)) * SEQ, (__attribute__((address_space(3))) unsigned*)(smem + ATT_MASK_OFF + (((b) * 4 + w) * 2) * 256), 4, 0, 0); \
        __builtin_amdgcn_global_load_lds(mq + (size_t)(2 * (j) + 1) * SEQ, (__attribute__((address_space(3))) unsigned*)(smem + ATT_MASK_OFF + (((b) * 4 + w) * 2 + 1) * 256), 4, 0, 0); } while (0)
    if constexpr (MODE == 0 && NQ == 2) { ATT_MASK_DMA(0, 0); }
    if constexpr (!F32SRC) { ATT_DMA(0, 0); } else { ATT_STAGE_F32(0, 0); }
    const unsigned* mrow[NQ];
    unsigned mwn[NQ][2];
#pragma unroll
    for (int nq = 0; nq < NQ; ++nq) {
        mrow[nq] = (MODE == 0 && NQ == 1) ? U.mask + (size_t)(qb + 32 * nq + l31) * U.ldm : nullptr;
        mwn[nq][0] = 0xffffffffu; mwn[nq][1] = 0xffffffffu;
        if (MODE == 0 && NQ == 1) { mwn[nq][0] = mrow[nq][0]; mwn[nq][1] = mrow[nq][1]; }
    }
    __syncthreads();
    const int pil = pi32(l31), ksw = (pil >> 1) & 7, vsw = (l31 >> 1) & 7;
    const int jlast = U.ntiles - 1;
    for (int j = 0; j < U.ntiles; ++j) {
        const int buf = j & 1;
        const int jn = j < jlast ? j + 1 : jlast;
        unsigned mw[NQ][2];
#pragma unroll
        for (int nq = 0; nq < NQ; ++nq) {
            if (NQ == 1) {
                mw[nq][0] = mwn[nq][0] >> (8 * hh); mw[nq][1] = mwn[nq][1] >> (8 * hh);
                if (MODE == 0) { mwn[nq][0] = mrow[nq][2 * jn]; mwn[nq][1] = mrow[nq][2 * jn + 1]; }
            } else {
                mw[nq][0] = 0xffffffffu; mw[nq][1] = 0xffffffffu;
                if (MODE == 0) {
                    const unsigned* ml = (const unsigned*)(smem + ATT_MASK_OFF + ((buf * 4 + w) * 2) * 256) + 32 * nq + l31;
                    mw[nq][0] = ml[0] >> (8 * hh); mw[nq][1] = ml[64] >> (8 * hh);
                }
            }
        }
        if constexpr (MODE == 0 && NQ == 2) { ATT_MASK_DMA(buf ^ 1, jn); }
        if constexpr (!F32SRC) ATT_DMA(buf ^ 1, jn);
        if constexpr (F32SRC) { ATT_LD_F32(jn); }
        if (active && (MODE == 2 || j <= chunk_w)) {
            const unsigned char* Kt = smem + buf * 16384;
            const unsigned char* Vt = Kt + 8192;
            const bool near = (MODE != 2) && (j >= chunk_w - 2);
#pragma unroll
            for (int u = 0; u < 2; ++u) {
                const unsigned char* kp = Kt + (32 * u + pil) * 128;
                bf16x8 pf[NQ][2];
                h16x8 kf[NQF];
#pragma unroll
                for (int s = 0; s < NQF; ++s) { const int ch = (MODE == 1) ? (4 * cmap + 2 * s + hh) : (2 * s + hh); kf[s] = *(const h16x8*)(kp + ((ch ^ ksw) << 4)); }
#pragma unroll
                for (int nq = 0; nq < NQ; ++nq) {
                    f32x16 S;
#pragma unroll
                    for (int r = 0; r < 16; ++r) S[r] = 0.f;
#pragma unroll
                    for (int s = 0; s < NQF; ++s) S = __builtin_amdgcn_mfma_f32_32x32x16_f16(kf[s], qf[nq][s], S, 0, 0, 0);
                    if (near) {
                        const int base = 64 * j + 32 * u + 8 * hh - (U.qpos0 + qb + 32 * nq + l31) + 191;
#pragma unroll
                        for (int i = 0; i < 16; ++i) S[i] += tb[base + (i & 7) + 16 * (i >> 3)];
                    }
#pragma unroll
                    for (int i = 0; i < 16; ++i) S[i] = __builtin_amdgcn_exp2f(S[i]);
#pragma unroll
                    for (int s2 = 0; s2 < 2; ++s2) {
                        u32x4 pk;
                        u32x4 mk4 = {0xffffffffu, 0xffffffffu, 0xffffffffu, 0xffffffffu};
                        if (MODE == 0) mk4 = lut[(mw[nq][u] >> (16 * s2)) & 0xffu];
#pragma unroll
                        for (int e = 0; e < 4; ++e) {
                            unsigned v = pkbf(S[8 * s2 + 2 * e], S[8 * s2 + 2 * e + 1]);
                            if (MODE == 0) v &= mk4[e];
                            lsum[nq] = __builtin_amdgcn_fdot2_f32_bf16(__builtin_bit_cast(bf16x2, v), __builtin_bit_cast(bf16x2, 0x3f803f80u), lsum[nq], false);
                            pk[e] = v;
                        }
                        pf[nq][s2] = __builtin_bit_cast(bf16x8, pk);
                    }
                }
#pragma unroll
                for (int m = 0; m < 2; ++m)
#pragma unroll
                    for (int s2 = 0; s2 < 2; ++s2) {
                        const bf16x8 vfr = *(const bf16x8*)(Vt + (32 * m + l31) * 128 + (((2 * (2 * u + s2) + hh) ^ vsw) << 4));
#pragma unroll
                        for (int nq = 0; nq < NQ; ++nq) O[nq][m] = __builtin_amdgcn_mfma_f32_32x32x16_bf16(vfr, pf[nq][s2], O[nq][m], 0, 0, 0);
                    }
            }
        }
        if constexpr (F32SRC) { ATT_ST_F32(buf ^ 1); }
        __syncthreads();
    }
#undef ATT_STAGE_F32
#undef ATT_LD_F32
#undef ATT_ST_F32
#undef ATT_DMA
#undef ATT_MASK_DMA
    float inv[NQ];
#pragma unroll
    for (int nq = 0; nq < NQ; ++nq) { const float l = lsum[nq] + __shfl_xor(lsum[nq], 32); inv[nq] = 1.0f / l; }
    if (MODE == 1) {
        float* X = (float*)smem;
        if (cmap == 1) {
#pragma unroll
            for (int nq = 0; nq < NQ; ++nq)
#pragma unroll
                for (int m = 0; m < 2; ++m)
#pragma unroll
                    for (int i = 0; i < 16; ++i) X[((wq * NQ + nq) * 32 + m * 16 + i) * 64 + lane] = O[nq][m][i] * inv[nq];
        }
        __syncthreads();
        if (cmap == 1) return;
#pragma unroll
        for (int nq = 0; nq < NQ; ++nq)
#pragma unroll
            for (int m = 0; m < 2; ++m)
#pragma unroll
                for (int i = 0; i < 16; ++i) O[nq][m][i] = O[nq][m][i] * inv[nq] - lam * X[((wq * NQ + nq) * 32 + m * 16 + i) * 64 + lane];
    } else {
        if (!active) return;
#pragma unroll
        for (int nq = 0; nq < NQ; ++nq)
#pragma unroll
            for (int m = 0; m < 2; ++m)
#pragma unroll
                for (int i = 0; i < 16; ++i) O[nq][m][i] *= inv[nq];
    }
    const int colbase = (MODE == 0 ? 0 : (MODE == 1 ? 512 : 768)) + U.head * 64;
#pragma unroll
    for (int nq = 0; nq < NQ; ++nq) {
        const int rowq = U.row0 + qb + 32 * nq + l31;
        const h16* G = (const h16*)(p.ws + WS_G) + (size_t)rowq * 1024 + colbase;
        h16* Oo = (h16*)(p.ws + WS_O16) + (size_t)rowq * 1024 + colbase;
        float sc = 1.f;
        if (MODE == 1) {
            float ss = 0.f;
#pragma unroll
            for (int m = 0; m < 2; ++m)
#pragma unroll
                for (int i = 0; i < 16; ++i) ss = fmaf(O[nq][m][i], O[nq][m][i], ss);
            ss += __shfl_xor(ss, 32);
            sc = (1.0f / sqrtf(ss * (1.0f / 64.0f) + EPS)) * 0.8f;
        }
#pragma unroll
        for (int m = 0; m < 2; ++m)
#pragma unroll
            for (int g4 = 0; g4 < 4; ++g4) {
                const int dv = 32 * m + 8 * g4 + 4 * hh;
                const h16x4 gv = *(const h16x4*)(G + dv);
                h16x4 o4;
#pragma unroll
                for (int e = 0; e < 4; ++e) {
                    float o = O[nq][m][4 * g4 + e];
                    if (MODE == 1) o = o * sc * p.in[18][dv + e];
                    o4[e] = (h16)(o * silu((float)gv[e]));
                }
                *(h16x4*)(Oo + dv) = o4;
            }
    }
}

__device__ __forceinline__ AttnUnit unit_zero() {
    AttnUnit U; U.row0 = 0; U.nrows = 0; U.ntiles = 0; U.qpos0 = 0; U.head = 0; U.Kh = nullptr; U.VTh = nullptr; U.ldk = 0; U.ldv = 0;
    U.Kc = nullptr; U.Vc = nullptr; U.Kn = nullptr; U.Vn = nullptr; U.ldf = 0; U.ntc = 0; U.mask = nullptr; U.ldm = 0; return U;
}
__device__ __forceinline__ void unit_a_prompt(const Params& p, unsigned char* smem, int g, int head) {
    AttnUnit U = unit_zero();
    U.row0 = 256 * g; U.nrows = 256; U.ntiles = 4 * g + 4; U.qpos0 = 256 * g; U.head = head;
    U.Kh = (const h16*)(p.ws + WS_KA_P) + head * 64; U.ldk = 512;
    U.VTh = (const h16*)(p.ws + WS_VTA_P) + (size_t)(head * 64) * SEQ; U.ldv = SEQ;
    U.mask = (const unsigned*)(p.ws + WS_MASK_P) + 256 * g; U.ldm = 0;
    attn_unit<0, false, 2>(p, smem, U, 0.f);
}
__device__ __forceinline__ void unit_b_prompt(const Params& p, unsigned char* smem, int g, int head, float lam) {
    AttnUnit U = unit_zero();
    U.row0 = 128 * g; U.nrows = 128; U.ntiles = 2 * g + 2; U.qpos0 = 128 * g; U.head = head;
    U.Kh = (const h16*)(p.ws + WS_KB_P) + head * 64; U.ldk = 256;
    U.VTh = (const h16*)(p.ws + WS_VTB_P) + (size_t)(head * 64) * SEQ; U.ldv = SEQ;
    attn_unit<1, false, 2>(p, smem, U, lam);
}
__device__ __forceinline__ void unit_a_sample(const Params& p, unsigned char* smem, int b, int head) {
    AttnUnit U = unit_zero();
    U.row0 = SEQ + 64 * b; U.nrows = 64; U.ntiles = 17; U.qpos0 = PAST; U.head = head;
    U.Kc = p.in[3] + (size_t)b * PAST * 512 + head * 64; U.Vc = p.in[4] + (size_t)b * PAST * 512 + head * 64;
    U.Kn = p.out + O_SAK + (size_t)b * DECS * 512 + head * 64; U.Vn = p.out + O_SAV + (size_t)b * DECS * 512 + head * 64;
    U.ldf = 512; U.ntc = 16;
    U.mask = (const unsigned*)(p.ws + WS_MASK_S) + (size_t)(64 * b) * 34; U.ldm = 34;
    attn_unit<0, true, 1>(p, smem, U, 0.f);
}
__device__ __forceinline__ void unit_b_sample(const Params& p, unsigned char* smem, int b, int head, float lam) {
    AttnUnit U = unit_zero();
    U.row0 = SEQ + 64 * b; U.nrows = 64; U.ntiles = 17; U.qpos0 = PAST; U.head = head;
    U.Kc = p.in[6] + (size_t)b * PAST * 256 + head * 64; U.Vc = p.in[7] + (size_t)b * PAST * 256 + head * 64;
    U.Kn = p.out + O_SBK + (size_t)b * DECS * 256 + head * 64; U.Vn = p.out + O_SBV + (size_t)b * DECS * 256 + head * 64;
    U.ldf = 256; U.ntc = 16;
    attn_unit<1, true, 1>(p, smem, U, lam);
}
__device__ __forceinline__ void unit_c_prompt(const Params& p, unsigned char* smem, int g, int head) {
    AttnUnit U = unit_zero();
    U.row0 = 128 * g; U.nrows = 128; U.ntiles = 4; U.head = head;
    U.Kh = (const h16*)(p.ws + WS_MK_P) + head * 64; U.ldk = 256;
    U.VTh = (const h16*)(p.ws + WS_MVT_P) + (size_t)(head * 64) * NMEM; U.ldv = NMEM;
    attn_unit<2, false, 1>(p, smem, U, 0.f);
}
__device__ __forceinline__ void unit_c_sample(const Params& p, unsigned char* smem, int b, int head) {
    AttnUnit U = unit_zero();
    U.row0 = SEQ + 64 * b; U.nrows = 64; U.ntiles = 4; U.head = head;
    U.Kc = p.in[8] + (size_t)b * NMEM * 256 + head * 64; U.Vc = p.in[9] + (size_t)b * NMEM * 256 + head * 64;
    U.Kn = U.Kc; U.Vn = U.Vc; U.ldf = 256; U.ntc = 4;
    attn_unit<2, true, 1>(p, smem, U, 0.f);
}

#define ZIGZAG_LOOP(NALL) for (int zk_ = 0, pos_ = 0; zk_ * (int)gridDim.x < (NALL); ++zk_) \
    if ((pos_ = (zk_ & 1) ? (zk_ + 1) * (int)gridDim.x - 1 - (int)blockIdx.x : zk_ * (int)gridDim.x + (int)blockIdx.x) < (NALL))

__device__ __forceinline__ float diff_lambda_of(const Params& p) {
    float s1 = 0.f, s2 = 0.f;
    for (int i = 0; i < 32; ++i) { s1 = fmaf(p.in[19][i], p.in[20][i], s1); s2 = fmaf(p.in[21][i], p.in[22][i], s2); }
    return expf(s1) - expf(s2) + 0.2f;
}

__device__ void phase2(const Params& p, unsigned char* smem) {
    const float lam = diff_lambda_of(p);
    constexpr int N_SP = 1024, N_BS = 128, N_CS = 128, N_SS = 128, N_CP = 512;
    constexpr int N_ALL = N_SP + N_BS + N_CS + N_SS + N_CP;
    ZIGZAG_LOOP(N_ALL) {
        int it = pos_;
        {
            const int ss = it - (N_SP + N_BS + N_CS);
            const int su = it < N_SP ? it : ((ss >= 0 && ss < N_SS) ? 1024 + ss : -1);
            if (su >= 0) { select_unit(p, smem, su); continue; }
        }
        it -= N_SP;
        if (it < N_BS) { unit_b_sample(p, smem, it >> 2, it & 3, lam); continue; }
        it -= N_BS;
        if (it < N_CS) { unit_c_sample(p, smem, it >> 2, it & 3); continue; }
        it -= N_CS + N_SS;
        unit_c_prompt(p, smem, it >> 2, it & 3);
    }
    {
        __syncthreads();
        const unsigned* fl = (const unsigned*)(p.ws + WS_REDO) + (size_t)blockIdx.x * REDO_LD;
        const unsigned n = __builtin_amdgcn_readfirstlane((int)__hip_atomic_load(fl, __ATOMIC_RELAXED, __HIP_MEMORY_SCOPE_AGENT));
        for (unsigned i = 0; i < n; ++i) {
            const int row = __builtin_amdgcn_readfirstlane((int)__hip_atomic_load(fl + 1 + i, __ATOMIC_RELAXED, __HIP_MEMORY_SCOPE_AGENT));
            select_item(p, smem, row);
        }
    }
}

__device__ void phase3(const Params& p, unsigned char* smem) {
    const float lam = diff_lambda_of(p);
    const int G = gridDim.x;
    for (int i0 = blockIdx.x; i0 < 512; i0 += G) {
        const int i = (G == 512 && i0 >= 256) ? 8 * (95 - (i0 >> 3)) + (i0 & 7) : i0;
        { const int g = 63 - (i >> 3), head = i & 7; unit_a_prompt(p, smem, g, head); }
        { const int r = 511 - i, g = 127 - (r >> 2), head = r & 3; unit_b_prompt(p, smem, g, head, lam); }
        if (i >= 256) { const int s = i - 256; unit_a_sample(p, smem, s >> 3, s & 7); }
    }
}

__device__ void phase4(const Params& p, unsigned char* smem) {
    const h16* O16 = (const h16*)(p.ws + WS_O16);
    const h16* WTOUT = (const h16*)(p.ws + WS_WTOUT);
    constexpr int NCT = D / 128, NRT = MROWS / 128;
    const EpiOut eo{};
    const int G = gridDim.x;
    if ((G & 7) == 0) {
        const int xcd = blockIdx.x & 7, local = blockIdx.x >> 3, LG = G >> 3;
        for (int lin = local; lin < (NRT / 8) * NCT; lin += LG) {
            const int rt = xcd + 8 * (lin / NCT), ct = lin % NCT;
            gemm_tile(p, O16, WTOUT, rt * 128, ct * 128, smem, eo);
        }
    } else {
        for (int it = blockIdx.x; it < NCT * NRT; it += gridDim.x) {
            const int rt = it / NCT, ct = it % NCT;
            gemm_tile(p, O16, WTOUT, rt * 128, ct * 128, smem, eo);
        }
    }
}

constexpr int SMEM_BYTES = 80 * 1024;

__device__ __forceinline__ void grid_barrier(unsigned* cnt, unsigned target) {
    asm volatile("s_waitcnt vmcnt(0)" ::: "memory");
    __syncthreads();
    if (threadIdx.x == 0) {
        __builtin_amdgcn_fence(__ATOMIC_RELEASE, "agent");
        asm volatile("s_waitcnt vmcnt(0)" ::: "memory");
        __hip_atomic_fetch_add(cnt, 1u, __ATOMIC_RELAXED, __HIP_MEMORY_SCOPE_AGENT);
        while (__hip_atomic_load(cnt, __ATOMIC_RELAXED, __HIP_MEMORY_SCOPE_AGENT) < target) __builtin_amdgcn_s_sleep(2);
        __builtin_amdgcn_fence(__ATOMIC_ACQUIRE, "agent");
        asm volatile("s_waitcnt vmcnt(0)" ::: "memory");
    }
    __syncthreads();
}

__global__ void __launch_bounds__(NT, 2) fwd_kernel(Params p) {
    __shared__ __attribute__((aligned(16))) unsigned char smem[SMEM_BYTES];
    static_assert(ATT_LDS <= SMEM_BYTES && sizeof(SmemDsa) <= SMEM_BYTES && sizeof(SelSm) <= SMEM_BYTES && CS_LD * 128 * 4 <= SMEM_BYTES, "smem");
    unsigned nbar = 0;
#define SEAM() grid_barrier((unsigned*)(p.ws + WS_CTL) + 48, ++nbar * gridDim.x)
    phase0(p, smem);
    if (p.ph_lo > 0) cg::this_grid().sync(); else SEAM();
    phase1(p, smem); SEAM();
    phase2(p, smem); SEAM();
    phase3(p, smem); SEAM();
    phase4(p, smem);
#undef SEAM
}

extern "C" void kernel_launch(void* const* d_in, const int* in_sizes, int n_in, void* d_out, int out_size, void* d_ws, size_t ws_size, hipStream_t stream) {
    static int grid_blocks = 0;
    if (!grid_blocks) {
        int dev = 0, cus = 0, per_cu = 0;
        (void)hipGetDevice(&dev);
        (void)hipDeviceGetAttribute(&cus, hipDeviceAttributeMultiprocessorCount, dev);
        (void)hipOccupancyMaxActiveBlocksPerMultiprocessor(&per_cu, fwd_kernel, NT, 0);
        if (per_cu < 1) per_cu = 1;
        if (per_cu > (160 * 1024) / SMEM_BYTES) per_cu = (160 * 1024) / SMEM_BYTES;
        grid_blocks = cus * per_cu;
        if (ws_size < WS_END) fprintf(stderr, "kernel_launch: workspace too small: %zu < %zu\n", ws_size, (size_t)WS_END);
    }
    if (ws_size < WS_END) return;
    (void)hipMemsetAsync((unsigned char*)d_ws + WS_CTL, 0, 256 + (size_t)2048 * REDO_LD * 4, stream);
    Params p{};
    for (int i = 0; i < 27; ++i) p.in[i] = (const float*)d_in[i];
    p.out = (float*)d_out; p.ws = (unsigned char*)d_ws;
    p.ph_lo = 0; p.ph_hi = 5;
    void* args[] = {&p};
    hipError_t e = hipLaunchCooperativeKernel((void*)fwd_kernel, dim3(grid_blocks), dim3(NT), args, 0, stream);
    if (e != hipSuccess) fprintf(stderr, "cooperative launch failed: %s (grid %d)\n", hipGetErrorString(e), grid_blocks);
}
```

```cpp
#include <hip/hip_runtime.h>
#include <hip/hip_cooperative_groups.h>
#include <cstdio>
#include <cstdint>
namespace cg = cooperative_groups;

#define NT 256

constexpr int D = 1024, SEQ = 16384, DECB = 32, DECS = 64, PAST = 1024, NMEM = 256;
constexpr int MROWS = SEQ + DECB * DECS;
constexpr int DIN = 3880;
constexpr int LDP = 264;
constexpr int PC_IQ = 0, PC_IW = 256;
constexpr float EPS = 1e-6f;

constexpr size_t O_YP = 0, O_YS = 16777216, O_PAK = 18874368, O_PAV = 27262976, O_PAKI = 35651584, O_PBK = 36175872,
                 O_PBV = 40370176, O_PMK = 44564480, O_PMV = 44630016, O_SAK = 44695552, O_SAV = 45744128,
                 O_SAKI = 46792704, O_SBK = 46858240, O_SBV = 47382528;

typedef _Float16 h16;
typedef h16 h16x2 __attribute__((ext_vector_type(2)));
typedef h16 h16x4 __attribute__((ext_vector_type(4)));
typedef h16 h16x8 __attribute__((ext_vector_type(8)));
typedef float f32x4 __attribute__((ext_vector_type(4)));
typedef unsigned u32x4 __attribute__((ext_vector_type(4)));
typedef __bf16 bf16x8 __attribute__((ext_vector_type(8)));
typedef __bf16 bf16x2 __attribute__((ext_vector_type(2)));
typedef float f32x2 __attribute__((ext_vector_type(2)));
__device__ __forceinline__ unsigned pkbf(float a, float b) { const f32x2 v = {a, b}; return __builtin_bit_cast(unsigned, __builtin_convertvector(v, bf16x2)); }
typedef float f32x16 __attribute__((ext_vector_type(16)));

constexpr int NPAD_IN = 3968;
constexpr float LOG2E = 1.4426950408889634f;
constexpr size_t WS_XH = 0;
constexpr size_t WS_O16 = WS_XH;
constexpr size_t WS_HMH = WS_XH + (size_t)MROWS * D * 2;
constexpr size_t WS_WTIN = WS_HMH + (size_t)NMEM * D * 2;
constexpr size_t WS_WTOUT = WS_WTIN + (size_t)NPAD_IN * D * 2;
constexpr size_t WS_WTMEM = WS_WTOUT + (size_t)D * D * 2;
constexpr size_t WS_QA = WS_WTMEM + (size_t)512 * D * 2;
constexpr size_t WS_QB = WS_QA + (size_t)MROWS * 512 * 2;
constexpr size_t WS_QC = WS_QB + (size_t)MROWS * 256 * 2;
constexpr size_t WS_G = WS_QC + (size_t)MROWS * 256 * 2;
constexpr size_t WS_KB_P = WS_G + (size_t)MROWS * 1024 * 2;
constexpr size_t WS_VTB_P = WS_KB_P + (size_t)SEQ * 256 * 2;
constexpr size_t WS_MK_P = WS_VTB_P + (size_t)SEQ * 256 * 2;
constexpr size_t WS_MVT_P = WS_MK_P + (size_t)NMEM * 256 * 2;
constexpr size_t WS_KA_P = WS_MVT_P + (size_t)NMEM * 256 * 2;
constexpr size_t WS_VTA_P = WS_KA_P + (size_t)SEQ * 512 * 2;
constexpr size_t WS_MASK_P = WS_VTA_P + (size_t)SEQ * 512 * 2;
constexpr size_t WS_MASK_S = WS_MASK_P + (size_t)SEQ * 512 * 4;
constexpr size_t WS_IQ16 = WS_MASK_S + (size_t)DECB * DECS * 34 * 4;
constexpr size_t WS_IK_P = WS_IQ16 + (size_t)MROWS * 256 * 2;
constexpr size_t WS_IK_S = WS_IK_P + (size_t)SEQ * 32 * 2;
constexpr size_t WS_CTL = WS_IK_S + (size_t)DECB * (PAST + DECS) * 32 * 2;
constexpr int SMEM_BYTES = 80 * 1024;
constexpr int REDO_LD = 64;
constexpr size_t WS_REDO = WS_CTL + 256;
constexpr size_t WS_RQ = WS_REDO + 16384;
constexpr int RQ_ITEMS = 256, RQ_CAP = MROWS;
constexpr size_t WS_ZSPAN = 16384 + (size_t)(RQ_ITEMS + RQ_CAP) * 4;
static_assert(WS_ZSPAN % 256 == 0, "alignment of what follows");
constexpr size_t WS_XBAR = WS_REDO;
constexpr size_t WS_P = WS_REDO + WS_ZSPAN;
constexpr size_t WS_END = WS_P + (size_t)MROWS * LDP * 4;

struct Params {
    const float* in[27];
    float* out;
    unsigned char* ws;
    int ph_lo, ph_hi;
};

template <int CTRL> __device__ __forceinline__ float dpp_mov(float v) {
    return __builtin_bit_cast(float, __builtin_amdgcn_update_dpp(0, __builtin_bit_cast(int, v), CTRL, 0xF, 0xF, true));
}
__device__ __forceinline__ float lane_f(float v, int l) { return __builtin_bit_cast(float, __builtin_amdgcn_readlane(__builtin_bit_cast(int, v), l)); }
__device__ __forceinline__ float wave_sum(float v) {
    v += dpp_mov<0xB1>(v); v += dpp_mov<0x4E>(v); v += dpp_mov<0x141>(v); v += dpp_mov<0x140>(v);
    return (lane_f(v, 0) + lane_f(v, 16)) + (lane_f(v, 32) + lane_f(v, 48));
}
__device__ __forceinline__ float wave_max(float v) {
    v = fmaxf(v, dpp_mov<0xB1>(v)); v = fmaxf(v, dpp_mov<0x4E>(v)); v = fmaxf(v, dpp_mov<0x141>(v)); v = fmaxf(v, dpp_mov<0x140>(v));
    return fmaxf(fmaxf(lane_f(v, 0), lane_f(v, 16)), fmaxf(lane_f(v, 32), lane_f(v, 48)));
}
__device__ __forceinline__ float silu(float x) { return x * __builtin_amdgcn_rcpf(1.0f + __builtin_amdgcn_exp2f(-1.4426950408889634f * x)); }

__device__ __forceinline__ int rel_bucket(int rel) {
    const int ret = rel > 0 ? 16 : 0;
    const int n = rel < 0 ? -rel : rel;
    int b;
    if (n < 8) b = n;
    else if (n < 12) b = 8;
    else if (n < 16) b = 9;
    else if (n < 23) b = 10;
    else if (n < 32) b = 11;
    else if (n < 46) b = 12;
    else if (n < 64) b = 13;
    else if (n < 91) b = 14;
    else b = 15;
    return ret + b;
}

__device__ __forceinline__ void rms_row_h(const float* x, const float* g, h16* o, int lane) {
    const float4* xr = (const float4*)x;
    const float4* gr = (const float4*)g;
    float4 v[4];
    float s = 0.f;
#pragma unroll
    for (int j = 0; j < 4; ++j) { v[j] = xr[lane + 64 * j]; s += v[j].x * v[j].x + v[j].y * v[j].y + v[j].z * v[j].z + v[j].w * v[j].w; }
    s = wave_sum(s);
    const float r = __builtin_amdgcn_rsqf(s * (1.0f / 1024.0f) + EPS);
#pragma unroll
    for (int j = 0; j < 4; ++j) {
        const float4 gg = gr[lane + 64 * j];
        h16x4 o4; o4.x = (h16)(v[j].x * r * gg.x); o4.y = (h16)(v[j].y * r * gg.y); o4.z = (h16)(v[j].z * r * gg.z); o4.w = (h16)(v[j].w * r * gg.w);
        ((h16x4*)o)[lane + 64 * j] = o4;
    }
}

__device__ __forceinline__ void transpose_item(const float* __restrict__ W, int ldw, int c0, int nvalid, int k0, h16* __restrict__ WT, int r0, float* scr, int lane) {
    float wv[32];
#pragma unroll
    for (int i = 0; i < 32; ++i) {
        const int kk = 2 * i + (lane >> 5), n = lane & 31;
        wv[i] = (n < nvalid) ? W[(size_t)(k0 + kk) * ldw + c0 + n] : 0.f;
    }
#pragma unroll
    for (int i = 0; i < 32; ++i) { const int kk = 2 * i + (lane >> 5), n = lane & 31; scr[kk * 33 + n] = wv[i]; }
    asm volatile("s_waitcnt lgkmcnt(0)" ::: "memory");
    const int c = lane & 7;
#pragma unroll
    for (int j = 0; j < 4; ++j) {
        const int n = (lane >> 3) + 8 * j;
        const float* s = scr + (8 * c) * 33 + n;
        h16x8 o;
#pragma unroll
        for (int e = 0; e < 8; ++e) o[e] = (h16)s[e * 33];
        *(h16x8*)(WT + (size_t)(r0 + n) * 1024 + k0 + 8 * c) = o;
    }
    asm volatile("s_waitcnt lgkmcnt(0)" ::: "memory");
}

__device__ __forceinline__ int inproj_col(int np) { return np < 2304 ? np : (np < 3840 ? np + 40 : np - 3840 + 2304); }

__device__ void phase0(const Params& p, unsigned char* smem) {
    int tid0 = threadIdx.x; asm volatile("" : "+v"(tid0));
    const int lane = tid0 & 63, w = tid0 >> 6;
    const int gw = blockIdx.x * 4 + w, ngw = gridDim.x * 4;
    h16* XH = (h16*)(p.ws + WS_XH);
    h16* HMH = (h16*)(p.ws + WS_HMH);
    h16* WTIN = (h16*)(p.ws + WS_WTIN);
    h16* WTOUT = (h16*)(p.ws + WS_WTOUT);
    h16* WTMEM = (h16*)(p.ws + WS_WTMEM);
    float* scr = (float*)smem + w * (64 * 33);
    constexpr int N_ROWS = MROWS + NMEM;
    constexpr int I_IN = 16 * (NPAD_IN / 32), I_OUT = 16 * 32, I_MEM = 16 * 16, I_KIDX = DECB * (PAST / 64);
    for (int it = gw; it < N_ROWS + I_IN + I_OUT + I_MEM + I_KIDX; it += ngw) {
        if (it < N_ROWS) {
            const int r = it;
            if (r < SEQ) rms_row_h(p.in[0] + (size_t)r * D, p.in[11], XH + (size_t)r * D, lane);
            else if (r < MROWS) rms_row_h(p.in[1] + (size_t)(r - SEQ) * D, p.in[11], XH + (size_t)r * D, lane);
            else rms_row_h(p.in[2] + (size_t)(r - MROWS) * D, p.in[25], HMH + (size_t)(r - MROWS) * D, lane);
        } else if (it < N_ROWS + I_IN) {
            const int r = it - N_ROWS, nb = r % (NPAD_IN / 32), kb = r / (NPAD_IN / 32);
            const int np0 = nb * 32;
            int nvalid = DIN - np0; nvalid = nvalid < 0 ? 0 : (nvalid > 32 ? 32 : nvalid);
            const int c0 = nvalid > 0 ? inproj_col(np0) : 0;
            transpose_item(p.in[12], DIN, c0, nvalid, kb * 64, WTIN, np0, scr, lane);
        } else if (it < N_ROWS + I_IN + I_OUT) {
            const int r = it - N_ROWS - I_IN, nb = r % 32, kb = r / 32;
            transpose_item(p.in[13], D, nb * 32, 32, kb * 64, WTOUT, nb * 32, scr, lane);
        } else if (it < N_ROWS + I_IN + I_OUT + I_MEM) {
            const int r = it - N_ROWS - I_IN - I_OUT, nb = r % 16, kb = r / 16;
            transpose_item(p.in[26], 512, nb * 32, 32, kb * 64, WTMEM, nb * 32, scr, lane);
        } else {
            const int r = it - N_ROWS - I_IN - I_OUT - I_MEM, b = r / (PAST / 64), key = (r % (PAST / 64)) * 64 + lane;
            const f32x4* src = (const f32x4*)(p.in[5] + ((size_t)b * PAST + key) * 32);
            h16* dst = (h16*)(p.ws + WS_IK_S) + ((size_t)b * (PAST + DECS) + key) * 32;
            float ss = 0.f;
            f32x4 xin[8];
#pragma unroll
            for (int c = 0; c < 8; ++c) xin[c] = src[c];
#pragma unroll
            for (int c = 0; c < 4; ++c) {
                const f32x4 x0 = xin[2 * c], x1 = xin[2 * c + 1];
                h16x8 o;
#pragma unroll
                for (int e = 0; e < 4; ++e) { o[e] = (h16)x0[e]; o[4 + e] = (h16)x1[e]; ss = fmaf(x0[e], x0[e], ss); ss = fmaf(x1[e], x1[e], ss); }
                *(h16x8*)(dst + 8 * c) = o;
            }
            ss = wave_max(ss);
            if (lane == 0) atomicMax((unsigned*)(p.ws + WS_CTL) + 1 + b, __float_as_uint(ss));
        }
    }
}

constexpr int CS_LD = 132;
template <class Epi>
__device__ __forceinline__ void gemm_tile(const Params& p, const h16* __restrict__ A, const h16* __restrict__ Bt, int m0, int n0, unsigned char* smem, const Epi& epi) {
    int tid = threadIdx.x; asm volatile("" : "+v"(tid));
    const int lane = tid & 63, wid = tid >> 6, wm = wid >> 1, wn = wid & 1;
    const int l31 = lane & 31, hh = lane >> 5;
    f32x16 acc[2][2];
#pragma unroll
    for (int a = 0; a < 2; ++a)
#pragma unroll
        for (int b = 0; b < 2; ++b)
#pragma unroll
            for (int r = 0; r < 16; ++r) acc[a][b][r] = 0.f;
    const unsigned char* agl[4]; const unsigned char* bgl[4]; int ldo[4];
#pragma unroll
    for (int i = 0; i < 4; ++i) {
        const int row = 32 * wid + 8 * i + (lane >> 3), slot = lane & 7, ch = slot ^ ((row >> 1) & 7);
        agl[i] = (const unsigned char*)(A + (size_t)(m0 + row) * 1024 + ch * 8);
        bgl[i] = (const unsigned char*)(Bt + (size_t)(n0 + row) * 1024 + ch * 8);
        ldo[i] = (32 * wid + 8 * i) * 128;
    }
#define GT_DMA(stage_, kt_) do { const int ko_ = ((kt_) < 15 ? (kt_) : 15) * 128; \
        _Pragma("unroll") for (int i = 0; i < 4; ++i) { \
            __builtin_amdgcn_global_load_lds((const unsigned*)(agl[i] + ko_), (__attribute__((address_space(3))) unsigned*)(smem + (stage_) * 32768 + ldo[i]), 16, 0, 0); \
            __builtin_amdgcn_global_load_lds((const unsigned*)(bgl[i] + ko_), (__attribute__((address_space(3))) unsigned*)(smem + (stage_) * 32768 + 16384 + ldo[i]), 16, 0, 0); } } while (0)
    const int sw = (l31 >> 1) & 7;
    const int arow = (wm * 64 + l31) * 128, brow = (wn * 64 + l31) * 128;
    __syncthreads();
    GT_DMA(0, 0);
    __syncthreads();
    for (int kt = 0; kt < 16; ++kt) {
        const unsigned char* As = smem + (kt & 1) * 32768; const unsigned char* Bs = As + 16384;
        GT_DMA((kt + 1) & 1, kt + 1);
#pragma unroll
        for (int s = 0; s < 4; ++s) {
            const int co = (((2 * s + hh) ^ sw) << 4);
            h16x8 a[2], b[2];
#pragma unroll
            for (int mt = 0; mt < 2; ++mt) a[mt] = *(const h16x8*)(As + arow + mt * 32 * 128 + co);
#pragma unroll
            for (int nt = 0; nt < 2; ++nt) b[nt] = *(const h16x8*)(Bs + brow + nt * 32 * 128 + co);
#pragma unroll
            for (int mt = 0; mt < 2; ++mt)
#pragma unroll
                for (int nt = 0; nt < 2; ++nt) acc[mt][nt] = __builtin_amdgcn_mfma_f32_32x32x16_f16(a[mt], b[nt], acc[mt][nt], 0, 0, 0);
        }
        __syncthreads();
    }
#undef GT_DMA
    float* Cs = (float*)smem;
#pragma unroll
    for (int mt = 0; mt < 2; ++mt)
#pragma unroll
        for (int nt = 0; nt < 2; ++nt)
#pragma unroll
            for (int r = 0; r < 16; ++r) {
                const int row = wm * 64 + mt * 32 + (r & 3) + 8 * (r >> 2) + 4 * hh, col = wn * 64 + nt * 32 + l31;
                Cs[row * CS_LD + col] = acc[mt][nt][r];
            }
    __syncthreads();
    epi(p, Cs, m0, n0, tid);
}

template <int CTRL> __device__ __forceinline__ float dpp_f(float v) {
    return __builtin_bit_cast(float, __builtin_amdgcn_update_dpp(0, __builtin_bit_cast(int, v), CTRL, 0xF, 0xF, true));
}
__device__ __forceinline__ float group_sum8(float v) { v += dpp_f<0xB1>(v); v += dpp_f<0x4E>(v); v += dpp_f<0x141>(v); return v; }
__device__ __forceinline__ float group_sum16(float v) { v = group_sum8(v); v += dpp_f<0x140>(v); return v; }

struct Seg {
    float* bp; float* bs; int ld; int col; int norm; const float* gain;
    h16* hp; h16* hs; int hld; int hcol; float hscale;
    int vt; int head;
};

__device__ __forceinline__ Seg seg_of(const Params& p, int n0) {
    float* P = (float*)(p.ws + WS_P);
    float* out = p.out;
    h16* QA = (h16*)(p.ws + WS_QA); h16* QB = (h16*)(p.ws + WS_QB); h16* QC = (h16*)(p.ws + WS_QC); h16* G = (h16*)(p.ws + WS_G);
    Seg s; s.norm = 0; s.gain = nullptr; s.hp = nullptr; s.hs = nullptr; s.hld = 0; s.hcol = 0; s.hscale = 1.f; s.vt = 0; s.head = 0;
    s.bp = nullptr; s.bs = nullptr; s.ld = 0; s.col = 0;
#define SEG_O(op, os, ldv, c) do { s.bp = out + (op); s.bs = out + (os) - (size_t)SEQ * (ldv); s.ld = (ldv); s.col = (c); } while (0)
#define SEG_H(ptr, ldv, c, sc) do { s.hp = (ptr); s.hs = (ptr); s.hld = (ldv); s.hcol = (c); s.hscale = (sc); } while (0)
    if (n0 < 512) { s.norm = 64; s.gain = p.in[14]; SEG_H(QA, 512, n0, 0.125f * LOG2E); }
    else if (n0 < 1024) { SEG_O(O_PAK, O_SAK, 512, n0 - 512); s.norm = 64; s.gain = p.in[15]; s.hp = (h16*)(p.ws + WS_KA_P); s.hs = nullptr; s.hld = 512; s.hcol = n0 - 512; }
    else if (n0 < 1536) { SEG_O(O_PAV, O_SAV, 512, n0 - 1024); s.vt = 1; s.head = (n0 - 1024) >> 6; }
    else if (n0 < 2048) { SEG_H(G, 1024, n0 - 1536, 1.f); }
    else if (n0 < 2304) { s.bp = P; s.bs = P; s.ld = LDP; s.col = PC_IQ + n0 - 2048; SEG_H((h16*)(p.ws + WS_IQ16), 256, n0 - 2048, 1.f); }
    else if (n0 < 2560) { s.norm = 32; s.gain = p.in[16]; SEG_H(QB, 256, n0 - 2304, 0.17677669529663687f * LOG2E); }
    else if (n0 < 2816) { SEG_O(O_PBK, O_SBK, 256, n0 - 2560); s.norm = 32; s.gain = p.in[17]; s.hp = (h16*)(p.ws + WS_KB_P); s.hs = nullptr; s.hld = 256; s.hcol = n0 - 2560; }
    else if (n0 < 3072) { SEG_O(O_PBV, O_SBV, 256, n0 - 2816); s.vt = 2; s.head = (n0 - 2816) >> 6; }
    else if (n0 < 3328) { SEG_H(G, 1024, 512 + n0 - 3072, 1.f); }
    else if (n0 < 3584) { s.norm = 64; s.gain = p.in[23]; SEG_H(QC, 256, n0 - 3328, 0.125f * LOG2E); }
    else { SEG_H(G, 1024, 768 + n0 - 3584, 1.f); }
#undef SEG_O
#undef SEG_H
    return s;
}

__device__ __forceinline__ void vt_store(const float* Cs, int j, h16* dst_base, size_t ldv, int tid) {
    const int dv = tid & 63, rq = tid >> 6;
    h16* dst = dst_base + (size_t)dv * ldv + 32 * rq;
#pragma unroll
    for (int e8 = 0; e8 < 4; ++e8) {
        u32x4 o;
#pragma unroll
        for (int e = 0; e < 4; ++e) o[e] = pkbf(Cs[(32 * rq + 8 * e8 + 2 * e) * CS_LD + 64 * j + dv], Cs[(32 * rq + 8 * e8 + 2 * e + 1) * CS_LD + 64 * j + dv]);
        *(u32x4*)(dst + 8 * e8) = o;
    }
}

struct EpiIn {
    __device__ __forceinline__ void operator()(const Params& p, const float* Cs, int m0, int n0, int tid) const {
        const int cg = tid & 15, r0 = tid >> 4;
#pragma unroll 1
        for (int j = 0; j < 2; ++j) {
            const int n0j = n0 + 64 * j;
            if (n0j >= DIN) continue;
            if (n0j == 3840) {
                float* P = (float*)(p.ws + WS_P);
                float mx0 = 0.f, mx1 = 0.f;
#pragma unroll 1
                for (int i = 0; i < 8; ++i) {
                    const int rl = r0 + 16 * i, row = m0 + rl;
                    const float4 v = *(const float4*)&Cs[rl * CS_LD + 4 * cg];
                    float ss = (cg < 8) ? (v.x * v.x + v.y * v.y + v.z * v.z + v.w * v.w) : 0.f;
                    ss = group_sum8(ss);
                    if (i < 4) mx0 = fmaxf(mx0, ss); else mx1 = fmaxf(mx1, ss);
                    if (cg < 8) {
                        float* dst = (row < SEQ ? p.out + O_PAKI + (size_t)row * 32 : p.out + O_SAKI + (size_t)(row - SEQ) * 32) + 4 * cg; *(float4*)dst = v;
                        h16x4 hv; hv.x = (h16)v.x; hv.y = (h16)v.y; hv.z = (h16)v.z; hv.w = (h16)v.w;
                        h16* hd = row < SEQ ? (h16*)(p.ws + WS_IK_P) + (size_t)row * 32 : (h16*)(p.ws + WS_IK_S) + ((size_t)((row - SEQ) >> 6) * (PAST + DECS) + PAST + ((row - SEQ) & 63)) * 32;
                        *(h16x4*)(hd + 4 * cg) = hv;
                    }
                    else if (cg < 10) { *(float4*)(P + (size_t)row * LDP + PC_IW + 4 * (cg - 8)) = v; }
                }
                if (cg == 0) {
                    unsigned* ctl = (unsigned*)(p.ws + WS_CTL);
                    if (m0 < SEQ) atomicMax(ctl, __float_as_uint(fmaxf(mx0, mx1)));
                    else { const int b0 = (m0 - SEQ) >> 6; atomicMax(ctl + 1 + b0, __float_as_uint(mx0)); atomicMax(ctl + 2 + b0, __float_as_uint(mx1)); }
                }
                continue;
            }
            const Seg s = seg_of(p, n0j);
            float4 g4 = make_float4(1.f, 1.f, 1.f, 1.f);
            if (s.norm == 64) g4 = *(const float4*)(s.gain + 4 * cg);
            else if (s.norm == 32) g4 = *(const float4*)(s.gain + ((4 * cg) & 31));
#pragma unroll 1
            for (int i = 0; i < 8; ++i) {
                const int rl = r0 + 16 * i, row = m0 + rl;
                float4 v = *(const float4*)&Cs[rl * CS_LD + 64 * j + 4 * cg];
                if (s.norm) {
                    float ss = v.x * v.x + v.y * v.y + v.z * v.z + v.w * v.w;
                    float sc;
                    if (s.norm == 64) { ss = group_sum16(ss); sc = __builtin_amdgcn_rsqf(ss * (1.0f / 64.0f) + EPS); }
                    else { ss = group_sum8(ss); sc = __builtin_amdgcn_rsqf(ss * (1.0f / 32.0f) + EPS); }
                    v.x *= sc * g4.x; v.y *= sc * g4.y; v.z *= sc * g4.z; v.w *= sc * g4.w;
                }
                if (s.bp) *(float4*)((row < SEQ ? s.bp : s.bs) + (size_t)row * s.ld + s.col + 4 * cg) = v;
                h16* hb = row < SEQ ? s.hp : s.hs;
                if (hb) {
                    h16x4 hv; hv.x = (h16)(v.x * s.hscale); hv.y = (h16)(v.y * s.hscale); hv.z = (h16)(v.z * s.hscale); hv.w = (h16)(v.w * s.hscale);
                    *(h16x4*)(hb + (size_t)row * s.hld + s.hcol + 4 * cg) = hv;
                }
            }
            if (s.vt == 2 && m0 < SEQ) vt_store(Cs, j, (h16*)(p.ws + WS_VTB_P) + (size_t)(s.head * 64) * SEQ + m0, SEQ, tid);
            if (s.vt == 1 && m0 < SEQ) vt_store(Cs, j, (h16*)(p.ws + WS_VTA_P) + (size_t)(s.head * 64) * SEQ + m0, SEQ, tid);
        }
    }
};

struct EpiMem {
    __device__ __forceinline__ void operator()(const Params& p, const float* Cs, int m0, int n0, int tid) const {
        const int cg = tid & 15, r0 = tid >> 4;
#pragma unroll 1
        for (int j = 0; j < 2; ++j) {
            const int n0j = n0 + 64 * j;
            const bool isk = n0j < 256;
            const float4 g4 = isk ? *(const float4*)(p.in[24] + 4 * cg) : make_float4(1.f, 1.f, 1.f, 1.f);
#pragma unroll 1
            for (int i = 0; i < 8; ++i) {
                const int rl = r0 + 16 * i, row = m0 + rl;
                float4 v = *(const float4*)&Cs[rl * CS_LD + 64 * j + 4 * cg];
                if (isk) {
                    float ss = group_sum16(v.x * v.x + v.y * v.y + v.z * v.z + v.w * v.w);
                    const float sc = __builtin_amdgcn_rsqf(ss * (1.0f / 64.0f) + EPS);
                    v.x *= sc * g4.x; v.y *= sc * g4.y; v.z *= sc * g4.z; v.w *= sc * g4.w;
                    h16x4 hv; hv.x = (h16)v.x; hv.y = (h16)v.y; hv.z = (h16)v.z; hv.w = (h16)v.w;
                    *(h16x4*)((h16*)(p.ws + WS_MK_P) + (size_t)row * 256 + n0j + 4 * cg) = hv;
                }
                float* dst = p.out + (isk ? O_PMK : O_PMV) + (size_t)row * 256 + (isk ? n0j : n0j - 256) + 4 * cg;
                *(float4*)dst = v;
            }
            if (!isk) vt_store(Cs, j, (h16*)(p.ws + WS_MVT_P) + (size_t)(((n0j - 256) >> 6) * 64) * NMEM + m0, NMEM, tid);
        }
    }
};

struct EpiOut {
    __device__ __forceinline__ void operator()(const Params& p, const float* Cs, int m0, int n0, int tid) const {
        const int cg = tid & 15, r0 = tid >> 4;
        f32x4 xv[8][2];
#pragma unroll
        for (int i = 0; i < 8; ++i) {
            const int row = m0 + r0 + 16 * i;
            const float* x = (row < SEQ ? p.in[0] + (size_t)row * D : p.in[1] + (size_t)(row - SEQ) * D) + n0 + 4 * cg;
#pragma unroll
            for (int j = 0; j < 2; ++j) xv[i][j] = *(const f32x4*)(x + 64 * j);
        }
#pragma unroll
        for (int i = 0; i < 8; ++i) {
            const int rl = r0 + 16 * i, row = m0 + rl;
            float* y = (row < SEQ ? p.out + O_YP + (size_t)row * D : p.out + O_YS + (size_t)(row - SEQ) * D) + n0 + 4 * cg;
#pragma unroll
            for (int j = 0; j < 2; ++j) {
                const f32x4 v = *(const f32x4*)&Cs[rl * CS_LD + 64 * j + 4 * cg];
                *(f32x4*)(y + 64 * j) = xv[i][j] + v;
            }
        }
    }
};

__device__ void phase1(const Params& p, unsigned char* smem) {
    const h16* XH = (const h16*)(p.ws + WS_XH);
    const h16* HMH = (const h16*)(p.ws + WS_HMH);
    const h16* WTIN = (const h16*)(p.ws + WS_WTIN);
    const h16* WTMEM = (const h16*)(p.ws + WS_WTMEM);
    const EpiIn ein{}; const EpiMem emem{};
    const int G = gridDim.x;
    if ((G & 7) == 0) {
        const int xcd = blockIdx.x & 7, local = blockIdx.x >> 3, LG = G >> 3;
        for (int lin = local; lin < 6 * 96; lin += LG) {
            const int rgroup = lin / 96, rem = lin % 96, chalf = rem / 48, rem2 = rem % 48, r = rem2 >> 4, c = chalf * 16 + (rem2 & 15);
            if (c >= 31) continue;
            const int rt = xcd + 8 * (rgroup * 3 + r);
            gemm_tile(p, XH, WTIN, rt * 128, c * 128, smem, ein);
        }
        if (blockIdx.x < 8) { const int rt = blockIdx.x / 4, ct = blockIdx.x % 4; gemm_tile(p, HMH, WTMEM, rt * 128, ct * 128, smem, emem); }
    } else {
        constexpr int NCT = NPAD_IN / 128, NRT = MROWS / 128;
        constexpr int N_IN = NCT * NRT, N_MEM = 2 * 4;
        for (int it = blockIdx.x; it < N_IN + N_MEM; it += gridDim.x) {
            if (it < N_IN) { const int rt = it / NCT, ct = it % NCT; gemm_tile(p, XH, WTIN, rt * 128, ct * 128, smem, ein); }
            else { const int im = it - N_IN, rt = im / 4, ct = im % 4; gemm_tile(p, HMH, WTMEM, rt * 128, ct * 128, smem, emem); }
        }
    }
}

struct KeySrc {
    const float* cache; const float* fresh; int past; int ld;
    __device__ __forceinline__ const float* row(int k) const { return k < past ? cache + (size_t)k * ld : fresh + (size_t)(k - past) * ld; }
};

__device__ __forceinline__ unsigned fkey(float f) { const unsigned u = __float_as_uint(f); return (u & 0x80000000u) ? ~u : (u | 0x80000000u); }

struct SmemDsa {
    float sc[16384];
    float iq[256]; float iw[8];
    unsigned hist[256]; unsigned mw[512];
    int wcnt[4]; int wcnt2[4]; int misc[4];
};

__device__ void select_item(const Params& p, unsigned char* smem, int item) {
    SmemDsa& S = *(SmemDsa*)smem;
    int tid = threadIdx.x; asm volatile("" : "+v"(tid));
    const int lane = tid & 63, w = tid >> 6;
    const float* P = (const float*)(p.ws + WS_P);
    int row, N, mst; KeySrc ki; unsigned* mout;
    if (item < SEQ) {
        row = item; N = 64 * (item / 64 + 1);
        ki = KeySrc{nullptr, p.out + O_PAKI, 0, 32};
        mout = (unsigned*)(p.ws + WS_MASK_P) + item; mst = SEQ;
    } else {
        const int bt = item - SEQ, b = bt / DECS;
        row = item; N = PAST + DECS;
        ki = KeySrc{p.in[5] + (size_t)b * PAST * 32, p.out + O_SAKI + (size_t)b * DECS * 32, PAST, 32};
        mout = (unsigned*)(p.ws + WS_MASK_S) + (size_t)bt * 34; mst = 1;
    }
    const int nw = N / 32;
    __syncthreads();
    if (N <= 256) {
        if (tid < nw) mout[(size_t)tid * mst] = 0xffffffffu;
        return;
    }
    S.iq[tid] = P[(size_t)row * LDP + PC_IQ + tid];
    if (tid < 8) S.iw[tid] = P[(size_t)row * LDP + PC_IW + tid];
    S.mw[tid] = 0u; S.mw[tid + 256] = 0u;
    __syncthreads();
    for (int k = tid; k < N; k += NT) {
        const float4* kr = (const float4*)ki.row(k);
        float kd[32];
#pragma unroll
        for (int i = 0; i < 8; ++i) { const float4 t4 = kr[i]; kd[4 * i] = t4.x; kd[4 * i + 1] = t4.y; kd[4 * i + 2] = t4.z; kd[4 * i + 3] = t4.w; }
        float score = 0.f;
#pragma unroll 1
        for (int h = 0; h < 8; ++h) {
            float d = 0.f;
#pragma unroll
            for (int i = 0; i < 32; ++i) d = fmaf(S.iq[h * 32 + i], kd[i], d);
            score = fmaf(S.iw[h], fmaxf(d, 0.f), score);
        }
        S.sc[k] = score;
    }
    __syncthreads();
    unsigned prefix = 0; int remaining = 256;
    for (int pass = 0; pass < 4; ++pass) {
        const int shift = 24 - 8 * pass;
        S.hist[tid] = 0;
        __syncthreads();
        for (int k = tid; k < N; k += NT) {
            const unsigned key = fkey(S.sc[k]);
            if (pass == 0 || (key >> (shift + 8)) == prefix) atomicAdd(&S.hist[(key >> shift) & 255u], 1u);
        }
        __syncthreads();
        const int hv = (int)S.hist[tid];
        int x = hv;
#pragma unroll
        for (int o = 1; o < 64; o <<= 1) { const int y = __shfl_down(x, o); if (lane + o < 64) x += y; }
        if (lane == 0) S.wcnt[w] = x;
        __syncthreads();
        int above = x - hv;
        for (int w2 = w + 1; w2 < 4; ++w2) above += S.wcnt[w2];
        if (above < remaining && remaining <= above + hv) { S.misc[0] = (int)((prefix << 8) | (unsigned)tid); S.misc[1] = remaining - above; }
        __syncthreads();
        prefix = (unsigned)S.misc[0]; remaining = S.misc[1];
        __syncthreads();
    }
    const unsigned T = prefix; const int r = remaining;
    int base_eq = 0;
    const unsigned long long lt = (lane == 0) ? 0ull : (~0ull >> (64 - lane));
    for (int k0 = 0; k0 < N; k0 += NT) {
        const int k = k0 + tid;
        const unsigned key = (k < N) ? fkey(S.sc[k]) : 0u;
        const bool gt = (k < N) && key > T, eq = (k < N) && key == T;
        const unsigned long long beq = __ballot(eq);
        const int eqpre = __popcll(beq & lt);
        if (lane == 0) S.wcnt[w] = __popcll(beq);
        __syncthreads();
        int eqbase = base_eq, eqtot = 0;
        for (int w2 = 0; w2 < 4; ++w2) { const int c = S.wcnt[w2]; if (w2 < w) eqbase += c; eqtot += c; }
        const bool sel = gt || (eq && (eqbase + eqpre) < r);
        const unsigned long long bs = __ballot(sel);
        if (lane == 0) S.mw[(k0 >> 5) + 2 * w] = (unsigned)bs;
        if (lane == 32) S.mw[(k0 >> 5) + 2 * w + 1] = (unsigned)(bs >> 32);
        base_eq += eqtot;
        __syncthreads();
    }
    for (int i = tid; i < nw; i += NT) mout[(size_t)i * mst] = S.mw[i];
}

typedef float f32x4m __attribute__((ext_vector_type(4)));
constexpr int CAND_CAP = 256;
struct SelSm {
    unsigned hist[16][1025];
    int cnt[16]; int bstar[16]; int nabove[16]; int ovf[16];
};

__device__ __forceinline__ void score_tile(const h16x8& a, const h16x8 (&bq)[8], const float (&wq)[8], float (&sc)[4]) {
    sc[0] = 0.f; sc[1] = 0.f; sc[2] = 0.f; sc[3] = 0.f;
#pragma unroll
    for (int h = 0; h < 8; ++h) {
        f32x4m z = {0.f, 0.f, 0.f, 0.f};
        const f32x4m d = __builtin_amdgcn_mfma_f32_16x16x32_f16(a, bq[h], z, 0, 0, 0);
#pragma unroll
        for (int i = 0; i < 4; ++i) { const int bits = (int)__float_as_uint(d[i]); sc[i] = fmaf(wq[h], __uint_as_float((unsigned)(bits > 0 ? bits : 0)), sc[i]); }
    }
}

__device__ __forceinline__ int bin_of(float sc, float inv, float off) {
    const int b = min(max((int)fmaf(sc, inv, off), 0), 1021);
    int sgn;
    asm("v_med3_i32 %0, %1, -1, 1" : "=v"(sgn) : "v"(sc));
    return b + sgn + 1;
}

__device__ __forceinline__ void select_unit(const Params& p, unsigned char* smem, int u) {
    SelSm& S = *(SelSm*)smem;
    int tid = threadIdx.x; asm volatile("" : "+v"(tid));
    const int lane = tid & 63, w = __builtin_amdgcn_readfirstlane(tid >> 6), q = lane & 15, g = lane >> 4;
    int row0, N, ldm, ldw, kslot; const h16* IK; unsigned* mask;
    if (u < 1024) {
        const int q0 = 16 * (1023 - u);
        row0 = q0; N = 64 * (q0 / 64 + 1); IK = (const h16*)(p.ws + WS_IK_P); mask = (unsigned*)(p.ws + WS_MASK_P) + q0; ldm = 1; ldw = SEQ; kslot = 0;
    } else {
        const int bu = u - 1024, b = bu >> 2, t0 = 16 * (bu & 3);
        row0 = SEQ + 64 * b + t0; N = PAST + DECS; IK = (const h16*)(p.ws + WS_IK_S) + (size_t)b * (PAST + DECS) * 32;
        mask = (unsigned*)(p.ws + WS_MASK_S) + (size_t)(64 * b + t0) * 34; ldm = 34; ldw = 1; kslot = 1 + b;
    }
    const int nw = N / 32;
    __syncthreads();
    if (N <= 256) {
        for (int i = tid; i < 16 * nw; i += NT) mask[(size_t)(i & 15) * ldm + (size_t)(i >> 4) * ldw] = 0xffffffffu;
        return;
    }
    for (int i = tid; i < 16 * 1025; i += NT) ((unsigned*)S.hist)[i] = 0u;
    if (tid < 16) { S.cnt[tid] = 0; S.ovf[tid] = 0; S.bstar[tid] = 0; S.nabove[tid] = 0; }
    const int rowq = row0 + q;
    const h16* IQ = (const h16*)(p.ws + WS_IQ16) + (size_t)rowq * 256 + 8 * g;
    const float* Pf = (const float*)(p.ws + WS_P) + (size_t)rowq * LDP + PC_IW;
    h16x8 bq[8]; float wq[8];
    float hi = 0.f, lo = 0.f;
#pragma unroll
    for (int h = 0; h < 8; ++h) {
        bq[h] = *(const h16x8*)(IQ + h * 32);
        wq[h] = Pf[h];
        float n2 = 0.f;
#pragma unroll
        for (int e = 0; e < 8; ++e) { const float x = (float)bq[h][e]; n2 = fmaf(x, x, n2); }
        n2 += __shfl_xor(n2, 16); n2 += __shfl_xor(n2, 32);
        const float t = wq[h] * sqrtf(n2);
        if (t > 0.f) hi += t; else lo += t;
    }
    const float kmax = sqrtf(__uint_as_float(((const unsigned*)(p.ws + WS_CTL))[kslot])) * 1.01f;
    if (hi == 0.f) lo *= fmaxf(0.0625f, fminf(1.f, 1024.f / (float)N));
    hi = hi * kmax + 1e-6f; lo = lo * kmax - 1e-6f;
    const float inv = 1022.0f / fmaxf(hi - lo, 1e-20f), off = -lo * inv;
    __syncthreads();
    const h16* ikp = IK + (size_t)q * 32 + 8 * g;
    const int ngw = (nw - w + 3) >> 2;
#define SEL_LD(dst0, dst1, it_) do { const int gi_ = w + 4 * ((it_) < ngw ? (it_) : ngw - 1); \
        dst0 = *(const h16x8*)(ikp + (size_t)(32 * gi_) * 32); dst1 = *(const h16x8*)(ikp + (size_t)(32 * gi_ + 16) * 32); } while (0)
#define SEL_GROUP_A(x0, x1) do { _Pragma("unroll") for (int t = 0; t < 2; ++t) { \
            float sc[4]; score_tile(t == 0 ? x0 : x1, bq, wq, sc); \
            _Pragma("unroll") for (int i = 0; i < 4; ++i) { const int b = bin_of(sc[i], inv, off); atomicAdd(&S.hist[q][b], 1u); } } } while (0)
    {
        h16x8 a0, a1, b0, b1, c0, c1;
        SEL_LD(a0, a1, 0); SEL_LD(b0, b1, 1); SEL_LD(c0, c1, 2);
        asm volatile("" ::: "memory");
        for (int it = 0; it < ngw; it += 3) {
            SEL_GROUP_A(a0, a1);
            asm volatile("" ::: "memory"); SEL_LD(a0, a1, it + 3); asm volatile("" ::: "memory");
            if (it + 1 < ngw) SEL_GROUP_A(b0, b1);
            asm volatile("" ::: "memory"); SEL_LD(b0, b1, it + 4); asm volatile("" ::: "memory");
            if (it + 2 < ngw) SEL_GROUP_A(c0, c1);
            asm volatile("" ::: "memory"); SEL_LD(c0, c1, it + 5); asm volatile("" ::: "memory");
        }
    }
#undef SEL_GROUP_A
    __syncthreads();
    for (int qq = 0; qq < 4; ++qq) {
        const int qi = 4 * w + qq;
        unsigned c = 0;
#pragma unroll
        for (int e = 0; e < 16; ++e) c += S.hist[qi][16 * lane + e];
        int x = (int)c;
#pragma unroll
        for (int o = 1; o < 64; o <<= 1) { const int y = __shfl_down(x, o); if (lane + o < 64) x += y; }
        const int above = x - (int)c;
        if (above < 256 && 256 <= above + (int)c) {
            int acc = above, bs = 16 * lane;
            for (int e = 15; e >= 0; --e) {
                const int v = (int)S.hist[qi][16 * lane + e];
                if (acc + v >= 256) { bs = 16 * lane + e; break; }
                acc += v;
            }
            S.bstar[qi] = bs; S.nabove[qi] = acc;
        }
    }
    __syncthreads();
    const int bst = S.bstar[q];
    unsigned* mrow = (unsigned*)S.hist;
    constexpr int MROW_LD = 513;
    static_assert(16 * MROW_LD * 4 + 16 * CAND_CAP * 8 <= (int)sizeof(S.hist), "mask rows + candidate lists inside the histogram");
    float* cand_s = (float*)((unsigned char*)S.hist + 16 * MROW_LD * 4);
    int* cand_k = (int*)(cand_s + 16 * CAND_CAP);
    {
        h16x8 a0, a1, b0, b1, c0, c1;
        SEL_LD(a0, a1, 0); SEL_LD(b0, b1, 1); SEL_LD(c0, c1, 2);
        asm volatile("" ::: "memory");
        for (int it = 0; it < ngw; it += 3) {
#pragma unroll
          for (int gg = 0; gg < 3; ++gg) {
           if (gg == 0 || it + gg < ngw) {
            const int grp = w + 4 * (it + gg);
            unsigned byte = 0u;
#pragma unroll
            for (int t = 0; t < 2; ++t) {
                const int k0 = 32 * grp + 16 * t;
                float sc[4]; score_tile(gg == 0 ? (t == 0 ? a0 : a1) : gg == 1 ? (t == 0 ? b0 : b1) : (t == 0 ? c0 : c1), bq, wq, sc);
                unsigned nib = 0u;
#pragma unroll
                for (int i = 0; i < 4; ++i) {
                    const int b = bin_of(sc[i], inv, off);
                    if (b > bst) nib |= 1u << i;
                    else if (b == bst) {
                        const int pos = atomicAdd(&S.cnt[q], 1);
                        if (pos < CAND_CAP) { cand_s[q * CAND_CAP + pos] = sc[i]; cand_k[q * CAND_CAP + pos] = k0 + 4 * g + i; }
                    }
                }
                byte |= nib << (4 * t);
            }
            ((unsigned char*)mrow)[(q * MROW_LD + grp) * 4 + g] = (unsigned char)byte;
           }
            asm volatile("" ::: "memory");
            if (gg == 0) SEL_LD(a0, a1, it + 3); else if (gg == 1) SEL_LD(b0, b1, it + 4); else SEL_LD(c0, c1, it + 5);
            asm volatile("" ::: "memory");
          }
        }
    }
#undef SEL_LD
    __syncthreads();
    for (int qq = 0; qq < 4; ++qq) {
        const int qi = 4 * w + qq;
        const int m = S.cnt[qi], r = 256 - S.nabove[qi];
        if (m > CAND_CAP) { if (lane == 0) S.ovf[qi] = 1; continue; }
        const int nparts = (m + 63) >> 6;
        for (int part = 0; part < nparts; ++part) {
            const int me = lane + 64 * part;
            const float s_me = me < m ? cand_s[qi * CAND_CAP + me] : 0.f;
            const int k_me = me < m ? cand_k[qi * CAND_CAP + me] : 0;
            int rank = 0;
#pragma unroll 4
            for (int j = 0; j < m; ++j) { const float sj = cand_s[qi * CAND_CAP + j]; const int kj = cand_k[qi * CAND_CAP + j]; rank += (sj > s_me || (sj == s_me && kj < k_me)) ? 1 : 0; }
            if (me < m && rank < r) { const int kk = k_me & 31; atomicOr(&mrow[qi * MROW_LD + (k_me >> 5)], 1u << (8 * ((kk >> 2) & 3) + 4 * (kk >> 4) + (kk & 3))); }
        }
    }
    __syncthreads();
    for (int i = tid; i < 16 * nw; i += NT) {
        const int qi = i & 15, wd = i >> 4;
        if (S.ovf[qi]) continue;
        const unsigned wl = mrow[qi * MROW_LD + wd];
        unsigned x = wl & 0x0f0f0f0fu, y = (wl >> 4) & 0x0f0f0f0fu;
        x = (x | (x >> 4)) & 0x00ff00ffu; y = (y | (y >> 4)) & 0x00ff00ffu;
        x = (x | (x >> 8)) & 0x0000ffffu; y = (y | (y >> 8)) & 0x0000ffffu;
        mask[(size_t)qi * ldm + (size_t)wd * ldw] = x | (y << 16);
    }
    __syncthreads();
    if (tid == 0) {
        unsigned* rq = (unsigned*)(p.ws + WS_RQ);
        for (int qi = 0; qi < 16; ++qi) if (S.ovf[qi]) {
            const unsigned idx = __hip_atomic_fetch_add(rq, 1u, __ATOMIC_RELAXED, __HIP_MEMORY_SCOPE_AGENT);
            if (idx < (unsigned)RQ_CAP) __hip_atomic_store(rq + RQ_ITEMS + idx, (unsigned)(row0 + qi) + 1u, __ATOMIC_RELAXED, __HIP_MEMORY_SCOPE_AGENT);
        }
        asm volatile("s_waitcnt vmcnt(0)" ::: "memory");
    }
}

constexpr int ATT_TB_OFF = 32768;
constexpr int ATT_MASK_OFF = ATT_TB_OFF + 1024 + 16;
constexpr int ATT_LUT_OFF = ATT_MASK_OFF + 4096;
constexpr int ATT_LDS = ATT_LUT_OFF + 4096;

__device__ __forceinline__ int pi32(int r) { return (r & 0x13) | ((r & 4) << 1) | ((r & 8) >> 1); }
__device__ __forceinline__ unsigned pkrtz(float a, float b) { return __builtin_bit_cast(unsigned, __builtin_amdgcn_cvt_pkrtz(a, b)); }

struct AttnUnit {
    int row0, nrows, ntiles, qpos0, head;
    const h16* Kh; const h16* VTh; int ldk; int ldv;
    const float* Kc; const float* Vc; const float* Kn; const float* Vn; int ldf; int ntc;
    const unsigned* mask; int ldm;
};

template <int MODE, bool F32SRC, int NQ>
__device__ __forceinline__ void attn_unit(const Params& p, unsigned char* smem, const AttnUnit& U, float lam) {
    int tid = threadIdx.x; asm volatile("" : "+v"(tid));
    const int lane = tid & 63, w = __builtin_amdgcn_readfirstlane(tid >> 6), l31 = lane & 31, hh = lane >> 5;
    const int wq = (MODE == 1) ? (w & 1) : w, cmap = (MODE == 1) ? (w >> 1) : 0;
    const int qb = wq * 32 * NQ;
    const bool active = qb < U.nrows;
    const int chunk_w = (U.qpos0 + qb) >> 6;
    float* tb = (float*)(smem + ATT_TB_OFF);
    __syncthreads();
    if (MODE != 2) {
        if (tid < 255) { const int hc = (MODE == 0 ? U.head : 8 + U.head); tb[tid] = (p.in[10][rel_bucket(tid - 191) * 12 + hc] - p.in[10][15 * 12 + hc]) * LOG2E; }
    }
    if (MODE == 0) {
        u32x4 e4;
#pragma unroll
        for (int e = 0; e < 4; ++e) { const int t2 = (tid >> (2 * e)) & 3; e4[e] = ((t2 & 1) ? 0x0000ffffu : 0u) | ((t2 & 2) ? 0xffff0000u : 0u); }
        ((u32x4*)(smem + ATT_LUT_OFF))[tid] = e4;
    }
    constexpr int NQF = (MODE == 1) ? 2 : 4;
    h16x8 qf[NQ][NQF];
#pragma unroll
    for (int nq = 0; nq < NQ; ++nq) {
        if (active) {
            const int rowq = U.row0 + qb + 32 * nq + l31;
            const h16* Qb = (MODE == 0) ? (const h16*)(p.ws + WS_QA) + (size_t)rowq * 512 + U.head * 64
                          : (MODE == 1) ? (const h16*)(p.ws + WS_QB) + (size_t)rowq * 256 + U.head * 64 + 32 * cmap
                                        : (const h16*)(p.ws + WS_QC) + (size_t)rowq * 256 + U.head * 64;
#pragma unroll
            for (int s = 0; s < NQF; ++s) qf[nq][s] = *(const h16x8*)(Qb + 16 * s + 8 * hh);
        } else {
#pragma unroll
            for (int s = 0; s < NQF; ++s)
#pragma unroll
                for (int e = 0; e < 8; ++e) qf[nq][s][e] = (h16)0.f;
        }
    }
    f32x16 O[NQ][2];
    float lsum[NQ];
    const u32x4* lut = (const u32x4*)(smem + ATT_LUT_OFF);
#pragma unroll
    for (int nq = 0; nq < NQ; ++nq) {
        lsum[nq] = 0.f;
#pragma unroll
        for (int m = 0; m < 2; ++m)
#pragma unroll
            for (int r = 0; r < 16; ++r) O[nq][m][r] = 0.f;
    }
    int crow[2], cch[2], so[2];
#pragma unroll
    for (int i = 0; i < 2; ++i) { const int c = tid + 256 * i; crow[i] = c >> 3; cch[i] = c & 7; so[i] = crow[i] * 128 + ((cch[i] ^ ((crow[i] >> 1) & 7)) << 4); }
#define ATT_STAGE_F32(b, j) do { \
        unsigned char* kt_ = smem + (b) * 16384; unsigned char* vt_ = kt_ + 8192; \
        const float* kb_ = ((j) < U.ntc) ? U.Kc + (size_t)(64 * (j)) * U.ldf : U.Kn + (size_t)(64 * ((j) - U.ntc)) * U.ldf; \
        const float* vb_ = ((j) < U.ntc) ? U.Vc + (size_t)(64 * (j)) * U.ldf : U.Vn + (size_t)(64 * ((j) - U.ntc)) * U.ldf; \
        { f32x4 f_[2][2]; \
          _Pragma("unroll") for (int i = 0; i < 2; ++i) { const float* ks_ = kb_ + (size_t)crow[i] * U.ldf + cch[i] * 8; f_[i][0] = *(const f32x4*)ks_; f_[i][1] = *(const f32x4*)(ks_ + 4); } \
          _Pragma("unroll") for (int i = 0; i < 2; ++i) { h16x8 hk_; _Pragma("unroll") for (int e = 0; e < 4; ++e) { hk_[e] = (h16)f_[i][0][e]; hk_[4 + e] = (h16)f_[i][1][e]; } \
            *(h16x8*)(kt_ + so[i]) = hk_; } } \
        asm volatile("" ::: "memory"); \
        { f32x4 f_[2][2]; \
          _Pragma("unroll") for (int i = 0; i < 2; ++i) { const float* vs_ = vb_ + (size_t)crow[i] * U.ldf + cch[i] * 8; f_[i][0] = *(const f32x4*)vs_; f_[i][1] = *(const f32x4*)(vs_ + 4); } \
          _Pragma("unroll") for (int i = 0; i < 2; ++i) { const int key_ = crow[i]; \
            _Pragma("unroll") for (int e = 0; e < 8; ++e) { const int dv_ = 8 * cch[i] + e; \
                *(__bf16*)(vt_ + dv_ * 128 + (((key_ >> 3) ^ ((dv_ >> 1) & 7)) << 4) + (key_ & 7) * 2) = (__bf16)(e < 4 ? f_[i][0][e] : f_[i][1][e - 4]); } } } } while (0)
    f32x4 fk_[2][2], fv_[2][2];
#define ATT_LD_F32(j) do { \
        const float* kb_ = ((j) < U.ntc) ? U.Kc + (size_t)(64 * (j)) * U.ldf : U.Kn + (size_t)(64 * ((j) - U.ntc)) * U.ldf; \
        const float* vb_ = ((j) < U.ntc) ? U.Vc + (size_t)(64 * (j)) * U.ldf : U.Vn + (size_t)(64 * ((j) - U.ntc)) * U.ldf; \
        _Pragma("unroll") for (int i = 0; i < 2; ++i) { const float* ks_ = kb_ + (size_t)crow[i] * U.ldf + cch[i] * 8; fk_[i][0] = *(const f32x4*)ks_; fk_[i][1] = *(const f32x4*)(ks_ + 4); \
                                                        const float* vs_ = vb_ + (size_t)crow[i] * U.ldf + cch[i] * 8; fv_[i][0] = *(const f32x4*)vs_; fv_[i][1] = *(const f32x4*)(vs_ + 4); } } while (0)
#define ATT_ST_F32(b) do { \
        unsigned char* kt_ = smem + (b) * 16384; unsigned char* vt_ = kt_ + 8192; \
        _Pragma("unroll") for (int i = 0; i < 2; ++i) { h16x8 hk_; _Pragma("unroll") for (int e = 0; e < 4; ++e) { hk_[e] = (h16)fk_[i][0][e]; hk_[4 + e] = (h16)fk_[i][1][e]; } \
            *(h16x8*)(kt_ + so[i]) = hk_; } \
        _Pragma("unroll") for (int i = 0; i < 2; ++i) { const int key_ = crow[i]; \
            _Pragma("unroll") for (int e = 0; e < 8; ++e) { const int dv_ = 8 * cch[i] + e; \
                *(__bf16*)(vt_ + dv_ * 128 + (((key_ >> 3) ^ ((dv_ >> 1) & 7)) << 4) + (key_ & 7) * 2) = (__bf16)(e < 4 ? fv_[i][0][e] : fv_[i][1][e - 4]); } } } while (0)
    const int drow0 = 16 * w + (lane >> 3), drow1 = drow0 + 8;
    const int dch0 = (lane & 7) ^ ((drow0 >> 1) & 7), dch1 = (lane & 7) ^ ((drow1 >> 1) & 7);
    const unsigned char* kbase = F32SRC ? nullptr : (const unsigned char*)U.Kh;
    const unsigned char* vbase = F32SRC ? nullptr : (const unsigned char*)U.VTh;
    const unsigned kof0 = (unsigned)(drow0 * U.ldk + dch0 * 8) * 2u, kof1 = (unsigned)(drow1 * U.ldk + dch1 * 8) * 2u;
    const size_t vof0 = ((size_t)drow0 * U.ldv + dch0 * 8) * 2, vof1 = ((size_t)drow1 * U.ldv + dch1 * 8) * 2;
    const int dmo0 = (16 * w) * 128, dmo1 = (16 * w + 8) * 128;
#define ATT_DMA(b, j) do { \
        const unsigned char* kt_ = kbase + (size_t)(64 * (j)) * U.ldk * 2; const unsigned char* vt_ = vbase + (size_t)(64 * (j)) * 2; \
        __builtin_amdgcn_global_load_lds((const unsigned*)(kt_ + kof0), (__attribute__((address_space(3))) unsigned*)(smem + (b) * 16384 + dmo0), 16, 0, 0); \
        __builtin_amdgcn_global_load_lds((const unsigned*)(vt_ + vof0), (__attribute__((address_space(3))) unsigned*)(smem + (b) * 16384 + 8192 + dmo0), 16, 0, 0); \
        __builtin_amdgcn_global_load_lds((const unsigned*)(kt_ + kof1), (__attribute__((address_space(3))) unsigned*)(smem + (b) * 16384 + dmo1), 16, 0, 0); \
        __builtin_amdgcn_global_load_lds((const unsigned*)(vt_ + vof1), (__attribute__((address_space(3))) unsigned*)(smem + (b) * 16384 + 8192 + dmo1), 16, 0, 0); } while (0)
    const unsigned* mq = (MODE == 0 && NQ == 2) ? U.mask + qb + lane : nullptr;
#define ATT_MASK_DMA(b, j) do { \
        __builtin_amdgcn_global_load_lds(mq + (size_t)(2 * (j)) * SEQ, (__attribute__((address_space(3))) unsigned*)(smem + ATT_MASK_OFF + (((b) * 4 + w) * 2) * 256), 4, 0, 0); \
        __builtin_amdgcn_global_load_lds(mq + (size_t)(2 * (j) + 1) * SEQ, (__attribute__((address_space(3))) unsigned*)(smem + ATT_MASK_OFF + (((b) * 4 + w) * 2 + 1) * 256), 4, 0, 0); } while (0)
    if constexpr (MODE == 0 && NQ == 2) { ATT_MASK_DMA(0, 0); }
    if constexpr (!F32SRC) { ATT_DMA(0, 0); } else { ATT_STAGE_F32(0, 0); }
    const unsigned* mrow[NQ];
    unsigned mwn[NQ][2];
#pragma unroll
    for (int nq = 0; nq < NQ; ++nq) {
        mrow[nq] = (MODE == 0 && NQ == 1) ? U.mask + (size_t)(qb + 32 * nq + l31) * U.ldm : nullptr;
        mwn[nq][0] = 0xffffffffu; mwn[nq][1] = 0xffffffffu;
        if (MODE == 0 && NQ == 1) { mwn[nq][0] = mrow[nq][0]; mwn[nq][1] = mrow[nq][1]; }
    }
    __syncthreads();
    const int pil = pi32(l31), ksw = (pil >> 1) & 7, vsw = (l31 >> 1) & 7;
    const int jlast = U.ntiles - 1;
    for (int j = 0; j < U.ntiles; ++j) {
        const int buf = j & 1;
        const int jn = j < jlast ? j + 1 : jlast;
        unsigned mw[NQ][2];
#pragma unroll
        for (int nq = 0; nq < NQ; ++nq) {
            if (NQ == 1) {
                mw[nq][0] = mwn[nq][0] >> (8 * hh); mw[nq][1] = mwn[nq][1] >> (8 * hh);
                if (MODE == 0) { mwn[nq][0] = mrow[nq][2 * jn]; mwn[nq][1] = mrow[nq][2 * jn + 1]; }
            } else {
                mw[nq][0] = 0xffffffffu; mw[nq][1] = 0xffffffffu;
                if (MODE == 0) {
                    const unsigned* ml = (const unsigned*)(smem + ATT_MASK_OFF + ((buf * 4 + w) * 2) * 256) + 32 * nq + l31;
                    mw[nq][0] = ml[0] >> (8 * hh); mw[nq][1] = ml[64] >> (8 * hh);
                }
            }
        }
        if constexpr (MODE == 0 && NQ == 2) { ATT_MASK_DMA(buf ^ 1, jn); }
        if constexpr (!F32SRC) ATT_DMA(buf ^ 1, jn);
        if constexpr (F32SRC) { ATT_LD_F32(jn); }
        if (active && (MODE == 2 || j <= chunk_w)) {
            const unsigned char* Kt = smem + buf * 16384;
            const unsigned char* Vt = Kt + 8192;
            const bool near = (MODE != 2) && (j >= chunk_w - 2);
#pragma unroll
            for (int u = 0; u < 2; ++u) {
                const unsigned char* kp = Kt + (32 * u + pil) * 128;
                bf16x8 pf[NQ][2];
                h16x8 kf[NQF];
#pragma unroll
                for (int s = 0; s < NQF; ++s) { const int ch = (MODE == 1) ? (4 * cmap + 2 * s + hh) : (2 * s + hh); kf[s] = *(const h16x8*)(kp + ((ch ^ ksw) << 4)); }
                u32x4 mk4h[NQ][2];
#pragma unroll
                for (int nq = 0; nq < NQ; ++nq)
#pragma unroll
                    for (int s2 = 0; s2 < 2; ++s2) {
                        mk4h[nq][s2] = (u32x4){0xffffffffu, 0xffffffffu, 0xffffffffu, 0xffffffffu};
                        if (MODE == 0) mk4h[nq][s2] = lut[(mw[nq][u] >> (16 * s2)) & 0xffu];
                    }
#pragma unroll
                for (int nq = 0; nq < NQ; ++nq) {
                    f32x16 S;
#pragma unroll
                    for (int r = 0; r < 16; ++r) S[r] = 0.f;
#pragma unroll
                    for (int s = 0; s < NQF; ++s) S = __builtin_amdgcn_mfma_f32_32x32x16_f16(kf[s], qf[nq][s], S, 0, 0, 0);
                    if (near) {
                        const int base = 64 * j + 32 * u + 8 * hh - (U.qpos0 + qb + 32 * nq + l31) + 191;
#pragma unroll
                        for (int i = 0; i < 16; ++i) S[i] += tb[base + (i & 7) + 16 * (i >> 3)];
                    }
#pragma unroll
                    for (int i = 0; i < 16; ++i) S[i] = __builtin_amdgcn_exp2f(S[i]);
#pragma unroll
                    for (int s2 = 0; s2 < 2; ++s2) {
                        u32x4 pk;
                        const u32x4 mk4 = mk4h[nq][s2];
#pragma unroll
                        for (int e = 0; e < 4; ++e) {
                            unsigned v = pkbf(S[8 * s2 + 2 * e], S[8 * s2 + 2 * e + 1]);
                            if (MODE == 0) v &= mk4[e];
                            lsum[nq] = __builtin_amdgcn_fdot2_f32_bf16(__builtin_bit_cast(bf16x2, v), __builtin_bit_cast(bf16x2, 0x3f803f80u), lsum[nq], false);
                            pk[e] = v;
                        }
                        pf[nq][s2] = __builtin_bit_cast(bf16x8, pk);
                    }
                }
#pragma unroll
                for (int m = 0; m < 2; ++m)
#pragma unroll
                    for (int s2 = 0; s2 < 2; ++s2) {
                        const bf16x8 vfr = *(const bf16x8*)(Vt + (32 * m + l31) * 128 + (((2 * (2 * u + s2) + hh) ^ vsw) << 4));
#pragma unroll
                        for (int nq = 0; nq < NQ; ++nq) O[nq][m] = __builtin_amdgcn_mfma_f32_32x32x16_bf16(vfr, pf[nq][s2], O[nq][m], 0, 0, 0);
                    }
            }
        }
        if constexpr (F32SRC) { ATT_ST_F32(buf ^ 1); }
        __syncthreads();
    }
#undef ATT_STAGE_F32
#undef ATT_LD_F32
#undef ATT_ST_F32
#undef ATT_DMA
#undef ATT_MASK_DMA
    float inv[NQ];
#pragma unroll
    for (int nq = 0; nq < NQ; ++nq) { const float l = lsum[nq] + __shfl_xor(lsum[nq], 32); inv[nq] = 1.0f / l; }
    if (MODE == 1) {
        float* X = (float*)smem;
        if (cmap == 1) {
#pragma unroll
            for (int nq = 0; nq < NQ; ++nq)
#pragma unroll
                for (int m = 0; m < 2; ++m)
#pragma unroll
                    for (int i = 0; i < 16; ++i) X[((wq * NQ + nq) * 32 + m * 16 + i) * 64 + lane] = O[nq][m][i] * inv[nq];
        }
        __syncthreads();
        if (cmap == 1) return;
#pragma unroll
        for (int nq = 0; nq < NQ; ++nq)
#pragma unroll
            for (int m = 0; m < 2; ++m)
#pragma unroll
                for (int i = 0; i < 16; ++i) O[nq][m][i] = O[nq][m][i] * inv[nq] - lam * X[((wq * NQ + nq) * 32 + m * 16 + i) * 64 + lane];
    } else {
        if (!active) return;
#pragma unroll
        for (int nq = 0; nq < NQ; ++nq)
#pragma unroll
            for (int m = 0; m < 2; ++m)
#pragma unroll
                for (int i = 0; i < 16; ++i) O[nq][m][i] *= inv[nq];
    }
    const int colbase = (MODE == 0 ? 0 : (MODE == 1 ? 512 : 768)) + U.head * 64;
#pragma unroll
    for (int nq = 0; nq < NQ; ++nq) {
        const int rowq = U.row0 + qb + 32 * nq + l31;
        const h16* G = (const h16*)(p.ws + WS_G) + (size_t)rowq * 1024 + colbase;
        h16* Oo = (h16*)(p.ws + WS_O16) + (size_t)rowq * 1024 + colbase;
        float sc = 1.f;
        if (MODE == 1) {
            float ss = 0.f;
#pragma unroll
            for (int m = 0; m < 2; ++m)
#pragma unroll
                for (int i = 0; i < 16; ++i) ss = fmaf(O[nq][m][i], O[nq][m][i], ss);
            ss += __shfl_xor(ss, 32);
            sc = (1.0f / sqrtf(ss * (1.0f / 64.0f) + EPS)) * 0.8f;
        }
#pragma unroll
        for (int m = 0; m < 2; ++m)
#pragma unroll
            for (int g4 = 0; g4 < 4; ++g4) {
                const int dv = 32 * m + 8 * g4 + 4 * hh;
                const h16x4 gv = *(const h16x4*)(G + dv);
                h16x4 o4;
#pragma unroll
                for (int e = 0; e < 4; ++e) {
                    float o = O[nq][m][4 * g4 + e];
                    if (MODE == 1) o = o * sc * p.in[18][dv + e];
                    o4[e] = (h16)(o * silu((float)gv[e]));
                }
                *(h16x4*)(Oo + dv) = o4;
            }
    }
}

__device__ __forceinline__ AttnUnit unit_zero() {
    AttnUnit U; U.row0 = 0; U.nrows = 0; U.ntiles = 0; U.qpos0 = 0; U.head = 0; U.Kh = nullptr; U.VTh = nullptr; U.ldk = 0; U.ldv = 0;
    U.Kc = nullptr; U.Vc = nullptr; U.Kn = nullptr; U.Vn = nullptr; U.ldf = 0; U.ntc = 0; U.mask = nullptr; U.ldm = 0; return U;
}
__device__ __forceinline__ void unit_a_prompt(const Params& p, unsigned char* smem, int g, int head) {
    AttnUnit U = unit_zero();
    U.row0 = 256 * g; U.nrows = 256; U.ntiles = 4 * g + 4; U.qpos0 = 256 * g; U.head = head;
    U.Kh = (const h16*)(p.ws + WS_KA_P) + head * 64; U.ldk = 512;
    U.VTh = (const h16*)(p.ws + WS_VTA_P) + (size_t)(head * 64) * SEQ; U.ldv = SEQ;
    U.mask = (const unsigned*)(p.ws + WS_MASK_P) + 256 * g; U.ldm = 0;
    attn_unit<0, false, 2>(p, smem, U, 0.f);
}
__device__ __forceinline__ void unit_b_prompt(const Params& p, unsigned char* smem, int g, int head, float lam) {
    AttnUnit U = unit_zero();
    U.row0 = 128 * g; U.nrows = 128; U.ntiles = 2 * g + 2; U.qpos0 = 128 * g; U.head = head;
    U.Kh = (const h16*)(p.ws + WS_KB_P) + head * 64; U.ldk = 256;
    U.VTh = (const h16*)(p.ws + WS_VTB_P) + (size_t)(head * 64) * SEQ; U.ldv = SEQ;
    attn_unit<1, false, 2>(p, smem, U, lam);
}
__device__ __forceinline__ void unit_a_sample(const Params& p, unsigned char* smem, int b, int head) {
    AttnUnit U = unit_zero();
    U.row0 = SEQ + 64 * b; U.nrows = 64; U.ntiles = 17; U.qpos0 = PAST; U.head = head;
    U.Kc = p.in[3] + (size_t)b * PAST * 512 + head * 64; U.Vc = p.in[4] + (size_t)b * PAST * 512 + head * 64;
    U.Kn = p.out + O_SAK + (size_t)b * DECS * 512 + head * 64; U.Vn = p.out + O_SAV + (size_t)b * DECS * 512 + head * 64;
    U.ldf = 512; U.ntc = 16;
    U.mask = (const unsigned*)(p.ws + WS_MASK_S) + (size_t)(64 * b) * 34; U.ldm = 34;
    attn_unit<0, true, 1>(p, smem, U, 0.f);
}
__device__ __forceinline__ void unit_b_sample(const Params& p, unsigned char* smem, int b, int head, float lam) {
    AttnUnit U = unit_zero();
    U.row0 = SEQ + 64 * b; U.nrows = 64; U.ntiles = 17; U.qpos0 = PAST; U.head = head;
    U.Kc = p.in[6] + (size_t)b * PAST * 256 + head * 64; U.Vc = p.in[7] + (size_t)b * PAST * 256 + head * 64;
    U.Kn = p.out + O_SBK + (size_t)b * DECS * 256 + head * 64; U.Vn = p.out + O_SBV + (size_t)b * DECS * 256 + head * 64;
    U.ldf = 256; U.ntc = 16;
    attn_unit<1, true, 1>(p, smem, U, lam);
}
__device__ __forceinline__ void unit_c_prompt(const Params& p, unsigned char* smem, int g, int head) {
    AttnUnit U = unit_zero();
    U.row0 = 128 * g; U.nrows = 128; U.ntiles = 4; U.head = head;
    U.Kh = (const h16*)(p.ws + WS_MK_P) + head * 64; U.ldk = 256;
    U.VTh = (const h16*)(p.ws + WS_MVT_P) + (size_t)(head * 64) * NMEM; U.ldv = NMEM;
    attn_unit<2, false, 1>(p, smem, U, 0.f);
}
__device__ __forceinline__ void unit_c_sample(const Params& p, unsigned char* smem, int b, int head) {
    AttnUnit U = unit_zero();
    U.row0 = SEQ + 64 * b; U.nrows = 64; U.ntiles = 4; U.head = head;
    U.Kc = p.in[8] + (size_t)b * NMEM * 256 + head * 64; U.Vc = p.in[9] + (size_t)b * NMEM * 256 + head * 64;
    U.Kn = U.Kc; U.Vn = U.Vc; U.ldf = 256; U.ntc = 4;
    attn_unit<2, true, 1>(p, smem, U, 0.f);
}

#define ZIGZAG_LOOP(NALL) for (int zk_ = 0, pos_ = 0; zk_ * (int)gridDim.x < (NALL); ++zk_) \
    if ((pos_ = (zk_ & 1) ? (zk_ + 1) * (int)gridDim.x - 1 - (int)blockIdx.x : zk_ * (int)gridDim.x + (int)blockIdx.x) < (NALL))

__device__ __forceinline__ float diff_lambda_of(const Params& p) {
    float s1 = 0.f, s2 = 0.f;
    for (int i = 0; i < 32; ++i) { s1 = fmaf(p.in[19][i], p.in[20][i], s1); s2 = fmaf(p.in[21][i], p.in[22][i], s2); }
    return expf(s1) - expf(s2) + 0.2f;
}

__device__ void phase2(const Params& p, unsigned char* smem) {
    const float lam = diff_lambda_of(p);
    constexpr int N_SP = 1024, N_BS = 128, N_SS = 128, N_CS = 128, N_CP = 512;
    constexpr int N_SMALL = N_BS + N_SS + N_CS + N_CP;
    const int G = gridDim.x;
    unsigned* tk = (unsigned*)(p.ws + WS_RQ) + 192;
    volatile int* tslot = (volatile int*)(smem + SMEM_BYTES - 32);
#pragma unroll 1
    for (int step = 0;; ++step) {
        int it;
        if (step * G < N_SP) {
            it = (step & 1) ? (step + 1) * G - 1 - (int)blockIdx.x : step * G + (int)blockIdx.x;
            if (it >= N_SP) continue;
        } else {
            __syncthreads();
            if (threadIdx.x == 0) *tslot = (int)__hip_atomic_fetch_add(tk, 1u, __ATOMIC_RELAXED, __HIP_MEMORY_SCOPE_AGENT);
            __syncthreads();
            const int t = __builtin_amdgcn_readfirstlane(*tslot);
            if (t >= N_SMALL) break;
            it = N_SP + t;
        }
        {
            const int ss = it - (N_SP + N_BS);
            const int su = it < N_SP ? it : ((ss >= 0 && ss < N_SS) ? 1024 + ss : -1);
            if (su >= 0) { select_unit(p, smem, su); continue; }
        }
        it -= N_SP;
        if (it < N_BS) { unit_b_sample(p, smem, it >> 2, it & 3, lam); continue; }
        it -= N_BS + N_SS;
        if (it < N_CS) { unit_c_sample(p, smem, it >> 2, it & 3); continue; }
        it -= N_CS;
        unit_c_prompt(p, smem, it >> 2, it & 3);
    }
    {
        unsigned* rq = (unsigned*)(p.ws + WS_RQ);
        volatile int* slot = (volatile int*)(smem + SMEM_BYTES - 32);
        __syncthreads();
        if (threadIdx.x == 0) { asm volatile("s_waitcnt vmcnt(0)" ::: "memory"); __hip_atomic_fetch_add(rq + 128, 1u, __ATOMIC_RELAXED, __HIP_MEMORY_SCOPE_AGENT); }
#pragma unroll 1
        for (;;) {
            if (threadIdx.x == 0) {
                int row = -1;
                for (unsigned sp = 0;; ++sp) {
                    const unsigned hd = __hip_atomic_load(rq + 64, __ATOMIC_RELAXED, __HIP_MEMORY_SCOPE_AGENT);
                    const unsigned tl = __hip_atomic_load(rq, __ATOMIC_RELAXED, __HIP_MEMORY_SCOPE_AGENT);
                    if (hd < tl) {
                        const unsigned my = __hip_atomic_fetch_add(rq + 64, 1u, __ATOMIC_RELAXED, __HIP_MEMORY_SCOPE_AGENT);
                        for (unsigned sp2 = 0;; ++sp2) {
                            const unsigned it = my < (unsigned)RQ_CAP ? __hip_atomic_load(rq + RQ_ITEMS + my, __ATOMIC_RELAXED, __HIP_MEMORY_SCOPE_AGENT) : 0u;
                            if (it != 0u) { row = (int)it - 1; break; }
                            if (__hip_atomic_load(rq + 128, __ATOMIC_RELAXED, __HIP_MEMORY_SCOPE_AGENT) >= gridDim.x &&
                                __hip_atomic_load(rq, __ATOMIC_RELAXED, __HIP_MEMORY_SCOPE_AGENT) <= my) break;
                            __builtin_amdgcn_s_sleep(4);
                            if (sp2 > (1u << 22)) break;
                        }
                        if (row >= 0) break;
                        continue;
                    }
                    if (__hip_atomic_load(rq + 128, __ATOMIC_RELAXED, __HIP_MEMORY_SCOPE_AGENT) >= gridDim.x) {
                        __builtin_amdgcn_fence(__ATOMIC_ACQUIRE, "agent");
                        if (__hip_atomic_load(rq + 64, __ATOMIC_RELAXED, __HIP_MEMORY_SCOPE_AGENT) >= __hip_atomic_load(rq, __ATOMIC_RELAXED, __HIP_MEMORY_SCOPE_AGENT)) break;
                    }
                    __builtin_amdgcn_s_sleep(16);
                    if (sp > (1u << 22)) break;
                }
                *slot = row;
            }
            __syncthreads();
            const int row = __builtin_amdgcn_readfirstlane(*slot);
            if (row < 0) break;
            select_item(p, smem, row);
            __syncthreads();
        }
    }
}

__device__ void phase3(const Params& p, unsigned char* smem) {
    const float lam = diff_lambda_of(p);
    const int G = gridDim.x;
    for (int i0 = blockIdx.x; i0 < 512; i0 += G) {
        const int i = (G == 512 && i0 >= 256) ? 8 * (95 - (i0 >> 3)) + (i0 & 7) : i0;
        { const int g = 63 - (i >> 3), head = i & 7; unit_a_prompt(p, smem, g, head); }
        { const int r = 511 - i, g = 127 - (r >> 2), head = r & 3; unit_b_prompt(p, smem, g, head, lam); }
    }
    {
        unsigned* tk = (unsigned*)(p.ws + WS_RQ) + 200;
        volatile int* tslot = (volatile int*)(smem + SMEM_BYTES - 32);
#pragma unroll 1
        for (;;) {
            __syncthreads();
            if (threadIdx.x == 0) *tslot = (int)__hip_atomic_fetch_add(tk, 1u, __ATOMIC_RELAXED, __HIP_MEMORY_SCOPE_AGENT);
            __syncthreads();
            const int t = __builtin_amdgcn_readfirstlane(*tslot);
            if (t >= 256) break;
            unit_a_sample(p, smem, t >> 3, t & 7);
        }
    }
}

__device__ void phase4(const Params& p, unsigned char* smem) {
    const h16* O16 = (const h16*)(p.ws + WS_O16);
    const h16* WTOUT = (const h16*)(p.ws + WS_WTOUT);
    constexpr int NCT = D / 128, NRT = MROWS / 128;
    const EpiOut eo{};
    const int G = gridDim.x;
    if ((G & 7) == 0) {
        const int xcd = blockIdx.x & 7, local = blockIdx.x >> 3, LG = G >> 3;
        for (int lin = local; lin < (NRT / 8) * NCT; lin += LG) {
            const int rt = xcd + 8 * (lin / NCT), ct = lin % NCT;
            gemm_tile(p, O16, WTOUT, rt * 128, ct * 128, smem, eo);
        }
    } else {
        for (int it = blockIdx.x; it < NCT * NRT; it += gridDim.x) {
            const int rt = it / NCT, ct = it % NCT;
            gemm_tile(p, O16, WTOUT, rt * 128, ct * 128, smem, eo);
        }
    }
}


constexpr int XB_TMO = 128, XB_TOP = 3328, XB_TOPGEN = 3392;
__device__ __forceinline__ int xb_xcnt(unsigned j) { return 256 + 64 * (int)j; }
__device__ __forceinline__ int xb_xsub(unsigned j) { return 1280 + 64 * (int)j; }
__device__ __forceinline__ int xb_xgen(unsigned j) { return 2304 + 64 * (int)j; }
__device__ __forceinline__ unsigned xb_ld(unsigned* q) { return __hip_atomic_load(q, __ATOMIC_RELAXED, __HIP_MEMORY_SCOPE_AGENT); }
__device__ __forceinline__ unsigned xb_add(unsigned* q, unsigned v) { return __hip_atomic_fetch_add(q, v, __ATOMIC_RELAXED, __HIP_MEMORY_SCOPE_AGENT); }
__device__ __forceinline__ unsigned xb_xcc_id() { return (unsigned)__builtin_amdgcn_s_getreg((3 << 11) | 20) & 0xFu; }
#define XB_SPIN(cond, bar) do { unsigned sp_ = 0; while (cond) { __builtin_amdgcn_s_sleep(1); \
    if ((++sp_ & 255u) == 0u) { if (xb_ld(&(bar)[XB_TMO])) break; if (sp_ > (1u << 20)) { atomicAdd(&(bar)[XB_TMO], 1u); break; } } } } while (0)
__device__ __forceinline__ void xcd_barrier(unsigned* bar, unsigned x, volatile unsigned* st) {
    asm volatile("s_waitcnt vmcnt(0)" ::: "memory");
    __syncthreads();
    if (threadIdx.x == 0) {
        __builtin_amdgcn_s_waitcnt(0);
        unsigned nloc = st[0], nx = st[1];
        if (nloc == 0u) {
            const unsigned G = gridDim.x;
            unsigned sum, cnt, mine, sp = 0u;
            for (;;) {
                sum = 0u; cnt = 0u; mine = 0u;
#pragma unroll
                for (unsigned j = 0; j < 16; ++j) { const unsigned c = xb_ld(&bar[xb_xcnt(j)]); sum += c; cnt += (c > 0u) ? 1u : 0u; mine = (j == x) ? c : mine; }
                if (sum == G) break;
                __builtin_amdgcn_s_sleep(1);
                if ((++sp & 255u) == 0u) { if (xb_ld(&bar[XB_TMO])) break; if (sp > (1u << 20)) { atomicAdd(&bar[XB_TMO], 1u); break; } }
            }
            nloc = mine > 0u ? mine : 1u; nx = cnt > 0u ? cnt : 1u;
            st[0] = nloc; st[1] = nx;
        }
        const unsigned old = xb_add(&bar[xb_xsub(x)], 1u);
        const unsigned gen = old / nloc;
        if (old + 1u == (gen + 1u) * nloc) {
            __builtin_amdgcn_fence(__ATOMIC_RELEASE, "agent");
            asm volatile("s_waitcnt vmcnt(0)" ::: "memory");
            const unsigned og = xb_add(&bar[XB_TOP], 1u);
            const unsigned tg = og / nx;
            if (og + 1u == (tg + 1u) * nx) xb_add(&bar[XB_TOPGEN], 1u);
            else XB_SPIN(xb_ld(&bar[XB_TOPGEN]) == tg, bar);
            __builtin_amdgcn_fence(__ATOMIC_ACQUIRE, "agent");
            xb_add(&bar[xb_xgen(x)], 1u);
            asm volatile("s_waitcnt vmcnt(0)" ::: "memory");
        } else {
            XB_SPIN(xb_ld(&bar[xb_xgen(x)]) == gen, bar);
            __builtin_amdgcn_fence(__ATOMIC_ACQUIRE, "agent");
            asm volatile("s_waitcnt vmcnt(0)" ::: "memory");
        }
    }
    __syncthreads();
}

__global__ void __launch_bounds__(NT, 2) fwd_kernel(Params p) {
    __shared__ __attribute__((aligned(16))) unsigned char smem[SMEM_BYTES];
    static_assert(ATT_LDS <= SMEM_BYTES && sizeof(SmemDsa) <= SMEM_BYTES && sizeof(SelSm) <= SMEM_BYTES && CS_LD * 128 * 4 <= SMEM_BYTES, "smem");
    unsigned* xbar = (unsigned*)(p.ws + WS_XBAR);
    volatile unsigned* xst = (volatile unsigned*)(smem + SMEM_BYTES - 16);
    static_assert(ATT_LDS <= SMEM_BYTES - 32 && sizeof(SmemDsa) <= SMEM_BYTES - 32 && sizeof(SelSm) <= SMEM_BYTES - 32 && CS_LD * 128 * 4 <= SMEM_BYTES - 32, "barrier words, redo slot");
    const unsigned xcc = xb_xcc_id();
    if (threadIdx.x == 0) { xst[0] = 0u; xst[1] = 0u; (void)xb_add(&xbar[xb_xcnt(xcc)], 1u); }
    __syncthreads();
#define SEAM() xcd_barrier(xbar, xcc, xst)
    phase0(p, smem);
    if (p.ph_lo > 0) cg::this_grid().sync(); else SEAM();
    phase1(p, smem); SEAM();
    phase2(p, smem); SEAM();
    phase3(p, smem); SEAM();
    phase4(p, smem);
#undef SEAM
}

extern "C" void kernel_launch(void* const* d_in, const int* in_sizes, int n_in, void* d_out, int out_size, void* d_ws, size_t ws_size, hipStream_t stream) {
    static int grid_blocks = 0;
    if (!grid_blocks) {
        int dev = 0, cus = 0, per_cu = 0;
        (void)hipGetDevice(&dev);
        (void)hipDeviceGetAttribute(&cus, hipDeviceAttributeMultiprocessorCount, dev);
        (void)hipOccupancyMaxActiveBlocksPerMultiprocessor(&per_cu, fwd_kernel, NT, 0);
        if (per_cu < 1) per_cu = 1;
        if (per_cu > (160 * 1024) / SMEM_BYTES) per_cu = (160 * 1024) / SMEM_BYTES;
        grid_blocks = cus * per_cu;
        if (ws_size < WS_END) fprintf(stderr, "kernel_launch: workspace too small: %zu < %zu\n", ws_size, (size_t)WS_END);
    }
    if (ws_size < WS_END) return;
    (void)hipMemsetAsync((unsigned char*)d_ws + WS_CTL, 0, 256 + WS_ZSPAN, stream);
    Params p{};
    for (int i = 0; i < 27; ++i) p.in[i] = (const float*)d_in[i];
    p.out = (float*)d_out; p.ws = (unsigned char*)d_ws;
    p.ph_lo = 0; p.ph_hi = 5;
    void* args[] = {&p};
    hipError_t e = hipLaunchCooperativeKernel((void*)fwd_kernel, dim3(grid_blocks), dim3(NT), args, 0, stream);
    if (e != hipSuccess) fprintf(stderr, "cooperative launch failed: %s (grid %d)\n", hipGetErrorString(e), grid_blocks);
}
```
